# Optimizing an MI355X kernel written in HIP

```python
import jax, jax.numpy as jnp
from jax import lax
import numpy as np

D_MODEL = 2048
BATCH = 4
SEQ = 4096
DEPTH = 4
DEC_BATCH = 32
DEC_SEQ = 32
PAST_LEN = 2048

CHUNK = 64
HEAD_DIM = 128
MEM_HEADS = 4
MEM_DIM = MEM_HEADS * HEAD_DIM
TOK_DIM = D_MODEL - MEM_DIM
TOK_HEADS = TOK_DIM // HEAD_DIM
N_MEM = 256
D_FF = 4 * D_MODEL
CONV_W = 4
N_A = DEPTH // 2
N_B = DEPTH - N_A
Q_BLOCK = 128
EPS = 1e-6
QKV_DIM = 3 * TOK_DIM
IN_A = QKV_DIM + TOK_DIM + 2 * TOK_HEADS + MEM_DIM
IN_B = 2 * TOK_DIM + MEM_DIM
KVF_DIM = 2 * TOK_DIM + TOK_HEADS
SCALE = HEAD_DIM ** -0.5
F32 = jnp.float32

kernel_name = "yoco_gdn_fox_stream_step"


def rmsnorm(x, g):
    xf = x.astype(F32)
    y = xf * lax.rsqrt(jnp.mean(xf * xf, axis=-1, keepdims=True) + EPS)
    return (y * g.astype(F32)).astype(x.dtype)


def l2norm(x):
    xf = x.astype(F32)
    return xf * lax.rsqrt(jnp.sum(xf * xf, axis=-1, keepdims=True) + EPS)


def causal_conv(x, hist, w):
    T = x.shape[1]
    xp = jnp.concatenate([hist.astype(x.dtype), x], axis=1)
    y = xp[:, 0:T] * w[0]
    for j in range(1, CONV_W):
        y = y + xp[:, j:j + T] * w[j]
    return y, xp[:, T:]


def gdn_chunk(S, inp):
    q, k, v, g, beta = inp
    L = q.shape[2]
    dv = v.shape[-1]
    idx = jnp.arange(L)
    incl = idx[:, None] >= idx[None, :]
    strict = idx[:, None] > idx[None, :]
    G = jnp.cumsum(g, axis=-1)
    decay = jnp.exp(jnp.where(incl, G[..., :, None] - G[..., None, :], -jnp.inf))
    A = jnp.where(strict, beta[..., :, None] * jnp.einsum('bhid,bhjd->bhij', k, k) * decay, 0.0)
    eye = jnp.eye(L, dtype=F32)
    rhs = jnp.concatenate([beta[..., None] * v, (beta * jnp.exp(G))[..., None] * k], axis=-1)
    sol = lax.linalg.triangular_solve(eye + A, rhs, left_side=True, lower=True, unit_diagonal=True)
    u, w = sol[..., :dv], sol[..., dv:]
    v_new = u - jnp.einsum('bhik,bhkv->bhiv', w, S)
    attn = jnp.einsum('bhid,bhjd->bhij', q, k) * decay
    out = (jnp.einsum('bhik,bhkv->bhiv', q * jnp.exp(G)[..., None], S)
           + jnp.einsum('bhij,bhjv->bhiv', attn, v_new))
    GL = G[..., -1:]
    S_new = (jnp.exp(GL)[..., None] * S
             + jnp.einsum('bhik,bhiv->bhkv', k * jnp.exp(GL - G)[..., None], v_new))
    return S_new, out


def gated_delta(q, k, v, g, beta, S0):
    B, T, H, D = q.shape
    L = min(T, CHUNK)
    N = T // L

    def blocks(a):
        a = a.reshape((B, N, L) + a.shape[2:])
        return a.transpose((1, 0, 3, 2) + tuple(range(4, a.ndim)))

    S_fin, outs = lax.scan(gdn_chunk, S0, (blocks(q), blocks(k), blocks(v), blocks(g), blocks(beta)))
    o = outs.transpose(1, 0, 3, 2, 4).reshape(B, T, H, D)
    return o, S_fin


def gdn_mixer(h, conv_hist, s0, w_in, conv_w, a_log, dt_bias, gdn_norm):
    B, T, _ = h.shape
    proj = h @ w_in
    o1 = QKV_DIM + TOK_DIM
    qkv = proj[..., :QKV_DIM]
    z = proj[..., QKV_DIM:o1]
    a = proj[..., o1:o1 + TOK_HEADS]
    b = proj[..., o1 + TOK_HEADS:o1 + 2 * TOK_HEADS]
    mq = proj[..., o1 + 2 * TOK_HEADS:]
    qkv, conv_state = causal_conv(qkv, conv_hist, conv_w)
    qkv = jax.nn.silu(qkv).reshape(B, T, 3, TOK_HEADS, HEAD_DIM)
    q = l2norm(qkv[:, :, 0]) * SCALE
    k = l2norm(qkv[:, :, 1])
    v = qkv[:, :, 2].astype(F32)
    g = -jnp.exp(a_log.astype(F32)) * jax.nn.softplus(a.astype(F32) + dt_bias.astype(F32))
    beta = jax.nn.sigmoid(b.astype(F32))
    o, s_new = gated_delta(q, k, v, g, beta, s0.astype(F32))
    o = rmsnorm(o, gdn_norm) * jax.nn.silu(z.reshape(B, T, TOK_HEADS, HEAD_DIM).astype(F32))
    return o.reshape(B, T, TOK_DIM).astype(h.dtype), conv_state, s_new, mq


def fox_block(q, cq, qpos, k, v, ckT, kpos):
    s = jnp.einsum('bqhd,bkhd->bhqk', q, k).astype(F32) * SCALE
    s = s + jnp.swapaxes(cq, 1, 2)[..., :, None] - ckT[..., None, :]
    s = jnp.where(kpos[None, :] <= qpos[:, None], s, -jnp.inf)
    p = jax.nn.softmax(s, axis=-1).astype(v.dtype)
    return jnp.einsum('bhqk,bkhd->bqhd', p, v)


def fox_attend(q, cq, qpos, k, v, ck, kpos):
    B, Tq, H, D = q.shape
    ckT = jnp.swapaxes(ck, 1, 2)
    if Tq <= Q_BLOCK:
        return fox_block(q, cq, qpos, k, v, ckT, kpos)
    nb = Tq // Q_BLOCK
    qb = jnp.swapaxes(q.reshape(B, nb, Q_BLOCK, H, D), 0, 1)
    cqb = jnp.swapaxes(cq.reshape(B, nb, Q_BLOCK, H), 0, 1)
    pb = qpos.reshape(nb, Q_BLOCK)
    out = lax.map(lambda a: fox_block(a[0], a[1], a[2], k, v, ckT, kpos), (qb, cqb, pb))
    return jnp.swapaxes(out, 0, 1).reshape(B, Tq, H, D)


def fox_mixer(h, w_in, k_all, v_all, c_all, qpos, kpos, P):
    B, T, _ = h.shape
    proj = h @ w_in
    q = proj[..., :TOK_DIM].reshape(B, T, TOK_HEADS, HEAD_DIM)
    gate = proj[..., TOK_DIM:2 * TOK_DIM]
    mq = proj[..., 2 * TOK_DIM:]
    o = fox_attend(q, c_all[:, P:], qpos, k_all, v_all, c_all, kpos)
    return o.reshape(B, T, TOK_DIM) * jax.nn.sigmoid(gate), mq


def shared_kv(x, norm_kv, w_kvf, b_f):
    B, T, _ = x.shape
    kvf = rmsnorm(x, norm_kv) @ w_kvf
    k = kvf[..., :TOK_DIM].reshape(B, T, TOK_HEADS, HEAD_DIM)
    v = kvf[..., TOK_DIM:2 * TOK_DIM].reshape(B, T, TOK_HEADS, HEAD_DIM)
    logf = jax.nn.log_sigmoid(kvf[..., 2 * TOK_DIM:].astype(F32) + b_f.astype(F32))
    return k, v, logf


def memory_kv(mem, norm_mem, w_mem_kv):
    hm = rmsnorm(mem[None], norm_mem[:, None, None, :])
    kv = jnp.einsum('lbnd,lde->lbne', hm, w_mem_kv)
    B, N = mem.shape[0], mem.shape[1]
    mk = kv[..., :MEM_DIM].reshape(DEPTH, B, N, MEM_HEADS, HEAD_DIM)
    mv = kv[..., MEM_DIM:].reshape(DEPTH, B, N, MEM_HEADS, HEAD_DIM)
    return mk, mv


def mem_attend(mq, mk, mv):
    B, T, _ = mq.shape
    q = mq.reshape(B, T, MEM_HEADS, HEAD_DIM)
    s = jnp.einsum('bthd,bnhd->bhtn', q, mk).astype(F32) * SCALE
    p = jax.nn.softmax(s, axis=-1).astype(mv.dtype)
    return jnp.einsum('bhtn,bnhd->bthd', p, mv).reshape(B, T, MEM_DIM)


def trunk(x, conv_hist, gdn_s0, past_k, past_v, past_logf, mem_k, mem_v, p):
    B, T, _ = x.shape
    P = past_k.shape[1]
    conv_out, gdn_out = [], []
    k_new = v_new = logf_new = None
    for l in range(DEPTH):
        if l == N_A:
            k_new, v_new, logf_new = shared_kv(x, p['norm_kv'], p['w_kvf'], p['b_f'])
            k_all = jnp.concatenate([past_k.astype(k_new.dtype), k_new], axis=1)
            v_all = jnp.concatenate([past_v.astype(v_new.dtype), v_new], axis=1)
            c_all = jnp.cumsum(jnp.concatenate([past_logf.astype(F32), logf_new], axis=1), axis=1)
            kpos = jnp.arange(P + T)
            qpos = P + jnp.arange(T)
        h = rmsnorm(x, p['norm_mix_pre'][l])
        if l < N_A:
            tok, cs, gs, mq = gdn_mixer(h, conv_hist[l], gdn_s0[l], p['w_in_a'][l], p['conv_w_a'][l],
                                        p['a_log'][l], p['dt_bias'][l], p['gdn_norm'][l])
            conv_out.append(cs)
            gdn_out.append(gs)
        else:
            tok, mq = fox_mixer(h, p['w_in_b'][l - N_A], k_all, v_all, c_all, qpos, kpos, P)
        mem_o = mem_attend(mq, mem_k[l], mem_v[l])
        mix = jnp.concatenate([tok, mem_o], axis=-1) @ p['w_o'][l]
        x = x + rmsnorm(mix, p['norm_mix_post'][l])
        hf = rmsnorm(x, p['norm_mlp_pre'][l])
        f = jnp.square(jax.nn.relu(hf @ p['w_up'][l])) @ p['w_down'][l]
        x = x + rmsnorm(f, p['norm_mlp_post'][l])
    return x, jnp.stack(conv_out), jnp.stack(gdn_out), k_new, v_new, logf_new


def setup_inputs(seed: int = 0) -> dict:
    key = jax.random.key(seed)
    ks = jax.random.split(key, 32)

    def nrm(k, shape, scale):
        return jax.random.normal(k, shape, F32) * scale

    def gain(k, shape):
        return 1.0 + 0.02 * jax.random.normal(k, shape, F32)

    dt = jnp.exp(jax.random.uniform(ks[7], (N_A, TOK_HEADS), F32, float(np.log(1e-3)), float(np.log(1e-1))))
    w_kvf = nrm(ks[12], (D_MODEL, KVF_DIM), D_MODEL ** -0.5)
    w_kvf = w_kvf.at[:, 2 * TOK_DIM:].multiply(0.3)
    logf_bias = jax.random.uniform(ks[20], (1, 1, TOK_HEADS), F32, 2.0, 6.0)
    return {
        "x_prompt": nrm(ks[0], (BATCH, SEQ, D_MODEL), 1.0),
        "x_sample": nrm(ks[1], (DEC_BATCH, DEC_SEQ, D_MODEL), 1.0),
        "state_gdn": nrm(ks[17], (N_A, DEC_BATCH, TOK_HEADS, HEAD_DIM, HEAD_DIM), 0.1),
        "state_conv": nrm(ks[18], (N_A, DEC_BATCH, CONV_W - 1, QKV_DIM), 1.0),
        "cache_k": nrm(ks[19], (DEC_BATCH, PAST_LEN, TOK_HEADS, HEAD_DIM), 1.0),
        "cache_v": nrm(ks[21], (DEC_BATCH, PAST_LEN, TOK_HEADS, HEAD_DIM), 1.0),
        "cache_logf": jax.nn.log_sigmoid(logf_bias + 0.3 * jax.random.normal(ks[22], (DEC_BATCH, PAST_LEN, TOK_HEADS), F32)),
        "cache_mem_k": nrm(ks[23], (DEPTH, DEC_BATCH, N_MEM, MEM_HEADS, HEAD_DIM), 1.0),
        "cache_mem_v": nrm(ks[24], (DEPTH, DEC_BATCH, N_MEM, MEM_HEADS, HEAD_DIM), 1.0),
        "mem_prompt": nrm(ks[2], (BATCH, N_MEM, D_MODEL), 1.0),
        "norm_mix_pre": gain(ks[3], (DEPTH, D_MODEL)),
        "norm_mix_post": gain(ks[4], (DEPTH, D_MODEL)),
        "norm_mlp_pre": gain(ks[5], (DEPTH, D_MODEL)),
        "norm_mlp_post": gain(ks[6], (DEPTH, D_MODEL)),
        "w_in_a": nrm(ks[8], (N_A, D_MODEL, IN_A), D_MODEL ** -0.5),
        "conv_w_a": nrm(ks[9], (N_A, CONV_W, QKV_DIM), CONV_W ** -0.5),
        "a_log": jnp.log(jax.random.uniform(ks[10], (N_A, TOK_HEADS), F32, 1.0, 16.0)),
        "dt_bias": dt + jnp.log(-jnp.expm1(-dt)),
        "gdn_norm": gain(ks[11], (N_A, HEAD_DIM)),
        "w_in_b": nrm(ks[13], (N_B, D_MODEL, IN_B), D_MODEL ** -0.5),
        "norm_kv": gain(ks[14], (D_MODEL,)),
        "w_kvf": w_kvf,
        "b_f": jax.random.uniform(ks[15], (TOK_HEADS,), F32, 2.0, 6.0),
        "norm_mem": gain(ks[16], (DEPTH, D_MODEL)),
        "w_mem_kv": nrm(ks[25], (DEPTH, D_MODEL, 2 * MEM_DIM), D_MODEL ** -0.5),
        "w_o": nrm(ks[26], (DEPTH, D_MODEL, D_MODEL), D_MODEL ** -0.5),
        "w_up": nrm(ks[27], (DEPTH, D_MODEL, D_FF), D_MODEL ** -0.5),
        "w_down": nrm(ks[28], (DEPTH, D_FF, D_MODEL), D_FF ** -0.5),
    }


def reference(x_prompt, x_sample, state_gdn, state_conv, cache_k, cache_v, cache_logf, cache_mem_k, cache_mem_v,
              mem_prompt, norm_mix_pre, norm_mix_post, norm_mlp_pre, norm_mlp_post, w_in_a, conv_w_a, a_log,
              dt_bias, gdn_norm, w_in_b, norm_kv, w_kvf, b_f, norm_mem, w_mem_kv, w_o, w_up, w_down):
    params = dict(norm_mix_pre=norm_mix_pre, norm_mix_post=norm_mix_post, norm_mlp_pre=norm_mlp_pre,
                  norm_mlp_post=norm_mlp_post, w_in_a=w_in_a, conv_w_a=conv_w_a, a_log=a_log, dt_bias=dt_bias,
                  gdn_norm=gdn_norm, w_in_b=w_in_b, norm_kv=norm_kv, w_kvf=w_kvf, b_f=b_f, w_o=w_o,
                  w_up=w_up, w_down=w_down)
    Bp = x_prompt.shape[0]
    dtp = x_prompt.dtype
    p_mem_k, p_mem_v = memory_kv(mem_prompt, norm_mem, w_mem_kv)
    zero_conv = jnp.zeros((N_A, Bp, CONV_W - 1, QKV_DIM), dtp)
    zero_gdn = jnp.zeros((N_A, Bp, TOK_HEADS, HEAD_DIM, HEAD_DIM), F32)
    empty_kv = jnp.zeros((Bp, 0, TOK_HEADS, HEAD_DIM), dtp)
    empty_logf = jnp.zeros((Bp, 0, TOK_HEADS), F32)
    y_prompt, p_conv, p_gdn, p_k, p_v, p_logf = trunk(
        x_prompt, zero_conv, zero_gdn, empty_kv, empty_kv, empty_logf, p_mem_k, p_mem_v, params)
    y_sample, s_conv, s_gdn, s_k, s_v, s_logf = trunk(
        x_sample, state_conv, state_gdn, cache_k, cache_v, cache_logf, cache_mem_k, cache_mem_v, params)
    return (y_prompt, y_sample, p_gdn, p_conv, p_k, p_v, p_logf, p_mem_k, p_mem_v,
            s_gdn, s_conv, s_k, s_v, s_logf)
```

```cpp
#include <hip/hip_runtime.h>
#include <cstdio>
#include <cstdint>
namespace pg8 {
#define PG8_LAS __attribute__((address_space(3)))
typedef unsigned short bf16_t;
typedef short bf16x8 __attribute__((ext_vector_type(8)));
typedef float f32x4 __attribute__((ext_vector_type(4)));
typedef unsigned u32x4 __attribute__((ext_vector_type(4)));
constexpr int BM = 256, BK = 64, HALF = 128, HTB = HALF * BK * 2  , STAGE_BYTES = 8 * HTB, NXCD = 8, WGM = 8;

__host__ __device__ __forceinline__ int lds_byte(int r, int c) { const int st = (r >> 4) * 2 + (c >> 5), rr = r & 15, cc = c & 31, ob = rr * 64 + cc * 2; return st * 1024 + (ob ^ (((ob >> 9) & 1) << 5)); }
__host__ __device__ __forceinline__ void stage_rc(int b, int& R, int& C) { const int st = b / 1024, sb = b % 1024, swz = sb ^ (((sb >> 9) & 1) << 5); R = (st >> 1) * 16 + swz / 64; C = (st & 1) * 32 + (swz % 64) / 2; }
__host__ __device__ __forceinline__ int perm32(int rho) { const int n = rho >> 4, i = rho & 15; return 8 * (i >> 2) + 4 * n + (i & 3); }

struct Unit { int pm, pn; };
struct Gemm { const bf16_t* A; const bf16_t* Bt; int M, N, K; };

struct StaticOrder {
    int nM, nN, nwg, G, c;
    __host__ __device__ void init(int M, int N, int G_, int c_) { nM = M / BM; nN = N / BM; nwg = nM * nN; G = G_; c = c_; }
    __host__ __device__ bool next(int i, Unit& u) const {
        const long L = (long)i * G + c; if (L >= nwg) return false;
        int wgid = (int)L; { const int q = nwg / NXCD, r = nwg % NXCD, xcd = wgid % NXCD, off = wgid / NXCD; wgid = (xcd < r ? xcd * (q + 1) : r * (q + 1) + (xcd - r) * q) + off; }
        const int nig = WGM * nN, gid = wgid / nig, fm = gid * WGM, gsz = (nM - fm) < WGM ? (nM - fm) : WGM;
        u.pm = fm + ((wgid % nig) % gsz); u.pn = (wgid % nig) / gsz; return true;
    }
    __device__ __forceinline__ void a_ready(const Unit&) const {}
    __device__ __forceinline__ void done(const Unit&) const {}
};

__device__ __forceinline__ unsigned cvt_pk_bf16(float lo, float hi) { unsigned r; asm volatile("v_cvt_pk_bf16_f32 %0, %1, %2" : "=v"(r) : "v"(lo), "v"(hi)); return r; }
}
#define LAS __attribute__((address_space(3)))
typedef unsigned short bf16_t;
typedef float f32x4 __attribute__((ext_vector_type(4)));
typedef unsigned u32x4 __attribute__((ext_vector_type(4)));
typedef unsigned u32x2 __attribute__((ext_vector_type(2)));
constexpr int D = 2048, MP = 16384, MS = 1024, M = MP + MS;
constexpr int H = 12, HD = 128, TOK = 1536, QKV = 4608, MEMD = 512, MH = 4, NMEM = 256, DFF = 8192, PAST = 2048;
constexpr int INA_W = 6680, INB_W = 3584, KVF_W = 3084;
constexpr int PJ = 6656;
constexpr float EPS = 1e-6f, SCALE = 0.08838834764831845f;
constexpr size_t O_YP = 0, O_YS = O_YP + (size_t)MP * D, O_PGDN = O_YS + (size_t)MS * D, O_PCONV = O_PGDN + (size_t)2 * 4 * 12 * 16384, O_PK = O_PCONV + (size_t)2 * 4 * 3 * 4608,
    O_PV = O_PK + (size_t)MP * TOK, O_PLOGF = O_PV + (size_t)MP * TOK, O_PMK = O_PLOGF + (size_t)MP * 12, O_PMV = O_PMK + (size_t)4 * 4 * 256 * 512, O_SGDN = O_PMV + (size_t)4 * 4 * 256 * 512,
    O_SCONV = O_SGDN + (size_t)2 * 32 * 12 * 16384, O_SK = O_SCONV + (size_t)2 * 32 * 3 * 4608, O_SV = O_SK + (size_t)MS * TOK, O_SLOGF = O_SV + (size_t)MS * TOK, O_END = O_SLOGF + (size_t)MS * 12;
static_assert(O_END == 108683264, "output size");
constexpr size_t MiB = 1u << 20;
constexpr size_t WS_CTL = 0, WS_WINA = 1 * MiB, WS_WINB0 = 53 * MiB, WS_WINB1 = 79 * MiB, WS_WO = 93 * MiB, WS_WUP = 125 * MiB, WS_WDN = 253 * MiB, WS_WMEM = 381 * MiB, WS_WSK = 397 * MiB,
    WS_X = 398 * MiB, WS_XN = 534 * MiB, WS_PROJ = 602 * MiB, WS_ACT = 823 * MiB, WS_DELTA = 891 * MiB, WS_KB = 1027 * MiB, WS_VB = 1078 * MiB, WS_G = 1129 * MiB, WS_BETA = 1130 * MiB,
    WS_LOGF = 1131 * MiB, WS_CUMP = 1132 * MiB, WS_CUMS = 1133 * MiB, WS_MEMN = 1137 * MiB, WS_BIG = 1141 * MiB, WS_QF = WS_BIG, WS_KF = WS_BIG + 102 * MiB, WS_VF = WS_BIG + 204 * MiB,
    WS_OF = WS_BIG + 306 * MiB, WS_UP = WS_BIG, WS_END = WS_BIG + 408 * MiB;
static_assert((size_t)6656 * 2048 * 2 == 26 * MiB && (size_t)M * D * 4 == 136 * MiB && (size_t)M * PJ * 2 == 221 * MiB && (size_t)M * TOK * 2 == 51 * MiB && (size_t)M * TOK * 4 == 102 * MiB && (size_t)M * DFF * 2 == 272 * MiB, "sizes");

struct Ctx { const float* in[28]; float* out; unsigned char* ws; int ph_lo, ph_hi; };
enum { I_XP = 0, I_XS, I_SGDN, I_SCONV, I_CK, I_CV, I_CLOGF, I_CMK, I_CMV, I_MEMP, I_NMIXPRE, I_NMIXPOST, I_NMLPPRE, I_NMLPPOST, I_WINA, I_CONVW, I_ALOG, I_DTB, I_GDNN, I_WINB, I_NKV, I_WKVF, I_BF, I_NMEM, I_WMEMKV, I_WO, I_WUP, I_WDN };

__device__ __forceinline__ float bf2f(bf16_t b) { return __uint_as_float(((unsigned)b) << 16); }
__device__ __forceinline__ float bflo(unsigned u) { return __uint_as_float(u << 16); }
__device__ __forceinline__ float bfhi(unsigned u) { return __uint_as_float(u & 0xffff0000u); }
__device__ __forceinline__ unsigned pk2(float lo, float hi) { return pg8::cvt_pk_bf16(lo, hi); }
__device__ __forceinline__ float wave_sum(float v) {
#pragma unroll
    for (int o = 1; o < 64; o <<= 1) v += __shfl_xor(v, o);
    return v; }
__device__ __forceinline__ float wave_max(float v) {
#pragma unroll
    for (int o = 1; o < 64; o <<= 1) v = fmaxf(v, __shfl_xor(v, o));
    return v; }
__device__ __forceinline__ float sigmoidf_(float x) { return 1.f / (1.f + expf(-x)); }
__device__ __forceinline__ float softplusf_(float x) { return fmaxf(x, 0.f) + log1pf(expf(-fabsf(x))); }
struct RowInfo { int grp, b, t, T, nb; };
__device__ __forceinline__ RowInfo rowinfo(int m) { RowInfo r; if (m < MP) { r.grp = 0; r.b = m >> 12; r.t = m & 4095; r.T = 4096; r.nb = 4; } else { const int ms = m - MP; r.grp = 1; r.b = ms >> 5; r.t = ms & 31; r.T = 32; r.nb = 32; } return r; }
namespace pg8 {
struct Epi {
    static constexpr bool PERM = true, AFTER_DRAIN = false;
    int mode;
    bf16_t* o16; int ld16; float* o32; int ld32;
    unsigned char* ws; float* out;
    __device__ __forceinline__ void operator()(const f32x4 (&acc)[2][2][4][2], const Unit& u, int wr, int wc, int fr, int fq) const {
        const int row0 = u.pm * BM + wr * 64 + fr, colt = u.pn * BM, cl = wc * 32 + 8 * fq;
        bf16_t* d16 = nullptr; size_t l16 = 0; float* d32 = nullptr; size_t l32 = 0; int radj = 0; const bool sq = (mode == 1);
        if (mode == 0 || mode == 1) { d16 = o16 + colt; l16 = (size_t)ld16; }
        else if (mode == 2) { d32 = o32 + colt; l32 = (size_t)ld32; }
        else if (mode == 3) {
            if (colt < 3584) { d16 = o16 + colt; l16 = (size_t)ld16; }
            else { const bool isv = colt >= 5120; const int cc = colt - (isv ? 5120 : 3584); const bool smp = u.pm >= 64;
                d16 = (bf16_t*)(ws + (isv ? WS_VB : WS_KB)) + cc; l16 = 1536; d32 = out + (smp ? (isv ? O_SV : O_SK) : (isv ? O_PV : O_PK)) + cc; l32 = 1536; radj = smp ? 16384 : 0; }
        } else { const int l = colt >> 10, within = colt & 1023; d32 = out + ((within >= 512) ? O_PMV : O_PMK) + (size_t)l * 1024 * 512 + (within & 511); l32 = 512; }
#pragma unroll
        for (int ai = 0; ai < 2; ++ai)
#pragma unroll
            for (int m = 0; m < 4; ++m) { const int row = row0 + ai * HALF + m * 16;
#pragma unroll
                for (int bj = 0; bj < 2; ++bj) { f32x4 v0 = acc[ai][bj][m][0], v1 = acc[ai][bj][m][1]; const int col = cl + bj * HALF;
                    if (sq) {
#pragma unroll
                        for (int j = 0; j < 4; ++j) { const float a = v0[j] > 0.f ? v0[j] : 0.f, b = v1[j] > 0.f ? v1[j] : 0.f; v0[j] = a * a; v1[j] = b * b; } }
                    if (d16) { u32x4 w; w.x = cvt_pk_bf16(v0[0], v0[1]); w.y = cvt_pk_bf16(v0[2], v0[3]); w.z = cvt_pk_bf16(v1[0], v1[1]); w.w = cvt_pk_bf16(v1[2], v1[3]);
                        *(u32x4*)(d16 + (size_t)row * l16 + col) = w; }
                    if (d32) { float* p = d32 + (size_t)(row - radj) * l32 + col; *(f32x4*)p = v0; *(f32x4*)(p + 4) = v1; } } }
    }
};
}
namespace pg8 {
template <class Epi, class Sched, bool ALIGN_EPI = false, bool SP2 = false>
__device__ __forceinline__ void gemm_phase(PG8_LAS unsigned char* lds, const Gemm g, const Sched& S, const Epi& E) {
    const int tid = threadIdx.x, wid = __builtin_amdgcn_readfirstlane(tid >> 6), lane = tid & 63, wr = wid >> 2, wc = wid & 3, fr = lane & 15, fq = lane >> 4;
    const int K = g.K, nt = K / BK;
    unsigned voffA[2], voffB[2];
#pragma unroll
    for (int i = 0; i < 2; ++i) { int R, C; stage_rc(tid * 16 + i * 8192, R, C); const int Rb = Epi::PERM ? ((R & ~31) + perm32(R & 31)) : R;
        voffA[i] = (unsigned)(R * K + C) * 2u; voffB[i] = (unsigned)(Rb * K + C) * 2u; }
    const size_t kstep = (size_t)(BK * 2);
    const size_t hstep = (size_t)HALF * K * 2;
    const size_t tstep = 2 * hstep;
    const unsigned ldsw = (unsigned)wid * 1024u;
    const int aoff = lds_byte(wr * 64 + fr, fq * 8), boff = lds_byte(wc * 32 + fr, fq * 8);
#define PG8_SA(b, h) (((b) * 2 + (h)) * HTB)
#define PG8_SB(b, h) ((4 + (b) * 2 + (h)) * HTB)
#define PG8_STAGE(bufoff, gbase, voff) do { _Pragma("unroll") for (int _i = 0; _i < 2; ++_i) \
        __builtin_amdgcn_global_load_lds((const unsigned*)((const char*)(gbase) + (voff)[_i]), (PG8_LAS unsigned*)(lds + (bufoff) + ldsw + _i * 8192), 16, 0, 0); } while (0)
#define PG8_LDA(dst, b, h) do { _Pragma("unroll") for (int m = 0; m < 4; ++m) _Pragma("unroll") for (int k = 0; k < 2; ++k) dst[m][k] = *(const PG8_LAS bf16x8*)(lds + PG8_SA(b, h) + aoff + m * 2048 + k * 1024); } while (0)
#define PG8_LDB(dst, b, h) do { _Pragma("unroll") for (int n = 0; n < 2; ++n) _Pragma("unroll") for (int k = 0; k < 2; ++k) dst[n][k] = *(const PG8_LAS bf16x8*)(lds + PG8_SB(b, h) + boff + n * 2048 + k * 1024); } while (0)
#define PG8_MMA(ai, bj, At, Bt) do { __builtin_amdgcn_s_setprio(1); _Pragma("unroll") for (int m = 0; m < 4; ++m) _Pragma("unroll") for (int n = 0; n < 2; ++n) _Pragma("unroll") for (int k = 0; k < 2; ++k) \
        acc[ai][bj][m][n] = __builtin_amdgcn_mfma_f32_16x16x32_bf16(Bt[n][k], At[m][k], acc[ai][bj][m][n], 0, 0, 0); __builtin_amdgcn_s_setprio(0); } while (0)
#define PG8_WAIT_V(n) asm volatile("s_waitcnt vmcnt(" #n ")" ::: "memory")
#define PG8_WAIT_L(n) asm volatile("s_waitcnt lgkmcnt(" #n ")" ::: "memory")
#define PG8_BAR __builtin_amdgcn_s_barrier()
#define PG8_SCHED __builtin_amdgcn_sched_barrier(0)
    Unit cur, nxt; int ui = 0;
    if (!S.next(0, cur)) return;
    f32x4 acc[2][2][4][2];
#pragma unroll
    for (int a = 0; a < 2; ++a)
#pragma unroll
        for (int b = 0; b < 2; ++b)
#pragma unroll
            for (int m = 0; m < 4; ++m)
#pragma unroll
                for (int n = 0; n < 2; ++n) acc[a][b][m][n] = (f32x4){0.f, 0.f, 0.f, 0.f};
    bf16x8 At[4][2], B0[2][2], B1[2][2];
    const char* cA = (const char*)g.A + (size_t)cur.pm * tstep; const char* cB = (const char*)g.Bt + (size_t)cur.pn * tstep;
    S.a_ready(cur);
    if constexpr (SP2) {
        PG8_STAGE(PG8_SB(0, 0), cB, voffB); PG8_STAGE(PG8_SB(0, 1), cB + hstep, voffB); PG8_STAGE(PG8_SA(0, 0), cA, voffA); PG8_STAGE(PG8_SA(0, 1), cA + hstep, voffA);
        if (wr == 1) PG8_BAR;
        PG8_WAIT_V(2); PG8_BAR;
        PG8_STAGE(PG8_SB(1, 0), cB + kstep, voffB); PG8_STAGE(PG8_SA(1, 0), cA + kstep, voffA); PG8_STAGE(PG8_SB(1, 1), cB + hstep + kstep, voffB);
        PG8_WAIT_V(6); PG8_BAR;
    } else {
        PG8_STAGE(PG8_SB(0, 0), cB, voffB); PG8_STAGE(PG8_SA(0, 0), cA, voffA); PG8_STAGE(PG8_SB(0, 1), cB + hstep, voffB); PG8_STAGE(PG8_SA(0, 1), cA + hstep, voffA);
        if (wr == 1) PG8_BAR;
        PG8_WAIT_V(4); PG8_BAR;
        PG8_STAGE(PG8_SB(1, 0), cB + kstep, voffB); PG8_STAGE(PG8_SA(1, 0), cA + kstep, voffA); PG8_STAGE(PG8_SB(1, 1), cB + hstep + kstep, voffB);
        PG8_WAIT_V(6); PG8_BAR;
    }
    for (;;) {
        const bool has_next = S.next(ui + 1, nxt);
        const char* nA = has_next ? (const char*)g.A + (size_t)nxt.pm * tstep : cA; const char* nB = has_next ? (const char*)g.Bt + (size_t)nxt.pn * tstep : cB;
        for (int t = 0; t < nt; t += 2) {
            const bool last = (t == nt - 2);
            const char* a1 = cA + (size_t)(t + 1) * kstep;
            const char* a2 = last ? nA : cA + (size_t)(t + 2) * kstep; const char* b2 = last ? nB : cB + (size_t)(t + 2) * kstep;
            const char* a3 = a2 + kstep; const char* b3 = b2 + kstep;
            if (last && has_next) S.a_ready(nxt);
            if constexpr (SP2) {
            PG8_LDB(B0, 0, 0); PG8_LDB(B1, 0, 1); PG8_SCHED; PG8_LDA(At, 0, 0); PG8_STAGE(PG8_SA(1, 1), a1 + hstep, voffA);
            PG8_WAIT_V(8); PG8_WAIT_L(0); PG8_BAR; PG8_MMA(0, 0, At, B0); PG8_MMA(0, 1, At, B1); PG8_BAR; PG8_SCHED;
            PG8_LDA(At, 0, 1); PG8_STAGE(PG8_SB(0, 0), b2, voffB); PG8_STAGE(PG8_SB(0, 1), b2 + hstep, voffB); PG8_STAGE(PG8_SA(0, 0), a2, voffA);
            PG8_WAIT_V(8); PG8_WAIT_L(0); PG8_BAR; PG8_MMA(1, 0, At, B0); PG8_MMA(1, 1, At, B1); PG8_BAR; PG8_SCHED;
            PG8_LDB(B0, 1, 0); PG8_LDB(B1, 1, 1); PG8_SCHED; PG8_LDA(At, 1, 0); PG8_STAGE(PG8_SA(0, 1), a2 + hstep, voffA);
            PG8_WAIT_V(8); PG8_WAIT_L(0); PG8_BAR; PG8_MMA(0, 0, At, B0); PG8_MMA(0, 1, At, B1); PG8_BAR; PG8_SCHED;
            PG8_LDA(At, 1, 1); PG8_STAGE(PG8_SB(1, 0), b3, voffB); PG8_STAGE(PG8_SB(1, 1), b3 + hstep, voffB); PG8_STAGE(PG8_SA(1, 0), a3, voffA);
            PG8_WAIT_V(8); PG8_WAIT_L(0); PG8_BAR; PG8_MMA(1, 0, At, B0); PG8_MMA(1, 1, At, B1); PG8_BAR; PG8_SCHED;
            } else {
            PG8_LDB(B0, 0, 0); PG8_SCHED; PG8_LDA(At, 0, 0); PG8_STAGE(PG8_SA(1, 1), a1 + hstep, voffA);
            PG8_WAIT_L(8); PG8_BAR; PG8_WAIT_L(0); PG8_MMA(0, 0, At, B0); PG8_BAR; PG8_SCHED;
            PG8_LDB(B1, 0, 1); PG8_STAGE(PG8_SB(0, 0), b2, voffB);
            PG8_BAR; PG8_WAIT_L(0); PG8_MMA(0, 1, At, B1); PG8_BAR;
            PG8_LDA(At, 0, 1); PG8_STAGE(PG8_SA(0, 0), a2, voffA);
            PG8_BAR; PG8_WAIT_L(0); PG8_MMA(1, 0, At, B0); PG8_BAR; PG8_SCHED;
            PG8_STAGE(PG8_SB(0, 1), b2 + hstep, voffB);
            PG8_WAIT_V(6); PG8_BAR; PG8_MMA(1, 1, At, B1); PG8_BAR;
            PG8_LDB(B0, 1, 0); PG8_SCHED; PG8_LDA(At, 1, 0); PG8_STAGE(PG8_SA(0, 1), a2 + hstep, voffA);
            PG8_WAIT_L(8); PG8_BAR; PG8_WAIT_L(0); PG8_MMA(0, 0, At, B0); PG8_BAR; PG8_SCHED;
            PG8_LDB(B1, 1, 1); PG8_STAGE(PG8_SB(1, 0), b3, voffB);
            PG8_BAR; PG8_WAIT_L(0); PG8_MMA(0, 1, At, B1); PG8_BAR;
            PG8_LDA(At, 1, 1); PG8_STAGE(PG8_SA(1, 0), a3, voffA);
            PG8_BAR; PG8_WAIT_L(0); PG8_MMA(1, 0, At, B0); PG8_BAR; PG8_SCHED;
            PG8_STAGE(PG8_SB(1, 1), b3 + hstep, voffB);
            PG8_WAIT_V(6); PG8_BAR; PG8_MMA(1, 1, At, B1); PG8_BAR;
            }
        }
        if constexpr (ALIGN_EPI) { if (wr == 0) PG8_BAR; }
        if constexpr (!Epi::AFTER_DRAIN) { E(acc, cur, wr, wc, fr, fq); S.done(cur); }
        if (!has_next) break;
#pragma unroll
        for (int a = 0; a < 2; ++a)
#pragma unroll
            for (int b = 0; b < 2; ++b)
#pragma unroll
                for (int m = 0; m < 4; ++m)
#pragma unroll
                    for (int n = 0; n < 2; ++n) acc[a][b][m][n] = (f32x4){0.f, 0.f, 0.f, 0.f};
        cur = nxt; cA = nA; cB = nB; ++ui;
        if constexpr (ALIGN_EPI) { if (wr == 1) PG8_BAR; }
    }
    PG8_WAIT_V(0);
    if constexpr (!ALIGN_EPI) { if (wr == 0) PG8_BAR; }
    PG8_BAR;
    if constexpr (Epi::AFTER_DRAIN) { E.fused(acc, cur, wr, wc, fr, fq, lds, wid, lane); S.done(cur); }
#undef PG8_SA
#undef PG8_SB
#undef PG8_STAGE
#undef PG8_LDA
#undef PG8_LDB
#undef PG8_MMA
#undef PG8_WAIT_V
#undef PG8_WAIT_L
#undef PG8_BAR
#undef PG8_SCHED
}
}
#define WS_PTR(T, off) ((T*)(c.ws + (off)))
struct TJob { const float* W; int ldw, K; const float* gain; bf16_t* WT; int src0, dst0, ncols; };
__device__ __forceinline__ TJob get_job(const Ctx& c, int j) {
    TJob J; J.gain = nullptr; J.src0 = 0; J.dst0 = 0; J.K = D;
    if (j < 4) { const int l = j >> 1, p = j & 1; J.W = c.in[I_WINA] + (size_t)l * D * INA_W; J.ldw = INA_W; J.gain = c.in[I_NMIXPRE] + l * D; J.WT = WS_PTR(bf16_t, WS_WINA) + (size_t)l * 6656 * D;
        if (p == 0) { J.ncols = 6144; } else { J.src0 = 6168; J.dst0 = 6144; J.ncols = 512; } }
    else if (j == 4) { J.W = c.in[I_WINB]; J.ldw = INB_W; J.gain = c.in[I_NMIXPRE] + 2 * D; J.WT = WS_PTR(bf16_t, WS_WINB0); J.ncols = 3584; }
    else if (j == 5) { J.W = c.in[I_WKVF]; J.ldw = KVF_W; J.gain = c.in[I_NKV]; J.WT = WS_PTR(bf16_t, WS_WINB0); J.dst0 = 3584; J.ncols = 3072; }
    else if (j == 6) { J.W = c.in[I_WINB] + (size_t)D * INB_W; J.ldw = INB_W; J.gain = c.in[I_NMIXPRE] + 3 * D; J.WT = WS_PTR(bf16_t, WS_WINB1); J.ncols = 3584; }
    else if (j < 11) { const int l = j - 7; J.W = c.in[I_WO] + (size_t)l * D * D; J.ldw = D; J.WT = WS_PTR(bf16_t, WS_WO) + (size_t)l * D * D; J.ncols = D; }
    else if (j < 15) { const int l = j - 11; J.W = c.in[I_WUP] + (size_t)l * D * DFF; J.ldw = DFF; J.gain = c.in[I_NMLPPRE] + l * D; J.WT = WS_PTR(bf16_t, WS_WUP) + (size_t)l * DFF * D; J.ncols = DFF; }
    else if (j < 19) { const int l = j - 15; J.W = c.in[I_WDN] + (size_t)l * DFF * D; J.ldw = D; J.K = DFF; J.WT = WS_PTR(bf16_t, WS_WDN) + (size_t)l * D * DFF; J.ncols = D; }
    else { const int l = j - 19; J.W = c.in[I_WMEMKV] + (size_t)l * D * 1024; J.ldw = 1024; J.gain = c.in[I_NMEM] + l * D; J.WT = WS_PTR(bf16_t, WS_WMEM); J.dst0 = l * 1024; J.ncols = 1024; }
    return J;
}
constexpr int NJOBS = 23;
__device__ __forceinline__ int job_items(const TJob& J) { return (J.K / 64) * (J.ncols / 32); }
__device__ __forceinline__ void transpose_item(const TJob& J, int item, LAS float* scr, int lane) {
    const int nblk = J.ncols / 32, kb = item / nblk, nb = item % nblk, k0 = 64 * kb, n0 = 32 * nb;
#pragma unroll 8
    for (int i = 0; i < 32; ++i) { const int kk = 2 * i + (lane >> 5); float w = J.W[(size_t)(k0 + kk) * J.ldw + J.src0 + n0 + (lane & 31)]; if (J.gain) w *= J.gain[k0 + kk]; scr[kk * 33 + (lane & 31)] = w; }
    asm volatile("s_waitcnt lgkmcnt(0)" ::: "memory");
    const int cc = lane & 7;
#pragma unroll
    for (int j = 0; j < 4; ++j) { const int n = (lane >> 3) + 8 * j; const LAS float* s = scr + (8 * cc) * 33 + n;
        u32x4 o; o.x = pk2(s[0 * 33], s[1 * 33]); o.y = pk2(s[2 * 33], s[3 * 33]); o.z = pk2(s[4 * 33], s[5 * 33]); o.w = pk2(s[6 * 33], s[7 * 33]);
        *(u32x4*)(J.WT + (size_t)(J.dst0 + n0 + n) * J.K + k0 + 8 * cc) = o; }
    asm volatile("s_waitcnt lgkmcnt(0)" ::: "memory");
}
__device__ __forceinline__ void ph_prep(const Ctx& c, LAS unsigned char* lds) {
    const int tid = threadIdx.x, lane = tid & 63, wave = tid >> 6, gw = blockIdx.x * 8 + wave, NGW = gridDim.x * 8;
    LAS float* scr = (LAS float*)(lds + wave * 16384);
    int base = 0;
    for (int j = 0; j < NJOBS; ++j) { const TJob J = get_job(c, j); const int n = job_items(J);
        int first = gw - (base % NGW); if (first < 0) first += NGW;
        for (int it = first; it < n; it += NGW) transpose_item(J, it, scr, lane);
        base += n; }
    float* wsk = WS_PTR(float, WS_WSK);
    for (int i = blockIdx.x * 512 + tid; i < 60 * D; i += gridDim.x * 512) { const int r = i / D, k = i % D; float v;
        if (r < 48) { const int l = r / 24, cc = r % 24; v = c.in[I_WINA][(size_t)l * D * INA_W + (size_t)k * INA_W + 6144 + cc] * c.in[I_NMIXPRE][l * D + k]; }
        else { const int cc = r - 48; v = c.in[I_WKVF][(size_t)k * KVF_W + 3072 + cc] * c.in[I_NKV][k]; }
        wsk[i] = v; }
}
__device__ __forceinline__ void ph_row(const Ctx& c, int src, const float* delta, const float* gpost, int write_y, int skmode  , int skl) {
    const int tid = threadIdx.x, lane = tid & 63, wave = tid >> 6, gw = blockIdx.x * 8 + wave, NGW = gridDim.x * 8;
    float* X = WS_PTR(float, WS_X); bf16_t* XN = WS_PTR(bf16_t, WS_XN);
    const int nrows = (src == 2) ? 1024 : M;
    for (int m = gw; m < nrows; m += NGW) {
        const float* xr = (src == 0) ? X + (size_t)m * D : (src == 1) ? (m < MP ? c.in[I_XP] + (size_t)m * D : c.in[I_XS] + (size_t)(m - MP) * D) : c.in[I_MEMP] + (size_t)m * D;
        f32x4 v[8];
#pragma unroll
        for (int j = 0; j < 8; ++j) v[j] = *(const f32x4*)(xr + 4 * lane + 256 * j);
        if (delta) { f32x4 d[8]; float ss = 0.f;
#pragma unroll
            for (int j = 0; j < 8; ++j) { d[j] = *(const f32x4*)(delta + (size_t)m * D + 4 * lane + 256 * j); ss += (d[j].x * d[j].x + d[j].y * d[j].y) + (d[j].z * d[j].z + d[j].w * d[j].w); }
            const float r = rsqrtf(wave_sum(ss) * (1.f / D) + EPS);
#pragma unroll
            for (int j = 0; j < 8; ++j) { const f32x4 g = *(const f32x4*)(gpost + 4 * lane + 256 * j); v[j] = v[j] + d[j] * r * g; } }
        if (src != 2) {
#pragma unroll
            for (int j = 0; j < 8; ++j) *(f32x4*)(X + (size_t)m * D + 4 * lane + 256 * j) = v[j]; }
        if (write_y) {
#pragma unroll
            for (int j = 0; j < 8; ++j) *(f32x4*)(c.out + O_YP + (size_t)m * D + 4 * lane + 256 * j) = v[j];
            continue; }
        float ss2 = 0.f;
#pragma unroll
        for (int j = 0; j < 8; ++j) ss2 += (v[j].x * v[j].x + v[j].y * v[j].y) + (v[j].z * v[j].z + v[j].w * v[j].w);
        const float r2 = rsqrtf(wave_sum(ss2) * (1.f / D) + EPS);
#pragma unroll
        for (int j = 0; j < 8; ++j) v[j] = v[j] * r2;
        bf16_t* xn = (src == 2) ? WS_PTR(bf16_t, WS_MEMN) + (size_t)m * D : XN + (size_t)m * D;
#pragma unroll
        for (int j = 0; j < 8; ++j) { u32x2 w; w.x = pk2(v[j].x, v[j].y); w.y = pk2(v[j].z, v[j].w); *(u32x2*)(xn + 4 * lane + 256 * j) = w; }
        if (skmode) {
            const int ns = (skmode == 1) ? 24 : 12; const float* wsk = WS_PTR(float, WS_WSK) + (size_t)((skmode == 1) ? skl * 24 : 48) * D;
            float mine_a = 0.f, mine_b = 0.f;
            for (int cc = 0; cc < ns; ++cc) { float p = 0.f;
#pragma unroll
                for (int j = 0; j < 8; ++j) { const f32x4 w = *(const f32x4*)(wsk + (size_t)cc * D + 4 * lane + 256 * j); p += (v[j].x * w.x + v[j].y * w.y) + (v[j].z * w.z + v[j].w * w.w); }
                p = wave_sum(p);
                if (lane == cc) mine_a = p; if (lane + 12 == cc) mine_b = p; }
            if (lane < 12) {
                if (skmode == 1) { const float g = -expf(c.in[I_ALOG][skl * 12 + lane]) * softplusf_(mine_a + c.in[I_DTB][skl * 12 + lane]);
                    WS_PTR(float, WS_G)[(size_t)m * 12 + lane] = g; WS_PTR(float, WS_BETA)[(size_t)m * 12 + lane] = sigmoidf_(mine_b); }
                else { const float lf = -softplusf_(-(mine_a + c.in[I_BF][lane])); WS_PTR(float, WS_LOGF)[(size_t)m * 12 + lane] = lf;
                    c.out[(m < MP ? O_PLOGF + (size_t)m * 12 : O_SLOGF + (size_t)(m - MP) * 12) + lane] = lf; } }
        }
    }
}
__device__ __forceinline__ void ph_gdn_a(const Ctx& c, int l) {
    const int tid = threadIdx.x, lane = tid & 63, wave = tid >> 6, gw = blockIdx.x * 8 + wave, NGW = gridDim.x * 8;
    const bf16_t* PROJ = WS_PTR(bf16_t, WS_PROJ); const float* cw = c.in[I_CONVW] + (size_t)l * 4 * QKV;
    for (int it = gw; it < M * H; it += NGW) { const int m = it / H, h = it % H; const RowInfo ri = rowinfo(m);
        float y[3][2];
#pragma unroll
        for (int part = 0; part < 3; ++part) { const int col = part * TOK + h * HD + 2 * lane; float a0 = 0.f, a1 = 0.f;
#pragma unroll
            for (int jj = 0; jj < 4; ++jj) { const int tt = ri.t - 3 + jj; float x0 = 0.f, x1 = 0.f;
                if (tt >= 0) { const unsigned u = *(const unsigned*)(PROJ + (size_t)(m - ri.t + tt) * PJ + col); x0 = bflo(u); x1 = bfhi(u); }
                else if (ri.grp) { const float* hp = c.in[I_SCONV] + (size_t)((l * 32 + ri.b) * 3 + (3 + tt)) * QKV + col; x0 = hp[0]; x1 = hp[1]; }
                a0 += x0 * cw[jj * QKV + col]; a1 += x1 * cw[jj * QKV + col + 1]; }
            y[part][0] = a0 * sigmoidf_(a0); y[part][1] = a1 * sigmoidf_(a1);
            if (ri.t >= ri.T - 3) { const unsigned u = *(const unsigned*)(PROJ + (size_t)m * PJ + col); const int j2 = ri.t - (ri.T - 3);
                float* dst = c.out + (ri.grp ? O_SCONV : O_PCONV) + (size_t)((l * ri.nb + ri.b) * 3 + j2) * QKV + col; dst[0] = bflo(u); dst[1] = bfhi(u); } }
        const float rq = rsqrtf(wave_sum(y[0][0] * y[0][0] + y[0][1] * y[0][1]) + EPS) * SCALE, rk = rsqrtf(wave_sum(y[1][0] * y[1][0] + y[1][1] * y[1][1]) + EPS);
        const size_t o = (size_t)m * TOK + h * HD + 2 * lane;
        WS_PTR(float, WS_QF)[o] = y[0][0] * rq; WS_PTR(float, WS_QF)[o + 1] = y[0][1] * rq;
        WS_PTR(float, WS_KF)[o] = y[1][0] * rk; WS_PTR(float, WS_KF)[o + 1] = y[1][1] * rk;
        WS_PTR(float, WS_VF)[o] = y[2][0]; WS_PTR(float, WS_VF)[o + 1] = y[2][1]; }
}
__device__ __forceinline__ void ph_gdn_b(const Ctx& c, int l, LAS unsigned char* lds) {
    LAS float* qkv = (LAS float*)lds; LAS float* red = qkv + 768; LAS float* red2 = red + 512;
    const int tid = threadIdx.x, dv = tid & 127, g4 = tid >> 7;
    const float* Qf = WS_PTR(float, WS_QF); const float* Kf = WS_PTR(float, WS_KF); const float* Vf = WS_PTR(float, WS_VF); float* Of = WS_PTR(float, WS_OF);
    const float* G = WS_PTR(float, WS_G); const float* BETA = WS_PTR(float, WS_BETA);
    for (int task = blockIdx.x; task < 48 + 384; task += gridDim.x) {
        int grp, b, h, T, m0; if (task < 48) { grp = 0; b = task / 12; h = task % 12; T = 4096; m0 = b * 4096; } else { const int ts = task - 48; grp = 1; b = ts / 12; h = ts % 12; T = 32; m0 = MP + b * 32; }
        float s[32];
        if (grp) { const float* S0 = c.in[I_SGDN] + (size_t)((l * 32 + b) * 12 + h) * 16384;
#pragma unroll
            for (int i = 0; i < 32; ++i) s[i] = S0[(32 * g4 + i) * 128 + dv]; }
        else {
#pragma unroll
            for (int i = 0; i < 32; ++i) s[i] = 0.f; }
        const float* src = (tid < 128 ? Qf : tid < 256 ? Kf : Vf) + h * HD + (tid & 127);
        __syncthreads();
        if (tid < 384) qkv[tid] = src[(size_t)m0 * TOK];
        __syncthreads();
        for (int t = 0; t < T; ++t) { const int cur = t & 1; const LAS float* qc = qkv + cur * 384;
            float nxtv = 0.f; if (tid < 384 && t + 1 < T) nxtv = src[(size_t)(m0 + t + 1) * TOK];
            const float a = expf(G[(size_t)(m0 + t) * 12 + h]), bt = BETA[(size_t)(m0 + t) * 12 + h];
            float part = 0.f;
#pragma unroll
            for (int i = 0; i < 32; ++i) part += qc[128 + 32 * g4 + i] * s[i];
            red[g4 * 128 + dv] = part; __syncthreads();
            const float kS = (red[dv] + red[128 + dv]) + (red[256 + dv] + red[384 + dv]);
            const float vv = bt * (qc[256 + dv] - a * kS);
            float op = 0.f;
#pragma unroll
            for (int i = 0; i < 32; ++i) { s[i] = a * s[i] + qc[128 + 32 * g4 + i] * vv; op += qc[32 * g4 + i] * s[i]; }
            red2[g4 * 128 + dv] = op;
            if (tid < 384 && t + 1 < T) qkv[(cur ^ 1) * 384 + tid] = nxtv;
            __syncthreads();
            if (g4 == 0) Of[(size_t)(m0 + t) * TOK + h * HD + dv] = (red2[dv] + red2[128 + dv]) + (red2[256 + dv] + red2[384 + dv]);
        }
        float* So = c.out + (grp ? O_SGDN + (size_t)((l * 32 + b) * 12 + h) * 16384 : O_PGDN + (size_t)((l * 4 + b) * 12 + h) * 16384);
#pragma unroll
        for (int i = 0; i < 32; ++i) So[(32 * g4 + i) * 128 + dv] = s[i];
    }
}
__device__ __forceinline__ void ph_gdn_c(const Ctx& c, int l) {
    const int tid = threadIdx.x, lane = tid & 63, wave = tid >> 6, gw = blockIdx.x * 8 + wave, NGW = gridDim.x * 8;
    const bf16_t* PROJ = WS_PTR(bf16_t, WS_PROJ); const float* Of = WS_PTR(float, WS_OF); bf16_t* ACT = WS_PTR(bf16_t, WS_ACT);
    for (int it = gw; it < M * H; it += NGW) { const int m = it / H, h = it % H;
        const float o0 = Of[(size_t)m * TOK + h * HD + 2 * lane], o1 = Of[(size_t)m * TOK + h * HD + 2 * lane + 1];
        const float r = rsqrtf(wave_sum(o0 * o0 + o1 * o1) * (1.f / HD) + EPS);
        const unsigned zu = *(const unsigned*)(PROJ + (size_t)m * PJ + QKV + h * HD + 2 * lane); const float z0 = bflo(zu), z1 = bfhi(zu);
        const float g0 = c.in[I_GDNN][l * HD + 2 * lane], g1 = c.in[I_GDNN][l * HD + 2 * lane + 1];
        *(unsigned*)(ACT + (size_t)m * D + h * HD + 2 * lane) = pk2(o0 * r * g0 * (z0 * sigmoidf_(z0)), o1 * r * g1 * (z1 * sigmoidf_(z1))); }
}
__device__ __forceinline__ void ph_cumsum(const Ctx& c) {
    const int tid = threadIdx.x, lane = tid & 63, wave = tid >> 6, gw = blockIdx.x * 8 + wave, NGW = gridDim.x * 8;
    const float* LOGF = WS_PTR(float, WS_LOGF); float* CUMP = WS_PTR(float, WS_CUMP); float* CUMS = WS_PTR(float, WS_CUMS);
    for (int task = gw; task < 48 + 384; task += NGW) {
        const bool smp = task >= 48; const int ts = smp ? task - 48 : task, b = ts / 12, h = ts % 12, n = smp ? PAST + 32 : 4096; float carry = 0.f;
        for (int j0 = 0; j0 < n; j0 += 64) { const int j = j0 + lane; float v = 0.f;
            if (j < n) v = !smp ? LOGF[(size_t)(b * 4096 + j) * 12 + h] : (j < PAST ? c.in[I_CLOGF][(size_t)(b * PAST + j) * 12 + h] : LOGF[(size_t)(MP + b * 32 + j - PAST) * 12 + h]);
#pragma unroll
            for (int o = 1; o < 64; o <<= 1) { const float nb = __shfl_up(v, o); if (lane >= o) v += nb; }
            if (j < n) { if (smp) CUMS[(size_t)(b * (PAST + 32) + j) * 12 + h] = carry + v; else CUMP[(size_t)(b * 4096 + j) * 12 + h] = carry + v; }
            carry += __shfl(v, 63); }
    }
}
struct AttnDesc { int nseq, nh, T, nkeys, P, causal, rowbase;
    const bf16_t* q; int qpitch, qcol; const float* kold; const float* vold; int oldpitch; const bf16_t* knew; const bf16_t* vnew; int newpitch;
    const float* cum; bf16_t* out; int opitch, ocol; const bf16_t* gate; int gpitch, gcol; };
constexpr int ATTN_LDS = (64 * 129 + 64 * 128 + 8 * 4 * 128 + 8 * 4 * 64) * 4;
__device__ __forceinline__ void attn_simple(const AttnDesc& A, LAS unsigned char* lds) {
    LAS float* Ks = (LAS float*)lds; LAS float* Vs = Ks + 64 * 129; LAS float* qs = Vs + 64 * 128; LAS float* ps = qs + 8 * 4 * 128;
    const int tid = threadIdx.x, lane = tid & 63, w = tid >> 6;
    const int nqt = A.T / 32, nitems = A.nseq * A.nh * nqt;
    for (int item = blockIdx.x; item < nitems; item += gridDim.x) {
        const int qt = item % nqt, h = (item / nqt) % A.nh, seq = item / (nqt * A.nh), t0 = qt * 32 + 4 * w;
        __syncthreads();
#pragma unroll
        for (int qi = 0; qi < 4; ++qi) { const size_t row = (size_t)A.rowbase + (size_t)seq * A.T + t0 + qi;
            qs[(w * 4 + qi) * 128 + lane] = bf2f(A.q[row * A.qpitch + A.qcol + h * HD + lane]); qs[(w * 4 + qi) * 128 + 64 + lane] = bf2f(A.q[row * A.qpitch + A.qcol + h * HD + 64 + lane]); }
        float mrun[4], lrun[4], o[4][2], cq[4];
#pragma unroll
        for (int qi = 0; qi < 4; ++qi) { mrun[qi] = -1e30f; lrun[qi] = 0.f; o[qi][0] = 0.f; o[qi][1] = 0.f; cq[qi] = A.cum ? A.cum[((size_t)seq * A.nkeys + A.P + t0 + qi) * A.nh + h] : 0.f; }
        int nk = A.nkeys; if (A.causal) { const int lim = A.P + qt * 32 + 32; nk = lim < nk ? lim : nk; }
        const int ntile = (nk + 63) / 64;
        for (int kt = 0; kt < ntile; ++kt) {
            __syncthreads();
            { const int key = tid >> 3, dseg = (tid & 7) * 16, j = kt * 64 + key; float kv[16], vv[16];
                if (j < nk) {
                    if (j < A.P) { const float* kp = A.kold + ((size_t)seq * A.P + j) * A.oldpitch + h * HD + dseg; const float* vp = A.vold + ((size_t)seq * A.P + j) * A.oldpitch + h * HD + dseg;
#pragma unroll
                        for (int i = 0; i < 4; ++i) { const f32x4 a = *(const f32x4*)(kp + 4 * i), b = *(const f32x4*)(vp + 4 * i);
                            kv[4 * i] = a.x; kv[4 * i + 1] = a.y; kv[4 * i + 2] = a.z; kv[4 * i + 3] = a.w; vv[4 * i] = b.x; vv[4 * i + 1] = b.y; vv[4 * i + 2] = b.z; vv[4 * i + 3] = b.w; } }
                    else { const size_t row = (size_t)A.rowbase + (size_t)seq * A.T + (j - A.P); const bf16_t* kp = A.knew + row * A.newpitch + h * HD + dseg; const bf16_t* vp = A.vnew + row * A.newpitch + h * HD + dseg;
#pragma unroll
                        for (int i = 0; i < 2; ++i) { const u32x4 a = *(const u32x4*)(kp + 8 * i), b = *(const u32x4*)(vp + 8 * i);
                            kv[8 * i] = bflo(a.x); kv[8 * i + 1] = bfhi(a.x); kv[8 * i + 2] = bflo(a.y); kv[8 * i + 3] = bfhi(a.y); kv[8 * i + 4] = bflo(a.z); kv[8 * i + 5] = bfhi(a.z); kv[8 * i + 6] = bflo(a.w); kv[8 * i + 7] = bfhi(a.w);
                            vv[8 * i] = bflo(b.x); vv[8 * i + 1] = bfhi(b.x); vv[8 * i + 2] = bflo(b.y); vv[8 * i + 3] = bfhi(b.y); vv[8 * i + 4] = bflo(b.z); vv[8 * i + 5] = bfhi(b.z); vv[8 * i + 6] = bflo(b.w); vv[8 * i + 7] = bfhi(b.w); } }
                } else {
#pragma unroll
                    for (int i = 0; i < 16; ++i) { kv[i] = 0.f; vv[i] = 0.f; } }
#pragma unroll
                for (int i = 0; i < 16; ++i) { Ks[key * 129 + dseg + i] = kv[i]; Vs[key * 128 + dseg + i] = vv[i]; } }
            __syncthreads();
            const int j = kt * 64 + lane; float s[4] = {0.f, 0.f, 0.f, 0.f};
            for (int d = 0; d < 128; ++d) { const float kk = Ks[lane * 129 + d];
#pragma unroll
                for (int qi = 0; qi < 4; ++qi) s[qi] += qs[(w * 4 + qi) * 128 + d] * kk; }
            const float ck = A.cum ? A.cum[((size_t)seq * A.nkeys + (j < A.nkeys ? j : A.nkeys - 1)) * A.nh + h] : 0.f;
#pragma unroll
            for (int qi = 0; qi < 4; ++qi) { float sc = s[qi] * SCALE + (cq[qi] - ck); const bool valid = j < nk && (!A.causal || j <= A.P + t0 + qi); if (!valid) sc = -__builtin_inff();
                const float mx = wave_max(sc), mn = fmaxf(mrun[qi], mx), alpha = expf(mrun[qi] - mn), p = expf(sc - mn);
                lrun[qi] = lrun[qi] * alpha + wave_sum(p); mrun[qi] = mn; ps[(w * 4 + qi) * 64 + lane] = p; o[qi][0] *= alpha; o[qi][1] *= alpha; }
            for (int jj = 0; jj < 64; ++jj) { const float v0 = Vs[jj * 128 + lane], v1 = Vs[jj * 128 + 64 + lane];
#pragma unroll
                for (int qi = 0; qi < 4; ++qi) { const float p = ps[(w * 4 + qi) * 64 + jj]; o[qi][0] += p * v0; o[qi][1] += p * v1; } }
        }
#pragma unroll
        for (int qi = 0; qi < 4; ++qi) { const float inv = 1.f / lrun[qi]; const size_t row = (size_t)A.rowbase + (size_t)seq * A.T + t0 + qi;
#pragma unroll
            for (int e = 0; e < 2; ++e) { const int d = lane + 64 * e; float val = o[qi][e] * inv;
                if (A.gate) val *= sigmoidf_(bf2f(A.gate[row * A.gpitch + A.gcol + h * HD + d]));
                A.out[row * A.opitch + A.ocol + h * HD + d] = (bf16_t)(pk2(val, 0.f) & 0xffffu); } }
    }
}
constexpr int GEMM_LDS = pg8::STAGE_BYTES;
__device__ __forceinline__ void ph_gemm(const Ctx& c, int which, int l, LAS unsigned char* lds) {
    const bf16_t* A = WS_PTR(bf16_t, WS_XN); const bf16_t* Bt; int Mg = M, N, K = D, mode; bf16_t* o16 = nullptr; int ld16 = 0; float* o32 = nullptr; int ld32 = 0;
    if (which == 0) { A = WS_PTR(bf16_t, WS_MEMN); Bt = WS_PTR(bf16_t, WS_WMEM); Mg = 1024; N = 4096; mode = 4; }
    else if (which == 1) { Bt = (l < 2) ? WS_PTR(bf16_t, WS_WINA) + (size_t)l * 6656 * D : (l == 2 ? WS_PTR(bf16_t, WS_WINB0) : WS_PTR(bf16_t, WS_WINB1)); N = (l == 3) ? 3584 : 6656;
        mode = (l == 2) ? 3 : 0; o16 = WS_PTR(bf16_t, WS_PROJ); ld16 = PJ; }
    else if (which == 2) { A = WS_PTR(bf16_t, WS_ACT); Bt = WS_PTR(bf16_t, WS_WO) + (size_t)l * D * D; N = D; mode = 2; o32 = WS_PTR(float, WS_DELTA); ld32 = D; }
    else if (which == 3) { Bt = WS_PTR(bf16_t, WS_WUP) + (size_t)l * DFF * D; N = DFF; mode = 1; o16 = WS_PTR(bf16_t, WS_UP); ld16 = DFF; }
    else { A = WS_PTR(bf16_t, WS_UP); Bt = WS_PTR(bf16_t, WS_WDN) + (size_t)l * D * DFF; N = D; K = DFF; mode = 2; o32 = WS_PTR(float, WS_DELTA); ld32 = D; }
    const pg8::Gemm g{A, Bt, Mg, N, K};
    const pg8::Epi E{mode, o16, ld16, o32, ld32, c.ws, c.out};
    pg8::StaticOrder S; S.init(g.M, g.N, (int)gridDim.x, (int)blockIdx.x);
    pg8::gemm_phase<pg8::Epi, pg8::StaticOrder, true, true>(lds, g, S, E);
}
__device__ __forceinline__ void ph_attn(const Ctx& c, int which, int grp, int l, LAS unsigned char* lds) {
    AttnDesc A; A.rowbase = grp ? MP : 0; A.nseq = grp ? 32 : 4; A.T = grp ? 32 : 4096; A.q = WS_PTR(bf16_t, WS_PROJ); A.qpitch = PJ; A.out = WS_PTR(bf16_t, WS_ACT); A.opitch = D;
    A.knew = nullptr; A.vnew = nullptr; A.newpitch = 0; A.kold = nullptr; A.vold = nullptr; A.oldpitch = 0; A.cum = nullptr; A.gate = nullptr; A.gpitch = 0; A.gcol = 0;
    if (which == 0) { A.nh = MH; A.nkeys = NMEM; A.P = NMEM; A.causal = 0; A.qcol = (l < 2) ? 6144 : 3072; A.ocol = TOK; A.oldpitch = MEMD;
        if (grp) { A.kold = c.in[I_CMK] + (size_t)l * 32 * NMEM * MEMD; A.vold = c.in[I_CMV] + (size_t)l * 32 * NMEM * MEMD; }
        else { A.kold = c.out + O_PMK + (size_t)l * 4 * NMEM * MEMD; A.vold = c.out + O_PMV + (size_t)l * 4 * NMEM * MEMD; } }
    else { A.nh = H; A.causal = 1; A.qcol = 0; A.ocol = 0; A.knew = WS_PTR(bf16_t, WS_KB); A.vnew = WS_PTR(bf16_t, WS_VB); A.newpitch = TOK; A.gate = WS_PTR(bf16_t, WS_PROJ); A.gpitch = PJ; A.gcol = TOK;
        if (grp) { A.nkeys = PAST + 32; A.P = PAST; A.kold = c.in[I_CK]; A.vold = c.in[I_CV]; A.oldpitch = TOK; A.cum = WS_PTR(float, WS_CUMS); }
        else { A.nkeys = 4096; A.P = 0; A.cum = WS_PTR(float, WS_CUMP); } }
    attn_simple(A, lds);
}
enum { K_PREP = 0, K_ROW0, K_ROWMEM, K_GEMM, K_GDNA, K_GDNB, K_GDNC, K_ATTN, K_ROWMIX, K_ROWMLP, K_CUMSUM };
template <int KIND> __global__ void __launch_bounds__(512, 2) k_phase(Ctx c, int a0, int a1, int a2) {
    extern __shared__ __attribute__((aligned(16))) unsigned char lds_raw[];
    LAS unsigned char* lds = (LAS unsigned char*)lds_raw;
    if constexpr (KIND == K_PREP) ph_prep(c, lds);
    else if constexpr (KIND == K_ROW0) ph_row(c, 1, nullptr, nullptr, 0, 1, 0);
    else if constexpr (KIND == K_ROWMEM) ph_row(c, 2, nullptr, nullptr, 0, 0, 0);
    else if constexpr (KIND == K_GEMM) ph_gemm(c, a0, a1, lds);
    else if constexpr (KIND == K_GDNA) ph_gdn_a(c, a0);
    else if constexpr (KIND == K_GDNB) ph_gdn_b(c, a0, lds);
    else if constexpr (KIND == K_GDNC) ph_gdn_c(c, a0);
    else if constexpr (KIND == K_ATTN) ph_attn(c, a0, a1, a2, lds);
    else if constexpr (KIND == K_ROWMIX) ph_row(c, 0, WS_PTR(float, WS_DELTA), c.in[I_NMIXPOST] + a0 * D, 0, 0, 0);
    else if constexpr (KIND == K_ROWMLP) { const int l = a0; ph_row(c, 0, WS_PTR(float, WS_DELTA), c.in[I_NMLPPOST] + l * D, l == 3, l == 0 ? 1 : (l == 1 ? 2 : 0), 1); }
    else if constexpr (KIND == K_CUMSUM) ph_cumsum(c);
}
extern "C" void kernel_launch(void* const* d_in, const int* in_sizes, int n_in, void* d_out, int out_size, void* d_ws, size_t ws_size, hipStream_t stream) {
    static int ok = 0;
    if (ok == 0) {
        if (n_in != 28 || (size_t)out_size != O_END || ws_size < WS_END) { fprintf(stderr, "kernel_launch: unexpected shapes: n_in %d out %d ws %zu (need %zu)\n", n_in, out_size, ws_size, (size_t)WS_END); ok = -1; return; }
        if (hipFuncSetAttribute((const void*)k_phase<K_GEMM>, hipFuncAttributeMaxDynamicSharedMemorySize, GEMM_LDS) != hipSuccess || hipFuncSetAttribute((const void*)k_phase<K_PREP>, hipFuncAttributeMaxDynamicSharedMemorySize, GEMM_LDS) != hipSuccess || hipFuncSetAttribute((const void*)k_phase<K_ATTN>, hipFuncAttributeMaxDynamicSharedMemorySize, GEMM_LDS) != hipSuccess) { fprintf(stderr, "kernel_launch: hipFuncSetAttribute failed\n"); ok = -1; return; }
        ok = 1;
    }
    if (ok < 0) return;
    Ctx c{}; for (int i = 0; i < 28; ++i) c.in[i] = (const float*)d_in[i]; c.out = (float*)d_out; c.ws = (unsigned char*)d_ws; c.ph_lo = 0; c.ph_hi = 0;
    const int G = 256;
#define RUN(kind, a0, a1, a2) hipLaunchKernelGGL(k_phase<kind>, dim3(G), dim3(512), ((kind) == K_GEMM || (kind) == K_PREP || (kind) == K_ATTN) ? GEMM_LDS : 16384, stream, c, (int)(a0), (int)(a1), (int)(a2))
    RUN(K_PREP, 0, 0, 0); RUN(K_ROWMEM, 0, 0, 0); RUN(K_ROW0, 0, 0, 0); RUN(K_GEMM, 0, 0, 0);
    for (int l = 0; l < 4; ++l) {
        RUN(K_GEMM, 1, l, 0);
        if (l < 2) { RUN(K_GDNA, l, 0, 0); RUN(K_GDNB, l, 0, 0); RUN(K_GDNC, l, 0, 0); }
        else { if (l == 2) RUN(K_CUMSUM, 0, 0, 0); RUN(K_ATTN, 1, 0, l); RUN(K_ATTN, 1, 1, l); }
        RUN(K_ATTN, 0, 0, l); RUN(K_ATTN, 0, 1, l);
        RUN(K_GEMM, 2, l, 0); RUN(K_ROWMIX, l, 0, 0); RUN(K_GEMM, 3, l, 0); RUN(K_GEMM, 4, l, 0); RUN(K_ROWMLP, l, 0, 0);
    }
#undef RUN
}
```

```cpp
#include <hip/hip_runtime.h>
#include <cstdio>
#include <cstdint>
namespace pg8 {
#define PG8_LAS __attribute__((address_space(3)))
typedef unsigned short bf16_t;
typedef short bf16x8 __attribute__((ext_vector_type(8)));
typedef float f32x4 __attribute__((ext_vector_type(4)));
typedef unsigned u32x4 __attribute__((ext_vector_type(4)));
constexpr int BM = 256, BK = 64, HALF = 128, HTB = HALF * BK * 2  , STAGE_BYTES = 8 * HTB, NXCD = 8, WGM = 4;

__host__ __device__ __forceinline__ int lds_byte(int r, int c) { const int st = (r >> 4) * 2 + (c >> 5), rr = r & 15, cc = c & 31, ob = rr * 64 + cc * 2; return st * 1024 + (ob ^ (((ob >> 9) & 1) << 5)); }
__host__ __device__ __forceinline__ void stage_rc(int b, int& R, int& C) { const int st = b / 1024, sb = b % 1024, swz = sb ^ (((sb >> 9) & 1) << 5); R = (st >> 1) * 16 + swz / 64; C = (st & 1) * 32 + (swz % 64) / 2; }
__host__ __device__ __forceinline__ int perm32(int rho) { const int n = rho >> 4, i = rho & 15; return 8 * (i >> 2) + 4 * n + (i & 3); }

struct Unit { int pm, pn, kt0, nt, ks; };
struct Gemm { const bf16_t* A; const bf16_t* Bt; int M, N, K; };

struct StaticOrder {
    int nM, nN, nwg, G, c, ntf;
    __host__ __device__ void init(int M, int N, int K, int G_, int c_) { nM = M / BM; nN = N / BM; nwg = nM * nN; G = G_; c = c_; ntf = K / BK; }
    __host__ __device__ bool next(int i, Unit& u) const {
        const long L = (long)i * G + c; if (L >= nwg) return false;
        int wgid = (int)L; { const int q = nwg / NXCD, r = nwg % NXCD, xcd = wgid % NXCD, off = wgid / NXCD; wgid = (xcd < r ? xcd * (q + 1) : r * (q + 1) + (xcd - r) * q) + off; }
        const int nig = WGM * nN, gid = wgid / nig, fm = gid * WGM, gsz = (nM - fm) < WGM ? (nM - fm) : WGM;
        u.pm = fm + ((wgid % nig) % gsz); u.pn = (wgid % nig) / gsz; u.kt0 = 0; u.nt = ntf; u.ks = 0; return true;
    }
    __device__ __forceinline__ void a_ready(const Unit&) const {}
    __device__ __forceinline__ void done(const Unit&) const {}
};

__device__ __forceinline__ unsigned cvt_pk_bf16(float lo, float hi) { unsigned r; asm volatile("v_cvt_pk_bf16_f32 %0, %1, %2" : "=v"(r) : "v"(lo), "v"(hi)); return r; }
}
#define LAS __attribute__((address_space(3)))
typedef unsigned short bf16_t;
typedef float f32x4 __attribute__((ext_vector_type(4)));
typedef unsigned u32x4 __attribute__((ext_vector_type(4)));
typedef unsigned u32x2 __attribute__((ext_vector_type(2)));
constexpr int D = 2048, MP = 16384, MS = 1024, M = MP + MS;
constexpr int H = 12, HD = 128, TOK = 1536, QKV = 4608, MEMD = 512, MH = 4, NMEM = 256, DFF = 8192, PAST = 2048;
constexpr int INA_W = 6680, INB_W = 3584, KVF_W = 3084;
constexpr int PJ = 6656;
constexpr float EPS = 1e-6f, SCALE = 0.08838834764831845f;
constexpr size_t O_YP = 0, O_YS = O_YP + (size_t)MP * D, O_PGDN = O_YS + (size_t)MS * D, O_PCONV = O_PGDN + (size_t)2 * 4 * 12 * 16384, O_PK = O_PCONV + (size_t)2 * 4 * 3 * 4608,
    O_PV = O_PK + (size_t)MP * TOK, O_PLOGF = O_PV + (size_t)MP * TOK, O_PMK = O_PLOGF + (size_t)MP * 12, O_PMV = O_PMK + (size_t)4 * 4 * 256 * 512, O_SGDN = O_PMV + (size_t)4 * 4 * 256 * 512,
    O_SCONV = O_SGDN + (size_t)2 * 32 * 12 * 16384, O_SK = O_SCONV + (size_t)2 * 32 * 3 * 4608, O_SV = O_SK + (size_t)MS * TOK, O_SLOGF = O_SV + (size_t)MS * TOK, O_END = O_SLOGF + (size_t)MS * 12;
static_assert(O_END == 108683264, "output size");
constexpr size_t MiB = 1u << 20;
constexpr size_t WS_CTL = 0, WS_WINA = 1 * MiB, WS_WINB0 = 53 * MiB, WS_WINB1 = 79 * MiB, WS_WO = 93 * MiB, WS_WUP = 125 * MiB, WS_WDN = 253 * MiB, WS_WMEM = 381 * MiB, WS_WSK = 397 * MiB,
    WS_X = 398 * MiB, WS_XN = 534 * MiB, WS_PROJ = 602 * MiB, WS_ACT = 823 * MiB, WS_DELTA = 891 * MiB, WS_KB = 1027 * MiB, WS_VB = 1078 * MiB, WS_G = 1129 * MiB, WS_BETA = 1130 * MiB,
    WS_LOGF = 1131 * MiB, WS_CUMP = 1132 * MiB, WS_CUMS = 1133 * MiB, WS_MEMN = 1137 * MiB, WS_BIG = 1141 * MiB, WS_QF = WS_BIG, WS_KF = WS_BIG + 102 * MiB, WS_VF = WS_BIG + 204 * MiB,
    WS_OF = WS_BIG + 306 * MiB, WS_UP = WS_BIG, WS_END = WS_BIG + 408 * MiB,
    WS_EGL = WS_END, WS_QX = WS_EGL + 1 * MiB, WS_KX = WS_QX + 3 * MiB, WS_MEMKVB = WS_KX + 3 * MiB, WS_WSKB = WS_MEMKVB + 8 * MiB, WS_END2 = WS_WSKB + 1 * MiB;
constexpr size_t WS_SLAB = WS_PROJ;
constexpr size_t CTL_ZROW = 61440, CTL_QFOX = 32768;
static_assert((size_t)6656 * 2048 * 2 == 26 * MiB && (size_t)M * D * 4 == 136 * MiB && (size_t)M * PJ * 2 == 221 * MiB && (size_t)M * TOK * 2 == 51 * MiB && (size_t)M * TOK * 4 == 102 * MiB && (size_t)M * DFF * 2 == 272 * MiB, "sizes");

struct Ctx { const float* in[28]; float* out; unsigned char* ws; int ph_lo, ph_hi; };
typedef const __attribute__((address_space(4))) Ctx* CtxP;
__device__ __forceinline__ int otid_cp(CtxP cp) {
#if defined(__HIP_DEVICE_COMPILE__)
    unsigned long long a = (unsigned long long)cp; asm volatile("" : "+s"(a));
    int ln; asm volatile("v_mbcnt_lo_u32_b32 %0, -1, 0\n\tv_mbcnt_hi_u32_b32 %0, -1, %0" : "=v"(ln));
    return (int)((unsigned)a & 7u) * 64 + ln;
#else
    (void)cp; return 0;
#endif
}
#define otid() otid_cp(cp)
__device__ __forceinline__ int obid() { int b = blockIdx.x; asm volatile("" : "+s"(b)); return b; }
__device__ __forceinline__ int ogrid() { int g = gridDim.x; asm volatile("" : "+s"(g)); return g; }
__device__ __forceinline__ Ctx ctx_load(CtxP cp) {
#if defined(__HIP_DEVICE_COMPILE__)
    asm volatile("" : "+s"(cp)); cp = (CtxP)((unsigned long long)cp & ~7ull); Ctx r; __builtin_memcpy(&r, cp, sizeof(Ctx)); return r;
#else
    (void)cp; return Ctx{};
#endif
}
#define CTX_LOAD(cp) const Ctx c = ctx_load(cp)
enum { I_XP = 0, I_XS, I_SGDN, I_SCONV, I_CK, I_CV, I_CLOGF, I_CMK, I_CMV, I_MEMP, I_NMIXPRE, I_NMIXPOST, I_NMLPPRE, I_NMLPPOST, I_WINA, I_CONVW, I_ALOG, I_DTB, I_GDNN, I_WINB, I_NKV, I_WKVF, I_BF, I_NMEM, I_WMEMKV, I_WO, I_WUP, I_WDN };

__device__ __forceinline__ float bf2f(bf16_t b) { return __uint_as_float(((unsigned)b) << 16); }
__device__ __forceinline__ float bflo(unsigned u) { return __uint_as_float(u << 16); }
__device__ __forceinline__ float bfhi(unsigned u) { return __uint_as_float(u & 0xffff0000u); }
__device__ __forceinline__ unsigned pk2(float lo, float hi) { return pg8::cvt_pk_bf16(lo, hi); }
__device__ __forceinline__ float lane_get(float v, int src_lane) { return __int_as_float(__builtin_amdgcn_ds_bpermute(src_lane << 2, __float_as_int(v))); }
__device__ __forceinline__ float wave_sum(float v, int lane) {
#pragma unroll
    for (int o = 1; o < 64; o <<= 1) v += lane_get(v, lane ^ o);
    return v; }
__device__ __forceinline__ float wave_max(float v, int lane) {
#pragma unroll
    for (int o = 1; o < 64; o <<= 1) v = fmaxf(v, lane_get(v, lane ^ o));
    return v; }
__device__ __forceinline__ float wave_sum_dpp(float v) {
    v += __int_as_float(__builtin_amdgcn_update_dpp(0, __float_as_int(v), 0x111, 0xf, 0xf, true));
    v += __int_as_float(__builtin_amdgcn_update_dpp(0, __float_as_int(v), 0x112, 0xf, 0xf, true));
    v += __int_as_float(__builtin_amdgcn_update_dpp(0, __float_as_int(v), 0x114, 0xf, 0xf, true));
    v += __int_as_float(__builtin_amdgcn_update_dpp(0, __float_as_int(v), 0x118, 0xf, 0xf, true));
    const int iv = __float_as_int(v);
    return (__int_as_float(__builtin_amdgcn_readlane(iv, 15)) + __int_as_float(__builtin_amdgcn_readlane(iv, 31))) + (__int_as_float(__builtin_amdgcn_readlane(iv, 47)) + __int_as_float(__builtin_amdgcn_readlane(iv, 63)));
}
__device__ __forceinline__ float sigmoidf_(float x) { return 1.f / (1.f + expf(-x)); }
__device__ __forceinline__ float softplusf_(float x) { return fmaxf(x, 0.f) + log1pf(expf(-fabsf(x))); }
__device__ __forceinline__ float softplus_fast(float x) { return fmaxf(x, 0.f) + 0.6931471805599453f * __builtin_amdgcn_logf(1.f + __builtin_amdgcn_exp2f(-1.4426950408889634f * fabsf(x))); }
__device__ __forceinline__ float fast_sigmoid(float x) { return __builtin_amdgcn_rcpf(1.f + __builtin_amdgcn_exp2f(-1.4426950408889634f * x)); }
__device__ __forceinline__ float exp_fast(float x) { return __builtin_amdgcn_exp2f(1.4426950408889634f * x); }
struct RowInfo { int grp, b, t, T, nb; };
__device__ __forceinline__ RowInfo rowinfo(int m) { RowInfo r; if (m < MP) { r.grp = 0; r.b = m >> 12; r.t = m & 4095; r.T = 4096; r.nb = 4; } else { const int ms = m - MP; r.grp = 1; r.b = ms >> 5; r.t = ms & 31; r.T = 32; r.nb = 32; } return r; }
namespace pg8 {
struct Epi {
    static constexpr bool PERM = true, AFTER_DRAIN = false;
    int mode;
    bf16_t* o16; int ld16; float* o32; int ld32;
    unsigned char* ws; float* out;
    int ntfull;
    int ntcol;
    __device__ __forceinline__ void operator()(const f32x4 (&acc)[2][2][4][2], const Unit& u, int wr, int wc, int fr, int fq) const {
        const int row0 = u.pm * BM + wr * 64 + fr, colt = u.pn * BM, cl = wc * 32 + 8 * fq;
        bf16_t* d16 = nullptr; size_t l16 = 0; float* d32 = nullptr; size_t l32 = 0; int radj = 0; const bool sq = (mode == 1);
        bool nt16 = false;
        if (mode == 0 || mode == 1) { d16 = o16 + colt; l16 = (size_t)ld16; nt16 = (mode == 0) && (ntcol >= 0) && (colt >= ntcol); }
        else if (mode == 2) {
            if (u.nt != ntfull) { d32 = (float*)(ws + WS_SLAB) + (size_t)u.ks * 1024 * 2048 + colt; l32 = 2048; radj = 16384; }
            else { d16 = o16 + colt; l16 = (size_t)ld16; } }
        else if (mode == 3) {
            if (colt < 3584) { d16 = o16 + colt; l16 = (size_t)ld16; nt16 = true; }
            else { const bool isv = colt >= 5120; const int cc = colt - (isv ? 5120 : 3584); const bool smp = u.pm >= 64;
                d16 = (bf16_t*)(ws + (isv ? WS_VB : WS_KB)) + cc; l16 = 1536; d32 = out + (smp ? (isv ? O_SV : O_SK) : (isv ? O_PV : O_PK)) + cc; l32 = 1536; radj = smp ? 16384 : 0; }
        } else { const int l = colt >> 10, within = colt & 1023; d32 = out + ((within >= 512) ? O_PMV : O_PMK) + (size_t)l * 1024 * 512 + (within & 511); l32 = 512;  d16 = (bf16_t*)(ws + WS_MEMKVB) + colt; l16 = 4096; }
#pragma unroll
        for (int ai = 0; ai < 2; ++ai)
#pragma unroll
            for (int m = 0; m < 4; ++m) { const int row = row0 + ai * HALF + m * 16;
#pragma unroll
                for (int bj = 0; bj < 2; ++bj) { f32x4 v0 = acc[ai][bj][m][0], v1 = acc[ai][bj][m][1]; const int col = cl + bj * HALF;
                    if (sq) {
#pragma unroll
                        for (int j = 0; j < 4; ++j) { const float a = v0[j] > 0.f ? v0[j] : 0.f, b = v1[j] > 0.f ? v1[j] : 0.f; v0[j] = a * a; v1[j] = b * b; } }
                    if (d16) { u32x4 w; w.x = cvt_pk_bf16(v0[0], v0[1]); w.y = cvt_pk_bf16(v0[2], v0[3]); w.z = cvt_pk_bf16(v1[0], v1[1]); w.w = cvt_pk_bf16(v1[2], v1[3]);
                        if (nt16) __builtin_nontemporal_store(w, (u32x4*)(d16 + (size_t)row * l16 + col)); else *(u32x4*)(d16 + (size_t)row * l16 + col) = w; }
                    if (d32) { float* p = d32 + (size_t)(row - radj) * l32 + col;
                        if (mode >= 3) { __builtin_nontemporal_store(v0, (f32x4*)p); __builtin_nontemporal_store(v1, (f32x4*)(p + 4)); }
                        else { *(f32x4*)p = v0; *(f32x4*)(p + 4) = v1; } } } }
    }
};
struct TailSplit {
    StaticOrder full; int nF, nN, nsl, nts, G, c, split;
    __device__ void init(int M, int N, int K, int G_, int c_, int split_) { split = split_; full.init(split_ ? 64 * BM : M, N, K, G_, c_); nN = N / BM; nF = 64 * nN; nsl = 8; nts = K / BK / nsl; G = G_; c = c_; }
    __device__ __forceinline__ bool next(int i, Unit& u) const {
        const long L = (long)i * G + c; int pm = 0, pn = 0, kt0 = 0, nt = full.ntf, ks = 0; bool ok; if (c < 0) { u.pm = 0; u.pn = 0; u.kt0 = 0; u.nt = nt; u.ks = 0; return false; }
        if (!split || L < nF) { Unit t; ok = full.next(i, t); pm = t.pm; pn = t.pn; }
        else { const int Ls = (int)(L - nF); ok = Ls < 4 * nN * nsl; pn = Ls % nN; const int rest = Ls / nN; pm = 64 + (rest & 3); ks = rest >> 2; kt0 = ks * nts; nt = nts; }
        u.pm = pm; u.pn = pn; u.kt0 = kt0; u.nt = nt; u.ks = ks; return ok;
    }
    __device__ __forceinline__ void a_ready(const Unit&) const {}
    __device__ __forceinline__ void done(const Unit&) const {}
};
}
namespace pg8 {
template <class Epi, class Sched, bool ALIGN_EPI = false, bool SP2 = false>
__device__ __forceinline__ void gemm_phase(PG8_LAS unsigned char* lds, const Gemm g, const Sched& S, const Epi& E, const int tid) {
    const int wid = __builtin_amdgcn_readfirstlane(tid >> 6), lane = tid & 63, wr = wid >> 2, wc = wid & 3, fr = lane & 15, fq = lane >> 4;
    const int K = g.K;
    unsigned voffA[2], voffB[2];
#pragma unroll
    for (int i = 0; i < 2; ++i) { int R, C; stage_rc(tid * 16 + i * 8192, R, C); const int Rb = Epi::PERM ? ((R & ~31) + perm32(R & 31)) : R;
        voffA[i] = (unsigned)(R * K + C) * 2u; voffB[i] = (unsigned)(Rb * K + C) * 2u; }
    const size_t kstep = (size_t)(BK * 2);
    const size_t hstep = (size_t)HALF * K * 2;
    const size_t tstep = 2 * hstep;
    const unsigned ldsw = (unsigned)wid * 1024u;
    const int aoff = lds_byte(wr * 64 + fr, fq * 8), boff = lds_byte(wc * 32 + fr, fq * 8);
#define PG8_SA(b, h) (((b) * 2 + (h)) * HTB)
#define PG8_SB(b, h) ((4 + (b) * 2 + (h)) * HTB)
#define PG8_STAGE(bufoff, gbase, voff) do { _Pragma("unroll") for (int _i = 0; _i < 2; ++_i) \
        __builtin_amdgcn_global_load_lds((const unsigned*)((const char*)(gbase) + (voff)[_i]), (PG8_LAS unsigned*)(lds + (bufoff) + ldsw + _i * 8192), 16, 0, 0); } while (0)
#define PG8_LDA(dst, b, h) do { _Pragma("unroll") for (int m = 0; m < 4; ++m) _Pragma("unroll") for (int k = 0; k < 2; ++k) dst[m][k] = *(const PG8_LAS bf16x8*)(lds + PG8_SA(b, h) + aoff + m * 2048 + k * 1024); } while (0)
#define PG8_LDB(dst, b, h) do { _Pragma("unroll") for (int n = 0; n < 2; ++n) _Pragma("unroll") for (int k = 0; k < 2; ++k) dst[n][k] = *(const PG8_LAS bf16x8*)(lds + PG8_SB(b, h) + boff + n * 2048 + k * 1024); } while (0)
#define PG8_MMA(ai, bj, At, Bt) do { __builtin_amdgcn_s_setprio(1); _Pragma("unroll") for (int m = 0; m < 4; ++m) _Pragma("unroll") for (int n = 0; n < 2; ++n) _Pragma("unroll") for (int k = 0; k < 2; ++k) \
        acc[ai][bj][m][n] = __builtin_amdgcn_mfma_f32_16x16x32_bf16(Bt[n][k], At[m][k], acc[ai][bj][m][n], 0, 0, 0); __builtin_amdgcn_s_setprio(0); } while (0)
#define PG8_WAIT_V(n) asm volatile("s_waitcnt vmcnt(" #n ")" ::: "memory")
#define PG8_WAIT_L(n) asm volatile("s_waitcnt lgkmcnt(" #n ")" ::: "memory")
#define PG8_BAR __builtin_amdgcn_s_barrier()
#define PG8_SCHED __builtin_amdgcn_sched_barrier(0)
    Unit cur, nxt; int ui = 0;
    if (!S.next(0, cur)) return;
    f32x4 acc[2][2][4][2];
#pragma unroll
    for (int a = 0; a < 2; ++a)
#pragma unroll
        for (int b = 0; b < 2; ++b)
#pragma unroll
            for (int m = 0; m < 4; ++m)
#pragma unroll
                for (int n = 0; n < 2; ++n) acc[a][b][m][n] = (f32x4){0.f, 0.f, 0.f, 0.f};
    bf16x8 At[4][2], B0[2][2], B1[2][2];
    const char* cA = (const char*)g.A + (size_t)cur.pm * tstep + (size_t)cur.kt0 * kstep; const char* cB = (const char*)g.Bt + (size_t)cur.pn * tstep + (size_t)cur.kt0 * kstep;
    S.a_ready(cur);
    if constexpr (SP2) {
        PG8_STAGE(PG8_SB(0, 0), cB, voffB); PG8_STAGE(PG8_SB(0, 1), cB + hstep, voffB); PG8_STAGE(PG8_SA(0, 0), cA, voffA); PG8_STAGE(PG8_SA(0, 1), cA + hstep, voffA);
        if (wr == 1) PG8_BAR;
        PG8_WAIT_V(2); PG8_BAR;
        PG8_STAGE(PG8_SB(1, 0), cB + kstep, voffB); PG8_STAGE(PG8_SA(1, 0), cA + kstep, voffA); PG8_STAGE(PG8_SB(1, 1), cB + hstep + kstep, voffB);
        PG8_WAIT_V(6); PG8_BAR;
    } else {
        PG8_STAGE(PG8_SB(0, 0), cB, voffB); PG8_STAGE(PG8_SA(0, 0), cA, voffA); PG8_STAGE(PG8_SB(0, 1), cB + hstep, voffB); PG8_STAGE(PG8_SA(0, 1), cA + hstep, voffA);
        if (wr == 1) PG8_BAR;
        PG8_WAIT_V(4); PG8_BAR;
        PG8_STAGE(PG8_SB(1, 0), cB + kstep, voffB); PG8_STAGE(PG8_SA(1, 0), cA + kstep, voffA); PG8_STAGE(PG8_SB(1, 1), cB + hstep + kstep, voffB);
        PG8_WAIT_V(6); PG8_BAR;
    }
    for (;;) {
        const bool has_next = S.next(ui + 1, nxt);
        const char* nA = has_next ? (const char*)g.A + (size_t)nxt.pm * tstep + (size_t)nxt.kt0 * kstep : cA; const char* nB = has_next ? (const char*)g.Bt + (size_t)nxt.pn * tstep + (size_t)nxt.kt0 * kstep : cB;
        const int nt = cur.nt;
        for (int t = 0; t < nt; t += 2) {
            const bool last = (t == nt - 2);
            const char* a1 = cA + (size_t)(t + 1) * kstep;
            const char* a2 = last ? nA : cA + (size_t)(t + 2) * kstep; const char* b2 = last ? nB : cB + (size_t)(t + 2) * kstep;
            const char* a3 = a2 + kstep; const char* b3 = b2 + kstep;
            if (last && has_next) S.a_ready(nxt);
            if constexpr (SP2) {
            PG8_LDB(B0, 0, 0); PG8_LDB(B1, 0, 1); PG8_SCHED; PG8_LDA(At, 0, 0); PG8_STAGE(PG8_SA(1, 1), a1 + hstep, voffA);
            PG8_WAIT_V(8); PG8_WAIT_L(0); PG8_BAR; PG8_MMA(0, 0, At, B0); PG8_MMA(0, 1, At, B1); PG8_BAR; PG8_SCHED;
            PG8_LDA(At, 0, 1); PG8_STAGE(PG8_SB(0, 0), b2, voffB); PG8_STAGE(PG8_SB(0, 1), b2 + hstep, voffB); PG8_STAGE(PG8_SA(0, 0), a2, voffA);
            PG8_WAIT_V(8); PG8_WAIT_L(0); PG8_BAR; PG8_MMA(1, 0, At, B0); PG8_MMA(1, 1, At, B1); PG8_BAR; PG8_SCHED;
            PG8_LDB(B0, 1, 0); PG8_LDB(B1, 1, 1); PG8_SCHED; PG8_LDA(At, 1, 0); PG8_STAGE(PG8_SA(0, 1), a2 + hstep, voffA);
            PG8_WAIT_V(8); PG8_WAIT_L(0); PG8_BAR; PG8_MMA(0, 0, At, B0); PG8_MMA(0, 1, At, B1); PG8_BAR; PG8_SCHED;
            PG8_LDA(At, 1, 1); PG8_STAGE(PG8_SB(1, 0), b3, voffB); PG8_STAGE(PG8_SB(1, 1), b3 + hstep, voffB); PG8_STAGE(PG8_SA(1, 0), a3, voffA);
            PG8_WAIT_V(8); PG8_WAIT_L(0); PG8_BAR; PG8_MMA(1, 0, At, B0); PG8_MMA(1, 1, At, B1); PG8_BAR; PG8_SCHED;
            } else {
            PG8_LDB(B0, 0, 0); PG8_SCHED; PG8_LDA(At, 0, 0); PG8_STAGE(PG8_SA(1, 1), a1 + hstep, voffA);
            PG8_WAIT_L(8); PG8_BAR; PG8_WAIT_L(0); PG8_MMA(0, 0, At, B0); PG8_BAR; PG8_SCHED;
            PG8_LDB(B1, 0, 1); PG8_STAGE(PG8_SB(0, 0), b2, voffB);
            PG8_BAR; PG8_WAIT_L(0); PG8_MMA(0, 1, At, B1); PG8_BAR;
            PG8_LDA(At, 0, 1); PG8_STAGE(PG8_SA(0, 0), a2, voffA);
            PG8_BAR; PG8_WAIT_L(0); PG8_MMA(1, 0, At, B0); PG8_BAR; PG8_SCHED;
            PG8_STAGE(PG8_SB(0, 1), b2 + hstep, voffB);
            PG8_WAIT_V(6); PG8_BAR; PG8_MMA(1, 1, At, B1); PG8_BAR;
            PG8_LDB(B0, 1, 0); PG8_SCHED; PG8_LDA(At, 1, 0); PG8_STAGE(PG8_SA(0, 1), a2 + hstep, voffA);
            PG8_WAIT_L(8); PG8_BAR; PG8_WAIT_L(0); PG8_MMA(0, 0, At, B0); PG8_BAR; PG8_SCHED;
            PG8_LDB(B1, 1, 1); PG8_STAGE(PG8_SB(1, 0), b3, voffB);
            PG8_BAR; PG8_WAIT_L(0); PG8_MMA(0, 1, At, B1); PG8_BAR;
            PG8_LDA(At, 1, 1); PG8_STAGE(PG8_SA(1, 0), a3, voffA);
            PG8_BAR; PG8_WAIT_L(0); PG8_MMA(1, 0, At, B0); PG8_BAR; PG8_SCHED;
            PG8_STAGE(PG8_SB(1, 1), b3 + hstep, voffB);
            PG8_WAIT_V(6); PG8_BAR; PG8_MMA(1, 1, At, B1); PG8_BAR;
            }
        }
        if constexpr (ALIGN_EPI) { if (wr == 0) PG8_BAR; }
        if constexpr (!Epi::AFTER_DRAIN) { E(acc, cur, wr, wc, fr, fq); S.done(cur); }
        if (!has_next) break;
#pragma unroll
        for (int a = 0; a < 2; ++a)
#pragma unroll
            for (int b = 0; b < 2; ++b)
#pragma unroll
                for (int m = 0; m < 4; ++m)
#pragma unroll
                    for (int n = 0; n < 2; ++n) acc[a][b][m][n] = (f32x4){0.f, 0.f, 0.f, 0.f};
        cur = nxt; cA = nA; cB = nB; ++ui;
        if constexpr (ALIGN_EPI) { if (wr == 1) PG8_BAR; }
    }
    PG8_WAIT_V(0);
    if constexpr (!ALIGN_EPI) { if (wr == 0) PG8_BAR; }
    PG8_BAR;
    if constexpr (Epi::AFTER_DRAIN) { E.fused(acc, cur, wr, wc, fr, fq, lds, wid, lane); S.done(cur); }
#undef PG8_SA
#undef PG8_SB
#undef PG8_STAGE
#undef PG8_LDA
#undef PG8_LDB
#undef PG8_MMA
#undef PG8_WAIT_V
#undef PG8_WAIT_L
#undef PG8_BAR
#undef PG8_SCHED
}
}
typedef short bf16x8s __attribute__((ext_vector_type(8)));
#define WS_PTR(T, off) ((T*)(c.ws + (off)))
struct TJob { const float* W; int ldw, K; const float* gain; bf16_t* WT; int src0, dst0, ncols; };
__device__ __forceinline__ TJob get_job(const Ctx& c, int j) {
    TJob J; J.gain = nullptr; J.src0 = 0; J.dst0 = 0; J.K = D;
    if (j < 4) { const int l = j >> 1, p = j & 1; J.W = c.in[I_WINA] + (size_t)l * D * INA_W; J.ldw = INA_W; J.gain = c.in[I_NMIXPRE] + l * D; J.WT = WS_PTR(bf16_t, WS_WINA) + (size_t)l * 6656 * D;
        if (p == 0) { J.ncols = 6144; } else { J.src0 = 6168; J.dst0 = 6144; J.ncols = 512; } }
    else if (j == 4) { J.W = c.in[I_WINB]; J.ldw = INB_W; J.gain = c.in[I_NMIXPRE] + 2 * D; J.WT = WS_PTR(bf16_t, WS_WINB0); J.ncols = 3584; }
    else if (j == 5) { J.W = c.in[I_WKVF]; J.ldw = KVF_W; J.gain = c.in[I_NKV]; J.WT = WS_PTR(bf16_t, WS_WINB0); J.dst0 = 3584; J.ncols = 3072; }
    else if (j == 6) { J.W = c.in[I_WINB] + (size_t)D * INB_W; J.ldw = INB_W; J.gain = c.in[I_NMIXPRE] + 3 * D; J.WT = WS_PTR(bf16_t, WS_WINB1); J.ncols = 3584; }
    else if (j < 11) { const int l = j - 7; J.W = c.in[I_WO] + (size_t)l * D * D; J.ldw = D; J.WT = WS_PTR(bf16_t, WS_WO) + (size_t)l * D * D; J.ncols = D; }
    else if (j < 15) { const int l = j - 11; J.W = c.in[I_WUP] + (size_t)l * D * DFF; J.ldw = DFF; J.gain = c.in[I_NMLPPRE] + l * D; J.WT = WS_PTR(bf16_t, WS_WUP) + (size_t)l * DFF * D; J.ncols = DFF; }
    else if (j < 19) { const int l = j - 15; J.W = c.in[I_WDN] + (size_t)l * DFF * D; J.ldw = D; J.K = DFF; J.WT = WS_PTR(bf16_t, WS_WDN) + (size_t)l * D * DFF; J.ncols = D; }
    else { const int l = j - 19; J.W = c.in[I_WMEMKV] + (size_t)l * D * 1024; J.ldw = 1024; J.gain = c.in[I_NMEM] + l * D; J.WT = WS_PTR(bf16_t, WS_WMEM); J.dst0 = l * 1024; J.ncols = 1024; }
    return J;
}
constexpr int NJOBS = 23;
__device__ __forceinline__ int job_items(const TJob& J) { return (J.K / 64) * (J.ncols / 32); }
__device__ __forceinline__ void transpose_item(const TJob& J, int item, LAS float* scr, int lane) {
    const int nblk = J.ncols / 32, kb = item / nblk, nb = item % nblk, k0 = 64 * kb, n0 = 32 * nb;
    float wv[32];
#pragma unroll
    for (int i = 0; i < 32; ++i) wv[i] = __builtin_nontemporal_load(J.W + (size_t)(k0 + 2 * i + (lane >> 5)) * J.ldw + J.src0 + n0 + (lane & 31));
#pragma unroll
    for (int i = 0; i < 32; ++i) { const int kk = 2 * i + (lane >> 5); float w = wv[i]; if (J.gain) w *= J.gain[k0 + kk]; scr[kk * 33 + (lane & 31)] = w; }
    asm volatile("s_waitcnt lgkmcnt(0)" ::: "memory");
    const int cc = lane & 7;
#pragma unroll
    for (int j = 0; j < 4; ++j) { const int n = (lane >> 3) + 8 * j; const LAS float* s = scr + (8 * cc) * 33 + n;
        u32x4 o; o.x = pk2(s[0 * 33], s[1 * 33]); o.y = pk2(s[2 * 33], s[3 * 33]); o.z = pk2(s[4 * 33], s[5 * 33]); o.w = pk2(s[6 * 33], s[7 * 33]);
        __builtin_nontemporal_store(o, (u32x4*)(J.WT + (size_t)(J.dst0 + n0 + n) * J.K + k0 + 8 * cc)); }
    asm volatile("s_waitcnt lgkmcnt(0)" ::: "memory");
}
constexpr unsigned JOBS_L0 = 0x3u | (1u << 7) | (1u << 11) | (1u << 15) | (0xfu << 19), JOBS_L1 = 0xcu | (1u << 8) | (1u << 12) | (1u << 16), JOBS_L2 = 0x30u | (1u << 9) | (1u << 13) | (1u << 17), JOBS_L3 = 0x40u | (1u << 10) | (1u << 14) | (1u << 18);
static_assert((JOBS_L0 | JOBS_L1 | JOBS_L2 | JOBS_L3) == (1u << 23) - 1 && (JOBS_L0 & JOBS_L1) == 0 && (JOBS_L2 & JOBS_L3) == 0 && ((JOBS_L0 | JOBS_L1) & (JOBS_L2 | JOBS_L3)) == 0, "every weight job in exactly one group");
__device__ __forceinline__ void ph_prep(CtxP cp, LAS unsigned char* lds, unsigned mask, int wg0, int nwg, int small) {
    CTX_LOAD(cp);
    const int bid_ = obid() - wg0, grid_ = nwg; const int tid = otid(), lane = tid & 63, wave = tid >> 6, gw = bid_ * 8 + wave, NGW = grid_ * 8;
    if (bid_ < 0) return;
    __syncthreads();
    LAS float* scr = (LAS float*)(lds + wave * 16384);
    int base = 0;
    for (int j = 0; j < NJOBS; ++j) { if (!((mask >> j) & 1u)) continue; const TJob J = get_job(c, j); const int n = job_items(J);
        int first = gw - (base % NGW); if (first < 0) first += NGW;
        for (int it = first; it < n; it += NGW) transpose_item(J, it, scr, lane);
        base += n; }
    if (!small) return;
    bf16_t* wskb = WS_PTR(bf16_t, WS_WSKB);
    for (int i = bid_ * 512 + tid; i < 3 * 32 * D; i += grid_ * 512) { const int var = i / (32 * D), r = (i / D) % 32, k = i % D; float v = 0.f;
        if (var < 2) { if (r < 24) v = c.in[I_WINA][(size_t)var * D * INA_W + (size_t)k * INA_W + 6144 + r] * c.in[I_NMIXPRE][var * D + k]; }
        else if (r < 12) v = c.in[I_WKVF][(size_t)k * KVF_W + 3072 + r] * c.in[I_NKV][k];
        wskb[i] = (bf16_t)(pk2(v, 0.f) & 0xffffu); }
}
__device__ __forceinline__ void ph_row2(CtxP cp, int src, int use_delta, int gidx, int gl, int write_y, int first = 0, int wg0 = 0, int nwg = 0) {
    CTX_LOAD(cp);
    const int bid_ = obid() - wg0, grid_ = nwg ? nwg : ogrid();
    if (bid_ < 0 || bid_ >= grid_) return; const int tid = otid(), lane = tid & 63, wave = tid >> 6, gw = bid_ * 8 + wave, NGW = grid_ * 8;
    float* X = WS_PTR(float, WS_X); bf16_t* XN = WS_PTR(bf16_t, WS_XN); const bf16_t* delta = WS_PTR(bf16_t, WS_DELTA); const float* gpost = use_delta ? c.in[gidx] + gl * D : nullptr;
    const int nrows = (src == 2) ? 1024 : M;
#define LD_DELTA(dst, mrow, j) do { const u32x2 t_ = __builtin_nontemporal_load((const u32x2*)(delta + (size_t)(mrow) * D + 4 * lane + 256 * (j))); dst = (f32x4){bflo(t_.x), bfhi(t_.x), bflo(t_.y), bfhi(t_.y)}; } while (0)
    const bool deal2 = (src == 0) && use_delta && (NGW == 2048);
    const int half_gw = gw >> 1, isA = !(gw & 1);
    const int nsteps = deal2 ? (isA ? 4 : 5) : (nrows + 2 * NGW - 1) / (2 * NGW);
    for (int st = 0; st < nsteps; ++st) {
        int m0, m1; bool two;
        if (deal2) { if (isA) { if (st == 0) { m0 = MP + half_gw; m1 = m0; two = false; } else { m0 = half_gw + 1024 * (2 * (st - 1)); m1 = m0 + 1024; two = true; } }
            else { m0 = 6144 + half_gw + 1024 * (2 * st); m1 = m0 + 1024; two = true; } }
        else { m0 = gw + st * 2 * NGW; if (m0 >= nrows) break; const int m1r = m0 + NGW; two = m1r < nrows; m1 = two ? m1r : m0; }
        const bool fromx = (src == 0) && !first;
        const float* xr0 = fromx ? X + (size_t)m0 * D : (src != 2) ? (m0 < MP ? c.in[I_XP] + (size_t)m0 * D : c.in[I_XS] + (size_t)(m0 - MP) * D) : c.in[I_MEMP] + (size_t)m0 * D;
        const float* xr1 = fromx ? X + (size_t)m1 * D : (src != 2) ? (m1 < MP ? c.in[I_XP] + (size_t)m1 * D : c.in[I_XS] + (size_t)(m1 - MP) * D) : c.in[I_MEMP] + (size_t)m1 * D;
        f32x4 v0[8], v1[8];
#pragma unroll
        for (int j = 0; j < 8; ++j) { v0[j] = __builtin_nontemporal_load((const f32x4*)(xr0 + 4 * lane + 256 * j)); v1[j] = two ? __builtin_nontemporal_load((const f32x4*)(xr1 + 4 * lane + 256 * j)) : v0[j]; }
        if (use_delta) { f32x4 d0[8], d1[8]; float s0 = 0.f, s1 = 0.f;
#pragma unroll
            for (int j = 0; j < 8; ++j) {
                if (m0 < MP) LD_DELTA(d0[j], m0, j);
                else { const float* sp = WS_PTR(float, WS_SLAB) + (size_t)(m0 - MP) * D + 4 * lane + 256 * j; d0[j] = *(const f32x4*)sp;
#pragma unroll
                    for (int s8 = 1; s8 < 8; ++s8) d0[j] = d0[j] + *(const f32x4*)(sp + (size_t)s8 * 1024 * D); }
                if (!two) d1[j] = d0[j];
                else if (m1 < MP) LD_DELTA(d1[j], m1, j);
                else { const float* sp = WS_PTR(float, WS_SLAB) + (size_t)(m1 - MP) * D + 4 * lane + 256 * j; d1[j] = *(const f32x4*)sp;
#pragma unroll
                    for (int s8 = 1; s8 < 8; ++s8) d1[j] = d1[j] + *(const f32x4*)(sp + (size_t)s8 * 1024 * D); }
                s0 += (d0[j].x * d0[j].x + d0[j].y * d0[j].y) + (d0[j].z * d0[j].z + d0[j].w * d0[j].w); s1 += (d1[j].x * d1[j].x + d1[j].y * d1[j].y) + (d1[j].z * d1[j].z + d1[j].w * d1[j].w); }
            const float r0 = rsqrtf(wave_sum_dpp(s0) * (1.f / D) + EPS), r1 = rsqrtf(wave_sum_dpp(s1) * (1.f / D) + EPS);
#pragma unroll
            for (int j = 0; j < 8; ++j) { const f32x4 g = *(const f32x4*)(gpost + 4 * lane + 256 * j); v0[j] = v0[j] + d0[j] * r0 * g; v1[j] = v1[j] + d1[j] * r1 * g; } }
        if (src == 0 && !write_y) {
#pragma unroll
            for (int j = 0; j < 8; ++j) { __builtin_nontemporal_store(v0[j], (f32x4*)(X + (size_t)m0 * D + 4 * lane + 256 * j)); if (two) __builtin_nontemporal_store(v1[j], (f32x4*)(X + (size_t)m1 * D + 4 * lane + 256 * j)); } }
        if (write_y) {
#pragma unroll
            for (int j = 0; j < 8; ++j) { __builtin_nontemporal_store(v0[j], (f32x4*)(c.out + O_YP + (size_t)m0 * D + 4 * lane + 256 * j)); if (two) __builtin_nontemporal_store(v1[j], (f32x4*)(c.out + O_YP + (size_t)m1 * D + 4 * lane + 256 * j)); }
            continue; }
        float q0 = 0.f, q1 = 0.f;
#pragma unroll
        for (int j = 0; j < 8; ++j) { q0 += (v0[j].x * v0[j].x + v0[j].y * v0[j].y) + (v0[j].z * v0[j].z + v0[j].w * v0[j].w); q1 += (v1[j].x * v1[j].x + v1[j].y * v1[j].y) + (v1[j].z * v1[j].z + v1[j].w * v1[j].w); }
        const float t0 = rsqrtf(wave_sum_dpp(q0) * (1.f / D) + EPS), t1 = rsqrtf(wave_sum_dpp(q1) * (1.f / D) + EPS);
        bf16_t* xn0 = ((src == 2) ? WS_PTR(bf16_t, WS_MEMN) : XN) + (size_t)m0 * D; bf16_t* xn1 = ((src == 2) ? WS_PTR(bf16_t, WS_MEMN) : XN) + (size_t)m1 * D;
#pragma unroll
        for (int j = 0; j < 8; ++j) { u32x2 w0, w1; w0.x = pk2(v0[j].x * t0, v0[j].y * t0); w0.y = pk2(v0[j].z * t0, v0[j].w * t0); w1.x = pk2(v1[j].x * t1, v1[j].y * t1); w1.y = pk2(v1[j].z * t1, v1[j].w * t1);
            *(u32x2*)(xn0 + 4 * lane + 256 * j) = w0; if (two) *(u32x2*)(xn1 + 4 * lane + 256 * j) = w1; }
    }
}
__device__ __forceinline__ void ph_skinny(CtxP cp, int var, LAS unsigned char* lds) {
    CTX_LOAD(cp);
    const int bid_ = obid(), grid_ = ogrid(); const int tid = otid(), lane = tid & 63, wave = tid >> 6, n16 = lane & 15, q = lane >> 4;
    const bf16_t* Wb = WS_PTR(bf16_t, WS_WSKB) + (size_t)var * 32 * D + (size_t)n16 * D + 8 * q + 256 * wave;
    bf16x8s wa[8], wb[8];
#pragma unroll
    for (int ks = 0; ks < 8; ++ks) { wa[ks] = *(const bf16x8s*)(Wb + 32 * ks); wb[ks] = *(const bf16x8s*)(Wb + (size_t)16 * D + 32 * ks); }
    LAS float* P = (LAS float*)lds;
    const bf16_t* xp = WS_PTR(bf16_t, WS_XN) + (size_t)n16 * D + 8 * q + 256 * wave;
    __syncthreads();
    bf16x8s xb[8];
#pragma unroll
    for (int ks = 0; ks < 8; ++ks) xb[ks] = *(const bf16x8s*)(xp + (size_t)(16 * bid_) * D + 32 * ks);
    int nt = 0;
    for (int rt = bid_; rt < M / 16; rt += grid_, ++nt) {
        bf16x8s xn[8]; const int rn = rt + grid_;
        if (rn < M / 16) {
#pragma unroll
            for (int ks = 0; ks < 8; ++ks) xn[ks] = *(const bf16x8s*)(xp + (size_t)(16 * rn) * D + 32 * ks); }
        else {
#pragma unroll
            for (int ks = 0; ks < 8; ++ks) xn[ks] = xb[ks]; }
        f32x4 a0 = {0.f, 0.f, 0.f, 0.f}, a1 = {0.f, 0.f, 0.f, 0.f};
#pragma unroll
        for (int ks = 0; ks < 8; ++ks) { a0 = __builtin_amdgcn_mfma_f32_16x16x32_bf16(wa[ks], xb[ks], a0, 0, 0, 0); a1 = __builtin_amdgcn_mfma_f32_16x16x32_bf16(wb[ks], xb[ks], a1, 0, 0, 0); }
        LAS float* pp = P + (size_t)((nt * 8 + wave) * 8) * 64 + lane;
#pragma unroll
        for (int i = 0; i < 4; ++i) { pp[i * 64] = a0[i]; pp[(4 + i) * 64] = a1[i]; }
#pragma unroll
        for (int ks = 0; ks < 8; ++ks) xb[ks] = xn[ks];
    }
    __syncthreads();
    const int cc = (wave < 4) ? 4 * q + wave : 16 + 4 * q + (wave - 4);
    for (int t = 0; t < nt; ++t) { const int m = 16 * (bid_ + t * grid_) + n16; float s = 0.f;
#pragma unroll
        for (int w = 0; w < 8; ++w) s += P[(size_t)((t * 8 + w) * 8 + wave) * 64 + lane];
        if (var < 2) {
            if (cc < 12) WS_PTR(float, WS_G)[(size_t)m * 12 + cc] = -exp_fast(c.in[I_ALOG][var * 12 + cc]) * softplus_fast(s + c.in[I_DTB][var * 12 + cc]);
            else if (cc < 24) WS_PTR(float, WS_BETA)[(size_t)m * 12 + (cc - 12)] = fast_sigmoid(s); }
        else if (cc < 12) { const float lf = -softplus_fast(-(s + c.in[I_BF][cc])); WS_PTR(float, WS_LOGF)[(size_t)m * 12 + cc] = lf;
            c.out[(m < MP ? O_PLOGF + (size_t)m * 12 : O_SLOGF + (size_t)(m - MP) * 12) + cc] = lf; } }
    __syncthreads();
}
__device__ __forceinline__ void ph_gdn_c(CtxP cp, int l) {
    CTX_LOAD(cp);
    const int bid_ = obid(), grid_ = ogrid(); const int tid = otid(), lane = tid & 63, wave = tid >> 6, gw = bid_ * 8 + wave, NGW = grid_ * 8, sub = lane >> 4, c8 = (lane & 15) * 8;
    const bf16_t* PROJ = WS_PTR(bf16_t, WS_PROJ); const bf16_t* Of = WS_PTR(bf16_t, WS_OF); bf16_t* ACT = WS_PTR(bf16_t, WS_ACT);
    const f32x4 g0 = *(const f32x4*)(c.in[I_GDNN] + l * HD + c8), g1 = *(const f32x4*)(c.in[I_GDNN] + l * HD + c8 + 4);
    for (int it = gw * 4 + sub; it < M * H; it += NGW * 4) { const int m = it / H, h = it % H;
        const u32x4 ou = __builtin_nontemporal_load((const u32x4*)(Of + (size_t)m * TOK + h * HD + c8));
        const f32x4 o0 = {bflo(ou.x), bfhi(ou.x), bflo(ou.y), bfhi(ou.y)}, o1 = {bflo(ou.z), bfhi(ou.z), bflo(ou.w), bfhi(ou.w)};
        const u32x4 zu = __builtin_nontemporal_load((const u32x4*)(PROJ + (size_t)m * PJ + QKV + h * HD + c8));
        float ss = (o0.x * o0.x + o0.y * o0.y) + (o0.z * o0.z + o0.w * o0.w) + (o1.x * o1.x + o1.y * o1.y) + (o1.z * o1.z + o1.w * o1.w);
        ss += __int_as_float(__builtin_amdgcn_update_dpp(0, __float_as_int(ss), 0x111, 0xf, 0xf, true)); ss += __int_as_float(__builtin_amdgcn_update_dpp(0, __float_as_int(ss), 0x112, 0xf, 0xf, true));
        ss += __int_as_float(__builtin_amdgcn_update_dpp(0, __float_as_int(ss), 0x114, 0xf, 0xf, true)); ss += __int_as_float(__builtin_amdgcn_update_dpp(0, __float_as_int(ss), 0x118, 0xf, 0xf, true));
        ss = lane_get(ss, lane | 15);
        const float r = rsqrtf(ss * (1.f / HD) + EPS);
        const float z0 = bflo(zu.x), z1 = bfhi(zu.x), z2 = bflo(zu.y), z3 = bfhi(zu.y), z4 = bflo(zu.z), z5 = bfhi(zu.z), z6 = bflo(zu.w), z7 = bfhi(zu.w);
        u32x4 w4; w4.x = pk2(o0.x * r * g0.x * (z0 * fast_sigmoid(z0)), o0.y * r * g0.y * (z1 * fast_sigmoid(z1))); w4.y = pk2(o0.z * r * g0.z * (z2 * fast_sigmoid(z2)), o0.w * r * g0.w * (z3 * fast_sigmoid(z3)));
        w4.z = pk2(o1.x * r * g1.x * (z4 * fast_sigmoid(z4)), o1.y * r * g1.y * (z5 * fast_sigmoid(z5))); w4.w = pk2(o1.z * r * g1.z * (z6 * fast_sigmoid(z6)), o1.w * r * g1.w * (z7 * fast_sigmoid(z7)));
        *(u32x4*)(ACT + (size_t)m * D + h * HD + c8) = w4; }
}
__device__ __forceinline__ float wave_scan_dpp(float v, int lane, float& total) {
    v += __int_as_float(__builtin_amdgcn_update_dpp(0, __float_as_int(v), 0x111, 0xf, 0xf, true));
    v += __int_as_float(__builtin_amdgcn_update_dpp(0, __float_as_int(v), 0x112, 0xf, 0xf, true));
    v += __int_as_float(__builtin_amdgcn_update_dpp(0, __float_as_int(v), 0x114, 0xf, 0xf, true));
    v += __int_as_float(__builtin_amdgcn_update_dpp(0, __float_as_int(v), 0x118, 0xf, 0xf, true));
    const int iv = __float_as_int(v);
    const float r0 = __int_as_float(__builtin_amdgcn_readlane(iv, 15)), r1 = __int_as_float(__builtin_amdgcn_readlane(iv, 31)), r2 = __int_as_float(__builtin_amdgcn_readlane(iv, 47)), r3 = __int_as_float(__builtin_amdgcn_readlane(iv, 63));
    const int row = lane >> 4; total = ((r0 + r1) + r2) + r3;
    return v + (row == 0 ? 0.f : row == 1 ? r0 : row == 2 ? r0 + r1 : (r0 + r1) + r2);
}
__device__ __forceinline__ void ph_cumsum(CtxP cp) {
    CTX_LOAD(cp);
    const int bid_ = obid(), grid_ = ogrid(); const int tid = otid(), lane = tid & 63, wave = tid >> 6, NGW = grid_ * 8;
    const float* LOGF = WS_PTR(float, WS_LOGF); float* CUMP = WS_PTR(float, WS_CUMP); float* CUMS = WS_PTR(float, WS_CUMS);
    for (int task = bid_ + grid_ * wave; task < 192 + 384; task += NGW) {
        const bool smp = task >= 192; int b, h, jb, n; float carry = 0.f;
        if (!smp) { const int seg = task / 48, ts = task % 48; b = ts / 12; h = ts % 12; jb = seg * 1024; n = jb + 1024; float ps = 0.f;
#pragma unroll 16
            for (int j = lane; j < jb; j += 64) ps += LOGF[(size_t)(b * 4096 + j) * 12 + h];
            carry = wave_sum_dpp(ps); }
        else { const int ts = task - 192; b = ts / 12; h = ts % 12; jb = 0; n = PAST + 32; }
        for (int j0 = jb; j0 < n; j0 += 1024) { float vv[16];
#pragma unroll
            for (int u = 0; u < 16; ++u) { const int j = j0 + 64 * u + lane; vv[u] = 0.f;
                if (j < n) vv[u] = !smp ? LOGF[(size_t)(b * 4096 + j) * 12 + h] : (j < PAST ? c.in[I_CLOGF][(size_t)(b * PAST + j) * 12 + h] : LOGF[(size_t)(MP + b * 32 + j - PAST) * 12 + h]); }
#pragma unroll
            for (int u = 0; u < 16; ++u) { const int j = j0 + 64 * u + lane; float tot; const float v = wave_scan_dpp(vv[u], lane, tot);
                if (j < n) { if (smp) CUMS[(size_t)(b * (PAST + 32) + j) * 12 + h] = carry + v; else { CUMP[(size_t)(b * 4096 + j) * 12 + h] = carry + v;
                        const float cr = (carry + v) * (1.f / SCALE); const unsigned c1 = pk2(cr, 0.f) & 0xffffu; const float r1 = cr - __uint_as_float(c1 << 16); const unsigned c2 = pk2(r1, 0.f) & 0xffffu;
                        const float r2 = r1 - __uint_as_float(c2 << 16); const unsigned c3 = pk2(r2, 0.f) & 0xffffu; const size_t o8 = ((size_t)(b * 12 + h) * 4096 + j) * 8;
                        u32x4 qv, kv; qv.x = c1 | (c2 << 16); qv.y = c3 | 0x3f800000u; qv.z = 0x3f803f80u; qv.w = 0u; kv.x = 0x3f803f80u; kv.y = 0x3f80u | ((c1 ^ 0x8000u) << 16); kv.z = (c2 ^ 0x8000u) | ((c3 ^ 0x8000u) << 16); kv.w = 0u;
                        *(u32x4*)(WS_PTR(bf16_t, WS_QX) + o8) = qv; *(u32x4*)(WS_PTR(bf16_t, WS_KX) + o8) = kv; } }
                carry += tot; } }
    }
}
typedef short bf16x8 __attribute__((ext_vector_type(8)));
typedef float f32x16 __attribute__((ext_vector_type(16)));
constexpr int GT_W = 0, GT_QG = 16384, GT_KG = 32768, GT_AT = 49152, GT_U = 57344, GT_BYTES = 73728;
constexpr int NTASK_P = 4 * 12 * 64, NTASK = NTASK_P + 384;
constexpr size_t WS_GDNBUF = WS_BIG;
static_assert((size_t)NTASK * GT_BYTES <= 306 * MiB, "GDNBUF must not reach WS_OF");
__device__ __forceinline__ int permpos(int x) { return (x & ~31) | (((x >> 2) & 3) << 3) | (((x >> 4) & 1) << 2) | (x & 3); }
__device__ __forceinline__ int crow32(int r, int hi) { return (r & 3) + 8 * (r >> 2) + 4 * hi; }
constexpr int L_KN = 0, L_QN = 17408, L_VBT = 34816, L_KBT = 53248, L_AS = 71680, L_TS = 88320, L_KGT = 97536, L_ATP = 113920, L_GS = 122112, L_BS = 122368, L_TD = 122624, L_CW = 131072;
#define LDS_BARRIER() do { asm volatile("s_waitcnt lgkmcnt(0)" ::: "memory"); __builtin_amdgcn_s_barrier(); asm volatile("" ::: "memory"); } while (0)
__device__ __forceinline__ void ph_gdn_prep(CtxP cp, int l, LAS unsigned char* lds) {
    CTX_LOAD(cp);
    const int bid_ = obid(), grid_ = ogrid(); const int tid0 = otid();
    const bf16_t* PROJ = WS_PTR(bf16_t, WS_PROJ); const float* cw = c.in[I_CONVW] + (size_t)l * 4 * QKV;
    LAS float* Gs = (LAS float*)(lds + L_GS); LAS float* Bs = (LAS float*)(lds + L_BS); LAS float* As = (LAS float*)(lds + L_AS);
    unsigned warm = 0u;
    for (int tk = bid_; tk < NTASK; tk += grid_) {
        asm volatile("" :: "v"(warm));
        int tid = tid0; asm volatile("" : "+v"(tid));
        const int lane = tid & 63, w = __builtin_amdgcn_readfirstlane(tid >> 6);
        int grp, b, h, ch, L, m0, t0;
        if (tk < NTASK_P) { grp = 0; ch = tk & 63; const int bh = tk >> 6; b = bh / 12; h = bh % 12; L = 64; t0 = ch * 64; m0 = b * 4096 + t0; }
        else { grp = 1; ch = 0; const int bh = tk - NTASK_P; b = bh / 12; h = bh % 12; L = 32; t0 = 0; m0 = MP + b * 32; }
        const int T = grp ? 32 : 4096, nb = grp ? 32 : 4;
        unsigned char* gb = c.ws + WS_GDNBUF + (size_t)tk * GT_BYTES;
        if (tid >= 128) { const int e4 = 4 * (tid - 128); *(LAS f32x4*)(lds + L_CW + e4 * 4) = *(const f32x4*)(cw + (size_t)((e4 >> 7) & 3) * QKV + (e4 >> 9) * TOK + h * HD + (e4 & 127)); }
        if (tid < 64) { const bool v = tid < L; float gv = v ? WS_PTR(float, WS_G)[(size_t)(m0 + tid) * 12 + h] : 0.f; const float bv = v ? WS_PTR(float, WS_BETA)[(size_t)(m0 + tid) * 12 + h] : 0.f;
#pragma unroll
            for (int o = 1; o < 64; o <<= 1) { const float n = lane_get(gv, lane - o); if (lane >= o) gv += n; }
            Gs[tid] = gv; Bs[tid] = bv; }
        LDS_BARRIER();
        const int r = tid >> 3, seg = tid & 7; const bool valid = r < L; const int t = t0 + r, m = m0 + r;
        const float gr = Gs[r], eg = expf(gr), egl = expf(Gs[63] - gr), bt = Bs[r]; const int pr = permpos(r);
#pragma unroll
        for (int pi = 0; pi < 3; ++pi) { const int part = (pi == 0) ? 1 : (pi == 1 ? 0 : 2);
            const int col0 = part * TOK + h * HD + 16 * seg; float y[16];
#pragma unroll
            for (int e = 0; e < 16; ++e) y[e] = 0.f;
            if (valid) {
#pragma unroll
                for (int jj = 0; jj < 4; ++jj) { const int tt = t - 3 + jj; float x[16];
                    if (tt >= 0) { const u32x4 a = *(const u32x4*)(PROJ + (size_t)(m - 3 + jj) * PJ + col0), bq = *(const u32x4*)(PROJ + (size_t)(m - 3 + jj) * PJ + col0 + 8);
                        x[0] = bflo(a.x); x[1] = bfhi(a.x); x[2] = bflo(a.y); x[3] = bfhi(a.y); x[4] = bflo(a.z); x[5] = bfhi(a.z); x[6] = bflo(a.w); x[7] = bfhi(a.w);
                        x[8] = bflo(bq.x); x[9] = bfhi(bq.x); x[10] = bflo(bq.y); x[11] = bfhi(bq.y); x[12] = bflo(bq.z); x[13] = bfhi(bq.z); x[14] = bflo(bq.w); x[15] = bfhi(bq.w); }
                    else if (grp) { const float* hp = c.in[I_SCONV] + (size_t)((l * 32 + b) * 3 + (3 + tt)) * QKV + col0;
#pragma unroll
                        for (int i = 0; i < 4; ++i) { const f32x4 a = *(const f32x4*)(hp + 4 * i); x[4 * i] = a.x; x[4 * i + 1] = a.y; x[4 * i + 2] = a.z; x[4 * i + 3] = a.w; } }
                    else {
#pragma unroll
                        for (int e = 0; e < 16; ++e) x[e] = 0.f; }
#pragma unroll
                    for (int i = 0; i < 4; ++i) { const f32x4 wv = *(const LAS f32x4*)(lds + L_CW + ((part * 4 + jj) * 128 + 16 * seg + 4 * i) * 4);
                        y[4 * i] += x[4 * i] * wv.x; y[4 * i + 1] += x[4 * i + 1] * wv.y; y[4 * i + 2] += x[4 * i + 2] * wv.z; y[4 * i + 3] += x[4 * i + 3] * wv.w; } }
                if (t >= T - 3) { const u32x4 a = *(const u32x4*)(PROJ + (size_t)m * PJ + col0), bq = *(const u32x4*)(PROJ + (size_t)m * PJ + col0 + 8);
                    float* dst = c.out + (grp ? O_SCONV : O_PCONV) + (size_t)((l * nb + b) * 3 + (t - (T - 3))) * QKV + col0;
                    *(f32x4*)(dst) = (f32x4){bflo(a.x), bfhi(a.x), bflo(a.y), bfhi(a.y)}; *(f32x4*)(dst + 4) = (f32x4){bflo(a.z), bfhi(a.z), bflo(a.w), bfhi(a.w)};
                    *(f32x4*)(dst + 8) = (f32x4){bflo(bq.x), bfhi(bq.x), bflo(bq.y), bfhi(bq.y)}; *(f32x4*)(dst + 12) = (f32x4){bflo(bq.z), bfhi(bq.z), bflo(bq.w), bfhi(bq.w)}; }
#pragma unroll
                for (int e = 0; e < 16; ++e) y[e] = y[e] * fast_sigmoid(y[e]);
            }
            if (part < 2) { float ss = 0.f;
#pragma unroll
                for (int e = 0; e < 16; ++e) ss += y[e] * y[e];
                ss += lane_get(ss, lane ^ 1); ss += lane_get(ss, lane ^ 2); ss += lane_get(ss, lane ^ 4);
                const float rn = rsqrtf(ss + EPS) * (part == 0 ? SCALE : 1.f);
#pragma unroll
                for (int e = 0; e < 16; ++e) y[e] *= rn;
                u32x4 p0, p1; p0.x = pk2(y[0], y[1]); p0.y = pk2(y[2], y[3]); p0.z = pk2(y[4], y[5]); p0.w = pk2(y[6], y[7]); p1.x = pk2(y[8], y[9]); p1.y = pk2(y[10], y[11]); p1.z = pk2(y[12], y[13]); p1.w = pk2(y[14], y[15]);
                const int dst = (part == 1 ? L_KN : L_QN) + r * 272 + seg * 32;
                *(LAS u32x4*)(lds + dst) = p0; *(LAS u32x4*)(lds + dst + 16) = p1; }
            if (part == 1) {
#pragma unroll
                for (int e = 0; e < 16; ++e) { const int col = 16 * seg + e;
                    *(LAS bf16_t*)(lds + L_KBT + col * 144 + (((r >> 3) ^ seg) << 4) + (r & 7) * 2) = (bf16_t)(pk2(bt * eg * y[e], 0.f) & 0xffffu);
                    *(LAS bf16_t*)(lds + L_KGT + col * 128 + (((pr >> 3) ^ seg) << 4) + (pr & 7) * 2) = (bf16_t)(pk2(egl * y[e], 0.f) & 0xffffu); } }
            else if (part == 0) {
#pragma unroll
                for (int q4 = 0; q4 < 4; ++q4) { u32x2 v2; v2.x = pk2(eg * y[4 * q4], eg * y[4 * q4 + 1]); v2.y = pk2(eg * y[4 * q4 + 2], eg * y[4 * q4 + 3]);
                    __builtin_nontemporal_store(v2, (u32x2*)(gb + GT_QG + r * 256 + (32 * (seg >> 1) + 8 * q4 + 4 * (seg & 1)) * 2)); } }
            else {
#pragma unroll
                for (int e = 0; e < 16; ++e) *(LAS bf16_t*)(lds + L_VBT + (16 * seg + e) * 144 + (((r >> 3) ^ seg) << 4) + (r & 7) * 2) = (bf16_t)(pk2(bt * y[e], 0.f) & 0xffffu); }
            __builtin_amdgcn_sched_barrier(0);
        }
        if (tid == 0) WS_PTR(float, WS_EGL)[tk] = expf(Gs[63]);
        { const int tkn = tk + grid_;
            if (tkn < NTASK && tid < 402) { int m0n, hn; if (tkn < NTASK_P) { const int bh = tkn >> 6; hn = bh % 12; m0n = (bh / 12) * 4096 + (tkn & 63) * 64; } else { const int bh = tkn - NTASK_P; hn = bh % 12; m0n = MP + (bh / 12) * 32; }
                const int row = tid / 6, rem = tid % 6; int mm = m0n - 3 + row; mm = mm < 0 ? 0 : (mm >= M ? M - 1 : mm);
                warm = *(const volatile unsigned*)(PROJ + (size_t)mm * PJ + (rem >> 1) * TOK + hn * HD + (rem & 1) * 64); } }
        LDS_BARRIER();
        { const int r32 = lane & 31, hi = lane >> 5;
            if (w < 6) { const int which = w / 3, tt3 = w % 3, ib = tt3 ? 1 : 0, jb = (tt3 == 2) ? 1 : 0; f32x16 acc = {};
                const int xoff = (which ? L_QN : L_KN) + (ib * 32 + r32) * 272 + hi * 16, koff = L_KN + (jb * 32 + r32) * 272 + hi * 16;
#pragma unroll
                for (int kk = 0; kk < 8; ++kk) { const bf16x8 a = *(const LAS bf16x8*)(lds + xoff + kk * 32), bq = *(const LAS bf16x8*)(lds + koff + kk * 32);
                    acc = __builtin_amdgcn_mfma_f32_32x32x16_bf16(a, bq, acc, 0, 0, 0); }
                const int j = jb * 32 + r32; const float gj = Gs[j]; const int pj = permpos(j);
#pragma unroll
                for (int rr = 0; rr < 16; ++rr) { const int i = ib * 32 + crow32(rr, hi); const float dec = expf(fminf(Gs[i] - gj, 0.f));
                    if (which == 0) As[i * 65 + j] = (i > j) ? Bs[i] * acc[rr] * dec : 0.f;
                    else *(LAS bf16_t*)(lds + L_ATP + i * 128 + pj * 2) = (bf16_t)(pk2((i >= j) ? acc[rr] * dec : 0.f, 0.f) & 0xffffu); } }
            else { const int j = 32 + r32;
#pragma unroll
                for (int rr = 0; rr < 16; ++rr) { const int i = crow32(rr, hi);
                    if (w == 6) As[i * 65 + j] = 0.f; else *(LAS bf16_t*)(lds + L_ATP + i * 128 + permpos(j) * 2) = (bf16_t)0; } } }
        LDS_BARRIER();
        if (w == 0) { const int blk = lane >> 5, col = lane & 31, r32 = col, hi = blk; float x[32];
            const LAS float* Asv = As + blk * (32 * 65 + 32); asm volatile("" : "+v"(Asv));
            LAS float* Td = (LAS float*)(lds + L_TD);
#pragma unroll
            for (int i = 0; i < 32; ++i) { float a = (col == i) ? 1.f : 0.f;
#pragma unroll
                for (int j = 0; j < i; ++j) a -= Asv[i * 65 + j] * x[j];
                x[i] = a; Td[blk * (32 * 33) + i * 33 + col] = a;
                *(LAS bf16_t*)(lds + L_TS + (blk * 32 + i) * 144 + (blk * 32 + col) * 2) = (bf16_t)(pk2(a, 0.f) & 0xffffu);
                if (blk) *(LAS bf16_t*)(lds + L_TS + i * 144 + (32 + col) * 2) = (bf16_t)0;
                if ((i & 7) == 7) __builtin_amdgcn_sched_barrier(0); }
            f32x16 acc = {};
#pragma unroll
            for (int s = 0; s < 16; ++s) acc = __builtin_amdgcn_mfma_f32_32x32x2f32(As[(32 + r32) * 65 + 2 * s + hi], Td[(2 * s + hi) * 33 + r32], acc, 0, 0, 0);
#pragma unroll
            for (int rr = 0; rr < 16; ++rr) Td[crow32(rr, hi) * 33 + r32] = acc[rr];
            f32x16 acc2 = {};
#pragma unroll
            for (int s = 0; s < 16; ++s) acc2 = __builtin_amdgcn_mfma_f32_32x32x2f32(Td[32 * 33 + r32 * 33 + 2 * s + hi], Td[(2 * s + hi) * 33 + r32], acc2, 0, 0, 0);
#pragma unroll
            for (int rr = 0; rr < 16; ++rr) *(LAS bf16_t*)(lds + L_TS + (32 + crow32(rr, hi)) * 144 + r32 * 2) = (bf16_t)(pk2(-acc2[rr], 0.f) & 0xffffu); }
        LDS_BARRIER();
        { const int r32 = lane & 31, hi = lane >> 5; const int src = (w < 4 ? L_VBT : L_KBT) + ((w & 3) * 32 + r32) * 144, sw = (((w & 3) * 32 + r32) >> 4) & 7;
#pragma unroll
            for (int ib = 0; ib < 2; ++ib) { f32x16 acc = {}; const int toff = L_TS + (ib * 32 + r32) * 144 + hi * 16;
#pragma unroll
                for (int kk = 0; kk < 4; ++kk) { if (kk < 2 * (ib + 1)) { const bf16x8 a = *(const LAS bf16x8*)(lds + toff + kk * 32), bq = *(const LAS bf16x8*)(lds + src + (((2 * kk + hi) ^ sw) << 4));
                        acc = __builtin_amdgcn_mfma_f32_32x32x16_bf16(a, bq, acc, 0, 0, 0); } }
                const int col = (w & 3) * 32 + r32;
                if (w < 4) {
#pragma unroll
                    for (int g = 0; g < 4; ++g) { u32x2 v2; v2.x = pk2(acc[4 * g], acc[4 * g + 1]); v2.y = pk2(acc[4 * g + 2], acc[4 * g + 3]);
                        *(LAS u32x2*)(lds + L_QN + col * 128 + (((4 * ib + g) ^ (col & 7)) << 4) + hi * 8) = v2; } }
                else { const int pc = permpos(col);
#pragma unroll
                    for (int rr = 0; rr < 16; ++rr) { const int i = ib * 32 + crow32(rr, hi); *(LAS bf16_t*)(lds + L_KN + i * 256 + pc * 2) = (bf16_t)(pk2(acc[rr], 0.f) & 0xffffu); } } } }
        LDS_BARRIER();
#pragma unroll
        for (int k = 0; k < 7; ++k) { const int u = tid + 512 * k; int lo, go;
            if (k < 2) { lo = L_KN + u * 16; go = GT_W + u * 16; } else if (k < 4) { const int uu = u - 1024, row = uu >> 3; lo = L_QN + row * 128 + (((uu & 7) ^ (row & 7)) << 4); go = GT_U + uu * 16; }
            else if (k < 6) { const int uu = u - 2048, row = uu >> 3; lo = L_KGT + row * 128 + (((uu & 7) ^ ((row >> 4) & 7)) << 4); go = GT_KG + uu * 16; } else { lo = L_ATP + (u - 3072) * 16; go = GT_AT + (u - 3072) * 16; }
            __builtin_nontemporal_store(*(const LAS u32x4*)(lds + lo), (u32x4*)(gb + go)); }
    }
}
constexpr int SC_W = 0, SC_QG = 17408, SC_KG = 34816, SC_AT = 53248, SC_BUF = 62464, SC_OS = 2 * SC_BUF;
__device__ __forceinline__ void ph_gdn_scan(CtxP cp, int l, LAS unsigned char* lds) {
    CTX_LOAD(cp);
    const int bid_ = obid(), grid_ = ogrid(); const int tid = otid(), lane = tid & 63, w = __builtin_amdgcn_readfirstlane(tid >> 6), m16 = lane & 15, q = lane >> 4;
    const float* EGL = WS_PTR(float, WS_EGL);
    const int nsmpwg = grid_ - 96;
    for (int it = 0;; ++it) {
        int grp, bh, half, nch, tk0;
        if (bid_ < 96) { if (it > 0) break; grp = 0; bh = bid_ >> 1; half = bid_ & 1; nch = 64; tk0 = bh * 64; }
        else { const int si = (bid_ - 96) + nsmpwg * it; if (si >= 768) break; grp = 1; bh = si >> 1; half = si & 1; nch = 1; tk0 = NTASK_P + bh; }
        const int b = bh / 12, h = bh % 12, m0 = grp ? MP + b * 32 : b * 4096;
        __syncthreads();
        if (w >= 4) {
            const int lt = tid - 256; u32x4 stA[14], stB[14];
#define SC_LOAD(ST, tk) do { const unsigned char* gsrc = c.ws + WS_GDNBUF + (size_t)(tk) * GT_BYTES; _Pragma("unroll") for (int k = 0; k < 14; ++k) ST[k] = __builtin_nontemporal_load((const u32x4*)(gsrc + (size_t)(lt + 256 * k) * 16)); } while (0)
#define SC_WRITE(ST, bufoff) do { _Pragma("unroll") for (int k = 0; k < 14; ++k) { const int u = lt + 256 * k; int lo; \
            if (k < 4) lo = SC_W + (u >> 4) * 272 + (u & 15) * 16; else if (k < 8) lo = SC_QG + ((u - 1024) >> 4) * 272 + (u & 15) * 16; \
            else if (k < 12) lo = SC_KG + ((u - 2048) >> 3) * 144 + (u & 7) * 16; else lo = SC_AT + ((u - 3072) >> 3) * 144 + (u & 7) * 16; \
            *(LAS u32x4*)(lds + (bufoff) + lo) = ST[k]; } } while (0)
            bf16_t* Ob = WS_PTR(bf16_t, WS_OF) + (size_t)m0 * TOK + h * HD + half * 64; const int nou = grp ? 256 : 512;
#define SC_OUT(ch_) do { _Pragma("unroll") for (int k = 0; k < 2; ++k) { const int u = lt + 256 * k; if (u < nou) \
                *(u32x4*)(Ob + (size_t)((ch_) * 64 + (u >> 3)) * TOK + (u & 7) * 8) = *(const LAS u32x4*)(lds + SC_OS + ((ch_) & 1) * 8192 + u * 16); } } while (0)
            SC_LOAD(stA, tk0); SC_WRITE(stA, 0);
            if (1 < nch) SC_LOAD(stA, tk0 + 1);
            if (2 < nch) SC_LOAD(stB, tk0 + 2);
            LDS_BARRIER();
            for (int ch = 0; ch < nch; ch += 2) {
                if (ch >= 1) SC_OUT(ch - 1);
                if (ch + 1 < nch) SC_WRITE(stA, ((ch + 1) & 1) * SC_BUF);
                if (ch + 3 < nch) SC_LOAD(stA, tk0 + ch + 3);
                LDS_BARRIER();
                if (ch + 1 < nch) {
                    SC_OUT(ch);
                    if (ch + 2 < nch) SC_WRITE(stB, ((ch + 2) & 1) * SC_BUF);
                    if (ch + 4 < nch) SC_LOAD(stB, tk0 + ch + 4);
                    LDS_BARRIER(); }
            }
            SC_OUT(nch - 1);
#undef SC_OUT
#undef SC_LOAD
#undef SC_WRITE
        } else {
            __builtin_amdgcn_s_setprio(2);
            const int c0 = half * 64 + 16 * w;
            f32x4 S[8];
            if (grp) { const float* S0 = c.in[I_SGDN] + (size_t)((l * 32 + b) * 12 + h) * 16384;
#pragma unroll
                for (int dt = 0; dt < 8; ++dt)
#pragma unroll
                    for (int i = 0; i < 4; ++i) S[dt][i] = S0[(16 * dt + 4 * q + i) * 128 + c0 + m16]; }
            else {
#pragma unroll
                for (int dt = 0; dt < 8; ++dt) S[dt] = (f32x4){0.f, 0.f, 0.f, 0.f}; }
            u32x2 un[4]; float egn;
#define UE_LOAD(tk_) do { const unsigned char* ut_ = c.ws + WS_GDNBUF + (size_t)(tk_) * GT_BYTES + GT_U + (c0 + m16) * 128 + 8 * q; \
            _Pragma("unroll") for (int mt = 0; mt < 4; ++mt) un[mt] = *(const u32x2*)(ut_ + 32 * mt); egn = EGL[tk_]; } while (0)
            UE_LOAD(tk0);
            LDS_BARRIER();
            for (int ch = 0; ch < nch; ++ch) { const int bo = (ch & 1) * SC_BUF; const int tk = tk0 + ch;
                u32x2 uc[4]; const float egl = egn;
#pragma unroll
                for (int mt = 0; mt < 4; ++mt) uc[mt] = un[mt];
                if (ch + 1 < nch) UE_LOAD(tk + 1);
                bf16x8 Sb[4];
#pragma unroll
                for (int ks = 0; ks < 4; ++ks) { u32x4 t4; t4.x = pk2(S[2 * ks][0], S[2 * ks][1]); t4.y = pk2(S[2 * ks][2], S[2 * ks][3]); t4.z = pk2(S[2 * ks + 1][0], S[2 * ks + 1][1]); t4.w = pk2(S[2 * ks + 1][2], S[2 * ks + 1][3]);
                    Sb[ks] = __builtin_bit_cast(bf16x8, t4); }
                f32x4 Vn[4], Out[4];
#pragma unroll
                for (int mt = 0; mt < 4; ++mt) { f32x4 a1 = {0.f, 0.f, 0.f, 0.f}, a2 = {0.f, 0.f, 0.f, 0.f};
#pragma unroll
                    for (int ks = 0; ks < 4; ++ks) { const bf16x8 aw = *(const LAS bf16x8*)(lds + bo + SC_W + (16 * mt + m16) * 272 + ks * 64 + q * 16), aq = *(const LAS bf16x8*)(lds + bo + SC_QG + (16 * mt + m16) * 272 + ks * 64 + q * 16);
                        a1 = __builtin_amdgcn_mfma_f32_16x16x32_bf16(aw, Sb[ks], a1, 0, 0, 0); a2 = __builtin_amdgcn_mfma_f32_16x16x32_bf16(aq, Sb[ks], a2, 0, 0, 0); }
                    const u32x2 uu = uc[mt];
                    Vn[mt] = (f32x4){bflo(uu.x) - a1[0], bfhi(uu.x) - a1[1], bflo(uu.y) - a1[2], bfhi(uu.y) - a1[3]}; Out[mt] = a2; }
                bf16x8 Vb[2];
#pragma unroll
                for (int ks = 0; ks < 2; ++ks) { u32x4 t4; t4.x = pk2(Vn[2 * ks][0], Vn[2 * ks][1]); t4.y = pk2(Vn[2 * ks][2], Vn[2 * ks][3]); t4.z = pk2(Vn[2 * ks + 1][0], Vn[2 * ks + 1][1]); t4.w = pk2(Vn[2 * ks + 1][2], Vn[2 * ks + 1][3]);
                    Vb[ks] = __builtin_bit_cast(bf16x8, t4); }
#pragma unroll
                for (int mt = 0; mt < 4; ++mt)
#pragma unroll
                    for (int ks = 0; ks < 2; ++ks) { const bf16x8 aa = *(const LAS bf16x8*)(lds + bo + SC_AT + (16 * mt + m16) * 144 + ks * 64 + q * 16);
                        Out[mt] = __builtin_amdgcn_mfma_f32_16x16x32_bf16(aa, Vb[ks], Out[mt], 0, 0, 0); }
#pragma unroll
                for (int dt = 0; dt < 8; ++dt) { S[dt] = S[dt] * egl;
#pragma unroll
                    for (int ks = 0; ks < 2; ++ks) { const bf16x8 ak = *(const LAS bf16x8*)(lds + bo + SC_KG + (16 * dt + m16) * 144 + ks * 64 + q * 16);
                        S[dt] = __builtin_amdgcn_mfma_f32_16x16x32_bf16(ak, Vb[ks], S[dt], 0, 0, 0); } }
#pragma unroll
                for (int mt = 0; mt < 4; ++mt)
#pragma unroll
                    for (int e = 0; e < 4; ++e) *(LAS bf16_t*)(lds + SC_OS + (ch & 1) * 8192 + (16 * mt + 4 * q + e) * 128 + (16 * w + m16) * 2) = (bf16_t)(pk2(Out[mt][e], 0.f) & 0xffffu);
                LDS_BARRIER();
            }
            float* So = c.out + (grp ? O_SGDN + (size_t)((l * 32 + b) * 12 + h) * 16384 : O_PGDN + (size_t)((l * 4 + b) * 12 + h) * 16384);
#pragma unroll
            for (int dt = 0; dt < 8; ++dt)
#pragma unroll
                for (int i = 0; i < 4; ++i) So[(16 * dt + 4 * q + i) * 128 + c0 + m16] = S[dt][i];
            __builtin_amdgcn_s_setprio(0);
#undef UE_LOAD
        }
    }
}
#undef LDS_BARRIER
#define XB_TMO      128
#define XB_XCNT(j)  (256  + 64 * (j))
#define XB_XSUB(j)  (1280 + 64 * (j))
#define XB_XGEN(j)  (2304 + 64 * (j))
#define XB_TOP      3328
#define XB_TOPGEN   3392
#define XCD_BAR_WORDS 3456
#define XB_SPIN_CAP (1u << 18)

__device__ __forceinline__ unsigned xb_ld(unsigned* p)              { return __hip_atomic_load(p, __ATOMIC_RELAXED, __HIP_MEMORY_SCOPE_AGENT); }
__device__ __forceinline__ unsigned xb_add(unsigned* p, unsigned v) { return __hip_atomic_fetch_add(p, v, __ATOMIC_RELAXED, __HIP_MEMORY_SCOPE_AGENT); }
__device__ __forceinline__ unsigned xb_xcc_id() { return (unsigned)__builtin_amdgcn_s_getreg((3 << 11) | 20) & 0xFu; }
#define XB_SPIN(cond, bar) do { unsigned _sp = 0; while (cond) { __builtin_amdgcn_s_sleep(1); \
    if ((++_sp & 255u) == 0u) { if (xb_ld(&(bar)[XB_TMO])) break; if (_sp > XB_SPIN_CAP) { atomicAdd(&(bar)[XB_TMO], 1u); break; } } } } while (0)
struct XcdBarrier {
    unsigned* bar; unsigned x;
    volatile LAS unsigned* st;
};

__device__ __forceinline__ XcdBarrier xcd_barrier_post(unsigned* bar, volatile LAS unsigned* st) {
    XcdBarrier b; b.bar = bar; b.x = xb_xcc_id(); b.st = st;
    if (threadIdx.x == 0) (void)xb_add(&bar[XB_XCNT(b.x)], 1u);
    return b;
}
__device__ __forceinline__ void xcd_barrier_complete(unsigned* bar, unsigned x, unsigned& nloc, unsigned& nx) {
    const unsigned G = gridDim.x * gridDim.y * gridDim.z;
    unsigned sum, cnt, mine, sp = 0u;
    for (;;) {
        sum = 0u; cnt = 0u; mine = 0u;
#pragma unroll
        for (unsigned j = 0; j < 16; ++j) { const unsigned c = xb_ld(&bar[XB_XCNT(j)]); sum += c; cnt += (c > 0u) ? 1u : 0u; mine = (j == x) ? c : mine; }
        if (sum == G) break;
        __builtin_amdgcn_s_sleep(1);
        if ((++sp & 255u) == 0u) { if (xb_ld(&bar[XB_TMO])) break; if (sp > XB_SPIN_CAP) { atomicAdd(&bar[XB_TMO], 1u); break; } }
    }
    nloc = mine > 0u ? mine : 1u; nx = cnt > 0u ? cnt : 1u;
}

__device__ __forceinline__ void xcd_barrier(const XcdBarrier& b, const bool leader  ) {
    asm volatile("s_waitcnt vmcnt(0)" ::: "memory");
    __syncthreads();
    if (leader) {
        unsigned* bar = b.bar;
        __builtin_amdgcn_s_waitcnt(0);
        unsigned nloc = b.st[0], nx = b.st[1];
        if (nloc == 0u) { xcd_barrier_complete(bar, b.x, nloc, nx); b.st[0] = nloc; b.st[1] = nx; }
        const unsigned old = xb_add(&bar[XB_XSUB(b.x)], 1u);
        const unsigned gen = old / nloc;
        if (old + 1u == (gen + 1u) * nloc) {
            __builtin_amdgcn_fence(__ATOMIC_RELEASE, "agent");
            asm volatile("s_waitcnt vmcnt(0)" ::: "memory");
            const unsigned og = xb_add(&bar[XB_TOP], 1u);
            const unsigned tg = og / nx;
            if (og + 1u == (tg + 1u) * nx) xb_add(&bar[XB_TOPGEN], 1u);
            else XB_SPIN(xb_ld(&bar[XB_TOPGEN]) == tg, bar);
            __builtin_amdgcn_fence(__ATOMIC_ACQUIRE, "agent");
            xb_add(&bar[XB_XGEN(b.x)], 1u);
            asm volatile("s_waitcnt vmcnt(0)" ::: "memory");
        } else {
            XB_SPIN(xb_ld(&bar[XB_XGEN(b.x)]) == gen, bar);
            __builtin_amdgcn_fence(__ATOMIC_ACQUIRE, "agent");
            asm volatile("s_waitcnt vmcnt(0)" ::: "memory");
        }
    }
    __syncthreads();
}
namespace fa {
constexpr int NW = 8, QBLK = 32, KVBLK = 64, QB = NW * QBLK, HDm = 128;
constexpr int SHM_V = KVBLK * HDm * 2, SHM_K = KVBLK * HDm * 2;
constexpr int LDS_BYTES = 2 * SHM_V + 2 * SHM_K + NW * 64 * 4;
constexpr float THR = 8.f;
constexpr int XOFF = LDS_BYTES + 64, XBUF = 2048;
typedef short s16x4 __attribute__((ext_vector_type(4)));
#define KSWZ(row, colB) ((row) * 256 + ((colB) ^ (((row) & 7) << 4)))
#define SBAR() __builtin_amdgcn_sched_barrier(0)
__device__ __forceinline__ int v_st(int k, int c) { const int kk = (k & ~0xC) | ((k & 4) << 1) | ((k & 8) >> 1); return ((kk >> 3) * 4 + (c >> 5)) * 512 + ((kk & 7) * 32 + (c & 31)) * 2; }
__device__ __forceinline__ int v_rd_base(int lane) { return ((lane & 3) << 3) | (((lane >> 2) & 3) << 6) | (((lane >> 4) & 1) << 5) | (((lane >> 5) & 1) << 8); }
constexpr int v_rd_off(int d0, int ks, int half) { return d0 * 512 + ks * 4096 + half * 2048; }
__device__ __forceinline__ int crow(int r, int hi) { return (r & 3) + 8 * (r >> 2) + 4 * hi; }
__device__ __forceinline__ unsigned cvtpk(float lo, float hi) { unsigned r; asm volatile("v_cvt_pk_bf16_f32 %0, %1, %2" : "=v"(r) : "v"(lo), "v"(hi)); return r; }
__device__ __forceinline__ bf16x8 load8(const bf16_t* p) { return *reinterpret_cast<const bf16x8*>(p); }
__device__ __forceinline__ void mask_tile(f32x16& p0, f32x16& p1, int dq, unsigned W) {
    const float NEG = -__builtin_inff();
#pragma unroll
    for (int r = 0; r < 16; ++r) { const int c = (r & 3) + 8 * (r >> 2);
        if ((unsigned)(dq - c) >= W) p0[r] = NEG;
        if ((unsigned)(dq - c - 32) >= W) p1[r] = NEG; }
}
__device__ __forceinline__ void partialSM(f32x16& p0, f32x16& p1, float& m_reg, float& mn, float& alpha) {
    float pmax = p0[0]; for (int r = 1; r < 16; ++r) pmax = fmaxf(pmax, p0[r]); for (int r = 0; r < 16; ++r) pmax = fmaxf(pmax, p1[r]);
    { auto rr = __builtin_amdgcn_permlane32_swap(__float_as_uint(pmax), __float_as_uint(pmax), false, false);
      pmax = fmaxf(__uint_as_float(rr[0]), __uint_as_float(rr[1])); }
    constexpr float C2 = 1.4426950408889634f * SCALE;
    if (__builtin_expect(__all((pmax - m_reg) * SCALE <= THR), 1)) { mn = m_reg; alpha = 1.f; }
    else { mn = fmaxf(m_reg, pmax); alpha = __builtin_amdgcn_exp2f((m_reg - mn) * C2); m_reg = mn; }
    const float mnL = -mn * C2;
    for (int r = 0; r < 16; ++r) p0[r] = fmaf(p0[r], C2, mnL); for (int r = 0; r < 16; ++r) p1[r] = fmaf(p1[r], C2, mnL);
    for (int r = 0; r < 16; ++r) p0[r] = __builtin_amdgcn_exp2f(p0[r]);
}
__device__ __forceinline__ void finishSM(f32x16& p0, f32x16& p1, float alpha, float& l_reg, bf16x8& pa0, bf16x8& pa1, bf16x8& pa2, bf16x8& pa3) {
    for (int r = 0; r < 16; ++r) p1[r] = __builtin_amdgcn_exp2f(p1[r]);
    float ps = 0; for (int r = 0; r < 16; ++r) ps += p0[r]; for (int r = 0; r < 16; ++r) ps += p1[r];
    { auto rr = __builtin_amdgcn_permlane32_swap(__float_as_uint(ps), __float_as_uint(ps), false, false);
      ps = __uint_as_float(rr[0]) + __uint_as_float(rr[1]); }
    l_reg = l_reg * alpha + ps;
#define PK4(P, B_, OUT) do { unsigned a0 = cvtpk(P[B_+0], P[B_+1]), a1 = cvtpk(P[B_+2], P[B_+3]);                          \
        unsigned b0 = cvtpk(P[B_+4], P[B_+5]), b1 = cvtpk(P[B_+6], P[B_+7]);                                             \
        auto r0 = __builtin_amdgcn_permlane32_swap(a0, b0, false, false); auto r1 = __builtin_amdgcn_permlane32_swap(a1, b1, false, false); \
        u32x4 w = {r0[0], r1[0], r0[1], r1[1]}; OUT = *reinterpret_cast<bf16x8*>(&w); } while (0)
    PK4(p0, 0, pa0); PK4(p0, 8, pa1); PK4(p1, 0, pa2); PK4(p1, 8, pa3);
#undef PK4
}
template <int KB, bool BIAS>
__device__ __forceinline__ void qkt(f32x16& p0, f32x16& p1, const char* K_lds, const char* X_lds, int r32, int hi, const bf16x8* qr, bf16x8 qx) {
    p0 = f32x16{}; p1 = f32x16{};
    const char* kb[4];
#pragma unroll
    for (int dd = 0; dd < 4; ++dd) kb[dd] = K_lds + KB * SHM_K + KSWZ(r32, (dd * 16 + hi * 8) * 2);
    if (BIAS) { const bf16x8 kx0 = *reinterpret_cast<const bf16x8*>(X_lds + KB * XBUF + r32 * 32 + hi * 16), kx1 = *reinterpret_cast<const bf16x8*>(X_lds + KB * XBUF + (32 + r32) * 32 + hi * 16);
        p0 = __builtin_amdgcn_mfma_f32_32x32x16_bf16(kx0, qx, p0, 0, 0, 0); p1 = __builtin_amdgcn_mfma_f32_32x32x16_bf16(kx1, qx, p1, 0, 0, 0); }
#pragma unroll
    for (int d0 = 0; d0 < 8; ++d0) { const char* a = kb[d0 & 3] + (d0 >> 2) * 128;
        bf16x8 b0 = *reinterpret_cast<const bf16x8*>(a);
        bf16x8 b1 = *reinterpret_cast<const bf16x8*>(a + 32 * 256);
        p0 = __builtin_amdgcn_mfma_f32_32x32x16_bf16(b0, qr[d0], p0, 0, 0, 0);
        p1 = __builtin_amdgcn_mfma_f32_32x32x16_bf16(b1, qr[d0], p1, 0, 0, 0); }
}
template <int VB>
__device__ __forceinline__ void pv_tile(f32x16* o, int vb0, bf16x8 pa0, bf16x8 pa1, bf16x8 pa2, bf16x8 pa3) {
#define TRRD(dst, off) asm volatile("ds_read_b64_tr_b16 %0, %1 offset:%2" : "=&v"(dst) : "v"(vb0), "i"(off) : "memory")
#define PV_D0(d0) do { s16x4 l0, l1, l2, l3, h0, h1, h2, h3; constexpr int b_ = VB * SHM_V + v_rd_off(d0, 0, 0); \
        TRRD(l0, b_); TRRD(h0, b_ + 2048); TRRD(l1, b_ + 4096); TRRD(h1, b_ + 6144); TRRD(l2, b_ + 8192); TRRD(h2, b_ + 10240); TRRD(l3, b_ + 12288); TRRD(h3, b_ + 14336); \
        asm volatile("s_waitcnt lgkmcnt(0)" ::: "memory"); SBAR();   \
        o[d0] = __builtin_amdgcn_mfma_f32_32x32x16_bf16(pa0, (bf16x8){l0[0], l0[1], l0[2], l0[3], h0[0], h0[1], h0[2], h0[3]}, o[d0], 0, 0, 0);   \
        o[d0] = __builtin_amdgcn_mfma_f32_32x32x16_bf16(pa1, (bf16x8){l1[0], l1[1], l1[2], l1[3], h1[0], h1[1], h1[2], h1[3]}, o[d0], 0, 0, 0);   \
        o[d0] = __builtin_amdgcn_mfma_f32_32x32x16_bf16(pa2, (bf16x8){l2[0], l2[1], l2[2], l2[3], h2[0], h2[1], h2[2], h2[3]}, o[d0], 0, 0, 0);   \
        o[d0] = __builtin_amdgcn_mfma_f32_32x32x16_bf16(pa3, (bf16x8){l3[0], l3[1], l3[2], l3[3], h3[0], h3[1], h3[2], h3[3]}, o[d0], 0, 0, 0); } while (0)
    PV_D0(0); PV_D0(1); PV_D0(2); PV_D0(3);
#undef PV_D0
#undef TRRD
}
struct Ref { int a, b, c; };
struct Seam { bf16x8 qr[8]; bf16x8 qx; bf16x8 st_v0, st_v1, st_k0, st_k1, st_kx; };
__device__ __forceinline__ int swa_jlo(int P0, int W) { const int lowk = P0 - W + 1; return lowk > 0 ? lowk / KVBLK : 0; }
#define ROW(p, k0, rr) ((p) + (size_t)((k0) + (rr)) * KP + sc)
#define VMW() asm volatile("s_waitcnt vmcnt(0)" ::: "memory")
#define VMWN(n) asm volatile("s_waitcnt vmcnt(%0)" :: "i"(n) : "memory")
#define SLOAD_H(Kp, Vp, k0) do { S.st_v0 = load8(ROW(Vp, k0, sr)); S.st_v1 = load8(ROW(Vp, k0, 32 + sr)); S.st_k0 = load8(ROW(Kp, k0, sr)); S.st_k1 = load8(ROW(Kp, k0, 32 + sr)); } while (0)
#define LOADKX(KXp, k0) do { if (BIAS && tid < 64) S.st_kx = load8((KXp) + (size_t)((k0) + tid) * 8); } while (0)
#define SWRITE_HK(bf) do { *(bf16x8*)(K_lds + (bf) * SHM_K + kws) = S.st_k0; *(bf16x8*)(K_lds + (bf) * SHM_K + kws + 32 * 256) = S.st_k1; if (BIAS && tid < 64) *(bf16x8*)(lds + XOFF + (bf) * XBUF + tid * 32) = S.st_kx; } while (0)
#define SWRITE_HV(bf) do { *(bf16x8*)(V_lds + (bf) * SHM_V + vst0) = S.st_v0; *(bf16x8*)(V_lds + (bf) * SHM_V + vst1) = S.st_v1; } while (0)
#define SWRITE_H(bf) do { SWRITE_HV(bf); SWRITE_HK(bf); } while (0)
template <class Lay>
__device__ __forceinline__ void prime(unsigned char* wsb, const Ref& cur, int W, char* lds, Seam& S, int tid) {
    constexpr int QP = Lay::QP, KP = Lay::KP; constexpr bool BIAS = Lay::BIAS;
    const int wid = __builtin_amdgcn_readfirstlane(tid >> 6), lane = tid & 63, r32 = lane & 31, hi = lane >> 5;
    const int sr = tid >> 4, sc = (tid & 15) * 8, kws = KSWZ(sr, sc * 2); char* K_lds = lds + 2 * SHM_V;
    const int kb0 = swa_jlo(Lay::p0(cur), W) * KVBLK; const bf16_t* Qc = Lay::q(wsb, cur);
#pragma unroll
    for (int d0 = 0; d0 < 8; ++d0) S.qr[d0] = load8(Qc + (size_t)(wid * QBLK + r32) * QP + d0 * 16 + hi * 8);
    S.qx = bf16x8{}; S.st_kx = bf16x8{};
    if (BIAS && tid < 128) { unsigned zz = 0u; asm volatile("" : "+v"(zz)); *(u32x4*)(lds + XOFF + (tid >> 6) * XBUF + (tid & 63) * 32 + 16) = (u32x4){zz, zz, zz, zz}; }
    if (BIAS) S.qx = load8(hi ? Lay::z(wsb) : Lay::qx(wsb, cur) + (size_t)(wid * QBLK + r32) * 8);
    { const bf16_t* Kc = Lay::k(wsb, cur); const bf16_t* Vc = Lay::v(wsb, cur); SLOAD_H(Kc, Vc, kb0); LOADKX(Lay::kx(wsb, cur), kb0); } VMW(); SWRITE_HK(0);
    __syncthreads();
}
template <class Lay>
__device__ __forceinline__ void block(unsigned char* wsb, const Ref& cur, const Ref& nxt, int skv, int W, char* lds, Seam& S, int tid) {
    asm volatile("" : "+v"(tid));
    constexpr int QP = Lay::QP, KP = Lay::KP, OP = Lay::OP; constexpr bool BIAS = Lay::BIAS, GATE = Lay::GATE; const int P0c = Lay::p0(cur);
    const int wid = __builtin_amdgcn_readfirstlane(tid >> 6), lane = tid & 63, r32 = lane & 31, hi = lane >> 5;
    const int j_lo = swa_jlo(P0c, W);
    int j_hi = (P0c + QB - 1) / KVBLK + 1; if (j_hi > skv / KVBLK) j_hi = skv / KVBLK;
    const int NT = j_hi - j_lo;
    const int kbn = swa_jlo(Lay::p0(nxt), W) * KVBLK;
    const int qlo = P0c + wid * QBLK, qm = qlo + r32 - 4 * hi;
    char* V_lds = lds; char* K_lds = lds + 2 * SHM_V;
    float* ws = (float*)(lds + 2 * SHM_V + 2 * SHM_K) + wid * 64; float* li_l = ws, * al_l = ws + 32;
    float m_reg = -1e30f, l_reg = 0; f32x16 o[4] = {};
    const int sr = tid >> 4, sc = (tid & 15) * 8, vst0 = v_st(sr, sc), vst1 = v_st(32 + sr, sc), kws = KSWZ(sr, sc * 2);
    const int vb0 = (int)(uintptr_t)V_lds + v_rd_base(lane);
    const bf16_t* Kh = Lay::k(wsb, cur); const bf16_t* Vh = Lay::v(wsb, cur); const bf16_t* KXh = Lay::kx(wsb, cur);
    const char* X_lds = lds + XOFF;
#define RESC(a) do { if (__any((a) < 1.f)) { if (hi == 0) al_l[r32] = (a); asm volatile("s_waitcnt lgkmcnt(0)" ::: "memory");              \
                     for (int d_ = 0; d_ < 4; ++d_) for (int r = 0; r < 16; ++r) o[d_][r] *= al_l[crow(r, hi)]; } } while (0)
#define KBASE(t) ((j_lo + (t)) * KVBLK)
#define MASKT(P0_, P1_, t) do { const int kb_ = KBASE(t); if (kb_ + KVBLK - 1 > qlo || kb_ <= qlo + QBLK - 1 - W) mask_tile(P0_, P1_, qm - kb_, (unsigned)W); } while (0)
    constexpr int NQL = BIAS ? 9 : 8;
#define SEAM_K0() do { VMWN(NQL); SWRITE_HK(0); SBAR(); } while (0)
    f32x16 pA0, pA1, pB0, pB1; float mnA, mnB, alA, alB; bf16x8 pa0, pa1, pa2, pa3;
    SWRITE_HV(0); SBAR();
    if (NT > 1) { SLOAD_H(Kh, Vh, KBASE(1)); LOADKX(KXh, KBASE(1)); }
    SBAR(); qkt<0, BIAS>(pA0, pA1, K_lds, X_lds, r32, hi, S.qr, S.qx);
    MASKT(pA0, pA1, 0); partialSM(pA0, pA1, m_reg, mnA, alA);
    if (NT > 1) { VMW(); SWRITE_H(1); }
    __syncthreads();
#define HALF_STEP(PX0, PX1, mnX, alX, PY0, PY1, alY, t, KB, VB, SB) do {                                                      \
        SBAR(); qkt<KB, BIAS>(PX0, PX1, K_lds, X_lds, r32, hi, S.qr, S.qx);                                             \
        finishSM(PY0, PY1, alY, l_reg, pa0, pa1, pa2, pa3); SBAR();                                                           \
        if ((t) + 1 < NT) { SLOAD_H(Kh, Vh, KBASE((t) + 1)); LOADKX(KXh, KBASE((t) + 1)); SBAR(); }               \
        pv_tile<VB>(o, vb0, pa0, pa1, pa2, pa3); MASKT(PX0, PX1, (t)); partialSM(PX0, PX1, m_reg, mnX, alX);                  \
        __syncthreads();                                                                                                      \
        if ((t) + 1 < NT) { VMW(); SWRITE_H(SB); }                                                                            \
        RESC(alX); __syncthreads(); } while (0)
    for (int t = 1; t + 1 < NT; t += 2) {
        HALF_STEP(pB0, pB1, mnB, alB, pA0, pA1, alA, t, 1, 0, 0);
        HALF_STEP(pA0, pA1, mnA, alA, pB0, pB1, alB, t + 1, 0, 1, 1);
    }
    const bool even = (NT & 1) == 0;
    if (even) { SBAR(); qkt<1, BIAS>(pB0, pB1, K_lds, X_lds, r32, hi, S.qr, S.qx); SBAR(); }
    { const bf16_t* Kn = Lay::k(wsb, nxt); const bf16_t* Vn = Lay::v(wsb, nxt); SLOAD_H(Kn, Vn, kbn); LOADKX(Lay::kx(wsb, nxt), kbn); } SBAR();
    { const bf16_t* Qn = Lay::q(wsb, nxt);
#pragma unroll
    for (int d0 = 0; d0 < 8; ++d0) S.qr[d0] = load8(Qn + (size_t)(wid * QBLK + r32) * QP + d0 * 16 + hi * 8); }
    if (BIAS) S.qx = load8(hi ? Lay::z(wsb) : Lay::qx(wsb, nxt) + (size_t)(wid * QBLK + r32) * 8);
    SBAR();
    finishSM(pA0, pA1, alA, l_reg, pa0, pa1, pa2, pa3); SBAR();
    pv_tile<0>(o, vb0, pa0, pa1, pa2, pa3);
    if (even) { MASKT(pB0, pB1, NT - 1); partialSM(pB0, pB1, m_reg, mnB, alB); __syncthreads(); RESC(alB);
        finishSM(pB0, pB1, alB, l_reg, pa0, pa1, pa2, pa3); SBAR(); pv_tile<1>(o, vb0, pa0, pa1, pa2, pa3); }
    SBAR(); SEAM_K0();
    if (hi == 0) li_l[r32] = l_reg; asm volatile("s_waitcnt lgkmcnt(0)" ::: "memory");
    float rli[16];
#pragma unroll
    for (int r = 0; r < 16; ++r) rli[r] = __builtin_amdgcn_rcpf(li_l[crow(r, hi)]);
    bf16_t* Ow = Lay::o(wsb, cur) + (size_t)(wid * QBLK) * OP; const bf16_t* Gw = Lay::g(wsb, cur) + (size_t)(wid * QBLK) * QP;
#pragma unroll
    for (int r = 0; r < 16; ++r) { const int orow = crow(r, hi);
#pragma unroll
        for (int d0 = 0; d0 < 4; ++d0) { const float v = o[d0][r] * rli[r];
            const float vn = lane_get(v, lane ^ 1);
            if ((r32 & 1) == 0) { float a = v, b = vn;
                if (GATE) { const unsigned gu = *(const unsigned*)(Gw + (size_t)orow * QP + d0 * 32 + r32); a *= fast_sigmoid(bflo(gu)); b *= fast_sigmoid(bfhi(gu)); }
                *(unsigned*)(Ow + (size_t)orow * OP + d0 * 32 + r32) = cvtpk(a, b); } } }
    __syncthreads();
#undef RESC
#undef KBASE
#undef MASKT
#undef SEAM_K0
#undef HALF_STEP
}
#undef ROW
#undef VMW
#undef VMWN
#undef SLOAD_H
#undef LOADKX
#undef SWRITE_HK
#undef SWRITE_HV
#undef SWRITE_H
#undef KSWZ
#undef SBAR
}
struct LayFox {
    static constexpr int QP = PJ, KP = TOK, OP = D; static constexpr bool BIAS = true, GATE = false;
    static __device__ __forceinline__ size_t row0(const fa::Ref& r) { return (size_t)(r.a / 12) * 4096 + r.b * 256; }
    static __device__ __forceinline__ int p0(const fa::Ref& r) { return r.b * 256; }
    static __device__ __forceinline__ const bf16_t* q(unsigned char* ws, const fa::Ref& r) { return (const bf16_t*)(ws + WS_PROJ) + row0(r) * PJ + (r.a % 12) * HD; }
    static __device__ __forceinline__ const bf16_t* g(unsigned char* ws, const fa::Ref& r) { return q(ws, r) + TOK; }
    static __device__ __forceinline__ const bf16_t* k(unsigned char* ws, const fa::Ref& r) { return (const bf16_t*)(ws + WS_KB) + (size_t)(r.a / 12) * 4096 * TOK + (r.a % 12) * HD; }
    static __device__ __forceinline__ const bf16_t* v(unsigned char* ws, const fa::Ref& r) { return (const bf16_t*)(ws + WS_VB) + (size_t)(r.a / 12) * 4096 * TOK + (r.a % 12) * HD; }
    static __device__ __forceinline__ bf16_t* o(unsigned char* ws, const fa::Ref& r) { return (bf16_t*)(ws + WS_ACT) + row0(r) * D + (r.a % 12) * HD; }
    static __device__ __forceinline__ const bf16_t* qx(unsigned char* ws, const fa::Ref& r) { return (const bf16_t*)(ws + WS_QX) + ((size_t)r.a * 4096 + r.b * 256) * 8; }
    static __device__ __forceinline__ const bf16_t* kx(unsigned char* ws, const fa::Ref& r) { return (const bf16_t*)(ws + WS_KX) + (size_t)r.a * 4096 * 8; }
    static __device__ __forceinline__ const bf16_t* z(unsigned char* ws) { return (const bf16_t*)(ws + WS_CTL + CTL_ZROW); }
};
__device__ __forceinline__ void fox_gate_block(unsigned char* ws, const fa::Ref& r, int tid) {
    asm volatile("s_waitcnt vmcnt(0)" ::: "memory"); __syncthreads();
    asm volatile("" : "+v"(tid));
    bf16_t* O = LayFox::o(ws, r); const bf16_t* G = LayFox::g(ws, r);
#pragma unroll
    for (int k = 0; k < 8; ++k) { const int u = tid + 512 * k, row = u >> 4, cu = (u & 15) * 8;
        const u32x4 ov = *(const u32x4*)(O + (size_t)row * D + cu), gv = __builtin_nontemporal_load((const u32x4*)(G + (size_t)row * PJ + cu)); u32x4 w;
        w.x = pk2(bflo(ov.x) * fast_sigmoid(bflo(gv.x)), bfhi(ov.x) * fast_sigmoid(bfhi(gv.x))); w.y = pk2(bflo(ov.y) * fast_sigmoid(bflo(gv.y)), bfhi(ov.y) * fast_sigmoid(bfhi(gv.y)));
        w.z = pk2(bflo(ov.z) * fast_sigmoid(bflo(gv.z)), bfhi(ov.z) * fast_sigmoid(bfhi(gv.z))); w.w = pk2(bflo(ov.w) * fast_sigmoid(bflo(gv.w)), bfhi(ov.w) * fast_sigmoid(bfhi(gv.w)));
        *(u32x4*)(O + (size_t)row * D + cu) = w; }
}
__device__ __forceinline__ void ph_fox_prompt(CtxP cp, int l, char* ldsg, LAS unsigned char* lds) {
    CTX_LOAD(cp);
    const int tid = otid();
    unsigned* qheads = (unsigned*)(c.ws + WS_CTL + CTL_QFOX) + 64 * 8 * l;
    LAS int* slot = (LAS int*)(lds + fa::LDS_BYTES);
    if (tid == 0) { slot[2] = (int)(xb_xcc_id() & 7u); slot[3] = 8; }
#define FOX_FETCH(dst, k) do { if (tid == 0) { int r_ = -1, myq_ = slot[2], qleft_ = slot[3]; while (qleft_ > 0) { const int i_ = (int)__hip_atomic_fetch_add(qheads + 64 * myq_, 1u, __ATOMIC_RELAXED, __HIP_MEMORY_SCOPE_AGENT); \
                if (i_ < 96) { r_ = ((i_ % 6) * 8 + myq_) * 16 + (15 - i_ / 6); break; } myq_ = (myq_ + 1) & 7; --qleft_; } slot[k] = r_; slot[2] = myq_; slot[3] = qleft_; } \
            __syncthreads(); dst = __builtin_amdgcn_readfirstlane(slot[k]); } while (0)
    int idx; FOX_FETCH(idx, 0);
    if (idx >= 0) {
        fa::Ref cur{idx >> 4, idx & 15, 0}, nxt; fa::Seam S;
        fa::prime<LayFox>(c.ws, cur, 1 << 29, ldsg, S, tid);
        for (int k = 1;; k ^= 1) {
            int nidx; FOX_FETCH(nidx, k);
            const bool more = nidx >= 0;
            if (more) nxt = fa::Ref{nidx >> 4, nidx & 15, 0}; else nxt = cur;
            fa::block<LayFox>(c.ws, cur, nxt, 4096, 1 << 29, ldsg, S, tid);
            fox_gate_block(c.ws, cur, tid);
            if (!more) break;
            cur = nxt;
        }
    }
#undef FOX_FETCH
}
struct LayMem {
    static constexpr int QP = PJ, KP = 4096, OP = D; static constexpr bool BIAS = false, GATE = false;
    static __device__ __forceinline__ size_t row0(const fa::Ref& r) { return (size_t)(r.a >> 2) * 4096 + r.b * 256; }
    static __device__ __forceinline__ int p0(const fa::Ref&) { return 256; }
    static __device__ __forceinline__ const bf16_t* q(unsigned char* ws, const fa::Ref& r) { return (const bf16_t*)(ws + WS_PROJ) + row0(r) * PJ + (r.c < 2 ? 6144 : 3072) + (r.a & 3) * HD; }
    static __device__ __forceinline__ const bf16_t* g(unsigned char* ws, const fa::Ref& r) { return q(ws, r); }
    static __device__ __forceinline__ const bf16_t* k(unsigned char* ws, const fa::Ref& r) { return (const bf16_t*)(ws + WS_MEMKVB) + (size_t)(r.a >> 2) * 256 * 4096 + r.c * 1024 + (r.a & 3) * HD; }
    static __device__ __forceinline__ const bf16_t* v(unsigned char* ws, const fa::Ref& r) { return k(ws, r) + 512; }
    static __device__ __forceinline__ bf16_t* o(unsigned char* ws, const fa::Ref& r) { return (bf16_t*)(ws + WS_ACT) + row0(r) * D + TOK + (r.a & 3) * HD; }
    static __device__ __forceinline__ const bf16_t* qx(unsigned char* ws, const fa::Ref& r) { return nullptr; }
    static __device__ __forceinline__ const bf16_t* kx(unsigned char* ws, const fa::Ref& r) { return nullptr; }
    static __device__ __forceinline__ const bf16_t* z(unsigned char* ws) { return nullptr; }
};
__device__ __forceinline__ void ph_mem_prompt(CtxP cp, int l, char* ldsg, int wg0, int nwg) {
    CTX_LOAD(cp);
    const int tid = otid(), bid_ = obid() - wg0, grid_ = nwg;
    int idx = bid_;
    if (idx >= 0 && idx < 256) {
        fa::Ref cur{idx >> 4, idx & 15, l}, nxt; fa::Seam S;
        fa::prime<LayMem>(c.ws, cur, 1 << 29, ldsg, S, tid);
        for (;;) {
            const int nidx = idx + grid_; const bool more = nidx < 256;
            if (more) nxt = fa::Ref{nidx >> 4, nidx & 15, l}; else nxt = cur;
            fa::block<LayMem>(c.ws, cur, nxt, 256, 1 << 29, ldsg, S, tid);
            if (!more) break;
            cur = nxt; idx = nidx;
        }
    }
}
constexpr int SF_REG = 16384, SF_AUX = 8 * SF_REG, SF_Q = SF_AUX + 8 * 512, SF_LDS = SF_Q + 32 * 272;
template <bool FOX>
__device__ __forceinline__ void ph_attn_sample(CtxP cp, int l, LAS unsigned char* lds, int wg0, int nwg) {
    CTX_LOAD(cp);
    const int bid_ = obid() - wg0, grid_ = nwg; const int tid0 = otid();
    if (bid_ < 0) return;
    constexpr int NH = FOX ? 12 : 4, NTASKS = 32 * NH, NTILE = FOX ? 65 : 8, KP = FOX ? TOK : MEMD, NPAST = FOX ? PAST : NMEM;
    constexpr float LOG2E = 1.4426950408889634f, C2 = LOG2E * SCALE;
    for (int task = bid_; task < NTASKS; task += grid_) {
        int tid = tid0; asm volatile("" : "+v"(tid));
        const int lane = tid & 63, w = __builtin_amdgcn_readfirstlane(tid >> 6), r32 = lane & 31, hi = lane >> 5;
        const int b = task / NH, h = task % NH;
        LAS unsigned char* T = lds + w * SF_REG; LAS float* aux = (LAS float*)(lds + SF_AUX + w * 512);
        const float* CUM = WS_PTR(float, WS_CUMS) + (size_t)b * (PAST + 32) * 12 + h;
        const float* Kc = (FOX ? c.in[I_CK] : c.in[I_CMK] + (size_t)l * 32 * NMEM * MEMD) + (size_t)b * NPAST * KP + h * HD; const float* Vc = (FOX ? c.in[I_CV] : c.in[I_CMV] + (size_t)l * 32 * NMEM * MEMD) + (size_t)b * NPAST * KP + h * HD;
        const int qcol = FOX ? h * HD : ((l < 2) ? 6144 : 3072) + h * HD, ocol = FOX ? h * HD : TOK + h * HD;
        float cq2 = 0.f; if (FOX) cq2 = CUM[(size_t)(PAST + r32) * 12] * LOG2E;
        float m_run = -1e30f, l_run = 0.f; f32x16 o[4] = {};
        f32x4 st[16];
        const int lrow = lane >> 5, lcol = (lane & 31) * 4;
        const unsigned voff = (unsigned)(lrow * KP + lcol) * 4u;
#define SF_LOAD(P, j0) do { const char* p_ = (const char*)((P) + (size_t)(j0) * KP);     \
        _Pragma("unroll") for (int i = 0; i < 16; ++i) st[i] = __builtin_nontemporal_load((const f32x4*)(p_ + (size_t)(2 * i) * KP * 4 + voff)); } while (0)
        __syncthreads();
        *(LAS u32x4*)(lds + SF_Q + (tid >> 4) * 272 + (tid & 15) * 16) = *(const u32x4*)(WS_PTR(bf16_t, WS_PROJ) + (size_t)(MP + b * 32 + (tid >> 4)) * PJ + qcol + (tid & 15) * 8);
        int t = w; SF_LOAD(Kc, 32 * t);
        __syncthreads();
        for (; t < NTILE; t += 8) { const bool isnew = FOX && (t == 64); const int j0 = 32 * t;
            if (!isnew) {
#pragma unroll
                for (int i = 0; i < 16; ++i) { u32x2 v2; v2.x = pk2(st[i].x, st[i].y); v2.y = pk2(st[i].z, st[i].w); *(LAS u32x2*)(T + (2 * i + lrow) * 272 + lcol * 2) = v2; }
                SF_LOAD(Vc, j0); }
            else { const char* kp = (const char*)(WS_PTR(bf16_t, WS_KB) + (size_t)(MP + b * 32) * TOK + h * HD);
                int ln = lane; asm volatile("" : "+v"(ln)); const int rw0 = ln >> 4, cc = (ln & 15) * 8; const unsigned vo = (unsigned)(rw0 * TOK + cc) * 2u;
#pragma unroll
                for (int i = 0; i < 8; ++i) *(LAS u32x4*)(T + (4 * i + rw0) * 272 + cc * 2) = *(const u32x4*)(kp + (size_t)(4 * i) * TOK * 2 + vo); }
            if (lane < 32) aux[lane] = FOX ? CUM[(size_t)(j0 + lane) * 12] * LOG2E : 0.f;
            f32x16 p = {};
#pragma unroll
            for (int d0 = 0; d0 < 8; ++d0) p = __builtin_amdgcn_mfma_f32_32x32x16_bf16(*(const LAS bf16x8*)(T + r32 * 272 + d0 * 32 + hi * 16), *(const LAS bf16x8*)(lds + SF_Q + r32 * 272 + d0 * 32 + hi * 16), p, 0, 0, 0);
            float pmax = -__builtin_inff();
#pragma unroll
            for (int g = 0; g < 4; ++g) { const f32x4 ck = *(const LAS f32x4*)(aux + 8 * g + 4 * hi);
#pragma unroll
                for (int e = 0; e < 4; ++e) { const int rr = 4 * g + e; float s = fmaf(p[rr], C2, cq2 - ck[e]);
                    if (isnew && (8 * g + 4 * hi + e) > r32) s = -__builtin_inff();
                    p[rr] = s; pmax = fmaxf(pmax, s); } }
            pmax = fmaxf(pmax, lane_get(pmax, lane ^ 32));
            const float mn = fmaxf(m_run, pmax), alpha = __builtin_amdgcn_exp2f(m_run - mn); m_run = mn;
            float ps = 0.f;
#pragma unroll
            for (int rr = 0; rr < 16; ++rr) { p[rr] = __builtin_amdgcn_exp2f(p[rr] - mn); ps += p[rr]; }
            ps += lane_get(ps, lane ^ 32); l_run = l_run * alpha + ps;
            bf16x8 pa0, pa1;
#define PK4(P, B_, OUT) do { unsigned a0 = pk2(P[B_+0], P[B_+1]), a1 = pk2(P[B_+2], P[B_+3]); unsigned b0 = pk2(P[B_+4], P[B_+5]), b1 = pk2(P[B_+6], P[B_+7]); \
            auto r0 = __builtin_amdgcn_permlane32_swap(a0, b0, false, false); auto r1 = __builtin_amdgcn_permlane32_swap(a1, b1, false, false); \
            u32x4 w4 = {r0[0], r1[0], r0[1], r1[1]}; OUT = __builtin_bit_cast(bf16x8, w4); } while (0)
            PK4(p, 0, pa0); PK4(p, 8, pa1);
#undef PK4
            if (hi == 0) aux[32 + r32] = alpha;
            if (!isnew) {
#pragma unroll
                for (int i = 0; i < 16; ++i) { const int key = 2 * i + lrow;
                    *(LAS bf16_t*)(T + (lcol + 0) * 80 + key * 2) = (bf16_t)(pk2(st[i].x, 0.f) & 0xffffu); *(LAS bf16_t*)(T + (lcol + 1) * 80 + key * 2) = (bf16_t)(pk2(st[i].y, 0.f) & 0xffffu);
                    *(LAS bf16_t*)(T + (lcol + 2) * 80 + key * 2) = (bf16_t)(pk2(st[i].z, 0.f) & 0xffffu); *(LAS bf16_t*)(T + (lcol + 3) * 80 + key * 2) = (bf16_t)(pk2(st[i].w, 0.f) & 0xffffu); }
                if (FOX && t + 8 < 64) SF_LOAD(Kc, j0 + 256); }
            else { const char* vp = (const char*)(WS_PTR(bf16_t, WS_VB) + (size_t)(MP + b * 32) * TOK + h * HD);
                int ln = lane; asm volatile("" : "+v"(ln)); const int rw0 = ln >> 4, cc = (ln & 15) * 8; const unsigned vo = (unsigned)(rw0 * TOK + cc) * 2u;
#pragma unroll
                for (int i = 0; i < 8; ++i) { const int rw = 4 * i + rw0; const u32x4 v4 = *(const u32x4*)(vp + (size_t)(4 * i) * TOK * 2 + vo);
                    *(LAS bf16_t*)(T + (cc + 0) * 80 + rw * 2) = (bf16_t)(v4.x & 0xffffu); *(LAS bf16_t*)(T + (cc + 1) * 80 + rw * 2) = (bf16_t)(v4.x >> 16);
                    *(LAS bf16_t*)(T + (cc + 2) * 80 + rw * 2) = (bf16_t)(v4.y & 0xffffu); *(LAS bf16_t*)(T + (cc + 3) * 80 + rw * 2) = (bf16_t)(v4.y >> 16);
                    *(LAS bf16_t*)(T + (cc + 4) * 80 + rw * 2) = (bf16_t)(v4.z & 0xffffu); *(LAS bf16_t*)(T + (cc + 5) * 80 + rw * 2) = (bf16_t)(v4.z >> 16);
                    *(LAS bf16_t*)(T + (cc + 6) * 80 + rw * 2) = (bf16_t)(v4.w & 0xffffu); *(LAS bf16_t*)(T + (cc + 7) * 80 + rw * 2) = (bf16_t)(v4.w >> 16); } }
            if (__any(alpha < 1.f)) {
#pragma unroll
                for (int g = 0; g < 4; ++g) { const f32x4 al = *(const LAS f32x4*)(aux + 32 + 8 * g + 4 * hi);
#pragma unroll
                    for (int e = 0; e < 4; ++e)
#pragma unroll
                        for (int db = 0; db < 4; ++db) o[db][4 * g + e] *= al[e]; } }
#pragma unroll
            for (int db = 0; db < 4; ++db) {
                o[db] = __builtin_amdgcn_mfma_f32_32x32x16_bf16(pa0, *(const LAS bf16x8*)(T + (db * 32 + r32) * 80 + hi * 16), o[db], 0, 0, 0);
                o[db] = __builtin_amdgcn_mfma_f32_32x32x16_bf16(pa1, *(const LAS bf16x8*)(T + (db * 32 + r32) * 80 + 32 + hi * 16), o[db], 0, 0, 0); }
        }
        asm volatile("s_waitcnt lgkmcnt(0)" ::: "memory");
#pragma unroll
        for (int db = 0; db < 4; ++db)
#pragma unroll
            for (int rr = 0; rr < 16; ++rr) *(LAS float*)(T + crow32(rr, hi) * 512 + (db * 32 + r32) * 4) = o[db][rr];
        if (hi == 0) { aux[64 + r32] = m_run; aux[96 + r32] = l_run; }
        __syncthreads();
        { const int qy = tid >> 4, d0 = (tid & 15) * 8; float M = -1e30f;
#pragma unroll
            for (int ww = 0; ww < 8; ++ww) M = fmaxf(M, *(const LAS float*)(lds + SF_AUX + ww * 512 + (64 + qy) * 4));
            float num[8] = {0.f, 0.f, 0.f, 0.f, 0.f, 0.f, 0.f, 0.f}, den = 0.f;
#pragma unroll
            for (int ww = 0; ww < 8; ++ww) { const float e = __builtin_amdgcn_exp2f(*(const LAS float*)(lds + SF_AUX + ww * 512 + (64 + qy) * 4) - M); den += e * *(const LAS float*)(lds + SF_AUX + ww * 512 + (96 + qy) * 4);
                const f32x4 a = *(const LAS f32x4*)(lds + ww * SF_REG + qy * 512 + d0 * 4), bq = *(const LAS f32x4*)(lds + ww * SF_REG + qy * 512 + d0 * 4 + 16);
                num[0] += e * a.x; num[1] += e * a.y; num[2] += e * a.z; num[3] += e * a.w; num[4] += e * bq.x; num[5] += e * bq.y; num[6] += e * bq.z; num[7] += e * bq.w; }
            const float inv = 1.f / den; const size_t row = (size_t)(MP + b * 32 + qy);
            u32x4 gv = {0x7f007f00u, 0x7f007f00u, 0x7f007f00u, 0x7f007f00u};
            if (FOX) gv = *(const u32x4*)(WS_PTR(bf16_t, WS_PROJ) + row * PJ + TOK + h * HD + d0);
            u32x4 ov;
            ov.x = pk2(num[0] * inv * fast_sigmoid(bflo(gv.x)), num[1] * inv * fast_sigmoid(bfhi(gv.x))); ov.y = pk2(num[2] * inv * fast_sigmoid(bflo(gv.y)), num[3] * inv * fast_sigmoid(bfhi(gv.y)));
            ov.z = pk2(num[4] * inv * fast_sigmoid(bflo(gv.z)), num[5] * inv * fast_sigmoid(bfhi(gv.z))); ov.w = pk2(num[6] * inv * fast_sigmoid(bflo(gv.w)), num[7] * inv * fast_sigmoid(bfhi(gv.w)));
            *(u32x4*)(WS_PTR(bf16_t, WS_ACT) + row * D + ocol + d0) = ov; }
#undef SF_LOAD
    }
}
constexpr int GEMM_LDS = pg8::STAGE_BYTES;
constexpr int LDS_BAR = 147456 - 256, LDS_BYTES = 147456;
static_assert(SF_LDS <= LDS_BAR && GEMM_LDS <= LDS_BAR, "LDS map");
constexpr size_t CTL_ZERO_BYTES = 65536;
__device__ __forceinline__ void ph_gemm(CtxP cp, int which, int l, LAS unsigned char* lds) {
    CTX_LOAD(cp);
    const bf16_t* A = WS_PTR(bf16_t, WS_XN); const bf16_t* Bt; int Mg = M, N, K = D, mode; bf16_t* o16 = nullptr; int ld16 = 0; float* o32 = nullptr; int ld32 = 0;
    if (which == 0) { A = WS_PTR(bf16_t, WS_MEMN); Bt = WS_PTR(bf16_t, WS_WMEM); Mg = 1024; N = 4096; mode = 4; }
    else if (which == 1) { Bt = (l < 2) ? WS_PTR(bf16_t, WS_WINA) + (size_t)l * 6656 * D : (l == 2 ? WS_PTR(bf16_t, WS_WINB0) : WS_PTR(bf16_t, WS_WINB1)); N = (l == 3) ? 3584 : 6656;
        mode = (l == 2) ? 3 : 0; o16 = WS_PTR(bf16_t, WS_PROJ); ld16 = PJ; }
    else if (which == 2) { A = WS_PTR(bf16_t, WS_ACT); Bt = WS_PTR(bf16_t, WS_WO) + (size_t)l * D * D; N = D; mode = 2; o16 = WS_PTR(bf16_t, WS_DELTA); ld16 = D; }
    else if (which == 3) { Bt = WS_PTR(bf16_t, WS_WUP) + (size_t)l * DFF * D; N = DFF; mode = 1; o16 = WS_PTR(bf16_t, WS_UP); ld16 = DFF; }
    else { A = WS_PTR(bf16_t, WS_UP); Bt = WS_PTR(bf16_t, WS_WDN) + (size_t)l * D * DFF; N = D; K = DFF; mode = 2; o16 = WS_PTR(bf16_t, WS_DELTA); ld16 = D; }
    const pg8::Gemm g{A, Bt, Mg, N, K};
    const pg8::Epi E{mode, o16, ld16, o32, ld32, c.ws, c.out, K / pg8::BK, (which == 1) ? (l < 2 ? 4608 : 0) : -1};
    pg8::TailSplit S; if (which == 0) S.init(g.M, g.N, g.K, 64, obid() - (ogrid() - 64), 0); else S.init(g.M, g.N, g.K, ogrid(), obid(), (which == 2 || which == 4) ? 1 : 0);
    pg8::gemm_phase<pg8::Epi, pg8::TailSplit, true, true>(lds, g, S, E, otid());
}
__global__ void __launch_bounds__(512, 2) fwd(Ctx carg) {
    CtxP c = (CtxP)((unsigned long long)__builtin_amdgcn_kernarg_segment_ptr() | (unsigned long long)__builtin_amdgcn_readfirstlane((int)(threadIdx.x >> 6)));
    extern __shared__ __attribute__((aligned(16))) unsigned char lds_raw[];
    LAS unsigned char* lds = (LAS unsigned char*)lds_raw;
    if (threadIdx.x < 4) ((LAS unsigned*)(lds + LDS_BAR))[threadIdx.x] = 0u;
    __syncthreads();
    const XcdBarrier bar = xcd_barrier_post((unsigned*)(((CtxP)((unsigned long long)c & ~7ull))->ws + WS_CTL), (volatile LAS unsigned*)(lds + LDS_BAR));
#define BAR() do { XcdBarrier b2_; b2_.bar = (unsigned*)(((CtxP)((unsigned long long)c & ~7ull))->ws + WS_CTL); b2_.st = bar.st; unsigned bx_ = bar.x; asm volatile("" : "+s"(bx_)); b2_.x = bx_; xcd_barrier(b2_, otid_cp(c) == 0); } while (0)
    ph_prep(c, lds, 0x3u | (0xfu << 19), 0, (int)gridDim.x, 1); ph_row2(c, 2, 0, 0, 0, 0); BAR();
    ph_row2(c, 1, 0, 0, 0, 0, 0, 0, (int)gridDim.x - 64); ph_gemm(c, 0, 0, lds); BAR();
    const bool upt = (gridDim.x == 256);
    for (int l = 0; l < 4; ++l) {
        if (l < 2) ph_skinny(c, l, lds);
        else if (l == 2) { ph_skinny(c, 2, lds); BAR(); ph_cumsum(c); }
        ph_gemm(c, 1, l, lds); BAR();
        if (l < 2) { ph_gdn_prep(c, l, lds); BAR(); ph_gdn_scan(c, l, lds);
            ph_prep(c, lds, upt ? (l == 0 ? (0xcu | (3u << 7) | (1u << 11) | (1u << 15)) : (0x70u | (3u << 9) | (1u << 16) | (1u << 17))) : (l == 0 ? (JOBS_L1 | (1u << 7) | (1u << 11) | (1u << 15)) : (JOBS_L2 | JOBS_L3)), 96, (int)gridDim.x - 96, 0);
            BAR(); ph_gdn_c(c, l); }
        if (l >= 2) { ph_attn_sample<true>(c, l, lds, 0, (int)gridDim.x); __syncthreads(); }
        ph_mem_prompt(c, l, (char*)lds_raw, 0, (int)gridDim.x); ph_attn_sample<false>(c, l, lds, 0, (int)gridDim.x);
        if (l >= 2) { __syncthreads(); ph_fox_prompt(c, l, (char*)lds_raw, lds); }
        BAR();
        ph_gemm(c, 2, l, lds); BAR();
        ph_row2(c, 0, 1, I_NMIXPOST, l, 0, l == 0); BAR();
        ph_gemm(c, 3, l, lds); if (upt) ph_prep(c, lds, l < 3 ? (1u << (12 + l)) : (1u << 18), 128, 128, 0); BAR();
        ph_gemm(c, 4, l, lds); BAR();
        ph_row2(c, 0, 1, I_NMLPPOST, l, l == 3);
        if (l < 3) BAR();
    }
#undef BAR
}
extern "C" void kernel_launch(void* const* d_in, const int* in_sizes, int n_in, void* d_out, int out_size, void* d_ws, size_t ws_size, hipStream_t stream) {
    static int grid = 0;
    if (grid == 0) {
        if (n_in != 28 || (size_t)out_size != O_END || ws_size < WS_END2) { fprintf(stderr, "kernel_launch: unexpected shapes: n_in %d out %d ws %zu (need %zu)\n", n_in, out_size, ws_size, (size_t)WS_END2); grid = -1; return; }
        int dev = 0, cus = 0, per_cu = 0;
        if (hipGetDevice(&dev) != hipSuccess || hipDeviceGetAttribute(&cus, hipDeviceAttributeMultiprocessorCount, dev) != hipSuccess) { grid = -1; return; }
        if (hipFuncSetAttribute((const void*)fwd, hipFuncAttributeMaxDynamicSharedMemorySize, LDS_BYTES) != hipSuccess) { fprintf(stderr, "kernel_launch: hipFuncSetAttribute failed\n"); grid = -1; return; }
        if (hipOccupancyMaxActiveBlocksPerMultiprocessor(&per_cu, (const void*)fwd, 512, LDS_BYTES) != hipSuccess || per_cu < 1) { fprintf(stderr, "kernel_launch: occupancy query says %d blocks per CU\n", per_cu); grid = -1; return; }
        (void)hipGetLastError();
        grid = cus;
    }
    if (grid < 0) return;
    (void)hipMemsetAsync((char*)d_ws + WS_CTL, 0, CTL_ZERO_BYTES, stream);
    Ctx c{}; for (int i = 0; i < 28; ++i) c.in[i] = (const float*)d_in[i]; c.out = (float*)d_out; c.ws = (unsigned char*)d_ws; c.ph_lo = 0; c.ph_hi = 0;
    hipLaunchKernelGGL(fwd, dim3(grid), dim3(512), LDS_BYTES, stream, c);
}
```

```cpp
#include <hip/hip_runtime.h>
#include <cstdio>
#include <cstdint>
namespace pg8 {
#define PG8_LAS __attribute__((address_space(3)))
typedef unsigned short bf16_t;
typedef short bf16x8 __attribute__((ext_vector_type(8)));
typedef float f32x4 __attribute__((ext_vector_type(4)));
typedef unsigned u32x4 __attribute__((ext_vector_type(4)));
constexpr int BM = 256, BK = 64, HALF = 128, HTB = HALF * BK * 2  , STAGE_BYTES = 8 * HTB, NXCD = 8, WGM = 4;

__host__ __device__ __forceinline__ int lds_byte(int r, int c) { const int st = (r >> 4) * 2 + (c >> 5), rr = r & 15, cc = c & 31, ob = rr * 64 + cc * 2; return st * 1024 + (ob ^ (((ob >> 9) & 1) << 5)); }
__host__ __device__ __forceinline__ void stage_rc(int b, int& R, int& C) { const int st = b / 1024, sb = b % 1024, swz = sb ^ (((sb >> 9) & 1) << 5); R = (st >> 1) * 16 + swz / 64; C = (st & 1) * 32 + (swz % 64) / 2; }
__host__ __device__ __forceinline__ int perm32(int rho) { const int n = rho >> 4, i = rho & 15; return 8 * (i >> 2) + 4 * n + (i & 3); }

struct Unit { int pm, pn, kt0, nt, ks; };
struct Gemm { const bf16_t* A; const bf16_t* Bt; int M, N, K; };

struct StaticOrder {
    int nM, nN, nwg, G, c, ntf;
    __host__ __device__ void init(int M, int N, int K, int G_, int c_) { nM = M / BM; nN = N / BM; nwg = nM * nN; G = G_; c = c_; ntf = K / BK; }
    __host__ __device__ bool next(int i, Unit& u) const {
        const long L = (long)i * G + c; if (L >= nwg) return false;
        int wgid = (int)L; { const int q = nwg / NXCD, r = nwg % NXCD, xcd = wgid % NXCD, off = wgid / NXCD; wgid = (xcd < r ? xcd * (q + 1) : r * (q + 1) + (xcd - r) * q) + off; }
        const int nig = WGM * nN, gid = wgid / nig, fm = gid * WGM, gsz = (nM - fm) < WGM ? (nM - fm) : WGM;
        u.pm = fm + ((wgid % nig) % gsz); u.pn = (wgid % nig) / gsz; u.kt0 = 0; u.nt = ntf; u.ks = 0; return true;
    }
    __device__ __forceinline__ void a_ready(const Unit&) const {}
    __device__ __forceinline__ void done(const Unit&) const {}
};

__device__ __forceinline__ unsigned cvt_pk_bf16(float lo, float hi) { unsigned r; asm volatile("v_cvt_pk_bf16_f32 %0, %1, %2" : "=v"(r) : "v"(lo), "v"(hi)); return r; }
}
#define LAS __attribute__((address_space(3)))
typedef unsigned short bf16_t;
typedef float f32x4 __attribute__((ext_vector_type(4)));
typedef unsigned u32x4 __attribute__((ext_vector_type(4)));
typedef unsigned u32x2 __attribute__((ext_vector_type(2)));
constexpr int D = 2048, MP = 16384, MS = 1024, M = MP + MS;
constexpr int H = 12, HD = 128, TOK = 1536, QKV = 4608, MEMD = 512, MH = 4, NMEM = 256, DFF = 8192, PAST = 2048;
constexpr int INA_W = 6680, INB_W = 3584, KVF_W = 3084;
constexpr int PJ = 6656;
constexpr float EPS = 1e-6f, SCALE = 0.08838834764831845f;
constexpr size_t O_YP = 0, O_YS = O_YP + (size_t)MP * D, O_PGDN = O_YS + (size_t)MS * D, O_PCONV = O_PGDN + (size_t)2 * 4 * 12 * 16384, O_PK = O_PCONV + (size_t)2 * 4 * 3 * 4608,
    O_PV = O_PK + (size_t)MP * TOK, O_PLOGF = O_PV + (size_t)MP * TOK, O_PMK = O_PLOGF + (size_t)MP * 12, O_PMV = O_PMK + (size_t)4 * 4 * 256 * 512, O_SGDN = O_PMV + (size_t)4 * 4 * 256 * 512,
    O_SCONV = O_SGDN + (size_t)2 * 32 * 12 * 16384, O_SK = O_SCONV + (size_t)2 * 32 * 3 * 4608, O_SV = O_SK + (size_t)MS * TOK, O_SLOGF = O_SV + (size_t)MS * TOK, O_END = O_SLOGF + (size_t)MS * 12;
static_assert(O_END == 108683264, "output size");
constexpr size_t MiB = 1u << 20;
constexpr size_t WS_CTL = 0, WS_WINA = 1 * MiB, WS_WINB0 = 53 * MiB, WS_WINB1 = 79 * MiB, WS_WO = 93 * MiB, WS_WUP = 125 * MiB, WS_WDN = 253 * MiB, WS_WMEM = 381 * MiB, WS_WSK = 397 * MiB,
    WS_X = 398 * MiB, WS_XN = 534 * MiB, WS_PROJ = 602 * MiB, WS_ACT = 823 * MiB, WS_DELTA = 891 * MiB, WS_KB = 1027 * MiB, WS_VB = 1078 * MiB, WS_G = 1129 * MiB, WS_BETA = 1130 * MiB,
    WS_LOGF = 1131 * MiB, WS_CUMP = 1132 * MiB, WS_CUMS = 1133 * MiB, WS_MEMN = 1137 * MiB, WS_BIG = 1141 * MiB, WS_QF = WS_BIG, WS_KF = WS_BIG + 102 * MiB, WS_VF = WS_BIG + 204 * MiB,
    WS_OF = WS_BIG + 306 * MiB, WS_UP = WS_BIG, WS_END = WS_BIG + 408 * MiB,
    WS_EGL = WS_END, WS_QX = WS_EGL + 1 * MiB, WS_KX = WS_QX + 3 * MiB, WS_MEMKVB = WS_KX + 3 * MiB, WS_WSKB = WS_MEMKVB + 8 * MiB, WS_END2 = WS_WSKB + 1 * MiB;
constexpr size_t WS_SLAB = WS_PROJ;
constexpr size_t CTL_ZROW = 61440, CTL_QFOX = 32768;
static_assert((size_t)6656 * 2048 * 2 == 26 * MiB && (size_t)M * D * 4 == 136 * MiB && (size_t)M * PJ * 2 == 221 * MiB && (size_t)M * TOK * 2 == 51 * MiB && (size_t)M * TOK * 4 == 102 * MiB && (size_t)M * DFF * 2 == 272 * MiB, "sizes");

struct Ctx { const float* in[28]; float* out; unsigned char* ws; int ph_lo, ph_hi; };
typedef const __attribute__((address_space(4))) Ctx* CtxP;
__device__ __forceinline__ int otid_cp(CtxP cp) {
#if defined(__HIP_DEVICE_COMPILE__)
    unsigned long long a = (unsigned long long)cp; asm volatile("" : "+s"(a));
    int ln; asm volatile("v_mbcnt_lo_u32_b32 %0, -1, 0\n\tv_mbcnt_hi_u32_b32 %0, -1, %0" : "=v"(ln));
    return (int)((unsigned)a & 7u) * 64 + ln;
#else
    (void)cp; return 0;
#endif
}
#define otid() otid_cp(cp)
__device__ __forceinline__ int obid() { int b = blockIdx.x; asm volatile("" : "+s"(b)); return b; }
__device__ __forceinline__ int ogrid() { int g = gridDim.x; asm volatile("" : "+s"(g)); return g; }
__device__ __forceinline__ Ctx ctx_load(CtxP cp) {
#if defined(__HIP_DEVICE_COMPILE__)
    asm volatile("" : "+s"(cp)); cp = (CtxP)((unsigned long long)cp & ~7ull); Ctx r; __builtin_memcpy(&r, cp, sizeof(Ctx)); return r;
#else
    (void)cp; return Ctx{};
#endif
}
#define CTX_LOAD(cp) const Ctx c = ctx_load(cp)
enum { I_XP = 0, I_XS, I_SGDN, I_SCONV, I_CK, I_CV, I_CLOGF, I_CMK, I_CMV, I_MEMP, I_NMIXPRE, I_NMIXPOST, I_NMLPPRE, I_NMLPPOST, I_WINA, I_CONVW, I_ALOG, I_DTB, I_GDNN, I_WINB, I_NKV, I_WKVF, I_BF, I_NMEM, I_WMEMKV, I_WO, I_WUP, I_WDN };

__device__ __forceinline__ float bf2f(bf16_t b) { return __uint_as_float(((unsigned)b) << 16); }
__device__ __forceinline__ float bflo(unsigned u) { return __uint_as_float(u << 16); }
__device__ __forceinline__ float bfhi(unsigned u) { return __uint_as_float(u & 0xffff0000u); }
__device__ __forceinline__ unsigned pk2(float lo, float hi) { return pg8::cvt_pk_bf16(lo, hi); }
__device__ __forceinline__ float lane_get(float v, int src_lane) { return __int_as_float(__builtin_amdgcn_ds_bpermute(src_lane << 2, __float_as_int(v))); }
__device__ __forceinline__ float wave_sum(float v, int lane) {
#pragma unroll
    for (int o = 1; o < 64; o <<= 1) v += lane_get(v, lane ^ o);
    return v; }
__device__ __forceinline__ float wave_max(float v, int lane) {
#pragma unroll
    for (int o = 1; o < 64; o <<= 1) v = fmaxf(v, lane_get(v, lane ^ o));
    return v; }
__device__ __forceinline__ float wave_sum_dpp(float v) {
    v += __int_as_float(__builtin_amdgcn_update_dpp(0, __float_as_int(v), 0x111, 0xf, 0xf, true));
    v += __int_as_float(__builtin_amdgcn_update_dpp(0, __float_as_int(v), 0x112, 0xf, 0xf, true));
    v += __int_as_float(__builtin_amdgcn_update_dpp(0, __float_as_int(v), 0x114, 0xf, 0xf, true));
    v += __int_as_float(__builtin_amdgcn_update_dpp(0, __float_as_int(v), 0x118, 0xf, 0xf, true));
    const int iv = __float_as_int(v);
    return (__int_as_float(__builtin_amdgcn_readlane(iv, 15)) + __int_as_float(__builtin_amdgcn_readlane(iv, 31))) + (__int_as_float(__builtin_amdgcn_readlane(iv, 47)) + __int_as_float(__builtin_amdgcn_readlane(iv, 63)));
}
__device__ __forceinline__ float sigmoidf_(float x) { return 1.f / (1.f + expf(-x)); }
__device__ __forceinline__ float softplusf_(float x) { return fmaxf(x, 0.f) + log1pf(expf(-fabsf(x))); }
__device__ __forceinline__ float softplus_fast(float x) { return fmaxf(x, 0.f) + 0.6931471805599453f * __builtin_amdgcn_logf(1.f + __builtin_amdgcn_exp2f(-1.4426950408889634f * fabsf(x))); }
__device__ __forceinline__ float fast_sigmoid(float x) { return __builtin_amdgcn_rcpf(1.f + __builtin_amdgcn_exp2f(-1.4426950408889634f * x)); }
__device__ __forceinline__ float exp_fast(float x) { return __builtin_amdgcn_exp2f(1.4426950408889634f * x); }
struct RowInfo { int grp, b, t, T, nb; };
__device__ __forceinline__ RowInfo rowinfo(int m) { RowInfo r; if (m < MP) { r.grp = 0; r.b = m >> 12; r.t = m & 4095; r.T = 4096; r.nb = 4; } else { const int ms = m - MP; r.grp = 1; r.b = ms >> 5; r.t = ms & 31; r.T = 32; r.nb = 32; } return r; }
namespace pg8 {
struct Epi {
    static constexpr bool PERM = true, AFTER_DRAIN = false;
    int mode;
    bf16_t* o16; int ld16; float* o32; int ld32;
    unsigned char* ws; float* out;
    int ntfull;
    int ntcol;
    __device__ __forceinline__ void operator()(const f32x4 (&acc)[2][2][4][2], const Unit& u, int wr, int wc, int fr, int fq) const {
        const int row0 = u.pm * BM + wr * 64 + fr, colt = u.pn * BM, cl = wc * 32 + 8 * fq;
        bf16_t* d16 = nullptr; size_t l16 = 0; float* d32 = nullptr; size_t l32 = 0; int radj = 0; const bool sq = (mode == 1);
        bool nt16 = false;
        if (mode == 0 || mode == 1) { d16 = o16 + colt; l16 = (size_t)ld16; nt16 = (mode == 0) && (ntcol >= 0) && (colt >= ntcol); }
        else if (mode == 2) {
            if (u.nt != ntfull) { d32 = (float*)(ws + WS_SLAB) + (size_t)u.ks * 1024 * 2048 + colt; l32 = 2048; radj = 16384; }
            else { d16 = o16 + colt; l16 = (size_t)ld16; } }
        else if (mode == 3) {
            if (colt < 3584) { d16 = o16 + colt; l16 = (size_t)ld16; nt16 = true; }
            else { const bool isv = colt >= 5120; const int cc = colt - (isv ? 5120 : 3584); const bool smp = u.pm >= 64;
                d16 = (bf16_t*)(ws + (isv ? WS_VB : WS_KB)) + cc; l16 = 1536; d32 = out + (smp ? (isv ? O_SV : O_SK) : (isv ? O_PV : O_PK)) + cc; l32 = 1536; radj = smp ? 16384 : 0; }
        } else { const int l = colt >> 10, within = colt & 1023; d32 = out + ((within >= 512) ? O_PMV : O_PMK) + (size_t)l * 1024 * 512 + (within & 511); l32 = 512;  d16 = (bf16_t*)(ws + WS_MEMKVB) + colt; l16 = 4096; }
#pragma unroll
        for (int ai = 0; ai < 2; ++ai)
#pragma unroll
            for (int m = 0; m < 4; ++m) { const int row = row0 + ai * HALF + m * 16;
#pragma unroll
                for (int bj = 0; bj < 2; ++bj) { f32x4 v0 = acc[ai][bj][m][0], v1 = acc[ai][bj][m][1]; const int col = cl + bj * HALF;
                    if (sq) {
#pragma unroll
                        for (int j = 0; j < 4; ++j) { const float a = v0[j] > 0.f ? v0[j] : 0.f, b = v1[j] > 0.f ? v1[j] : 0.f; v0[j] = a * a; v1[j] = b * b; } }
                    if (d16) { u32x4 w; w.x = cvt_pk_bf16(v0[0], v0[1]); w.y = cvt_pk_bf16(v0[2], v0[3]); w.z = cvt_pk_bf16(v1[0], v1[1]); w.w = cvt_pk_bf16(v1[2], v1[3]);
                        if (nt16) __builtin_nontemporal_store(w, (u32x4*)(d16 + (size_t)row * l16 + col)); else *(u32x4*)(d16 + (size_t)row * l16 + col) = w; }
                    if (d32) { float* p = d32 + (size_t)(row - radj) * l32 + col;
                        if (mode >= 3) { __builtin_nontemporal_store(v0, (f32x4*)p); __builtin_nontemporal_store(v1, (f32x4*)(p + 4)); }
                        else { *(f32x4*)p = v0; *(f32x4*)(p + 4) = v1; } } } }
    }
};
struct TailSplit {
    StaticOrder full; int nF, nN, nsl, nts, G, c, split;
    __device__ void init(int M, int N, int K, int G_, int c_, int split_) { split = split_; full.init(split_ ? 64 * BM : M, N, K, G_, c_); nN = N / BM; nF = 64 * nN; nsl = 8; nts = K / BK / nsl; G = G_; c = c_; }
    __device__ __forceinline__ bool next(int i, Unit& u) const {
        const long L = (long)i * G + c; int pm = 0, pn = 0, kt0 = 0, nt = full.ntf, ks = 0; bool ok; if (c < 0) { u.pm = 0; u.pn = 0; u.kt0 = 0; u.nt = nt; u.ks = 0; return false; }
        if (!split || L < nF) { Unit t; ok = full.next(i, t); pm = t.pm; pn = t.pn; }
        else { const int Ls = (int)(L - nF); ok = Ls < 4 * nN * nsl; pn = Ls % nN; const int rest = Ls / nN; pm = 64 + (rest & 3); ks = rest >> 2; kt0 = ks * nts; nt = nts; }
        u.pm = pm; u.pn = pn; u.kt0 = kt0; u.nt = nt; u.ks = ks; return ok;
    }
    __device__ __forceinline__ void a_ready(const Unit&) const {}
    __device__ __forceinline__ void done(const Unit&) const {}
};
}
namespace pg8 {
template <class Epi, class Sched, bool ALIGN_EPI = false, bool SP2 = false>
__device__ __forceinline__ void gemm_phase(PG8_LAS unsigned char* lds, const Gemm g, const Sched& S, const Epi& E, const int tid) {
    const int wid = __builtin_amdgcn_readfirstlane(tid >> 6), lane = tid & 63, wr = wid >> 2, wc = wid & 3, fr = lane & 15, fq = lane >> 4;
    const int K = g.K;
    unsigned voffA[2], voffB[2];
#pragma unroll
    for (int i = 0; i < 2; ++i) { int R, C; stage_rc(tid * 16 + i * 8192, R, C); const int Rb = Epi::PERM ? ((R & ~31) + perm32(R & 31)) : R;
        voffA[i] = (unsigned)(R * K + C) * 2u; voffB[i] = (unsigned)(Rb * K + C) * 2u; }
    const size_t kstep = (size_t)(BK * 2);
    const size_t hstep = (size_t)HALF * K * 2;
    const size_t tstep = 2 * hstep;
    const unsigned ldsw = (unsigned)wid * 1024u;
    const int aoff = lds_byte(wr * 64 + fr, fq * 8), boff = lds_byte(wc * 32 + fr, fq * 8);
#define PG8_SA(b, h) (((b) * 2 + (h)) * HTB)
#define PG8_SB(b, h) ((4 + (b) * 2 + (h)) * HTB)
#define PG8_STAGE(bufoff, gbase, voff) do { _Pragma("unroll") for (int _i = 0; _i < 2; ++_i) \
        __builtin_amdgcn_global_load_lds((const unsigned*)((const char*)(gbase) + (voff)[_i]), (PG8_LAS unsigned*)(lds + (bufoff) + ldsw + _i * 8192), 16, 0, 0); } while (0)
#define PG8_LDA(dst, b, h) do { _Pragma("unroll") for (int m = 0; m < 4; ++m) _Pragma("unroll") for (int k = 0; k < 2; ++k) dst[m][k] = *(const PG8_LAS bf16x8*)(lds + PG8_SA(b, h) + aoff + m * 2048 + k * 1024); } while (0)
#define PG8_LDB(dst, b, h) do { _Pragma("unroll") for (int n = 0; n < 2; ++n) _Pragma("unroll") for (int k = 0; k < 2; ++k) dst[n][k] = *(const PG8_LAS bf16x8*)(lds + PG8_SB(b, h) + boff + n * 2048 + k * 1024); } while (0)
#define PG8_MMA(ai, bj, At, Bt) do { __builtin_amdgcn_s_setprio(1); _Pragma("unroll") for (int m = 0; m < 4; ++m) _Pragma("unroll") for (int n = 0; n < 2; ++n) _Pragma("unroll") for (int k = 0; k < 2; ++k) \
        acc[ai][bj][m][n] = __builtin_amdgcn_mfma_f32_16x16x32_bf16(Bt[n][k], At[m][k], acc[ai][bj][m][n], 0, 0, 0); __builtin_amdgcn_s_setprio(0); } while (0)
#define PG8_WAIT_V(n) asm volatile("s_waitcnt vmcnt(" #n ")" ::: "memory")
#define PG8_WAIT_L(n) asm volatile("s_waitcnt lgkmcnt(" #n ")" ::: "memory")
#define PG8_BAR __builtin_amdgcn_s_barrier()
#define PG8_SCHED __builtin_amdgcn_sched_barrier(0)
    Unit cur, nxt; int ui = 0;
    if (!S.next(0, cur)) return;
    f32x4 acc[2][2][4][2];
#pragma unroll
    for (int a = 0; a < 2; ++a)
#pragma unroll
        for (int b = 0; b < 2; ++b)
#pragma unroll
            for (int m = 0; m < 4; ++m)
#pragma unroll
                for (int n = 0; n < 2; ++n) acc[a][b][m][n] = (f32x4){0.f, 0.f, 0.f, 0.f};
    bf16x8 At[4][2], B0[2][2], B1[2][2];
    const char* cA = (const char*)g.A + (size_t)cur.pm * tstep + (size_t)cur.kt0 * kstep; const char* cB = (const char*)g.Bt + (size_t)cur.pn * tstep + (size_t)cur.kt0 * kstep;
    S.a_ready(cur);
    if constexpr (SP2) {
        PG8_STAGE(PG8_SB(0, 0), cB, voffB); PG8_STAGE(PG8_SB(0, 1), cB + hstep, voffB); PG8_STAGE(PG8_SA(0, 0), cA, voffA); PG8_STAGE(PG8_SA(0, 1), cA + hstep, voffA);
        if (wr == 1) PG8_BAR;
        PG8_WAIT_V(2); PG8_BAR;
        PG8_STAGE(PG8_SB(1, 0), cB + kstep, voffB); PG8_STAGE(PG8_SA(1, 0), cA + kstep, voffA); PG8_STAGE(PG8_SB(1, 1), cB + hstep + kstep, voffB);
        PG8_WAIT_V(6); PG8_BAR;
    } else {
        PG8_STAGE(PG8_SB(0, 0), cB, voffB); PG8_STAGE(PG8_SA(0, 0), cA, voffA); PG8_STAGE(PG8_SB(0, 1), cB + hstep, voffB); PG8_STAGE(PG8_SA(0, 1), cA + hstep, voffA);
        if (wr == 1) PG8_BAR;
        PG8_WAIT_V(4); PG8_BAR;
        PG8_STAGE(PG8_SB(1, 0), cB + kstep, voffB); PG8_STAGE(PG8_SA(1, 0), cA + kstep, voffA); PG8_STAGE(PG8_SB(1, 1), cB + hstep + kstep, voffB);
        PG8_WAIT_V(6); PG8_BAR;
    }
    for (;;) {
        const bool has_next = S.next(ui + 1, nxt);
        const char* nA = has_next ? (const char*)g.A + (size_t)nxt.pm * tstep + (size_t)nxt.kt0 * kstep : cA; const char* nB = has_next ? (const char*)g.Bt + (size_t)nxt.pn * tstep + (size_t)nxt.kt0 * kstep : cB;
        const int nt = cur.nt;
        for (int t = 0; t < nt; t += 2) {
            const bool last = (t == nt - 2);
            const char* a1 = cA + (size_t)(t + 1) * kstep;
            const char* a2 = last ? nA : cA + (size_t)(t + 2) * kstep; const char* b2 = last ? nB : cB + (size_t)(t + 2) * kstep;
            const char* a3 = a2 + kstep; const char* b3 = b2 + kstep;
            if (last && has_next) S.a_ready(nxt);
            if constexpr (SP2) {
            PG8_LDB(B0, 0, 0); PG8_LDB(B1, 0, 1); PG8_SCHED; PG8_LDA(At, 0, 0); PG8_STAGE(PG8_SA(1, 1), a1 + hstep, voffA);
            PG8_WAIT_V(8); PG8_WAIT_L(0); PG8_BAR; PG8_MMA(0, 0, At, B0); PG8_MMA(0, 1, At, B1); PG8_BAR; PG8_SCHED;
            PG8_LDA(At, 0, 1); PG8_STAGE(PG8_SB(0, 0), b2, voffB); PG8_STAGE(PG8_SB(0, 1), b2 + hstep, voffB); PG8_STAGE(PG8_SA(0, 0), a2, voffA);
            PG8_WAIT_V(8); PG8_WAIT_L(0); PG8_BAR; PG8_MMA(1, 0, At, B0); PG8_MMA(1, 1, At, B1); PG8_BAR; PG8_SCHED;
            PG8_LDB(B0, 1, 0); PG8_LDB(B1, 1, 1); PG8_SCHED; PG8_LDA(At, 1, 0); PG8_STAGE(PG8_SA(0, 1), a2 + hstep, voffA);
            PG8_WAIT_V(8); PG8_WAIT_L(0); PG8_BAR; PG8_MMA(0, 0, At, B0); PG8_MMA(0, 1, At, B1); PG8_BAR; PG8_SCHED;
            PG8_LDA(At, 1, 1); PG8_STAGE(PG8_SB(1, 0), b3, voffB); PG8_STAGE(PG8_SB(1, 1), b3 + hstep, voffB); PG8_STAGE(PG8_SA(1, 0), a3, voffA);
            PG8_WAIT_V(8); PG8_WAIT_L(0); PG8_BAR; PG8_MMA(1, 0, At, B0); PG8_MMA(1, 1, At, B1); PG8_BAR; PG8_SCHED;
            } else {
            PG8_LDB(B0, 0, 0); PG8_SCHED; PG8_LDA(At, 0, 0); PG8_STAGE(PG8_SA(1, 1), a1 + hstep, voffA);
            PG8_WAIT_L(8); PG8_BAR; PG8_WAIT_L(0); PG8_MMA(0, 0, At, B0); PG8_BAR; PG8_SCHED;
            PG8_LDB(B1, 0, 1); PG8_STAGE(PG8_SB(0, 0), b2, voffB);
            PG8_BAR; PG8_WAIT_L(0); PG8_MMA(0, 1, At, B1); PG8_BAR;
            PG8_LDA(At, 0, 1); PG8_STAGE(PG8_SA(0, 0), a2, voffA);
            PG8_BAR; PG8_WAIT_L(0); PG8_MMA(1, 0, At, B0); PG8_BAR; PG8_SCHED;
            PG8_STAGE(PG8_SB(0, 1), b2 + hstep, voffB);
            PG8_WAIT_V(6); PG8_BAR; PG8_MMA(1, 1, At, B1); PG8_BAR;
            PG8_LDB(B0, 1, 0); PG8_SCHED; PG8_LDA(At, 1, 0); PG8_STAGE(PG8_SA(0, 1), a2 + hstep, voffA);
            PG8_WAIT_L(8); PG8_BAR; PG8_WAIT_L(0); PG8_MMA(0, 0, At, B0); PG8_BAR; PG8_SCHED;
            PG8_LDB(B1, 1, 1); PG8_STAGE(PG8_SB(1, 0), b3, voffB);
            PG8_BAR; PG8_WAIT_L(0); PG8_MMA(0, 1, At, B1); PG8_BAR;
            PG8_LDA(At, 1, 1); PG8_STAGE(PG8_SA(1, 0), a3, voffA);
            PG8_BAR; PG8_WAIT_L(0); PG8_MMA(1, 0, At, B0); PG8_BAR; PG8_SCHED;
            PG8_STAGE(PG8_SB(1, 1), b3 + hstep, voffB);
            PG8_WAIT_V(6); PG8_BAR; PG8_MMA(1, 1, At, B1); PG8_BAR;
            }
        }
        if constexpr (ALIGN_EPI) { if (wr == 0) PG8_BAR; }
        if constexpr (!Epi::AFTER_DRAIN) { E(acc, cur, wr, wc, fr, fq); S.done(cur); }
        if (!has_next) break;
#pragma unroll
        for (int a = 0; a < 2; ++a)
#pragma unroll
            for (int b = 0; b < 2; ++b)
#pragma unroll
                for (int m = 0; m < 4; ++m)
#pragma unroll
                    for (int n = 0; n < 2; ++n) acc[a][b][m][n] = (f32x4){0.f, 0.f, 0.f, 0.f};
        cur = nxt; cA = nA; cB = nB; ++ui;
        if constexpr (ALIGN_EPI) { if (wr == 1) PG8_BAR; }
    }
    PG8_WAIT_V(0);
    if constexpr (!ALIGN_EPI) { if (wr == 0) PG8_BAR; }
    PG8_BAR;
    if constexpr (Epi::AFTER_DRAIN) { E.fused(acc, cur, wr, wc, fr, fq, lds, wid, lane); S.done(cur); }
#undef PG8_SA
#undef PG8_SB
#undef PG8_STAGE
#undef PG8_LDA
#undef PG8_LDB
#undef PG8_MMA
#undef PG8_WAIT_V
#undef PG8_WAIT_L
#undef PG8_BAR
#undef PG8_SCHED
}
}
typedef short bf16x8s __attribute__((ext_vector_type(8)));
#define WS_PTR(T, off) ((T*)(c.ws + (off)))
struct TJob { const float* W; int ldw, K; const float* gain; bf16_t* WT; int src0, dst0, ncols; };
__device__ __forceinline__ TJob get_job(const Ctx& c, int j) {
    TJob J; J.gain = nullptr; J.src0 = 0; J.dst0 = 0; J.K = D;
    if (j < 4) { const int l = j >> 1, p = j & 1; J.W = c.in[I_WINA] + (size_t)l * D * INA_W; J.ldw = INA_W; J.gain = c.in[I_NMIXPRE] + l * D; J.WT = WS_PTR(bf16_t, WS_WINA) + (size_t)l * 6656 * D;
        if (p == 0) { J.ncols = 6144; } else { J.src0 = 6168; J.dst0 = 6144; J.ncols = 512; } }
    else if (j == 4) { J.W = c.in[I_WINB]; J.ldw = INB_W; J.gain = c.in[I_NMIXPRE] + 2 * D; J.WT = WS_PTR(bf16_t, WS_WINB0); J.ncols = 3584; }
    else if (j == 5) { J.W = c.in[I_WKVF]; J.ldw = KVF_W; J.gain = c.in[I_NKV]; J.WT = WS_PTR(bf16_t, WS_WINB0); J.dst0 = 3584; J.ncols = 3072; }
    else if (j == 6) { J.W = c.in[I_WINB] + (size_t)D * INB_W; J.ldw = INB_W; J.gain = c.in[I_NMIXPRE] + 3 * D; J.WT = WS_PTR(bf16_t, WS_WINB1); J.ncols = 3584; }
    else if (j < 11) { const int l = j - 7; J.W = c.in[I_WO] + (size_t)l * D * D; J.ldw = D; J.WT = WS_PTR(bf16_t, WS_WO) + (size_t)l * D * D; J.ncols = D; }
    else if (j < 15) { const int l = j - 11; J.W = c.in[I_WUP] + (size_t)l * D * DFF; J.ldw = DFF; J.gain = c.in[I_NMLPPRE] + l * D; J.WT = WS_PTR(bf16_t, WS_WUP) + (size_t)l * DFF * D; J.ncols = DFF; }
    else if (j < 19) { const int l = j - 15; J.W = c.in[I_WDN] + (size_t)l * DFF * D; J.ldw = D; J.K = DFF; J.WT = WS_PTR(bf16_t, WS_WDN) + (size_t)l * D * DFF; J.ncols = D; }
    else { const int l = j - 19; J.W = c.in[I_WMEMKV] + (size_t)l * D * 1024; J.ldw = 1024; J.gain = c.in[I_NMEM] + l * D; J.WT = WS_PTR(bf16_t, WS_WMEM); J.dst0 = l * 1024; J.ncols = 1024; }
    return J;
}
constexpr int NJOBS = 23;
__device__ __forceinline__ int job_items(const TJob& J) { return (J.K / 64) * (J.ncols / 32); }
__device__ __forceinline__ void transpose_item(const TJob& J, int item, LAS float* scr, int lane) {
    const int nblk = J.ncols / 32, kb = item / nblk, nb = item % nblk, k0 = 64 * kb, n0 = 32 * nb;
    float wv[32];
#pragma unroll
    for (int i = 0; i < 32; ++i) wv[i] = __builtin_nontemporal_load(J.W + (size_t)(k0 + 2 * i + (lane >> 5)) * J.ldw + J.src0 + n0 + (lane & 31));
#pragma unroll
    for (int i = 0; i < 32; ++i) { const int kk = 2 * i + (lane >> 5); float w = wv[i]; if (J.gain) w *= J.gain[k0 + kk]; scr[kk * 33 + (lane & 31)] = w; }
    asm volatile("s_waitcnt lgkmcnt(0)" ::: "memory");
    const int cc = lane & 7;
#pragma unroll
    for (int j = 0; j < 4; ++j) { const int n = (lane >> 3) + 8 * j; const LAS float* s = scr + (8 * cc) * 33 + n;
        u32x4 o; o.x = pk2(s[0 * 33], s[1 * 33]); o.y = pk2(s[2 * 33], s[3 * 33]); o.z = pk2(s[4 * 33], s[5 * 33]); o.w = pk2(s[6 * 33], s[7 * 33]);
        __builtin_nontemporal_store(o, (u32x4*)(J.WT + (size_t)(J.dst0 + n0 + n) * J.K + k0 + 8 * cc)); }
    asm volatile("s_waitcnt lgkmcnt(0)" ::: "memory");
}
constexpr unsigned JOBS_L0 = 0x3u | (1u << 7) | (1u << 11) | (1u << 15) | (0xfu << 19), JOBS_L1 = 0xcu | (1u << 8) | (1u << 12) | (1u << 16), JOBS_L2 = 0x30u | (1u << 9) | (1u << 13) | (1u << 17), JOBS_L3 = 0x40u | (1u << 10) | (1u << 14) | (1u << 18);
static_assert((JOBS_L0 | JOBS_L1 | JOBS_L2 | JOBS_L3) == (1u << 23) - 1 && (JOBS_L0 & JOBS_L1) == 0 && (JOBS_L2 & JOBS_L3) == 0 && ((JOBS_L0 | JOBS_L1) & (JOBS_L2 | JOBS_L3)) == 0, "every weight job in exactly one group");
__device__ __forceinline__ void ph_prep(CtxP cp, LAS unsigned char* lds, unsigned mask, int wg0, int nwg, int small) {
    CTX_LOAD(cp);
    const int bid_ = obid() - wg0, grid_ = nwg; const int tid = otid(), lane = tid & 63, wave = tid >> 6, gw = bid_ * 8 + wave, NGW = grid_ * 8;
    if (bid_ < 0) return;
    __syncthreads();
    LAS float* scr = (LAS float*)(lds + wave * 16384);
    int base = 0;
    for (int j = 0; j < NJOBS; ++j) { if (!((mask >> j) & 1u)) continue; const TJob J = get_job(c, j); const int n = job_items(J);
        int first = gw - (base % NGW); if (first < 0) first += NGW;
        for (int it = first; it < n; it += NGW) transpose_item(J, it, scr, lane);
        base += n; }
    if (!small) return;
    bf16_t* wskb = WS_PTR(bf16_t, WS_WSKB);
    for (int i = bid_ * 512 + tid; i < 3 * 32 * D; i += grid_ * 512) { const int var = i / (32 * D), r = (i / D) % 32, k = i % D; float v = 0.f;
        if (var < 2) { if (r < 24) v = c.in[I_WINA][(size_t)var * D * INA_W + (size_t)k * INA_W + 6144 + r] * c.in[I_NMIXPRE][var * D + k]; }
        else if (r < 12) v = c.in[I_WKVF][(size_t)k * KVF_W + 3072 + r] * c.in[I_NKV][k];
        wskb[i] = (bf16_t)(pk2(v, 0.f) & 0xffffu); }
}
__device__ __forceinline__ void ph_row2(CtxP cp, int src, int use_delta, int gidx, int gl, int write_y, int first = 0, int wg0 = 0, int nwg = 0) {
    CTX_LOAD(cp);
    const int bid_ = obid() - wg0, grid_ = nwg ? nwg : ogrid();
    if (bid_ < 0 || bid_ >= grid_) return; const int tid = otid(), lane = tid & 63, wave = tid >> 6, gw = bid_ * 8 + wave, NGW = grid_ * 8;
    float* X = WS_PTR(float, WS_X); bf16_t* XN = WS_PTR(bf16_t, WS_XN); const bf16_t* delta = WS_PTR(bf16_t, WS_DELTA); const float* gpost = use_delta ? c.in[gidx] + gl * D : nullptr;
    const int nrows = (src == 2) ? 1024 : M;
#define LD_DELTA(dst, mrow, j) do { const u32x2 t_ = __builtin_nontemporal_load((const u32x2*)(delta + (size_t)(mrow) * D + 4 * lane + 256 * (j))); dst = (f32x4){bflo(t_.x), bfhi(t_.x), bflo(t_.y), bfhi(t_.y)}; } while (0)
    const bool deal2 = (src == 0) && use_delta && (NGW == 2048);
    const int half_gw = gw >> 1, isA = !(gw & 1);
    const int nsteps = deal2 ? (isA ? 4 : 5) : (nrows + 2 * NGW - 1) / (2 * NGW);
    for (int st = 0; st < nsteps; ++st) {
        int m0, m1; bool two;
        if (deal2) { if (isA) { if (st == 0) { m0 = MP + half_gw; m1 = m0; two = false; } else { m0 = half_gw + 1024 * (2 * (st - 1)); m1 = m0 + 1024; two = true; } }
            else { m0 = 6144 + half_gw + 1024 * (2 * st); m1 = m0 + 1024; two = true; } }
        else { m0 = gw + st * 2 * NGW; if (m0 >= nrows) break; const int m1r = m0 + NGW; two = m1r < nrows; m1 = two ? m1r : m0; }
        const bool fromx = (src == 0) && !first;
        const float* xr0 = fromx ? X + (size_t)m0 * D : (src != 2) ? (m0 < MP ? c.in[I_XP] + (size_t)m0 * D : c.in[I_XS] + (size_t)(m0 - MP) * D) : c.in[I_MEMP] + (size_t)m0 * D;
        const float* xr1 = fromx ? X + (size_t)m1 * D : (src != 2) ? (m1 < MP ? c.in[I_XP] + (size_t)m1 * D : c.in[I_XS] + (size_t)(m1 - MP) * D) : c.in[I_MEMP] + (size_t)m1 * D;
        f32x4 v0[8], v1[8];
#pragma unroll
        for (int j = 0; j < 8; ++j) { v0[j] = __builtin_nontemporal_load((const f32x4*)(xr0 + 4 * lane + 256 * j)); v1[j] = two ? __builtin_nontemporal_load((const f32x4*)(xr1 + 4 * lane + 256 * j)) : v0[j]; }
        if (use_delta) { f32x4 d0[8], d1[8]; float s0 = 0.f, s1 = 0.f;
#pragma unroll
            for (int j = 0; j < 8; ++j) {
                if (m0 < MP) LD_DELTA(d0[j], m0, j);
                else { const float* sp = WS_PTR(float, WS_SLAB) + (size_t)(m0 - MP) * D + 4 * lane + 256 * j; d0[j] = *(const f32x4*)sp;
#pragma unroll
                    for (int s8 = 1; s8 < 8; ++s8) d0[j] = d0[j] + *(const f32x4*)(sp + (size_t)s8 * 1024 * D); }
                if (!two) d1[j] = d0[j];
                else if (m1 < MP) LD_DELTA(d1[j], m1, j);
                else { const float* sp = WS_PTR(float, WS_SLAB) + (size_t)(m1 - MP) * D + 4 * lane + 256 * j; d1[j] = *(const f32x4*)sp;
#pragma unroll
                    for (int s8 = 1; s8 < 8; ++s8) d1[j] = d1[j] + *(const f32x4*)(sp + (size_t)s8 * 1024 * D); }
                s0 += (d0[j].x * d0[j].x + d0[j].y * d0[j].y) + (d0[j].z * d0[j].z + d0[j].w * d0[j].w); s1 += (d1[j].x * d1[j].x + d1[j].y * d1[j].y) + (d1[j].z * d1[j].z + d1[j].w * d1[j].w); }
            const float r0 = rsqrtf(wave_sum_dpp(s0) * (1.f / D) + EPS), r1 = rsqrtf(wave_sum_dpp(s1) * (1.f / D) + EPS);
#pragma unroll
            for (int j = 0; j < 8; ++j) { const f32x4 g = *(const f32x4*)(gpost + 4 * lane + 256 * j); v0[j] = v0[j] + d0[j] * r0 * g; v1[j] = v1[j] + d1[j] * r1 * g; } }
        if (src == 0 && !write_y) {
#pragma unroll
            for (int j = 0; j < 8; ++j) { __builtin_nontemporal_store(v0[j], (f32x4*)(X + (size_t)m0 * D + 4 * lane + 256 * j)); if (two) __builtin_nontemporal_store(v1[j], (f32x4*)(X + (size_t)m1 * D + 4 * lane + 256 * j)); } }
        if (write_y) {
#pragma unroll
            for (int j = 0; j < 8; ++j) { __builtin_nontemporal_store(v0[j], (f32x4*)(c.out + O_YP + (size_t)m0 * D + 4 * lane + 256 * j)); if (two) __builtin_nontemporal_store(v1[j], (f32x4*)(c.out + O_YP + (size_t)m1 * D + 4 * lane + 256 * j)); }
            continue; }
        float q0 = 0.f, q1 = 0.f;
#pragma unroll
        for (int j = 0; j < 8; ++j) { q0 += (v0[j].x * v0[j].x + v0[j].y * v0[j].y) + (v0[j].z * v0[j].z + v0[j].w * v0[j].w); q1 += (v1[j].x * v1[j].x + v1[j].y * v1[j].y) + (v1[j].z * v1[j].z + v1[j].w * v1[j].w); }
        const float t0 = rsqrtf(wave_sum_dpp(q0) * (1.f / D) + EPS), t1 = rsqrtf(wave_sum_dpp(q1) * (1.f / D) + EPS);
        bf16_t* xn0 = ((src == 2) ? WS_PTR(bf16_t, WS_MEMN) : XN) + (size_t)m0 * D; bf16_t* xn1 = ((src == 2) ? WS_PTR(bf16_t, WS_MEMN) : XN) + (size_t)m1 * D;
#pragma unroll
        for (int j = 0; j < 8; ++j) { u32x2 w0, w1; w0.x = pk2(v0[j].x * t0, v0[j].y * t0); w0.y = pk2(v0[j].z * t0, v0[j].w * t0); w1.x = pk2(v1[j].x * t1, v1[j].y * t1); w1.y = pk2(v1[j].z * t1, v1[j].w * t1);
            *(u32x2*)(xn0 + 4 * lane + 256 * j) = w0; if (two) *(u32x2*)(xn1 + 4 * lane + 256 * j) = w1; }
    }
}
__device__ __forceinline__ void ph_skinny(CtxP cp, int var, LAS unsigned char* lds) {
    CTX_LOAD(cp);
    const int bid_ = obid(), grid_ = ogrid(); const int tid = otid(), lane = tid & 63, wave = tid >> 6, n16 = lane & 15, q = lane >> 4;
    const bf16_t* Wb = WS_PTR(bf16_t, WS_WSKB) + (size_t)var * 32 * D + (size_t)n16 * D + 8 * q + 256 * wave;
    bf16x8s wa[8], wb[8];
#pragma unroll
    for (int ks = 0; ks < 8; ++ks) { wa[ks] = *(const bf16x8s*)(Wb + 32 * ks); wb[ks] = *(const bf16x8s*)(Wb + (size_t)16 * D + 32 * ks); }
    LAS float* P = (LAS float*)lds;
    const bf16_t* xp = WS_PTR(bf16_t, WS_XN) + (size_t)n16 * D + 8 * q + 256 * wave;
    __syncthreads();
    bf16x8s xb[8];
#pragma unroll
    for (int ks = 0; ks < 8; ++ks) xb[ks] = *(const bf16x8s*)(xp + (size_t)(16 * bid_) * D + 32 * ks);
    int nt = 0;
    for (int rt = bid_; rt < M / 16; rt += grid_, ++nt) {
        bf16x8s xn[8]; const int rn = rt + grid_;
        if (rn < M / 16) {
#pragma unroll
            for (int ks = 0; ks < 8; ++ks) xn[ks] = *(const bf16x8s*)(xp + (size_t)(16 * rn) * D + 32 * ks); }
        else {
#pragma unroll
            for (int ks = 0; ks < 8; ++ks) xn[ks] = xb[ks]; }
        f32x4 a0 = {0.f, 0.f, 0.f, 0.f}, a1 = {0.f, 0.f, 0.f, 0.f};
#pragma unroll
        for (int ks = 0; ks < 8; ++ks) { a0 = __builtin_amdgcn_mfma_f32_16x16x32_bf16(wa[ks], xb[ks], a0, 0, 0, 0); a1 = __builtin_amdgcn_mfma_f32_16x16x32_bf16(wb[ks], xb[ks], a1, 0, 0, 0); }
        LAS float* pp = P + (size_t)((nt * 8 + wave) * 8) * 64 + lane;
#pragma unroll
        for (int i = 0; i < 4; ++i) { pp[i * 64] = a0[i]; pp[(4 + i) * 64] = a1[i]; }
#pragma unroll
        for (int ks = 0; ks < 8; ++ks) xb[ks] = xn[ks];
    }
    __syncthreads();
    const int cc = (wave < 4) ? 4 * q + wave : 16 + 4 * q + (wave - 4);
    for (int t = 0; t < nt; ++t) { const int m = 16 * (bid_ + t * grid_) + n16; float s = 0.f;
#pragma unroll
        for (int w = 0; w < 8; ++w) s += P[(size_t)((t * 8 + w) * 8 + wave) * 64 + lane];
        if (var < 2) {
            if (cc < 12) WS_PTR(float, WS_G)[(size_t)m * 12 + cc] = -exp_fast(c.in[I_ALOG][var * 12 + cc]) * softplus_fast(s + c.in[I_DTB][var * 12 + cc]);
            else if (cc < 24) WS_PTR(float, WS_BETA)[(size_t)m * 12 + (cc - 12)] = fast_sigmoid(s); }
        else if (cc < 12) { const float lf = -softplus_fast(-(s + c.in[I_BF][cc])); WS_PTR(float, WS_LOGF)[(size_t)m * 12 + cc] = lf;
            c.out[(m < MP ? O_PLOGF + (size_t)m * 12 : O_SLOGF + (size_t)(m - MP) * 12) + cc] = lf; } }
    __syncthreads();
}
__device__ __forceinline__ void ph_gdn_c(CtxP cp, int l) {
    CTX_LOAD(cp);
    const int bid_ = obid(), grid_ = ogrid(); const int tid = otid(), lane = tid & 63, wave = tid >> 6, gw = bid_ * 8 + wave, NGW = grid_ * 8, sub = lane >> 4, c8 = (lane & 15) * 8;
    const bf16_t* PROJ = WS_PTR(bf16_t, WS_PROJ); const bf16_t* Of = WS_PTR(bf16_t, WS_OF); bf16_t* ACT = WS_PTR(bf16_t, WS_ACT);
    const f32x4 g0 = *(const f32x4*)(c.in[I_GDNN] + l * HD + c8), g1 = *(const f32x4*)(c.in[I_GDNN] + l * HD + c8 + 4);
    for (int it = gw * 4 + sub; it < M * H; it += NGW * 4) { const int m = it / H, h = it % H;
        const u32x4 ou = __builtin_nontemporal_load((const u32x4*)(Of + (size_t)m * TOK + h * HD + c8));
        const f32x4 o0 = {bflo(ou.x), bfhi(ou.x), bflo(ou.y), bfhi(ou.y)}, o1 = {bflo(ou.z), bfhi(ou.z), bflo(ou.w), bfhi(ou.w)};
        const u32x4 zu = __builtin_nontemporal_load((const u32x4*)(PROJ + (size_t)m * PJ + QKV + h * HD + c8));
        float ss = (o0.x * o0.x + o0.y * o0.y) + (o0.z * o0.z + o0.w * o0.w) + (o1.x * o1.x + o1.y * o1.y) + (o1.z * o1.z + o1.w * o1.w);
        ss += __int_as_float(__builtin_amdgcn_update_dpp(0, __float_as_int(ss), 0x111, 0xf, 0xf, true)); ss += __int_as_float(__builtin_amdgcn_update_dpp(0, __float_as_int(ss), 0x112, 0xf, 0xf, true));
        ss += __int_as_float(__builtin_amdgcn_update_dpp(0, __float_as_int(ss), 0x114, 0xf, 0xf, true)); ss += __int_as_float(__builtin_amdgcn_update_dpp(0, __float_as_int(ss), 0x118, 0xf, 0xf, true));
        ss = lane_get(ss, lane | 15);
        const float r = rsqrtf(ss * (1.f / HD) + EPS);
        const float z0 = bflo(zu.x), z1 = bfhi(zu.x), z2 = bflo(zu.y), z3 = bfhi(zu.y), z4 = bflo(zu.z), z5 = bfhi(zu.z), z6 = bflo(zu.w), z7 = bfhi(zu.w);
        u32x4 w4; w4.x = pk2(o0.x * r * g0.x * (z0 * fast_sigmoid(z0)), o0.y * r * g0.y * (z1 * fast_sigmoid(z1))); w4.y = pk2(o0.z * r * g0.z * (z2 * fast_sigmoid(z2)), o0.w * r * g0.w * (z3 * fast_sigmoid(z3)));
        w4.z = pk2(o1.x * r * g1.x * (z4 * fast_sigmoid(z4)), o1.y * r * g1.y * (z5 * fast_sigmoid(z5))); w4.w = pk2(o1.z * r * g1.z * (z6 * fast_sigmoid(z6)), o1.w * r * g1.w * (z7 * fast_sigmoid(z7)));
        *(u32x4*)(ACT + (size_t)m * D + h * HD + c8) = w4; }
}
__device__ __forceinline__ float wave_scan_dpp(float v, int lane, float& total) {
    v += __int_as_float(__builtin_amdgcn_update_dpp(0, __float_as_int(v), 0x111, 0xf, 0xf, true));
    v += __int_as_float(__builtin_amdgcn_update_dpp(0, __float_as_int(v), 0x112, 0xf, 0xf, true));
    v += __int_as_float(__builtin_amdgcn_update_dpp(0, __float_as_int(v), 0x114, 0xf, 0xf, true));
    v += __int_as_float(__builtin_amdgcn_update_dpp(0, __float_as_int(v), 0x118, 0xf, 0xf, true));
    const int iv = __float_as_int(v);
    const float r0 = __int_as_float(__builtin_amdgcn_readlane(iv, 15)), r1 = __int_as_float(__builtin_amdgcn_readlane(iv, 31)), r2 = __int_as_float(__builtin_amdgcn_readlane(iv, 47)), r3 = __int_as_float(__builtin_amdgcn_readlane(iv, 63));
    const int row = lane >> 4; total = ((r0 + r1) + r2) + r3;
    return v + (row == 0 ? 0.f : row == 1 ? r0 : row == 2 ? r0 + r1 : (r0 + r1) + r2);
}
__device__ __forceinline__ void ph_cumsum(CtxP cp) {
    CTX_LOAD(cp);
    const int bid_ = obid(), grid_ = ogrid(); const int tid = otid(), lane = tid & 63, wave = tid >> 6, NGW = grid_ * 8;
    const float* LOGF = WS_PTR(float, WS_LOGF); float* CUMP = WS_PTR(float, WS_CUMP); float* CUMS = WS_PTR(float, WS_CUMS);
    for (int task = bid_ + grid_ * wave; task < 192 + 384; task += NGW) {
        const bool smp = task >= 192; int b, h, jb, n; float carry = 0.f;
        if (!smp) { const int seg = task / 48, ts = task % 48; b = ts / 12; h = ts % 12; jb = seg * 1024; n = jb + 1024; float ps = 0.f;
#pragma unroll 16
            for (int j = lane; j < jb; j += 64) ps += LOGF[(size_t)(b * 4096 + j) * 12 + h];
            carry = wave_sum_dpp(ps); }
        else { const int ts = task - 192; b = ts / 12; h = ts % 12; jb = 0; n = PAST + 32; }
        for (int j0 = jb; j0 < n; j0 += 1024) { float vv[16];
#pragma unroll
            for (int u = 0; u < 16; ++u) { const int j = j0 + 64 * u + lane; vv[u] = 0.f;
                if (j < n) vv[u] = !smp ? LOGF[(size_t)(b * 4096 + j) * 12 + h] : (j < PAST ? c.in[I_CLOGF][(size_t)(b * PAST + j) * 12 + h] : LOGF[(size_t)(MP + b * 32 + j - PAST) * 12 + h]); }
#pragma unroll
            for (int u = 0; u < 16; ++u) { const int j = j0 + 64 * u + lane; float tot; const float v = wave_scan_dpp(vv[u], lane, tot);
                if (j < n) { if (smp) CUMS[(size_t)(b * (PAST + 32) + j) * 12 + h] = carry + v; else { CUMP[(size_t)(b * 4096 + j) * 12 + h] = carry + v;
                        const float cr = (carry + v) * (1.f / SCALE); const unsigned c1 = pk2(cr, 0.f) & 0xffffu; const float r1 = cr - __uint_as_float(c1 << 16); const unsigned c2 = pk2(r1, 0.f) & 0xffffu;
                        const float r2 = r1 - __uint_as_float(c2 << 16); const unsigned c3 = pk2(r2, 0.f) & 0xffffu; const size_t o8 = ((size_t)(b * 12 + h) * 4096 + j) * 8;
                        u32x4 qv, kv; qv.x = c1 | (c2 << 16); qv.y = c3 | 0x3f800000u; qv.z = 0x3f803f80u; qv.w = 0u; kv.x = 0x3f803f80u; kv.y = 0x3f80u | ((c1 ^ 0x8000u) << 16); kv.z = (c2 ^ 0x8000u) | ((c3 ^ 0x8000u) << 16); kv.w = 0u;
                        *(u32x4*)(WS_PTR(bf16_t, WS_QX) + o8) = qv; *(u32x4*)(WS_PTR(bf16_t, WS_KX) + o8) = kv; } }
                carry += tot; } }
    }
}
typedef short bf16x8 __attribute__((ext_vector_type(8)));
typedef float f32x16 __attribute__((ext_vector_type(16)));
constexpr int GT_W = 0, GT_QG = 16384, GT_KG = 32768, GT_AT = 49152, GT_U = 57344, GT_BYTES = 73728;
constexpr int NTASK_P = 4 * 12 * 64, NTASK = NTASK_P + 384;
constexpr size_t WS_GDNBUF = WS_BIG;
static_assert((size_t)NTASK * GT_BYTES <= 306 * MiB, "GDNBUF must not reach WS_OF");
__device__ __forceinline__ int permpos(int x) { return (x & ~31) | (((x >> 2) & 3) << 3) | (((x >> 4) & 1) << 2) | (x & 3); }
__device__ __forceinline__ int crow32(int r, int hi) { return (r & 3) + 8 * (r >> 2) + 4 * hi; }
constexpr int L_KN = 0, L_QN = 17408, L_VBT = 34816, L_KBT = 53248, L_AS = 71680, L_TS = 88320, L_KGT = 97536, L_ATP = 113920, L_GS = 122112, L_BS = 122368, L_TD = 122624, L_CW = 131072;
#define LDS_BARRIER() do { asm volatile("s_waitcnt lgkmcnt(0)" ::: "memory"); __builtin_amdgcn_s_barrier(); asm volatile("" ::: "memory"); } while (0)
__device__ __forceinline__ void ph_gdn_prep(CtxP cp, int l, LAS unsigned char* lds) {
    CTX_LOAD(cp);
    const int bid_ = obid(), grid_ = ogrid(); const int tid0 = otid();
    const bf16_t* PROJ = WS_PTR(bf16_t, WS_PROJ); const float* cw = c.in[I_CONVW] + (size_t)l * 4 * QKV;
    LAS float* Gs = (LAS float*)(lds + L_GS); LAS float* Bs = (LAS float*)(lds + L_BS); LAS float* As = (LAS float*)(lds + L_AS);
    unsigned warm = 0u;
    for (int tk = bid_; tk < NTASK; tk += grid_) {
        asm volatile("" :: "v"(warm));
        int tid = tid0; asm volatile("" : "+v"(tid));
        const int lane = tid & 63, w = __builtin_amdgcn_readfirstlane(tid >> 6);
        int grp, b, h, ch, L, m0, t0;
        if (tk < NTASK_P) { grp = 0; ch = tk & 63; const int bh = tk >> 6; b = bh / 12; h = bh % 12; L = 64; t0 = ch * 64; m0 = b * 4096 + t0; }
        else { grp = 1; ch = 0; const int bh = tk - NTASK_P; b = bh / 12; h = bh % 12; L = 32; t0 = 0; m0 = MP + b * 32; }
        const int T = grp ? 32 : 4096, nb = grp ? 32 : 4;
        unsigned char* gb = c.ws + WS_GDNBUF + (size_t)tk * GT_BYTES;
        if (tid >= 128) { const int e4 = 4 * (tid - 128); *(LAS f32x4*)(lds + L_CW + e4 * 4) = *(const f32x4*)(cw + (size_t)((e4 >> 7) & 3) * QKV + (e4 >> 9) * TOK + h * HD + (e4 & 127)); }
        if (tid < 64) { const bool v = tid < L; float gv = v ? WS_PTR(float, WS_G)[(size_t)(m0 + tid) * 12 + h] : 0.f; const float bv = v ? WS_PTR(float, WS_BETA)[(size_t)(m0 + tid) * 12 + h] : 0.f;
#pragma unroll
            for (int o = 1; o < 64; o <<= 1) { const float n = lane_get(gv, lane - o); if (lane >= o) gv += n; }
            Gs[tid] = gv; Bs[tid] = bv; }
        LDS_BARRIER();
        const int r = tid >> 3, seg = tid & 7; const bool valid = r < L; const int t = t0 + r, m = m0 + r;
        const float gr = Gs[r], eg = expf(gr), egl = expf(Gs[63] - gr), bt = Bs[r]; const int pr = permpos(r);
#pragma unroll
        for (int pi = 0; pi < 3; ++pi) { const int part = (pi == 0) ? 1 : (pi == 1 ? 0 : 2);
            const int col0 = part * TOK + h * HD + 16 * seg; float y[16];
#pragma unroll
            for (int e = 0; e < 16; ++e) y[e] = 0.f;
            if (valid) {
#pragma unroll
                for (int jj = 0; jj < 4; ++jj) { const int tt = t - 3 + jj; float x[16];
                    if (tt >= 0) { const u32x4 a = *(const u32x4*)(PROJ + (size_t)(m - 3 + jj) * PJ + col0), bq = *(const u32x4*)(PROJ + (size_t)(m - 3 + jj) * PJ + col0 + 8);
                        x[0] = bflo(a.x); x[1] = bfhi(a.x); x[2] = bflo(a.y); x[3] = bfhi(a.y); x[4] = bflo(a.z); x[5] = bfhi(a.z); x[6] = bflo(a.w); x[7] = bfhi(a.w);
                        x[8] = bflo(bq.x); x[9] = bfhi(bq.x); x[10] = bflo(bq.y); x[11] = bfhi(bq.y); x[12] = bflo(bq.z); x[13] = bfhi(bq.z); x[14] = bflo(bq.w); x[15] = bfhi(bq.w); }
                    else if (grp) { const float* hp = c.in[I_SCONV] + (size_t)((l * 32 + b) * 3 + (3 + tt)) * QKV + col0;
#pragma unroll
                        for (int i = 0; i < 4; ++i) { const f32x4 a = *(const f32x4*)(hp + 4 * i); x[4 * i] = a.x; x[4 * i + 1] = a.y; x[4 * i + 2] = a.z; x[4 * i + 3] = a.w; } }
                    else {
#pragma unroll
                        for (int e = 0; e < 16; ++e) x[e] = 0.f; }
#pragma unroll
                    for (int i = 0; i < 4; ++i) { const f32x4 wv = *(const LAS f32x4*)(lds + L_CW + ((part * 4 + jj) * 128 + 16 * seg + 4 * i) * 4);
                        y[4 * i] += x[4 * i] * wv.x; y[4 * i + 1] += x[4 * i + 1] * wv.y; y[4 * i + 2] += x[4 * i + 2] * wv.z; y[4 * i + 3] += x[4 * i + 3] * wv.w; } }
                if (t >= T - 3) { const u32x4 a = *(const u32x4*)(PROJ + (size_t)m * PJ + col0), bq = *(const u32x4*)(PROJ + (size_t)m * PJ + col0 + 8);
                    float* dst = c.out + (grp ? O_SCONV : O_PCONV) + (size_t)((l * nb + b) * 3 + (t - (T - 3))) * QKV + col0;
                    *(f32x4*)(dst) = (f32x4){bflo(a.x), bfhi(a.x), bflo(a.y), bfhi(a.y)}; *(f32x4*)(dst + 4) = (f32x4){bflo(a.z), bfhi(a.z), bflo(a.w), bfhi(a.w)};
                    *(f32x4*)(dst + 8) = (f32x4){bflo(bq.x), bfhi(bq.x), bflo(bq.y), bfhi(bq.y)}; *(f32x4*)(dst + 12) = (f32x4){bflo(bq.z), bfhi(bq.z), bflo(bq.w), bfhi(bq.w)}; }
#pragma unroll
                for (int e = 0; e < 16; ++e) y[e] = y[e] * fast_sigmoid(y[e]);
            }
            if (part < 2) { float ss = 0.f;
#pragma unroll
                for (int e = 0; e < 16; ++e) ss += y[e] * y[e];
                ss += lane_get(ss, lane ^ 1); ss += lane_get(ss, lane ^ 2); ss += lane_get(ss, lane ^ 4);
                const float rn = rsqrtf(ss + EPS) * (part == 0 ? SCALE : 1.f);
#pragma unroll
                for (int e = 0; e < 16; ++e) y[e] *= rn;
                u32x4 p0, p1; p0.x = pk2(y[0], y[1]); p0.y = pk2(y[2], y[3]); p0.z = pk2(y[4], y[5]); p0.w = pk2(y[6], y[7]); p1.x = pk2(y[8], y[9]); p1.y = pk2(y[10], y[11]); p1.z = pk2(y[12], y[13]); p1.w = pk2(y[14], y[15]);
                const int dst = (part == 1 ? L_KN : L_QN) + r * 272 + seg * 32;
                *(LAS u32x4*)(lds + dst) = p0; *(LAS u32x4*)(lds + dst + 16) = p1; }
            if (part == 1) {
#pragma unroll
                for (int e = 0; e < 16; ++e) { const int col = 16 * seg + e;
                    *(LAS bf16_t*)(lds + L_KBT + col * 144 + (((r >> 3) ^ seg) << 4) + (r & 7) * 2) = (bf16_t)(pk2(bt * eg * y[e], 0.f) & 0xffffu);
                    *(LAS bf16_t*)(lds + L_KGT + col * 128 + (((pr >> 3) ^ seg) << 4) + (pr & 7) * 2) = (bf16_t)(pk2(egl * y[e], 0.f) & 0xffffu); } }
            else if (part == 0) {
#pragma unroll
                for (int q4 = 0; q4 < 4; ++q4) { u32x2 v2; v2.x = pk2(eg * y[4 * q4], eg * y[4 * q4 + 1]); v2.y = pk2(eg * y[4 * q4 + 2], eg * y[4 * q4 + 3]);
                    __builtin_nontemporal_store(v2, (u32x2*)(gb + GT_QG + r * 256 + (32 * (seg >> 1) + 8 * q4 + 4 * (seg & 1)) * 2)); } }
            else {
#pragma unroll
                for (int e = 0; e < 16; ++e) *(LAS bf16_t*)(lds + L_VBT + (16 * seg + e) * 144 + (((r >> 3) ^ seg) << 4) + (r & 7) * 2) = (bf16_t)(pk2(bt * y[e], 0.f) & 0xffffu); }
            __builtin_amdgcn_sched_barrier(0);
        }
        if (tid == 0) WS_PTR(float, WS_EGL)[tk] = expf(Gs[63]);
        { const int tkn = tk + grid_;
            if (tkn < NTASK && tid < 402) { int m0n, hn; if (tkn < NTASK_P) { const int bh = tkn >> 6; hn = bh % 12; m0n = (bh / 12) * 4096 + (tkn & 63) * 64; } else { const int bh = tkn - NTASK_P; hn = bh % 12; m0n = MP + (bh / 12) * 32; }
                const int row = tid / 6, rem = tid % 6; int mm = m0n - 3 + row; mm = mm < 0 ? 0 : (mm >= M ? M - 1 : mm);
                warm = *(const volatile unsigned*)(PROJ + (size_t)mm * PJ + (rem >> 1) * TOK + hn * HD + (rem & 1) * 64); } }
        LDS_BARRIER();
        { const int r32 = lane & 31, hi = lane >> 5;
            if (w < 6) { const int which = w / 3, tt3 = w % 3, ib = tt3 ? 1 : 0, jb = (tt3 == 2) ? 1 : 0; f32x16 acc = {};
                const int xoff = (which ? L_QN : L_KN) + (ib * 32 + r32) * 272 + hi * 16, koff = L_KN + (jb * 32 + r32) * 272 + hi * 16;
#pragma unroll
                for (int kk = 0; kk < 8; ++kk) { const bf16x8 a = *(const LAS bf16x8*)(lds + xoff + kk * 32), bq = *(const LAS bf16x8*)(lds + koff + kk * 32);
                    acc = __builtin_amdgcn_mfma_f32_32x32x16_bf16(a, bq, acc, 0, 0, 0); }
                const int j = jb * 32 + r32; const float gj = Gs[j]; const int pj = permpos(j);
#pragma unroll
                for (int rr = 0; rr < 16; ++rr) { const int i = ib * 32 + crow32(rr, hi); const float dec = expf(fminf(Gs[i] - gj, 0.f));
                    if (which == 0) As[i * 65 + j] = (i > j) ? Bs[i] * acc[rr] * dec : 0.f;
                    else *(LAS bf16_t*)(lds + L_ATP + i * 128 + pj * 2) = (bf16_t)(pk2((i >= j) ? acc[rr] * dec : 0.f, 0.f) & 0xffffu); } }
            else { const int j = 32 + r32;
#pragma unroll
                for (int rr = 0; rr < 16; ++rr) { const int i = crow32(rr, hi);
                    if (w == 6) As[i * 65 + j] = 0.f; else *(LAS bf16_t*)(lds + L_ATP + i * 128 + permpos(j) * 2) = (bf16_t)0; } } }
        LDS_BARRIER();
        if (w == 0) { const int blk = lane >> 5, col = lane & 31, r32 = col, hi = blk; float x[32];
            const LAS float* Asv = As + blk * (32 * 65 + 32); asm volatile("" : "+v"(Asv));
            LAS float* Td = (LAS float*)(lds + L_TD);
#pragma unroll
            for (int i = 0; i < 32; ++i) { float a = (col == i) ? 1.f : 0.f;
#pragma unroll
                for (int j = 0; j < i; ++j) a -= Asv[i * 65 + j] * x[j];
                x[i] = a; Td[blk * (32 * 33) + i * 33 + col] = a;
                *(LAS bf16_t*)(lds + L_TS + (blk * 32 + i) * 144 + (blk * 32 + col) * 2) = (bf16_t)(pk2(a, 0.f) & 0xffffu);
                if (blk) *(LAS bf16_t*)(lds + L_TS + i * 144 + (32 + col) * 2) = (bf16_t)0;
                if ((i & 7) == 7) __builtin_amdgcn_sched_barrier(0); }
            f32x16 acc = {};
#pragma unroll
            for (int s = 0; s < 16; ++s) acc = __builtin_amdgcn_mfma_f32_32x32x2f32(As[(32 + r32) * 65 + 2 * s + hi], Td[(2 * s + hi) * 33 + r32], acc, 0, 0, 0);
#pragma unroll
            for (int rr = 0; rr < 16; ++rr) Td[crow32(rr, hi) * 33 + r32] = acc[rr];
            f32x16 acc2 = {};
#pragma unroll
            for (int s = 0; s < 16; ++s) acc2 = __builtin_amdgcn_mfma_f32_32x32x2f32(Td[32 * 33 + r32 * 33 + 2 * s + hi], Td[(2 * s + hi) * 33 + r32], acc2, 0, 0, 0);
#pragma unroll
            for (int rr = 0; rr < 16; ++rr) *(LAS bf16_t*)(lds + L_TS + (32 + crow32(rr, hi)) * 144 + r32 * 2) = (bf16_t)(pk2(-acc2[rr], 0.f) & 0xffffu); }
        LDS_BARRIER();
        { const int r32 = lane & 31, hi = lane >> 5; const int src = (w < 4 ? L_VBT : L_KBT) + ((w & 3) * 32 + r32) * 144, sw = (((w & 3) * 32 + r32) >> 4) & 7;
#pragma unroll
            for (int ib = 0; ib < 2; ++ib) { f32x16 acc = {}; const int toff = L_TS + (ib * 32 + r32) * 144 + hi * 16;
#pragma unroll
                for (int kk = 0; kk < 4; ++kk) { if (kk < 2 * (ib + 1)) { const bf16x8 a = *(const LAS bf16x8*)(lds + toff + kk * 32), bq = *(const LAS bf16x8*)(lds + src + (((2 * kk + hi) ^ sw) << 4));
                        acc = __builtin_amdgcn_mfma_f32_32x32x16_bf16(a, bq, acc, 0, 0, 0); } }
                const int col = (w & 3) * 32 + r32;
                if (w < 4) {
#pragma unroll
                    for (int g = 0; g < 4; ++g) { u32x2 v2; v2.x = pk2(acc[4 * g], acc[4 * g + 1]); v2.y = pk2(acc[4 * g + 2], acc[4 * g + 3]);
                        *(LAS u32x2*)(lds + L_QN + col * 128 + (((4 * ib + g) ^ (col & 7)) << 4) + hi * 8) = v2; } }
                else { const int pc = permpos(col);
#pragma unroll
                    for (int rr = 0; rr < 16; ++rr) { const int i = ib * 32 + crow32(rr, hi); *(LAS bf16_t*)(lds + L_KN + i * 256 + pc * 2) = (bf16_t)(pk2(acc[rr], 0.f) & 0xffffu); } } } }
        LDS_BARRIER();
#pragma unroll
        for (int k = 0; k < 7; ++k) { const int u = tid + 512 * k; int lo, go;
            if (k < 2) { lo = L_KN + u * 16; go = GT_W + u * 16; } else if (k < 4) { const int uu = u - 1024, row = uu >> 3; lo = L_QN + row * 128 + (((uu & 7) ^ (row & 7)) << 4); go = GT_U + uu * 16; }
            else if (k < 6) { const int uu = u - 2048, row = uu >> 3; lo = L_KGT + row * 128 + (((uu & 7) ^ ((row >> 4) & 7)) << 4); go = GT_KG + uu * 16; } else { lo = L_ATP + (u - 3072) * 16; go = GT_AT + (u - 3072) * 16; }
            __builtin_nontemporal_store(*(const LAS u32x4*)(lds + lo), (u32x4*)(gb + go)); }
    }
}
constexpr int SC_W = 0, SC_QG = 17408, SC_KG = 34816, SC_AT = 53248, SC_BUF = 62464, SC_OS = 2 * SC_BUF;
__device__ __forceinline__ void ph_gdn_scan(CtxP cp, int l, LAS unsigned char* lds) {
    CTX_LOAD(cp);
    const int bid_ = obid(), grid_ = ogrid(); const int tid = otid(), lane = tid & 63, w = __builtin_amdgcn_readfirstlane(tid >> 6), m16 = lane & 15, q = lane >> 4;
    const float* EGL = WS_PTR(float, WS_EGL);
    const int nsmpwg = grid_ - 96;
    for (int it = 0;; ++it) {
        int grp, bh, half, nch, tk0;
        if (bid_ < 96) { if (it > 0) break; grp = 0; half = (bid_ >> 3) & 1; bh = (bid_ >> 4) * 8 + (bid_ & 7); nch = 64; tk0 = bh * 64; }
        else { const int si = (bid_ - 96) + nsmpwg * it; if (si >= 768) break; grp = 1; bh = si >> 1; half = si & 1; nch = 1; tk0 = NTASK_P + bh; }
        const int b = bh / 12, h = bh % 12, m0 = grp ? MP + b * 32 : b * 4096;
        __syncthreads();
        if (w >= 4) {
            const int lt = tid - 256; u32x4 stA[14], stB[14];
#define SC_LOAD(ST, tk) do { const unsigned char* gsrc = c.ws + WS_GDNBUF + (size_t)(tk) * GT_BYTES; _Pragma("unroll") for (int k = 0; k < 14; ++k) ST[k] = *(const u32x4*)(gsrc + (size_t)(lt + 256 * k) * 16); } while (0)
#define SC_WRITE(ST, bufoff) do { _Pragma("unroll") for (int k = 0; k < 14; ++k) { const int u = lt + 256 * k; int lo; \
            if (k < 4) lo = SC_W + (u >> 4) * 272 + (u & 15) * 16; else if (k < 8) lo = SC_QG + ((u - 1024) >> 4) * 272 + (u & 15) * 16; \
            else if (k < 12) lo = SC_KG + ((u - 2048) >> 3) * 144 + (u & 7) * 16; else lo = SC_AT + ((u - 3072) >> 3) * 144 + (u & 7) * 16; \
            *(LAS u32x4*)(lds + (bufoff) + lo) = ST[k]; } } while (0)
            bf16_t* Ob = WS_PTR(bf16_t, WS_OF) + (size_t)m0 * TOK + h * HD + half * 64; const int nou = grp ? 256 : 512;
#define SC_OUT(ch_) do { _Pragma("unroll") for (int k = 0; k < 2; ++k) { const int u = lt + 256 * k; if (u < nou) \
                *(u32x4*)(Ob + (size_t)((ch_) * 64 + (u >> 3)) * TOK + (u & 7) * 8) = *(const LAS u32x4*)(lds + SC_OS + ((ch_) & 1) * 8192 + u * 16); } } while (0)
            SC_LOAD(stA, tk0); SC_WRITE(stA, 0);
            if (1 < nch) SC_LOAD(stA, tk0 + 1);
            if (2 < nch) SC_LOAD(stB, tk0 + 2);
            LDS_BARRIER();
            for (int ch = 0; ch < nch; ch += 2) {
                if (ch >= 1) SC_OUT(ch - 1);
                if (ch + 1 < nch) SC_WRITE(stA, ((ch + 1) & 1) * SC_BUF);
                if (ch + 3 < nch) SC_LOAD(stA, tk0 + ch + 3);
                LDS_BARRIER();
                if (ch + 1 < nch) {
                    SC_OUT(ch);
                    if (ch + 2 < nch) SC_WRITE(stB, ((ch + 2) & 1) * SC_BUF);
                    if (ch + 4 < nch) SC_LOAD(stB, tk0 + ch + 4);
                    LDS_BARRIER(); }
            }
            SC_OUT(nch - 1);
#undef SC_OUT
#undef SC_LOAD
#undef SC_WRITE
        } else {
            __builtin_amdgcn_s_setprio(2);
            const int c0 = half * 64 + 16 * w;
            f32x4 S[8];
            if (grp) { const float* S0 = c.in[I_SGDN] + (size_t)((l * 32 + b) * 12 + h) * 16384;
#pragma unroll
                for (int dt = 0; dt < 8; ++dt)
#pragma unroll
                    for (int i = 0; i < 4; ++i) S[dt][i] = S0[(16 * dt + 4 * q + i) * 128 + c0 + m16]; }
            else {
#pragma unroll
                for (int dt = 0; dt < 8; ++dt) S[dt] = (f32x4){0.f, 0.f, 0.f, 0.f}; }
            u32x2 un[4]; float egn;
#define UE_LOAD(tk_) do { const unsigned char* ut_ = c.ws + WS_GDNBUF + (size_t)(tk_) * GT_BYTES + GT_U + (c0 + m16) * 128 + 8 * q; \
            _Pragma("unroll") for (int mt = 0; mt < 4; ++mt) un[mt] = *(const u32x2*)(ut_ + 32 * mt); egn = EGL[tk_]; } while (0)
            UE_LOAD(tk0);
            LDS_BARRIER();
            for (int ch = 0; ch < nch; ++ch) { const int bo = (ch & 1) * SC_BUF; const int tk = tk0 + ch;
                u32x2 uc[4]; const float egl = egn;
#pragma unroll
                for (int mt = 0; mt < 4; ++mt) uc[mt] = un[mt];
                if (ch + 1 < nch) UE_LOAD(tk + 1);
                bf16x8 Sb[4];
#pragma unroll
                for (int ks = 0; ks < 4; ++ks) { u32x4 t4; t4.x = pk2(S[2 * ks][0], S[2 * ks][1]); t4.y = pk2(S[2 * ks][2], S[2 * ks][3]); t4.z = pk2(S[2 * ks + 1][0], S[2 * ks + 1][1]); t4.w = pk2(S[2 * ks + 1][2], S[2 * ks + 1][3]);
                    Sb[ks] = __builtin_bit_cast(bf16x8, t4); }
                f32x4 Vn[4], Out[4];
#pragma unroll
                for (int mt = 0; mt < 4; ++mt) { f32x4 a1 = {0.f, 0.f, 0.f, 0.f}, a2 = {0.f, 0.f, 0.f, 0.f};
#pragma unroll
                    for (int ks = 0; ks < 4; ++ks) { const bf16x8 aw = *(const LAS bf16x8*)(lds + bo + SC_W + (16 * mt + m16) * 272 + ks * 64 + q * 16), aq = *(const LAS bf16x8*)(lds + bo + SC_QG + (16 * mt + m16) * 272 + ks * 64 + q * 16);
                        a1 = __builtin_amdgcn_mfma_f32_16x16x32_bf16(aw, Sb[ks], a1, 0, 0, 0); a2 = __builtin_amdgcn_mfma_f32_16x16x32_bf16(aq, Sb[ks], a2, 0, 0, 0); }
                    const u32x2 uu = uc[mt];
                    Vn[mt] = (f32x4){bflo(uu.x) - a1[0], bfhi(uu.x) - a1[1], bflo(uu.y) - a1[2], bfhi(uu.y) - a1[3]}; Out[mt] = a2; }
                bf16x8 Vb[2];
#pragma unroll
                for (int ks = 0; ks < 2; ++ks) { u32x4 t4; t4.x = pk2(Vn[2 * ks][0], Vn[2 * ks][1]); t4.y = pk2(Vn[2 * ks][2], Vn[2 * ks][3]); t4.z = pk2(Vn[2 * ks + 1][0], Vn[2 * ks + 1][1]); t4.w = pk2(Vn[2 * ks + 1][2], Vn[2 * ks + 1][3]);
                    Vb[ks] = __builtin_bit_cast(bf16x8, t4); }
#pragma unroll
                for (int mt = 0; mt < 4; ++mt)
#pragma unroll
                    for (int ks = 0; ks < 2; ++ks) { const bf16x8 aa = *(const LAS bf16x8*)(lds + bo + SC_AT + (16 * mt + m16) * 144 + ks * 64 + q * 16);
                        Out[mt] = __builtin_amdgcn_mfma_f32_16x16x32_bf16(aa, Vb[ks], Out[mt], 0, 0, 0); }
#pragma unroll
                for (int dt = 0; dt < 8; ++dt) { S[dt] = S[dt] * egl;
#pragma unroll
                    for (int ks = 0; ks < 2; ++ks) { const bf16x8 ak = *(const LAS bf16x8*)(lds + bo + SC_KG + (16 * dt + m16) * 144 + ks * 64 + q * 16);
                        S[dt] = __builtin_amdgcn_mfma_f32_16x16x32_bf16(ak, Vb[ks], S[dt], 0, 0, 0); } }
#pragma unroll
                for (int mt = 0; mt < 4; ++mt)
#pragma unroll
                    for (int e = 0; e < 4; ++e) *(LAS bf16_t*)(lds + SC_OS + (ch & 1) * 8192 + (16 * mt + 4 * q + e) * 128 + (16 * w + m16) * 2) = (bf16_t)(pk2(Out[mt][e], 0.f) & 0xffffu);
                LDS_BARRIER();
            }
            float* So = c.out + (grp ? O_SGDN + (size_t)((l * 32 + b) * 12 + h) * 16384 : O_PGDN + (size_t)((l * 4 + b) * 12 + h) * 16384);
#pragma unroll
            for (int dt = 0; dt < 8; ++dt)
#pragma unroll
                for (int i = 0; i < 4; ++i) So[(16 * dt + 4 * q + i) * 128 + c0 + m16] = S[dt][i];
            __builtin_amdgcn_s_setprio(0);
#undef UE_LOAD
        }
    }
}
#undef LDS_BARRIER
#define XB_TMO      128
#define XB_XCNT(j)  (256  + 64 * (j))
#define XB_XSUB(j)  (1280 + 64 * (j))
#define XB_XGEN(j)  (2304 + 64 * (j))
#define XB_TOP      3328
#define XB_TOPGEN   3392
#define XCD_BAR_WORDS 3456
#define XB_SPIN_CAP (1u << 18)

__device__ __forceinline__ unsigned xb_ld(unsigned* p)              { return __hip_atomic_load(p, __ATOMIC_RELAXED, __HIP_MEMORY_SCOPE_AGENT); }
__device__ __forceinline__ unsigned xb_add(unsigned* p, unsigned v) { return __hip_atomic_fetch_add(p, v, __ATOMIC_RELAXED, __HIP_MEMORY_SCOPE_AGENT); }
__device__ __forceinline__ unsigned xb_xcc_id() { return (unsigned)__builtin_amdgcn_s_getreg((3 << 11) | 20) & 0xFu; }
#define XB_SPIN(cond, bar) do { unsigned _sp = 0; while (cond) { __builtin_amdgcn_s_sleep(1); \
    if ((++_sp & 255u) == 0u) { if (xb_ld(&(bar)[XB_TMO])) break; if (_sp > XB_SPIN_CAP) { atomicAdd(&(bar)[XB_TMO], 1u); break; } } } } while (0)
struct XcdBarrier {
    unsigned* bar; unsigned x;
    volatile LAS unsigned* st;
};

__device__ __forceinline__ XcdBarrier xcd_barrier_post(unsigned* bar, volatile LAS unsigned* st) {
    XcdBarrier b; b.bar = bar; b.x = xb_xcc_id(); b.st = st;
    if (threadIdx.x == 0) (void)xb_add(&bar[XB_XCNT(b.x)], 1u);
    return b;
}
__device__ __forceinline__ void xcd_barrier_complete(unsigned* bar, unsigned x, unsigned& nloc, unsigned& nx) {
    const unsigned G = gridDim.x * gridDim.y * gridDim.z;
    unsigned sum, cnt, mine, sp = 0u;
    for (;;) {
        sum = 0u; cnt = 0u; mine = 0u;
#pragma unroll
        for (unsigned j = 0; j < 16; ++j) { const unsigned c = xb_ld(&bar[XB_XCNT(j)]); sum += c; cnt += (c > 0u) ? 1u : 0u; mine = (j == x) ? c : mine; }
        if (sum == G) break;
        __builtin_amdgcn_s_sleep(1);
        if ((++sp & 255u) == 0u) { if (xb_ld(&bar[XB_TMO])) break; if (sp > XB_SPIN_CAP) { atomicAdd(&bar[XB_TMO], 1u); break; } }
    }
    nloc = mine > 0u ? mine : 1u; nx = cnt > 0u ? cnt : 1u;
}

__device__ __forceinline__ void xcd_barrier(const XcdBarrier& b, const bool leader  ) {
    asm volatile("s_waitcnt vmcnt(0)" ::: "memory");
    __syncthreads();
    if (leader) {
        unsigned* bar = b.bar;
        __builtin_amdgcn_s_waitcnt(0);
        unsigned nloc = b.st[0], nx = b.st[1];
        if (nloc == 0u) { xcd_barrier_complete(bar, b.x, nloc, nx); b.st[0] = nloc; b.st[1] = nx; }
        const unsigned old = xb_add(&bar[XB_XSUB(b.x)], 1u);
        const unsigned gen = old / nloc;
        if (old + 1u == (gen + 1u) * nloc) {
            __builtin_amdgcn_fence(__ATOMIC_RELEASE, "agent");
            asm volatile("s_waitcnt vmcnt(0)" ::: "memory");
            const unsigned og = xb_add(&bar[XB_TOP], 1u);
            const unsigned tg = og / nx;
            if (og + 1u == (tg + 1u) * nx) xb_add(&bar[XB_TOPGEN], 1u);
            else XB_SPIN(xb_ld(&bar[XB_TOPGEN]) == tg, bar);
            __builtin_amdgcn_fence(__ATOMIC_ACQUIRE, "agent");
            xb_add(&bar[XB_XGEN(b.x)], 1u);
            asm volatile("s_waitcnt vmcnt(0)" ::: "memory");
        } else {
            XB_SPIN(xb_ld(&bar[XB_XGEN(b.x)]) == gen, bar);
            __builtin_amdgcn_fence(__ATOMIC_ACQUIRE, "agent");
            asm volatile("s_waitcnt vmcnt(0)" ::: "memory");
        }
    }
    __syncthreads();
}
namespace fa {
constexpr int NW = 8, QBLK = 32, KVBLK = 64, QB = NW * QBLK, HDm = 128;
constexpr int SHM_V = KVBLK * HDm * 2, SHM_K = KVBLK * HDm * 2;
constexpr int LDS_BYTES = 2 * SHM_V + 2 * SHM_K + NW * 64 * 4;
constexpr float THR = 8.f;
constexpr int XOFF = LDS_BYTES + 64, XBUF = 2048;
typedef short s16x4 __attribute__((ext_vector_type(4)));
#define KSWZ(row, colB) ((row) * 256 + ((colB) ^ (((row) & 7) << 4)))
#define SBAR() __builtin_amdgcn_sched_barrier(0)
__device__ __forceinline__ int v_st(int k, int c) { const int kk = (k & ~0xC) | ((k & 4) << 1) | ((k & 8) >> 1); return ((kk >> 3) * 4 + (c >> 5)) * 512 + ((kk & 7) * 32 + (c & 31)) * 2; }
__device__ __forceinline__ int v_rd_base(int lane) { return ((lane & 3) << 3) | (((lane >> 2) & 3) << 6) | (((lane >> 4) & 1) << 5) | (((lane >> 5) & 1) << 8); }
constexpr int v_rd_off(int d0, int ks, int half) { return d0 * 512 + ks * 4096 + half * 2048; }
__device__ __forceinline__ int crow(int r, int hi) { return (r & 3) + 8 * (r >> 2) + 4 * hi; }
__device__ __forceinline__ unsigned cvtpk(float lo, float hi) { unsigned r; asm volatile("v_cvt_pk_bf16_f32 %0, %1, %2" : "=v"(r) : "v"(lo), "v"(hi)); return r; }
__device__ __forceinline__ bf16x8 load8(const bf16_t* p) { return *reinterpret_cast<const bf16x8*>(p); }
__device__ __forceinline__ void mask_tile(f32x16& p0, f32x16& p1, int dq, unsigned W) {
    const float NEG = -__builtin_inff();
#pragma unroll
    for (int r = 0; r < 16; ++r) { const int c = (r & 3) + 8 * (r >> 2);
        if ((unsigned)(dq - c) >= W) p0[r] = NEG;
        if ((unsigned)(dq - c - 32) >= W) p1[r] = NEG; }
}
__device__ __forceinline__ void partialSM(f32x16& p0, f32x16& p1, float& m_reg, float& mn, float& alpha) {
    float pmax = p0[0]; for (int r = 1; r < 16; ++r) pmax = fmaxf(pmax, p0[r]); for (int r = 0; r < 16; ++r) pmax = fmaxf(pmax, p1[r]);
    { auto rr = __builtin_amdgcn_permlane32_swap(__float_as_uint(pmax), __float_as_uint(pmax), false, false);
      pmax = fmaxf(__uint_as_float(rr[0]), __uint_as_float(rr[1])); }
    constexpr float C2 = 1.4426950408889634f * SCALE;
    if (__builtin_expect(__all((pmax - m_reg) * SCALE <= THR), 1)) { mn = m_reg; alpha = 1.f; }
    else { mn = fmaxf(m_reg, pmax); alpha = __builtin_amdgcn_exp2f((m_reg - mn) * C2); m_reg = mn; }
    const float mnL = -mn * C2;
    for (int r = 0; r < 16; ++r) p0[r] = fmaf(p0[r], C2, mnL); for (int r = 0; r < 16; ++r) p1[r] = fmaf(p1[r], C2, mnL);
    for (int r = 0; r < 16; ++r) p0[r] = __builtin_amdgcn_exp2f(p0[r]);
}
__device__ __forceinline__ void finishSM(f32x16& p0, f32x16& p1, float alpha, float& l_reg, bf16x8& pa0, bf16x8& pa1, bf16x8& pa2, bf16x8& pa3) {
    for (int r = 0; r < 16; ++r) p1[r] = __builtin_amdgcn_exp2f(p1[r]);
    float ps = 0; for (int r = 0; r < 16; ++r) ps += p0[r]; for (int r = 0; r < 16; ++r) ps += p1[r];
    { auto rr = __builtin_amdgcn_permlane32_swap(__float_as_uint(ps), __float_as_uint(ps), false, false);
      ps = __uint_as_float(rr[0]) + __uint_as_float(rr[1]); }
    l_reg = l_reg * alpha + ps;
#define PK4(P, B_, OUT) do { unsigned a0 = cvtpk(P[B_+0], P[B_+1]), a1 = cvtpk(P[B_+2], P[B_+3]);                          \
        unsigned b0 = cvtpk(P[B_+4], P[B_+5]), b1 = cvtpk(P[B_+6], P[B_+7]);                                             \
        auto r0 = __builtin_amdgcn_permlane32_swap(a0, b0, false, false); auto r1 = __builtin_amdgcn_permlane32_swap(a1, b1, false, false); \
        u32x4 w = {r0[0], r1[0], r0[1], r1[1]}; OUT = *reinterpret_cast<bf16x8*>(&w); } while (0)
    PK4(p0, 0, pa0); PK4(p0, 8, pa1); PK4(p1, 0, pa2); PK4(p1, 8, pa3);
#undef PK4
}
template <int KB, bool BIAS>
__device__ __forceinline__ void qkt(f32x16& p0, f32x16& p1, const char* K_lds, const char* X_lds, int r32, int hi, const bf16x8* qr, bf16x8 qx) {
    p0 = f32x16{}; p1 = f32x16{};
    const char* kb[4];
#pragma unroll
    for (int dd = 0; dd < 4; ++dd) kb[dd] = K_lds + KB * SHM_K + KSWZ(r32, (dd * 16 + hi * 8) * 2);
    if (BIAS) { const bf16x8 kx0 = *reinterpret_cast<const bf16x8*>(X_lds + KB * XBUF + r32 * 32 + hi * 16), kx1 = *reinterpret_cast<const bf16x8*>(X_lds + KB * XBUF + (32 + r32) * 32 + hi * 16);
        p0 = __builtin_amdgcn_mfma_f32_32x32x16_bf16(kx0, qx, p0, 0, 0, 0); p1 = __builtin_amdgcn_mfma_f32_32x32x16_bf16(kx1, qx, p1, 0, 0, 0); }
#pragma unroll
    for (int d0 = 0; d0 < 8; ++d0) { const char* a = kb[d0 & 3] + (d0 >> 2) * 128;
        bf16x8 b0 = *reinterpret_cast<const bf16x8*>(a);
        bf16x8 b1 = *reinterpret_cast<const bf16x8*>(a + 32 * 256);
        p0 = __builtin_amdgcn_mfma_f32_32x32x16_bf16(b0, qr[d0], p0, 0, 0, 0);
        p1 = __builtin_amdgcn_mfma_f32_32x32x16_bf16(b1, qr[d0], p1, 0, 0, 0); }
}
template <int VB>
__device__ __forceinline__ void pv_tile(f32x16* o, int vb0, bf16x8 pa0, bf16x8 pa1, bf16x8 pa2, bf16x8 pa3) {
#define TRRD(dst, off) asm volatile("ds_read_b64_tr_b16 %0, %1 offset:%2" : "=&v"(dst) : "v"(vb0), "i"(off) : "memory")
#define PV_D0(d0) do { s16x4 l0, l1, l2, l3, h0, h1, h2, h3; constexpr int b_ = VB * SHM_V + v_rd_off(d0, 0, 0); \
        TRRD(l0, b_); TRRD(h0, b_ + 2048); TRRD(l1, b_ + 4096); TRRD(h1, b_ + 6144); TRRD(l2, b_ + 8192); TRRD(h2, b_ + 10240); TRRD(l3, b_ + 12288); TRRD(h3, b_ + 14336); \
        asm volatile("s_waitcnt lgkmcnt(0)" ::: "memory"); SBAR();   \
        o[d0] = __builtin_amdgcn_mfma_f32_32x32x16_bf16(pa0, (bf16x8){l0[0], l0[1], l0[2], l0[3], h0[0], h0[1], h0[2], h0[3]}, o[d0], 0, 0, 0);   \
        o[d0] = __builtin_amdgcn_mfma_f32_32x32x16_bf16(pa1, (bf16x8){l1[0], l1[1], l1[2], l1[3], h1[0], h1[1], h1[2], h1[3]}, o[d0], 0, 0, 0);   \
        o[d0] = __builtin_amdgcn_mfma_f32_32x32x16_bf16(pa2, (bf16x8){l2[0], l2[1], l2[2], l2[3], h2[0], h2[1], h2[2], h2[3]}, o[d0], 0, 0, 0);   \
        o[d0] = __builtin_amdgcn_mfma_f32_32x32x16_bf16(pa3, (bf16x8){l3[0], l3[1], l3[2], l3[3], h3[0], h3[1], h3[2], h3[3]}, o[d0], 0, 0, 0); } while (0)
    PV_D0(0); PV_D0(1); PV_D0(2); PV_D0(3);
#undef PV_D0
#undef TRRD
}
struct Ref { int a, b, c; };
struct Seam { bf16x8 qr[8]; bf16x8 qx; bf16x8 st_v0, st_v1, st_k0, st_k1, st_kx; };
__device__ __forceinline__ int swa_jlo(int P0, int W) { const int lowk = P0 - W + 1; return lowk > 0 ? lowk / KVBLK : 0; }
#define ROW(p, k0, rr) ((p) + (size_t)((k0) + (rr)) * KP + sc)
#define VMW() asm volatile("s_waitcnt vmcnt(0)" ::: "memory")
#define VMWN(n) asm volatile("s_waitcnt vmcnt(%0)" :: "i"(n) : "memory")
#define SLOAD_H(Kp, Vp, k0) do { S.st_v0 = load8(ROW(Vp, k0, sr)); S.st_v1 = load8(ROW(Vp, k0, 32 + sr)); S.st_k0 = load8(ROW(Kp, k0, sr)); S.st_k1 = load8(ROW(Kp, k0, 32 + sr)); } while (0)
#define LOADKX(KXp, k0) do { if (BIAS && tid < 64) S.st_kx = load8((KXp) + (size_t)((k0) + tid) * 8); } while (0)
#define SWRITE_HK(bf) do { *(bf16x8*)(K_lds + (bf) * SHM_K + kws) = S.st_k0; *(bf16x8*)(K_lds + (bf) * SHM_K + kws + 32 * 256) = S.st_k1; if (BIAS && tid < 64) *(bf16x8*)(lds + XOFF + (bf) * XBUF + tid * 32) = S.st_kx; } while (0)
#define SWRITE_HV(bf) do { *(bf16x8*)(V_lds + (bf) * SHM_V + vst0) = S.st_v0; *(bf16x8*)(V_lds + (bf) * SHM_V + vst1) = S.st_v1; } while (0)
#define SWRITE_H(bf) do { SWRITE_HV(bf); SWRITE_HK(bf); } while (0)
template <class Lay>
__device__ __forceinline__ void prime(unsigned char* wsb, const Ref& cur, int W, char* lds, Seam& S, int tid) {
    constexpr int QP = Lay::QP, KP = Lay::KP; constexpr bool BIAS = Lay::BIAS;
    const int wid = __builtin_amdgcn_readfirstlane(tid >> 6), lane = tid & 63, r32 = lane & 31, hi = lane >> 5;
    const int sr = tid >> 4, sc = (tid & 15) * 8, kws = KSWZ(sr, sc * 2); char* K_lds = lds + 2 * SHM_V;
    const int kb0 = swa_jlo(Lay::p0(cur), W) * KVBLK; const bf16_t* Qc = Lay::q(wsb, cur);
#pragma unroll
    for (int d0 = 0; d0 < 8; ++d0) S.qr[d0] = load8(Qc + (size_t)(wid * QBLK + r32) * QP + d0 * 16 + hi * 8);
    S.qx = bf16x8{}; S.st_kx = bf16x8{};
    if (BIAS && tid < 128) { unsigned zz = 0u; asm volatile("" : "+v"(zz)); *(u32x4*)(lds + XOFF + (tid >> 6) * XBUF + (tid & 63) * 32 + 16) = (u32x4){zz, zz, zz, zz}; }
    if (BIAS) S.qx = load8(hi ? Lay::z(wsb) : Lay::qx(wsb, cur) + (size_t)(wid * QBLK + r32) * 8);
    { const bf16_t* Kc = Lay::k(wsb, cur); const bf16_t* Vc = Lay::v(wsb, cur); SLOAD_H(Kc, Vc, kb0); LOADKX(Lay::kx(wsb, cur), kb0); } VMW(); SWRITE_HK(0);
    __syncthreads();
}
template <class Lay>
__device__ __forceinline__ void block(unsigned char* wsb, const Ref& cur, const Ref& nxt, int skv, int W, char* lds, Seam& S, int tid) {
    asm volatile("" : "+v"(tid));
    constexpr int QP = Lay::QP, KP = Lay::KP, OP = Lay::OP; constexpr bool BIAS = Lay::BIAS, GATE = Lay::GATE; const int P0c = Lay::p0(cur);
    const int wid = __builtin_amdgcn_readfirstlane(tid >> 6), lane = tid & 63, r32 = lane & 31, hi = lane >> 5;
    const int j_lo = swa_jlo(P0c, W);
    int j_hi = (P0c + QB - 1) / KVBLK + 1; if (j_hi > skv / KVBLK) j_hi = skv / KVBLK;
    const int NT = j_hi - j_lo;
    const int kbn = swa_jlo(Lay::p0(nxt), W) * KVBLK;
    const int qlo = P0c + wid * QBLK, qm = qlo + r32 - 4 * hi;
    char* V_lds = lds; char* K_lds = lds + 2 * SHM_V;
    float* ws = (float*)(lds + 2 * SHM_V + 2 * SHM_K) + wid * 64; float* li_l = ws, * al_l = ws + 32;
    float m_reg = -1e30f, l_reg = 0; f32x16 o[4] = {};
    const int sr = tid >> 4, sc = (tid & 15) * 8, vst0 = v_st(sr, sc), vst1 = v_st(32 + sr, sc), kws = KSWZ(sr, sc * 2);
    const int vb0 = (int)(uintptr_t)V_lds + v_rd_base(lane);
    const bf16_t* Kh = Lay::k(wsb, cur); const bf16_t* Vh = Lay::v(wsb, cur); const bf16_t* KXh = Lay::kx(wsb, cur);
    const char* X_lds = lds + XOFF;
#define RESC(a) do { if (__any((a) < 1.f)) { if (hi == 0) al_l[r32] = (a); asm volatile("s_waitcnt lgkmcnt(0)" ::: "memory");              \
                     for (int d_ = 0; d_ < 4; ++d_) for (int r = 0; r < 16; ++r) o[d_][r] *= al_l[crow(r, hi)]; } } while (0)
#define KBASE(t) ((j_lo + (t)) * KVBLK)
#define MASKT(P0_, P1_, t) do { const int kb_ = KBASE(t); if (kb_ + KVBLK - 1 > qlo || kb_ <= qlo + QBLK - 1 - W) mask_tile(P0_, P1_, qm - kb_, (unsigned)W); } while (0)
    constexpr int NQL = BIAS ? 9 : 8;
#define SEAM_K0() do { VMWN(NQL); SWRITE_HK(0); SBAR(); } while (0)
    f32x16 pA0, pA1, pB0, pB1; float mnA, mnB, alA, alB; bf16x8 pa0, pa1, pa2, pa3;
    SWRITE_HV(0); SBAR();
    if (NT > 1) { SLOAD_H(Kh, Vh, KBASE(1)); LOADKX(KXh, KBASE(1)); }
    SBAR(); qkt<0, BIAS>(pA0, pA1, K_lds, X_lds, r32, hi, S.qr, S.qx);
    MASKT(pA0, pA1, 0); partialSM(pA0, pA1, m_reg, mnA, alA);
    if (NT > 1) { VMW(); SWRITE_H(1); }
    __syncthreads();
#define HALF_STEP(PX0, PX1, mnX, alX, PY0, PY1, alY, t, KB, VB, SB) do {                                                      \
        SBAR(); qkt<KB, BIAS>(PX0, PX1, K_lds, X_lds, r32, hi, S.qr, S.qx);                                             \
        finishSM(PY0, PY1, alY, l_reg, pa0, pa1, pa2, pa3); SBAR();                                                           \
        if ((t) + 1 < NT) { SLOAD_H(Kh, Vh, KBASE((t) + 1)); LOADKX(KXh, KBASE((t) + 1)); SBAR(); }               \
        pv_tile<VB>(o, vb0, pa0, pa1, pa2, pa3); MASKT(PX0, PX1, (t)); partialSM(PX0, PX1, m_reg, mnX, alX);                  \
        __syncthreads();                                                                                                      \
        if ((t) + 1 < NT) { VMW(); SWRITE_H(SB); }                                                                            \
        RESC(alX); __syncthreads(); } while (0)
    for (int t = 1; t + 1 < NT; t += 2) {
        HALF_STEP(pB0, pB1, mnB, alB, pA0, pA1, alA, t, 1, 0, 0);
        HALF_STEP(pA0, pA1, mnA, alA, pB0, pB1, alB, t + 1, 0, 1, 1);
    }
    const bool even = (NT & 1) == 0;
    if (even) { SBAR(); qkt<1, BIAS>(pB0, pB1, K_lds, X_lds, r32, hi, S.qr, S.qx); SBAR(); }
    { const bf16_t* Kn = Lay::k(wsb, nxt); const bf16_t* Vn = Lay::v(wsb, nxt); SLOAD_H(Kn, Vn, kbn); LOADKX(Lay::kx(wsb, nxt), kbn); } SBAR();
    { const bf16_t* Qn = Lay::q(wsb, nxt);
#pragma unroll
    for (int d0 = 0; d0 < 8; ++d0) S.qr[d0] = load8(Qn + (size_t)(wid * QBLK + r32) * QP + d0 * 16 + hi * 8); }
    if (BIAS) S.qx = load8(hi ? Lay::z(wsb) : Lay::qx(wsb, nxt) + (size_t)(wid * QBLK + r32) * 8);
    SBAR();
    finishSM(pA0, pA1, alA, l_reg, pa0, pa1, pa2, pa3); SBAR();
    pv_tile<0>(o, vb0, pa0, pa1, pa2, pa3);
    if (even) { MASKT(pB0, pB1, NT - 1); partialSM(pB0, pB1, m_reg, mnB, alB); __syncthreads(); RESC(alB);
        finishSM(pB0, pB1, alB, l_reg, pa0, pa1, pa2, pa3); SBAR(); pv_tile<1>(o, vb0, pa0, pa1, pa2, pa3); }
    SBAR(); SEAM_K0();
    if (hi == 0) li_l[r32] = l_reg; asm volatile("s_waitcnt lgkmcnt(0)" ::: "memory");
    float rli[16];
#pragma unroll
    for (int r = 0; r < 16; ++r) rli[r] = __builtin_amdgcn_rcpf(li_l[crow(r, hi)]);
    bf16_t* Ow = Lay::o(wsb, cur) + (size_t)(wid * QBLK) * OP; const bf16_t* Gw = Lay::g(wsb, cur) + (size_t)(wid * QBLK) * QP;
#pragma unroll
    for (int r = 0; r < 16; ++r) { const int orow = crow(r, hi);
#pragma unroll
        for (int d0 = 0; d0 < 4; ++d0) { const float v = o[d0][r] * rli[r];
            const float vn = lane_get(v, lane ^ 1);
            if ((r32 & 1) == 0) { float a = v, b = vn;
                if (GATE) { const unsigned gu = *(const unsigned*)(Gw + (size_t)orow * QP + d0 * 32 + r32); a *= fast_sigmoid(bflo(gu)); b *= fast_sigmoid(bfhi(gu)); }
                *(unsigned*)(Ow + (size_t)orow * OP + d0 * 32 + r32) = cvtpk(a, b); } } }
    __syncthreads();
#undef RESC
#undef KBASE
#undef MASKT
#undef SEAM_K0
#undef HALF_STEP
}
#undef ROW
#undef VMW
#undef VMWN
#undef SLOAD_H
#undef LOADKX
#undef SWRITE_HK
#undef SWRITE_HV
#undef SWRITE_H
#undef KSWZ
#undef SBAR
}
struct LayFox {
    static constexpr int QP = PJ, KP = TOK, OP = D; static constexpr bool BIAS = true, GATE = false;
    static __device__ __forceinline__ size_t row0(const fa::Ref& r) { return (size_t)(r.a / 12) * 4096 + r.b * 256; }
    static __device__ __forceinline__ int p0(const fa::Ref& r) { return r.b * 256; }
    static __device__ __forceinline__ const bf16_t* q(unsigned char* ws, const fa::Ref& r) { return (const bf16_t*)(ws + WS_PROJ) + row0(r) * PJ + (r.a % 12) * HD; }
    static __device__ __forceinline__ const bf16_t* g(unsigned char* ws, const fa::Ref& r) { return q(ws, r) + TOK; }
    static __device__ __forceinline__ const bf16_t* k(unsigned char* ws, const fa::Ref& r) { return (const bf16_t*)(ws + WS_KB) + (size_t)(r.a / 12) * 4096 * TOK + (r.a % 12) * HD; }
    static __device__ __forceinline__ const bf16_t* v(unsigned char* ws, const fa::Ref& r) { return (const bf16_t*)(ws + WS_VB) + (size_t)(r.a / 12) * 4096 * TOK + (r.a % 12) * HD; }
    static __device__ __forceinline__ bf16_t* o(unsigned char* ws, const fa::Ref& r) { return (bf16_t*)(ws + WS_ACT) + row0(r) * D + (r.a % 12) * HD; }
    static __device__ __forceinline__ const bf16_t* qx(unsigned char* ws, const fa::Ref& r) { return (const bf16_t*)(ws + WS_QX) + ((size_t)r.a * 4096 + r.b * 256) * 8; }
    static __device__ __forceinline__ const bf16_t* kx(unsigned char* ws, const fa::Ref& r) { return (const bf16_t*)(ws + WS_KX) + (size_t)r.a * 4096 * 8; }
    static __device__ __forceinline__ const bf16_t* z(unsigned char* ws) { return (const bf16_t*)(ws + WS_CTL + CTL_ZROW); }
};
__device__ __forceinline__ void fox_gate_block(unsigned char* ws, const fa::Ref& r, int tid) {
    asm volatile("s_waitcnt vmcnt(0)" ::: "memory"); __syncthreads();
    asm volatile("" : "+v"(tid));
    bf16_t* O = LayFox::o(ws, r); const bf16_t* G = LayFox::g(ws, r);
#pragma unroll
    for (int k = 0; k < 8; ++k) { const int u = tid + 512 * k, row = u >> 4, cu = (u & 15) * 8;
        const u32x4 ov = *(const u32x4*)(O + (size_t)row * D + cu), gv = __builtin_nontemporal_load((const u32x4*)(G + (size_t)row * PJ + cu)); u32x4 w;
        w.x = pk2(bflo(ov.x) * fast_sigmoid(bflo(gv.x)), bfhi(ov.x) * fast_sigmoid(bfhi(gv.x))); w.y = pk2(bflo(ov.y) * fast_sigmoid(bflo(gv.y)), bfhi(ov.y) * fast_sigmoid(bfhi(gv.y)));
        w.z = pk2(bflo(ov.z) * fast_sigmoid(bflo(gv.z)), bfhi(ov.z) * fast_sigmoid(bfhi(gv.z))); w.w = pk2(bflo(ov.w) * fast_sigmoid(bflo(gv.w)), bfhi(ov.w) * fast_sigmoid(bfhi(gv.w)));
        *(u32x4*)(O + (size_t)row * D + cu) = w; }
}
__device__ __forceinline__ void ph_fox_prompt(CtxP cp, int l, char* ldsg, LAS unsigned char* lds) {
    CTX_LOAD(cp);
    const int tid = otid();
    unsigned* qheads = (unsigned*)(c.ws + WS_CTL + CTL_QFOX) + 64 * 8 * l;
    LAS int* slot = (LAS int*)(lds + fa::LDS_BYTES);
    if (tid == 0) { slot[2] = (int)(xb_xcc_id() & 7u); slot[3] = 8; }
#define FOX_FETCH(dst, k) do { if (tid == 0) { int r_ = -1, myq_ = slot[2], qleft_ = slot[3]; while (qleft_ > 0) { const int i_ = (int)__hip_atomic_fetch_add(qheads + 64 * myq_, 1u, __ATOMIC_RELAXED, __HIP_MEMORY_SCOPE_AGENT); \
                if (i_ < 96) { r_ = ((i_ % 6) * 8 + myq_) * 16 + (15 - i_ / 6); break; } myq_ = (myq_ + 1) & 7; --qleft_; } slot[k] = r_; slot[2] = myq_; slot[3] = qleft_; } \
            __syncthreads(); dst = __builtin_amdgcn_readfirstlane(slot[k]); } while (0)
    int idx; FOX_FETCH(idx, 0);
    if (idx >= 0) {
        fa::Ref cur{idx >> 4, idx & 15, 0}, nxt; fa::Seam S;
        fa::prime<LayFox>(c.ws, cur, 1 << 29, ldsg, S, tid);
        for (int k = 1;; k ^= 1) {
            int nidx; FOX_FETCH(nidx, k);
            const bool more = nidx >= 0;
            if (more) nxt = fa::Ref{nidx >> 4, nidx & 15, 0}; else nxt = cur;
            fa::block<LayFox>(c.ws, cur, nxt, 4096, 1 << 29, ldsg, S, tid);
            fox_gate_block(c.ws, cur, tid);
            if (!more) break;
            cur = nxt;
        }
    }
#undef FOX_FETCH
}
struct LayMem {
    static constexpr int QP = PJ, KP = 4096, OP = D; static constexpr bool BIAS = false, GATE = false;
    static __device__ __forceinline__ size_t row0(const fa::Ref& r) { return (size_t)(r.a >> 2) * 4096 + r.b * 256; }
    static __device__ __forceinline__ int p0(const fa::Ref&) { return 256; }
    static __device__ __forceinline__ const bf16_t* q(unsigned char* ws, const fa::Ref& r) { return (const bf16_t*)(ws + WS_PROJ) + row0(r) * PJ + (r.c < 2 ? 6144 : 3072) + (r.a & 3) * HD; }
    static __device__ __forceinline__ const bf16_t* g(unsigned char* ws, const fa::Ref& r) { return q(ws, r); }
    static __device__ __forceinline__ const bf16_t* k(unsigned char* ws, const fa::Ref& r) { return (const bf16_t*)(ws + WS_MEMKVB) + (size_t)(r.a >> 2) * 256 * 4096 + r.c * 1024 + (r.a & 3) * HD; }
    static __device__ __forceinline__ const bf16_t* v(unsigned char* ws, const fa::Ref& r) { return k(ws, r) + 512; }
    static __device__ __forceinline__ bf16_t* o(unsigned char* ws, const fa::Ref& r) { return (bf16_t*)(ws + WS_ACT) + row0(r) * D + TOK + (r.a & 3) * HD; }
    static __device__ __forceinline__ const bf16_t* qx(unsigned char* ws, const fa::Ref& r) { return nullptr; }
    static __device__ __forceinline__ const bf16_t* kx(unsigned char* ws, const fa::Ref& r) { return nullptr; }
    static __device__ __forceinline__ const bf16_t* z(unsigned char* ws) { return nullptr; }
};
__device__ __forceinline__ void ph_mem_prompt(CtxP cp, int l, char* ldsg, int wg0, int nwg) {
    CTX_LOAD(cp);
    const int tid = otid(), bid_ = obid() - wg0, grid_ = nwg;
    int idx = bid_;
    if (idx >= 0 && idx < 256) {
        fa::Ref cur{idx >> 4, idx & 15, l}, nxt; fa::Seam S;
        fa::prime<LayMem>(c.ws, cur, 1 << 29, ldsg, S, tid);
        for (;;) {
            const int nidx = idx + grid_; const bool more = nidx < 256;
            if (more) nxt = fa::Ref{nidx >> 4, nidx & 15, l}; else nxt = cur;
            fa::block<LayMem>(c.ws, cur, nxt, 256, 1 << 29, ldsg, S, tid);
            if (!more) break;
            cur = nxt; idx = nidx;
        }
    }
}
constexpr int SF_REG = 16384, SF_AUX = 8 * SF_REG, SF_Q = SF_AUX + 8 * 512, SF_LDS = SF_Q + 32 * 272;
template <bool FOX>
__device__ __forceinline__ void ph_attn_sample(CtxP cp, int l, LAS unsigned char* lds, int wg0, int nwg) {
    CTX_LOAD(cp);
    const int bid_ = obid() - wg0, grid_ = nwg; const int tid0 = otid();
    if (bid_ < 0) return;
    constexpr int NH = FOX ? 12 : 4, NTASKS = 32 * NH, NTILE = FOX ? 65 : 8, KP = FOX ? TOK : MEMD, NPAST = FOX ? PAST : NMEM;
    constexpr float LOG2E = 1.4426950408889634f, C2 = LOG2E * SCALE;
    for (int task = bid_; task < NTASKS; task += grid_) {
        int tid = tid0; asm volatile("" : "+v"(tid));
        const int lane = tid & 63, w = __builtin_amdgcn_readfirstlane(tid >> 6), r32 = lane & 31, hi = lane >> 5;
        const int b = task / NH, h = task % NH;
        LAS unsigned char* T = lds + w * SF_REG; LAS float* aux = (LAS float*)(lds + SF_AUX + w * 512);
        const float* CUM = WS_PTR(float, WS_CUMS) + (size_t)b * (PAST + 32) * 12 + h;
        const float* Kc = (FOX ? c.in[I_CK] : c.in[I_CMK] + (size_t)l * 32 * NMEM * MEMD) + (size_t)b * NPAST * KP + h * HD; const float* Vc = (FOX ? c.in[I_CV] : c.in[I_CMV] + (size_t)l * 32 * NMEM * MEMD) + (size_t)b * NPAST * KP + h * HD;
        const int qcol = FOX ? h * HD : ((l < 2) ? 6144 : 3072) + h * HD, ocol = FOX ? h * HD : TOK + h * HD;
        float cq2 = 0.f; if (FOX) cq2 = CUM[(size_t)(PAST + r32) * 12] * LOG2E;
        float m_run = -1e30f, l_run = 0.f; f32x16 o[4] = {};
        f32x4 st[16];
        const int lrow = lane >> 5, lcol = (lane & 31) * 4;
        const unsigned voff = (unsigned)(lrow * KP + lcol) * 4u;
#define SF_LOAD(P, j0) do { const char* p_ = (const char*)((P) + (size_t)(j0) * KP);     \
        _Pragma("unroll") for (int i = 0; i < 16; ++i) st[i] = __builtin_nontemporal_load((const f32x4*)(p_ + (size_t)(2 * i) * KP * 4 + voff)); } while (0)
        __syncthreads();
        *(LAS u32x4*)(lds + SF_Q + (tid >> 4) * 272 + (tid & 15) * 16) = *(const u32x4*)(WS_PTR(bf16_t, WS_PROJ) + (size_t)(MP + b * 32 + (tid >> 4)) * PJ + qcol + (tid & 15) * 8);
        int t = w; SF_LOAD(Kc, 32 * t);
        __syncthreads();
        for (; t < NTILE; t += 8) { const bool isnew = FOX && (t == 64); const int j0 = 32 * t;
            if (!isnew) {
#pragma unroll
                for (int i = 0; i < 16; ++i) { u32x2 v2; v2.x = pk2(st[i].x, st[i].y); v2.y = pk2(st[i].z, st[i].w); *(LAS u32x2*)(T + (2 * i + lrow) * 272 + lcol * 2) = v2; }
                SF_LOAD(Vc, j0); }
            else { const char* kp = (const char*)(WS_PTR(bf16_t, WS_KB) + (size_t)(MP + b * 32) * TOK + h * HD);
                int ln = lane; asm volatile("" : "+v"(ln)); const int rw0 = ln >> 4, cc = (ln & 15) * 8; const unsigned vo = (unsigned)(rw0 * TOK + cc) * 2u;
#pragma unroll
                for (int i = 0; i < 8; ++i) *(LAS u32x4*)(T + (4 * i + rw0) * 272 + cc * 2) = *(const u32x4*)(kp + (size_t)(4 * i) * TOK * 2 + vo); }
            if (lane < 32) aux[lane] = FOX ? CUM[(size_t)(j0 + lane) * 12] * LOG2E : 0.f;
            f32x16 p = {};
#pragma unroll
            for (int d0 = 0; d0 < 8; ++d0) p = __builtin_amdgcn_mfma_f32_32x32x16_bf16(*(const LAS bf16x8*)(T + r32 * 272 + d0 * 32 + hi * 16), *(const LAS bf16x8*)(lds + SF_Q + r32 * 272 + d0 * 32 + hi * 16), p, 0, 0, 0);
            float pmax = -__builtin_inff();
#pragma unroll
            for (int g = 0; g < 4; ++g) { const f32x4 ck = *(const LAS f32x4*)(aux + 8 * g + 4 * hi);
#pragma unroll
                for (int e = 0; e < 4; ++e) { const int rr = 4 * g + e; float s = fmaf(p[rr], C2, cq2 - ck[e]);
                    if (isnew && (8 * g + 4 * hi + e) > r32) s = -__builtin_inff();
                    p[rr] = s; pmax = fmaxf(pmax, s); } }
            pmax = fmaxf(pmax, lane_get(pmax, lane ^ 32));
            const float mn = fmaxf(m_run, pmax), alpha = __builtin_amdgcn_exp2f(m_run - mn); m_run = mn;
            float ps = 0.f;
#pragma unroll
            for (int rr = 0; rr < 16; ++rr) { p[rr] = __builtin_amdgcn_exp2f(p[rr] - mn); ps += p[rr]; }
            ps += lane_get(ps, lane ^ 32); l_run = l_run * alpha + ps;
            bf16x8 pa0, pa1;
#define PK4(P, B_, OUT) do { unsigned a0 = pk2(P[B_+0], P[B_+1]), a1 = pk2(P[B_+2], P[B_+3]); unsigned b0 = pk2(P[B_+4], P[B_+5]), b1 = pk2(P[B_+6], P[B_+7]); \
            auto r0 = __builtin_amdgcn_permlane32_swap(a0, b0, false, false); auto r1 = __builtin_amdgcn_permlane32_swap(a1, b1, false, false); \
            u32x4 w4 = {r0[0], r1[0], r0[1], r1[1]}; OUT = __builtin_bit_cast(bf16x8, w4); } while (0)
            PK4(p, 0, pa0); PK4(p, 8, pa1);
#undef PK4
            if (hi == 0) aux[32 + r32] = alpha;
            if (!isnew) {
#pragma unroll
                for (int i = 0; i < 16; ++i) { const int key = 2 * i + lrow;
                    *(LAS bf16_t*)(T + (lcol + 0) * 80 + key * 2) = (bf16_t)(pk2(st[i].x, 0.f) & 0xffffu); *(LAS bf16_t*)(T + (lcol + 1) * 80 + key * 2) = (bf16_t)(pk2(st[i].y, 0.f) & 0xffffu);
                    *(LAS bf16_t*)(T + (lcol + 2) * 80 + key * 2) = (bf16_t)(pk2(st[i].z, 0.f) & 0xffffu); *(LAS bf16_t*)(T + (lcol + 3) * 80 + key * 2) = (bf16_t)(pk2(st[i].w, 0.f) & 0xffffu); }
                if (FOX && t + 8 < 64) SF_LOAD(Kc, j0 + 256); }
            else { const char* vp = (const char*)(WS_PTR(bf16_t, WS_VB) + (size_t)(MP + b * 32) * TOK + h * HD);
                int ln = lane; asm volatile("" : "+v"(ln)); const int rw0 = ln >> 4, cc = (ln & 15) * 8; const unsigned vo = (unsigned)(rw0 * TOK + cc) * 2u;
#pragma unroll
                for (int i = 0; i < 8; ++i) { const int rw = 4 * i + rw0; const u32x4 v4 = *(const u32x4*)(vp + (size_t)(4 * i) * TOK * 2 + vo);
                    *(LAS bf16_t*)(T + (cc + 0) * 80 + rw * 2) = (bf16_t)(v4.x & 0xffffu); *(LAS bf16_t*)(T + (cc + 1) * 80 + rw * 2) = (bf16_t)(v4.x >> 16);
                    *(LAS bf16_t*)(T + (cc + 2) * 80 + rw * 2) = (bf16_t)(v4.y & 0xffffu); *(LAS bf16_t*)(T + (cc + 3) * 80 + rw * 2) = (bf16_t)(v4.y >> 16);
                    *(LAS bf16_t*)(T + (cc + 4) * 80 + rw * 2) = (bf16_t)(v4.z & 0xffffu); *(LAS bf16_t*)(T + (cc + 5) * 80 + rw * 2) = (bf16_t)(v4.z >> 16);
                    *(LAS bf16_t*)(T + (cc + 6) * 80 + rw * 2) = (bf16_t)(v4.w & 0xffffu); *(LAS bf16_t*)(T + (cc + 7) * 80 + rw * 2) = (bf16_t)(v4.w >> 16); } }
            if (__any(alpha < 1.f)) {
#pragma unroll
                for (int g = 0; g < 4; ++g) { const f32x4 al = *(const LAS f32x4*)(aux + 32 + 8 * g + 4 * hi);
#pragma unroll
                    for (int e = 0; e < 4; ++e)
#pragma unroll
                        for (int db = 0; db < 4; ++db) o[db][4 * g + e] *= al[e]; } }
#pragma unroll
            for (int db = 0; db < 4; ++db) {
                o[db] = __builtin_amdgcn_mfma_f32_32x32x16_bf16(pa0, *(const LAS bf16x8*)(T + (db * 32 + r32) * 80 + hi * 16), o[db], 0, 0, 0);
                o[db] = __builtin_amdgcn_mfma_f32_32x32x16_bf16(pa1, *(const LAS bf16x8*)(T + (db * 32 + r32) * 80 + 32 + hi * 16), o[db], 0, 0, 0); }
        }
        asm volatile("s_waitcnt lgkmcnt(0)" ::: "memory");
#pragma unroll
        for (int db = 0; db < 4; ++db)
#pragma unroll
            for (int rr = 0; rr < 16; ++rr) *(LAS float*)(T + crow32(rr, hi) * 512 + (db * 32 + r32) * 4) = o[db][rr];
        if (hi == 0) { aux[64 + r32] = m_run; aux[96 + r32] = l_run; }
        __syncthreads();
        { const int qy = tid >> 4, d0 = (tid & 15) * 8; float M = -1e30f;
#pragma unroll
            for (int ww = 0; ww < 8; ++ww) M = fmaxf(M, *(const LAS float*)(lds + SF_AUX + ww * 512 + (64 + qy) * 4));
            float num[8] = {0.f, 0.f, 0.f, 0.f, 0.f, 0.f, 0.f, 0.f}, den = 0.f;
#pragma unroll
            for (int ww = 0; ww < 8; ++ww) { const float e = __builtin_amdgcn_exp2f(*(const LAS float*)(lds + SF_AUX + ww * 512 + (64 + qy) * 4) - M); den += e * *(const LAS float*)(lds + SF_AUX + ww * 512 + (96 + qy) * 4);
                const f32x4 a = *(const LAS f32x4*)(lds + ww * SF_REG + qy * 512 + d0 * 4), bq = *(const LAS f32x4*)(lds + ww * SF_REG + qy * 512 + d0 * 4 + 16);
                num[0] += e * a.x; num[1] += e * a.y; num[2] += e * a.z; num[3] += e * a.w; num[4] += e * bq.x; num[5] += e * bq.y; num[6] += e * bq.z; num[7] += e * bq.w; }
            const float inv = 1.f / den; const size_t row = (size_t)(MP + b * 32 + qy);
            u32x4 gv = {0x7f007f00u, 0x7f007f00u, 0x7f007f00u, 0x7f007f00u};
            if (FOX) gv = *(const u32x4*)(WS_PTR(bf16_t, WS_PROJ) + row * PJ + TOK + h * HD + d0);
            u32x4 ov;
            ov.x = pk2(num[0] * inv * fast_sigmoid(bflo(gv.x)), num[1] * inv * fast_sigmoid(bfhi(gv.x))); ov.y = pk2(num[2] * inv * fast_sigmoid(bflo(gv.y)), num[3] * inv * fast_sigmoid(bfhi(gv.y)));
            ov.z = pk2(num[4] * inv * fast_sigmoid(bflo(gv.z)), num[5] * inv * fast_sigmoid(bfhi(gv.z))); ov.w = pk2(num[6] * inv * fast_sigmoid(bflo(gv.w)), num[7] * inv * fast_sigmoid(bfhi(gv.w)));
            *(u32x4*)(WS_PTR(bf16_t, WS_ACT) + row * D + ocol + d0) = ov; }
#undef SF_LOAD
    }
}
constexpr int GEMM_LDS = pg8::STAGE_BYTES;
constexpr int LDS_BAR = 147456 - 256, LDS_BYTES = 147456;
static_assert(SF_LDS <= LDS_BAR && GEMM_LDS <= LDS_BAR, "LDS map");
constexpr size_t CTL_ZERO_BYTES = 65536;
__device__ __forceinline__ void ph_gemm(CtxP cp, int which, int l, LAS unsigned char* lds) {
    CTX_LOAD(cp);
    const bf16_t* A = WS_PTR(bf16_t, WS_XN); const bf16_t* Bt; int Mg = M, N, K = D, mode; bf16_t* o16 = nullptr; int ld16 = 0; float* o32 = nullptr; int ld32 = 0;
    if (which == 0) { A = WS_PTR(bf16_t, WS_MEMN); Bt = WS_PTR(bf16_t, WS_WMEM); Mg = 1024; N = 4096; mode = 4; }
    else if (which == 1) { Bt = (l < 2) ? WS_PTR(bf16_t, WS_WINA) + (size_t)l * 6656 * D : (l == 2 ? WS_PTR(bf16_t, WS_WINB0) : WS_PTR(bf16_t, WS_WINB1)); N = (l == 3) ? 3584 : 6656;
        mode = (l == 2) ? 3 : 0; o16 = WS_PTR(bf16_t, WS_PROJ); ld16 = PJ; }
    else if (which == 2) { A = WS_PTR(bf16_t, WS_ACT); Bt = WS_PTR(bf16_t, WS_WO) + (size_t)l * D * D; N = D; mode = 2; o16 = WS_PTR(bf16_t, WS_DELTA); ld16 = D; }
    else if (which == 3) { Bt = WS_PTR(bf16_t, WS_WUP) + (size_t)l * DFF * D; N = DFF; mode = 1; o16 = WS_PTR(bf16_t, WS_UP); ld16 = DFF; }
    else { A = WS_PTR(bf16_t, WS_UP); Bt = WS_PTR(bf16_t, WS_WDN) + (size_t)l * D * DFF; N = D; K = DFF; mode = 2; o16 = WS_PTR(bf16_t, WS_DELTA); ld16 = D; }
    const pg8::Gemm g{A, Bt, Mg, N, K};
    const pg8::Epi E{mode, o16, ld16, o32, ld32, c.ws, c.out, K / pg8::BK, (which == 1) ? (l < 2 ? 4608 : 0) : -1};
    pg8::TailSplit S; if (which == 0) S.init(g.M, g.N, g.K, 64, obid() - (ogrid() - 64), 0); else S.init(g.M, g.N, g.K, ogrid(), obid(), (which == 2 || which == 4) ? 1 : 0);
    pg8::gemm_phase<pg8::Epi, pg8::TailSplit, true, true>(lds, g, S, E, otid());
}
__global__ void __launch_bounds__(512, 2) fwd(Ctx carg) {
    CtxP c = (CtxP)((unsigned long long)__builtin_amdgcn_kernarg_segment_ptr() | (unsigned long long)__builtin_amdgcn_readfirstlane((int)(threadIdx.x >> 6)));
    extern __shared__ __attribute__((aligned(16))) unsigned char lds_raw[];
    LAS unsigned char* lds = (LAS unsigned char*)lds_raw;
    if (threadIdx.x < 4) ((LAS unsigned*)(lds + LDS_BAR))[threadIdx.x] = 0u;
    __syncthreads();
    const XcdBarrier bar = xcd_barrier_post((unsigned*)(((CtxP)((unsigned long long)c & ~7ull))->ws + WS_CTL), (volatile LAS unsigned*)(lds + LDS_BAR));
#define BAR() do { XcdBarrier b2_; b2_.bar = (unsigned*)(((CtxP)((unsigned long long)c & ~7ull))->ws + WS_CTL); b2_.st = bar.st; unsigned bx_ = bar.x; asm volatile("" : "+s"(bx_)); b2_.x = bx_; xcd_barrier(b2_, otid_cp(c) == 0); } while (0)
    ph_prep(c, lds, 0x3u | (0xfu << 19), 0, (int)gridDim.x, 1); ph_row2(c, 2, 0, 0, 0, 0); BAR();
    ph_row2(c, 1, 0, 0, 0, 0, 0, 0, (int)gridDim.x - 64); ph_gemm(c, 0, 0, lds); BAR();
    const bool upt = (gridDim.x == 256);
    for (int l = 0; l < 4; ++l) {
        if (l < 2) ph_skinny(c, l, lds);
        else if (l == 2) { ph_skinny(c, 2, lds); BAR(); ph_cumsum(c); }
        ph_gemm(c, 1, l, lds); BAR();
        if (l < 2) { ph_gdn_prep(c, l, lds); BAR(); ph_gdn_scan(c, l, lds);
            ph_prep(c, lds, (l == 0 ? (JOBS_L1 | (1u << 7) | (1u << 11) | (1u << 15)) : (JOBS_L2 | JOBS_L3)) & ~(upt ? (7u << 12) : 0u), 96, (int)gridDim.x - 96, 0);
            BAR(); ph_gdn_c(c, l); }
        if (l >= 2) { ph_attn_sample<true>(c, l, lds, 0, (int)gridDim.x); __syncthreads(); }
        ph_mem_prompt(c, l, (char*)lds_raw, 0, (int)gridDim.x); ph_attn_sample<false>(c, l, lds, 0, (int)gridDim.x);
        if (l >= 2) { __syncthreads(); ph_fox_prompt(c, l, (char*)lds_raw, lds); }
        BAR();
        ph_gemm(c, 2, l, lds); BAR();
        ph_row2(c, 0, 1, I_NMIXPOST, l, 0, l == 0); BAR();
        ph_gemm(c, 3, l, lds); if (upt && l < 3) ph_prep(c, lds, 1u << (12 + l), 128, 128, 0); BAR();
        ph_gemm(c, 4, l, lds); BAR();
        ph_row2(c, 0, 1, I_NMLPPOST, l, l == 3);
        if (l < 3) BAR();
    }
#undef BAR
}
extern "C" void kernel_launch(void* const* d_in, const int* in_sizes, int n_in, void* d_out, int out_size, void* d_ws, size_t ws_size, hipStream_t stream) {
    static int grid = 0;
    if (grid == 0) {
        if (n_in != 28 || (size_t)out_size != O_END || ws_size < WS_END2) { fprintf(stderr, "kernel_launch: unexpected shapes: n_in %d out %d ws %zu (need %zu)\n", n_in, out_size, ws_size, (size_t)WS_END2); grid = -1; return; }
        int dev = 0, cus = 0, per_cu = 0;
        if (hipGetDevice(&dev) != hipSuccess || hipDeviceGetAttribute(&cus, hipDeviceAttributeMultiprocessorCount, dev) != hipSuccess) { grid = -1; return; }
        if (hipFuncSetAttribute((const void*)fwd, hipFuncAttributeMaxDynamicSharedMemorySize, LDS_BYTES) != hipSuccess) { fprintf(stderr, "kernel_launch: hipFuncSetAttribute failed\n"); grid = -1; return; }
        if (hipOccupancyMaxActiveBlocksPerMultiprocessor(&per_cu, (const void*)fwd, 512, LDS_BYTES) != hipSuccess || per_cu < 1) { fprintf(stderr, "kernel_launch: occupancy query says %d blocks per CU\n", per_cu); grid = -1; return; }
        (void)hipGetLastError();
        grid = cus;
    }
    if (grid < 0) return;
    (void)hipMemsetAsync((char*)d_ws + WS_CTL, 0, CTL_ZERO_BYTES, stream);
    Ctx c{}; for (int i = 0; i < 28; ++i) c.in[i] = (const float*)d_in[i]; c.out = (float*)d_out; c.ws = (unsigned char*)d_ws; c.ph_lo = 0; c.ph_hi = 0;
    hipLaunchKernelGGL(fwd, dim3(grid), dim3(512), LDS_BYTES, stream, c);
}
```

```cpp
#include <hip/hip_runtime.h>
#include <cstdio>
#include <cstdint>
namespace pg8 {
#define PG8_LAS __attribute__((address_space(3)))
typedef unsigned short bf16_t;
typedef short bf16x8 __attribute__((ext_vector_type(8)));
typedef float f32x4 __attribute__((ext_vector_type(4)));
typedef unsigned u32x4 __attribute__((ext_vector_type(4)));
constexpr int BM = 256, BK = 64, HALF = 128, HTB = HALF * BK * 2  , STAGE_BYTES = 8 * HTB, NXCD = 8, WGM = 4;

__host__ __device__ __forceinline__ int lds_byte(int r, int c) { const int st = (r >> 4) * 2 + (c >> 5), rr = r & 15, cc = c & 31, ob = rr * 64 + cc * 2; return st * 1024 + (ob ^ (((ob >> 9) & 1) << 5)); }
__host__ __device__ __forceinline__ void stage_rc(int b, int& R, int& C) { const int st = b / 1024, sb = b % 1024, swz = sb ^ (((sb >> 9) & 1) << 5); R = (st >> 1) * 16 + swz / 64; C = (st & 1) * 32 + (swz % 64) / 2; }
__host__ __device__ __forceinline__ int perm32(int rho) { const int n = rho >> 4, i = rho & 15; return 8 * (i >> 2) + 4 * n + (i & 3); }

struct Unit { int pm, pn, kt0, nt, ks; };
struct Gemm { const bf16_t* A; const bf16_t* Bt; int M, N, K; };

struct StaticOrder {
    int nM, nN, nwg, G, c, ntf;
    __host__ __device__ void init(int M, int N, int K, int G_, int c_) { nM = M / BM; nN = N / BM; nwg = nM * nN; G = G_; c = c_; ntf = K / BK; }
    __host__ __device__ bool next(int i, Unit& u) const {
        const long L = (long)i * G + c; if (L >= nwg) return false;
        int wgid = (int)L; { const int q = nwg / NXCD, r = nwg % NXCD, xcd = wgid % NXCD, off = wgid / NXCD; wgid = (xcd < r ? xcd * (q + 1) : r * (q + 1) + (xcd - r) * q) + off; }
        const int nig = WGM * nN, gid = wgid / nig, fm = gid * WGM, gsz = (nM - fm) < WGM ? (nM - fm) : WGM;
        u.pm = fm + ((wgid % nig) % gsz); u.pn = (wgid % nig) / gsz; u.kt0 = 0; u.nt = ntf; u.ks = 0; return true;
    }
    __device__ __forceinline__ void a_ready(const Unit&) const {}
    __device__ __forceinline__ void done(const Unit&) const {}
};

__device__ __forceinline__ unsigned cvt_pk_bf16(float lo, float hi) { unsigned r; asm volatile("v_cvt_pk_bf16_f32 %0, %1, %2" : "=v"(r) : "v"(lo), "v"(hi)); return r; }
}
#define LAS __attribute__((address_space(3)))
typedef unsigned short bf16_t;
typedef float f32x4 __attribute__((ext_vector_type(4)));
typedef unsigned u32x4 __attribute__((ext_vector_type(4)));
typedef unsigned u32x2 __attribute__((ext_vector_type(2)));
constexpr int D = 2048, MP = 16384, MS = 1024, M = MP + MS;
constexpr int H = 12, HD = 128, TOK = 1536, QKV = 4608, MEMD = 512, MH = 4, NMEM = 256, DFF = 8192, PAST = 2048;
constexpr int INA_W = 6680, INB_W = 3584, KVF_W = 3084;
constexpr int PJ = 6656;
constexpr float EPS = 1e-6f, SCALE = 0.08838834764831845f;
constexpr size_t O_YP = 0, O_YS = O_YP + (size_t)MP * D, O_PGDN = O_YS + (size_t)MS * D, O_PCONV = O_PGDN + (size_t)2 * 4 * 12 * 16384, O_PK = O_PCONV + (size_t)2 * 4 * 3 * 4608,
    O_PV = O_PK + (size_t)MP * TOK, O_PLOGF = O_PV + (size_t)MP * TOK, O_PMK = O_PLOGF + (size_t)MP * 12, O_PMV = O_PMK + (size_t)4 * 4 * 256 * 512, O_SGDN = O_PMV + (size_t)4 * 4 * 256 * 512,
    O_SCONV = O_SGDN + (size_t)2 * 32 * 12 * 16384, O_SK = O_SCONV + (size_t)2 * 32 * 3 * 4608, O_SV = O_SK + (size_t)MS * TOK, O_SLOGF = O_SV + (size_t)MS * TOK, O_END = O_SLOGF + (size_t)MS * 12;
static_assert(O_END == 108683264, "output size");
constexpr size_t MiB = 1u << 20;
constexpr size_t WS_CTL = 0, WS_WINA = 1 * MiB, WS_WINB0 = 53 * MiB, WS_WINB1 = 79 * MiB, WS_WO = 93 * MiB, WS_WUP = 125 * MiB, WS_WDN = 253 * MiB, WS_WMEM = 381 * MiB, WS_WSK = 397 * MiB,
    WS_X = 398 * MiB, WS_XN = 534 * MiB, WS_PROJ = 602 * MiB, WS_ACT = 823 * MiB, WS_DELTA = 891 * MiB, WS_KB = 1027 * MiB, WS_VB = 1078 * MiB, WS_G = 1129 * MiB, WS_BETA = 1130 * MiB,
    WS_LOGF = 1131 * MiB, WS_CUMP = 1132 * MiB, WS_CUMS = 1133 * MiB, WS_MEMN = 1137 * MiB, WS_BIG = 1141 * MiB, WS_QF = WS_BIG, WS_KF = WS_BIG + 102 * MiB, WS_VF = WS_BIG + 204 * MiB,
    WS_OF = WS_BIG + 306 * MiB, WS_UP = WS_BIG, WS_END = WS_BIG + 408 * MiB,
    WS_EGL = WS_END, WS_QX = WS_EGL + 1 * MiB, WS_KX = WS_QX + 3 * MiB, WS_MEMKVB = WS_KX + 3 * MiB, WS_WSKB = WS_MEMKVB + 8 * MiB, WS_END2 = WS_WSKB + 1 * MiB;
constexpr size_t WS_SLAB = WS_PROJ;
constexpr size_t CTL_ZROW = 61440, CTL_QFOX = 32768;
static_assert((size_t)6656 * 2048 * 2 == 26 * MiB && (size_t)M * D * 4 == 136 * MiB && (size_t)M * PJ * 2 == 221 * MiB && (size_t)M * TOK * 2 == 51 * MiB && (size_t)M * TOK * 4 == 102 * MiB && (size_t)M * DFF * 2 == 272 * MiB, "sizes");

struct Ctx { const float* in[28]; float* out; unsigned char* ws; int ph_lo, ph_hi; };
typedef const __attribute__((address_space(4))) Ctx* CtxP;
__device__ __forceinline__ int otid_cp(CtxP cp) {
#if defined(__HIP_DEVICE_COMPILE__)
    unsigned long long a = (unsigned long long)cp; asm volatile("" : "+s"(a));
    int ln; asm volatile("v_mbcnt_lo_u32_b32 %0, -1, 0\n\tv_mbcnt_hi_u32_b32 %0, -1, %0" : "=v"(ln));
    return (int)((unsigned)a & 7u) * 64 + ln;
#else
    (void)cp; return 0;
#endif
}
#define otid() otid_cp(cp)
__device__ __forceinline__ int obid() { int b = blockIdx.x; asm volatile("" : "+s"(b)); return b; }
__device__ __forceinline__ int ogrid() { int g = gridDim.x; asm volatile("" : "+s"(g)); return g; }
__device__ __forceinline__ Ctx ctx_load(CtxP cp) {
#if defined(__HIP_DEVICE_COMPILE__)
    asm volatile("" : "+s"(cp)); cp = (CtxP)((unsigned long long)cp & ~7ull); Ctx r; __builtin_memcpy(&r, cp, sizeof(Ctx)); return r;
#else
    (void)cp; return Ctx{};
#endif
}
#define CTX_LOAD(cp) const Ctx c = ctx_load(cp)
enum { I_XP = 0, I_XS, I_SGDN, I_SCONV, I_CK, I_CV, I_CLOGF, I_CMK, I_CMV, I_MEMP, I_NMIXPRE, I_NMIXPOST, I_NMLPPRE, I_NMLPPOST, I_WINA, I_CONVW, I_ALOG, I_DTB, I_GDNN, I_WINB, I_NKV, I_WKVF, I_BF, I_NMEM, I_WMEMKV, I_WO, I_WUP, I_WDN };

__device__ __forceinline__ float bf2f(bf16_t b) { return __uint_as_float(((unsigned)b) << 16); }
__device__ __forceinline__ float bflo(unsigned u) { return __uint_as_float(u << 16); }
__device__ __forceinline__ float bfhi(unsigned u) { return __uint_as_float(u & 0xffff0000u); }
__device__ __forceinline__ unsigned pk2(float lo, float hi) { return pg8::cvt_pk_bf16(lo, hi); }
__device__ __forceinline__ float lane_get(float v, int src_lane) { return __int_as_float(__builtin_amdgcn_ds_bpermute(src_lane << 2, __float_as_int(v))); }
__device__ __forceinline__ float wave_sum(float v, int lane) {
#pragma unroll
    for (int o = 1; o < 64; o <<= 1) v += lane_get(v, lane ^ o);
    return v; }
__device__ __forceinline__ float wave_max(float v, int lane) {
#pragma unroll
    for (int o = 1; o < 64; o <<= 1) v = fmaxf(v, lane_get(v, lane ^ o));
    return v; }
__device__ __forceinline__ float wave_sum_dpp(float v) {
    v += __int_as_float(__builtin_amdgcn_update_dpp(0, __float_as_int(v), 0x111, 0xf, 0xf, true));
    v += __int_as_float(__builtin_amdgcn_update_dpp(0, __float_as_int(v), 0x112, 0xf, 0xf, true));
    v += __int_as_float(__builtin_amdgcn_update_dpp(0, __float_as_int(v), 0x114, 0xf, 0xf, true));
    v += __int_as_float(__builtin_amdgcn_update_dpp(0, __float_as_int(v), 0x118, 0xf, 0xf, true));
    const int iv = __float_as_int(v);
    return (__int_as_float(__builtin_amdgcn_readlane(iv, 15)) + __int_as_float(__builtin_amdgcn_readlane(iv, 31))) + (__int_as_float(__builtin_amdgcn_readlane(iv, 47)) + __int_as_float(__builtin_amdgcn_readlane(iv, 63)));
}
__device__ __forceinline__ float sigmoidf_(float x) { return 1.f / (1.f + expf(-x)); }
__device__ __forceinline__ float softplusf_(float x) { return fmaxf(x, 0.f) + log1pf(expf(-fabsf(x))); }
__device__ __forceinline__ float softplus_fast(float x) { return fmaxf(x, 0.f) + 0.6931471805599453f * __builtin_amdgcn_logf(1.f + __builtin_amdgcn_exp2f(-1.4426950408889634f * fabsf(x))); }
__device__ __forceinline__ float fast_sigmoid(float x) { return __builtin_amdgcn_rcpf(1.f + __builtin_amdgcn_exp2f(-1.4426950408889634f * x)); }
__device__ __forceinline__ float exp_fast(float x) { return __builtin_amdgcn_exp2f(1.4426950408889634f * x); }
struct RowInfo { int grp, b, t, T, nb; };
__device__ __forceinline__ RowInfo rowinfo(int m) { RowInfo r; if (m < MP) { r.grp = 0; r.b = m >> 12; r.t = m & 4095; r.T = 4096; r.nb = 4; } else { const int ms = m - MP; r.grp = 1; r.b = ms >> 5; r.t = ms & 31; r.T = 32; r.nb = 32; } return r; }
namespace pg8 {
struct Epi {
    static constexpr bool PERM = true, AFTER_DRAIN = false;
    int mode;
    bf16_t* o16; int ld16; float* o32; int ld32;
    unsigned char* ws; float* out;
    int ntfull;
    int ntcol;
    __device__ __forceinline__ void operator()(const f32x4 (&acc)[2][2][4][2], const Unit& u, int wr, int wc, int fr, int fq) const {
        const int row0 = u.pm * BM + wr * 64 + fr, colt = u.pn * BM, cl = wc * 32 + 8 * fq;
        bf16_t* d16 = nullptr; size_t l16 = 0; float* d32 = nullptr; size_t l32 = 0; int radj = 0; const bool sq = (mode == 1);
        bool nt16 = false;
        if (mode == 0 || mode == 1) { d16 = o16 + colt; l16 = (size_t)ld16; nt16 = (mode == 0) && (ntcol >= 0) && (colt >= ntcol); }
        else if (mode == 2) {
            if (u.nt != ntfull) { d16 = (bf16_t*)(ws + WS_SLAB) + (size_t)u.ks * 1024 * 2048 + colt - (size_t)16384 * 2048; l16 = 2048; }
            else { d16 = o16 + colt; l16 = (size_t)ld16; } }
        else if (mode == 3) {
            if (colt < 3584) { d16 = o16 + colt; l16 = (size_t)ld16; nt16 = true; }
            else { const bool isv = colt >= 5120; const int cc = colt - (isv ? 5120 : 3584); const bool smp = u.pm >= 64;
                d16 = (bf16_t*)(ws + (isv ? WS_VB : WS_KB)) + cc; l16 = 1536; d32 = out + (smp ? (isv ? O_SV : O_SK) : (isv ? O_PV : O_PK)) + cc; l32 = 1536; radj = smp ? 16384 : 0; }
        } else { const int l = colt >> 10, within = colt & 1023; d32 = out + ((within >= 512) ? O_PMV : O_PMK) + (size_t)l * 1024 * 512 + (within & 511); l32 = 512;  d16 = (bf16_t*)(ws + WS_MEMKVB) + colt; l16 = 4096; }
#pragma unroll
        for (int ai = 0; ai < 2; ++ai)
#pragma unroll
            for (int m = 0; m < 4; ++m) { const int row = row0 + ai * HALF + m * 16;
#pragma unroll
                for (int bj = 0; bj < 2; ++bj) { f32x4 v0 = acc[ai][bj][m][0], v1 = acc[ai][bj][m][1]; const int col = cl + bj * HALF;
                    if (sq) {
#pragma unroll
                        for (int j = 0; j < 4; ++j) { const float a = v0[j] > 0.f ? v0[j] : 0.f, b = v1[j] > 0.f ? v1[j] : 0.f; v0[j] = a * a; v1[j] = b * b; } }
                    if (d16) { u32x4 w; w.x = cvt_pk_bf16(v0[0], v0[1]); w.y = cvt_pk_bf16(v0[2], v0[3]); w.z = cvt_pk_bf16(v1[0], v1[1]); w.w = cvt_pk_bf16(v1[2], v1[3]);
                        if (nt16) __builtin_nontemporal_store(w, (u32x4*)(d16 + (size_t)row * l16 + col)); else *(u32x4*)(d16 + (size_t)row * l16 + col) = w; }
                    if (d32) { float* p = d32 + (size_t)(row - radj) * l32 + col;
                        if (mode >= 3) { __builtin_nontemporal_store(v0, (f32x4*)p); __builtin_nontemporal_store(v1, (f32x4*)(p + 4)); }
                        else { *(f32x4*)p = v0; *(f32x4*)(p + 4) = v1; } } } }
    }
};
struct TailSplit {
    StaticOrder full; int nF, nN, nsl, nts, G, c, split;
    __device__ void init(int M, int N, int K, int G_, int c_, int split_) { split = split_; full.init(split_ ? 64 * BM : M, N, K, G_, c_); nN = N / BM; nF = 64 * nN; nsl = 8; nts = K / BK / nsl; G = G_; c = c_; }
    __device__ __forceinline__ bool next(int i, Unit& u) const {
        const long L = (long)i * G + c; int pm = 0, pn = 0, kt0 = 0, nt = full.ntf, ks = 0; bool ok; if (c < 0) { u.pm = 0; u.pn = 0; u.kt0 = 0; u.nt = nt; u.ks = 0; return false; }
        if (!split || L < nF) { Unit t; ok = full.next(i, t); pm = t.pm; pn = t.pn; }
        else { const int Ls = (int)(L - nF); ok = Ls < 4 * nN * nsl; pn = Ls % nN; const int rest = Ls / nN; pm = 64 + (rest & 3); ks = rest >> 2; kt0 = ks * nts; nt = nts; }
        u.pm = pm; u.pn = pn; u.kt0 = kt0; u.nt = nt; u.ks = ks; return ok;
    }
    __device__ __forceinline__ void a_ready(const Unit&) const {}
    __device__ __forceinline__ void done(const Unit&) const {}
};
}
namespace pg8 {
template <class Epi, class Sched, bool ALIGN_EPI = false, bool SP2 = false>
__device__ __forceinline__ void gemm_phase(PG8_LAS unsigned char* lds, const Gemm g, const Sched& S, const Epi& E, const int tid) {
    const int wid = __builtin_amdgcn_readfirstlane(tid >> 6), lane = tid & 63, wr = wid >> 2, wc = wid & 3, fr = lane & 15, fq = lane >> 4;
    const int K = g.K;
    unsigned voffA[2], voffB[2];
#pragma unroll
    for (int i = 0; i < 2; ++i) { int R, C; stage_rc(tid * 16 + i * 8192, R, C); const int Rb = Epi::PERM ? ((R & ~31) + perm32(R & 31)) : R;
        voffA[i] = (unsigned)(R * K + C) * 2u; voffB[i] = (unsigned)(Rb * K + C) * 2u; }
    const size_t kstep = (size_t)(BK * 2);
    const size_t hstep = (size_t)HALF * K * 2;
    const size_t tstep = 2 * hstep;
    const unsigned ldsw = (unsigned)wid * 1024u;
    const int aoff = lds_byte(wr * 64 + fr, fq * 8), boff = lds_byte(wc * 32 + fr, fq * 8);
#define PG8_SA(b, h) (((b) * 2 + (h)) * HTB)
#define PG8_SB(b, h) ((4 + (b) * 2 + (h)) * HTB)
#define PG8_STAGE(bufoff, gbase, voff) do { _Pragma("unroll") for (int _i = 0; _i < 2; ++_i) \
        __builtin_amdgcn_global_load_lds((const unsigned*)((const char*)(gbase) + (voff)[_i]), (PG8_LAS unsigned*)(lds + (bufoff) + ldsw + _i * 8192), 16, 0, 0); } while (0)
#define PG8_LDA(dst, b, h) do { _Pragma("unroll") for (int m = 0; m < 4; ++m) _Pragma("unroll") for (int k = 0; k < 2; ++k) dst[m][k] = *(const PG8_LAS bf16x8*)(lds + PG8_SA(b, h) + aoff + m * 2048 + k * 1024); } while (0)
#define PG8_LDB(dst, b, h) do { _Pragma("unroll") for (int n = 0; n < 2; ++n) _Pragma("unroll") for (int k = 0; k < 2; ++k) dst[n][k] = *(const PG8_LAS bf16x8*)(lds + PG8_SB(b, h) + boff + n * 2048 + k * 1024); } while (0)
#define PG8_MMA(ai, bj, At, Bt) do { __builtin_amdgcn_s_setprio(1); _Pragma("unroll") for (int m = 0; m < 4; ++m) _Pragma("unroll") for (int n = 0; n < 2; ++n) _Pragma("unroll") for (int k = 0; k < 2; ++k) \
        acc[ai][bj][m][n] = __builtin_amdgcn_mfma_f32_16x16x32_bf16(Bt[n][k], At[m][k], acc[ai][bj][m][n], 0, 0, 0); __builtin_amdgcn_s_setprio(0); } while (0)
#define PG8_WAIT_V(n) asm volatile("s_waitcnt vmcnt(" #n ")" ::: "memory")
#define PG8_WAIT_L(n) asm volatile("s_waitcnt lgkmcnt(" #n ")" ::: "memory")
#define PG8_BAR __builtin_amdgcn_s_barrier()
#define PG8_SCHED __builtin_amdgcn_sched_barrier(0)
    Unit cur, nxt; int ui = 0;
    if (!S.next(0, cur)) return;
    f32x4 acc[2][2][4][2];
#pragma unroll
    for (int a = 0; a < 2; ++a)
#pragma unroll
        for (int b = 0; b < 2; ++b)
#pragma unroll
            for (int m = 0; m < 4; ++m)
#pragma unroll
                for (int n = 0; n < 2; ++n) acc[a][b][m][n] = (f32x4){0.f, 0.f, 0.f, 0.f};
    bf16x8 At[4][2], B0[2][2], B1[2][2];
    const char* cA = (const char*)g.A + (size_t)cur.pm * tstep + (size_t)cur.kt0 * kstep; const char* cB = (const char*)g.Bt + (size_t)cur.pn * tstep + (size_t)cur.kt0 * kstep;
    S.a_ready(cur);
    if constexpr (SP2) {
        PG8_STAGE(PG8_SB(0, 0), cB, voffB); PG8_STAGE(PG8_SB(0, 1), cB + hstep, voffB); PG8_STAGE(PG8_SA(0, 0), cA, voffA); PG8_STAGE(PG8_SA(0, 1), cA + hstep, voffA);
        if (wr == 1) PG8_BAR;
        PG8_WAIT_V(2); PG8_BAR;
        PG8_STAGE(PG8_SB(1, 0), cB + kstep, voffB); PG8_STAGE(PG8_SA(1, 0), cA + kstep, voffA); PG8_STAGE(PG8_SB(1, 1), cB + hstep + kstep, voffB);
        PG8_WAIT_V(6); PG8_BAR;
    } else {
        PG8_STAGE(PG8_SB(0, 0), cB, voffB); PG8_STAGE(PG8_SA(0, 0), cA, voffA); PG8_STAGE(PG8_SB(0, 1), cB + hstep, voffB); PG8_STAGE(PG8_SA(0, 1), cA + hstep, voffA);
        if (wr == 1) PG8_BAR;
        PG8_WAIT_V(4); PG8_BAR;
        PG8_STAGE(PG8_SB(1, 0), cB + kstep, voffB); PG8_STAGE(PG8_SA(1, 0), cA + kstep, voffA); PG8_STAGE(PG8_SB(1, 1), cB + hstep + kstep, voffB);
        PG8_WAIT_V(6); PG8_BAR;
    }
    for (;;) {
        const bool has_next = S.next(ui + 1, nxt);
        const char* nA = has_next ? (const char*)g.A + (size_t)nxt.pm * tstep + (size_t)nxt.kt0 * kstep : cA; const char* nB = has_next ? (const char*)g.Bt + (size_t)nxt.pn * tstep + (size_t)nxt.kt0 * kstep : cB;
        const int nt = cur.nt;
        for (int t = 0; t < nt; t += 2) {
            const bool last = (t == nt - 2);
            const char* a1 = cA + (size_t)(t + 1) * kstep;
            const char* a2 = last ? nA : cA + (size_t)(t + 2) * kstep; const char* b2 = last ? nB : cB + (size_t)(t + 2) * kstep;
            const char* a3 = a2 + kstep; const char* b3 = b2 + kstep;
            if (last && has_next) S.a_ready(nxt);
            if constexpr (SP2) {
            PG8_LDB(B0, 0, 0); PG8_LDB(B1, 0, 1); PG8_SCHED; PG8_LDA(At, 0, 0); PG8_STAGE(PG8_SA(1, 1), a1 + hstep, voffA);
            PG8_WAIT_V(8); PG8_WAIT_L(0); PG8_BAR; PG8_MMA(0, 0, At, B0); PG8_MMA(0, 1, At, B1); PG8_BAR; PG8_SCHED;
            PG8_LDA(At, 0, 1); PG8_STAGE(PG8_SB(0, 0), b2, voffB); PG8_STAGE(PG8_SB(0, 1), b2 + hstep, voffB); PG8_STAGE(PG8_SA(0, 0), a2, voffA);
            PG8_WAIT_V(8); PG8_WAIT_L(0); PG8_BAR; PG8_MMA(1, 0, At, B0); PG8_MMA(1, 1, At, B1); PG8_BAR; PG8_SCHED;
            PG8_LDB(B0, 1, 0); PG8_LDB(B1, 1, 1); PG8_SCHED; PG8_LDA(At, 1, 0); PG8_STAGE(PG8_SA(0, 1), a2 + hstep, voffA);
            PG8_WAIT_V(8); PG8_WAIT_L(0); PG8_BAR; PG8_MMA(0, 0, At, B0); PG8_MMA(0, 1, At, B1); PG8_BAR; PG8_SCHED;
            PG8_LDA(At, 1, 1); PG8_STAGE(PG8_SB(1, 0), b3, voffB); PG8_STAGE(PG8_SB(1, 1), b3 + hstep, voffB); PG8_STAGE(PG8_SA(1, 0), a3, voffA);
            PG8_WAIT_V(8); PG8_WAIT_L(0); PG8_BAR; PG8_MMA(1, 0, At, B0); PG8_MMA(1, 1, At, B1); PG8_BAR; PG8_SCHED;
            } else {
            PG8_LDB(B0, 0, 0); PG8_SCHED; PG8_LDA(At, 0, 0); PG8_STAGE(PG8_SA(1, 1), a1 + hstep, voffA);
            PG8_WAIT_L(8); PG8_BAR; PG8_WAIT_L(0); PG8_MMA(0, 0, At, B0); PG8_BAR; PG8_SCHED;
            PG8_LDB(B1, 0, 1); PG8_STAGE(PG8_SB(0, 0), b2, voffB);
            PG8_BAR; PG8_WAIT_L(0); PG8_MMA(0, 1, At, B1); PG8_BAR;
            PG8_LDA(At, 0, 1); PG8_STAGE(PG8_SA(0, 0), a2, voffA);
            PG8_BAR; PG8_WAIT_L(0); PG8_MMA(1, 0, At, B0); PG8_BAR; PG8_SCHED;
            PG8_STAGE(PG8_SB(0, 1), b2 + hstep, voffB);
            PG8_WAIT_V(6); PG8_BAR; PG8_MMA(1, 1, At, B1); PG8_BAR;
            PG8_LDB(B0, 1, 0); PG8_SCHED; PG8_LDA(At, 1, 0); PG8_STAGE(PG8_SA(0, 1), a2 + hstep, voffA);
            PG8_WAIT_L(8); PG8_BAR; PG8_WAIT_L(0); PG8_MMA(0, 0, At, B0); PG8_BAR; PG8_SCHED;
            PG8_LDB(B1, 1, 1); PG8_STAGE(PG8_SB(1, 0), b3, voffB);
            PG8_BAR; PG8_WAIT_L(0); PG8_MMA(0, 1, At, B1); PG8_BAR;
            PG8_LDA(At, 1, 1); PG8_STAGE(PG8_SA(1, 0), a3, voffA);
            PG8_BAR; PG8_WAIT_L(0); PG8_MMA(1, 0, At, B0); PG8_BAR; PG8_SCHED;
            PG8_STAGE(PG8_SB(1, 1), b3 + hstep, voffB);
            PG8_WAIT_V(6); PG8_BAR; PG8_MMA(1, 1, At, B1); PG8_BAR;
            }
        }
        if constexpr (ALIGN_EPI) { if (wr == 0) PG8_BAR; }
        if constexpr (!Epi::AFTER_DRAIN) { E(acc, cur, wr, wc, fr, fq); S.done(cur); }
        if (!has_next) break;
#pragma unroll
        for (int a = 0; a < 2; ++a)
#pragma unroll
            for (int b = 0; b < 2; ++b)
#pragma unroll
                for (int m = 0; m < 4; ++m)
#pragma unroll
                    for (int n = 0; n < 2; ++n) acc[a][b][m][n] = (f32x4){0.f, 0.f, 0.f, 0.f};
        cur = nxt; cA = nA; cB = nB; ++ui;
        if constexpr (ALIGN_EPI) { if (wr == 1) PG8_BAR; }
    }
    PG8_WAIT_V(0);
    if constexpr (!ALIGN_EPI) { if (wr == 0) PG8_BAR; }
    PG8_BAR;
    if constexpr (Epi::AFTER_DRAIN) { E.fused(acc, cur, wr, wc, fr, fq, lds, wid, lane); S.done(cur); }
#undef PG8_SA
#undef PG8_SB
#undef PG8_STAGE
#undef PG8_LDA
#undef PG8_LDB
#undef PG8_MMA
#undef PG8_WAIT_V
#undef PG8_WAIT_L
#undef PG8_BAR
#undef PG8_SCHED
}
}
typedef short bf16x8s __attribute__((ext_vector_type(8)));
#define WS_PTR(T, off) ((T*)(c.ws + (off)))
struct TJob { const float* W; int ldw, K; const float* gain; bf16_t* WT; int src0, dst0, ncols; };
__device__ __forceinline__ TJob get_job(const Ctx& c, int j) {
    TJob J; J.gain = nullptr; J.src0 = 0; J.dst0 = 0; J.K = D;
    if (j < 4) { const int l = j >> 1, p = j & 1; J.W = c.in[I_WINA] + (size_t)l * D * INA_W; J.ldw = INA_W; J.gain = c.in[I_NMIXPRE] + l * D; J.WT = WS_PTR(bf16_t, WS_WINA) + (size_t)l * 6656 * D;
        if (p == 0) { J.ncols = 6144; } else { J.src0 = 6168; J.dst0 = 6144; J.ncols = 512; } }
    else if (j == 4) { J.W = c.in[I_WINB]; J.ldw = INB_W; J.gain = c.in[I_NMIXPRE] + 2 * D; J.WT = WS_PTR(bf16_t, WS_WINB0); J.ncols = 3584; }
    else if (j == 5) { J.W = c.in[I_WKVF]; J.ldw = KVF_W; J.gain = c.in[I_NKV]; J.WT = WS_PTR(bf16_t, WS_WINB0); J.dst0 = 3584; J.ncols = 3072; }
    else if (j == 6) { J.W = c.in[I_WINB] + (size_t)D * INB_W; J.ldw = INB_W; J.gain = c.in[I_NMIXPRE] + 3 * D; J.WT = WS_PTR(bf16_t, WS_WINB1); J.ncols = 3584; }
    else if (j < 11) { const int l = j - 7; J.W = c.in[I_WO] + (size_t)l * D * D; J.ldw = D; J.WT = WS_PTR(bf16_t, WS_WO) + (size_t)l * D * D; J.ncols = D; }
    else if (j < 15) { const int l = j - 11; J.W = c.in[I_WUP] + (size_t)l * D * DFF; J.ldw = DFF; J.gain = c.in[I_NMLPPRE] + l * D; J.WT = WS_PTR(bf16_t, WS_WUP) + (size_t)l * DFF * D; J.ncols = DFF; }
    else if (j < 19) { const int l = j - 15; J.W = c.in[I_WDN] + (size_t)l * DFF * D; J.ldw = D; J.K = DFF; J.WT = WS_PTR(bf16_t, WS_WDN) + (size_t)l * D * DFF; J.ncols = D; }
    else { const int l = j - 19; J.W = c.in[I_WMEMKV] + (size_t)l * D * 1024; J.ldw = 1024; J.gain = c.in[I_NMEM] + l * D; J.WT = WS_PTR(bf16_t, WS_WMEM); J.dst0 = l * 1024; J.ncols = 1024; }
    return J;
}
constexpr int NJOBS = 23;
__device__ __forceinline__ int job_items(const TJob& J) { return (J.K / 64) * (J.ncols / 32); }
__device__ __forceinline__ void transpose_item(const TJob& J, int item, LAS float* scr, int lane) {
    const int nblk = J.ncols / 32, kb = item / nblk, nb = item % nblk, k0 = 64 * kb, n0 = 32 * nb;
    float wv[32];
#pragma unroll
    for (int i = 0; i < 32; ++i) wv[i] = __builtin_nontemporal_load(J.W + (size_t)(k0 + 2 * i + (lane >> 5)) * J.ldw + J.src0 + n0 + (lane & 31));
#pragma unroll
    for (int i = 0; i < 32; ++i) { const int kk = 2 * i + (lane >> 5); float w = wv[i]; if (J.gain) w *= J.gain[k0 + kk]; scr[kk * 33 + (lane & 31)] = w; }
    asm volatile("s_waitcnt lgkmcnt(0)" ::: "memory");
    const int cc = lane & 7;
#pragma unroll
    for (int j = 0; j < 4; ++j) { const int n = (lane >> 3) + 8 * j; const LAS float* s = scr + (8 * cc) * 33 + n;
        u32x4 o; o.x = pk2(s[0 * 33], s[1 * 33]); o.y = pk2(s[2 * 33], s[3 * 33]); o.z = pk2(s[4 * 33], s[5 * 33]); o.w = pk2(s[6 * 33], s[7 * 33]);
        __builtin_nontemporal_store(o, (u32x4*)(J.WT + (size_t)(J.dst0 + n0 + n) * J.K + k0 + 8 * cc)); }
    asm volatile("s_waitcnt lgkmcnt(0)" ::: "memory");
}
constexpr unsigned JOBS_L0 = 0x3u | (1u << 7) | (1u << 11) | (1u << 15) | (0xfu << 19), JOBS_L1 = 0xcu | (1u << 8) | (1u << 12) | (1u << 16), JOBS_L2 = 0x30u | (1u << 9) | (1u << 13) | (1u << 17), JOBS_L3 = 0x40u | (1u << 10) | (1u << 14) | (1u << 18);
static_assert((JOBS_L0 | JOBS_L1 | JOBS_L2 | JOBS_L3) == (1u << 23) - 1 && (JOBS_L0 & JOBS_L1) == 0 && (JOBS_L2 & JOBS_L3) == 0 && ((JOBS_L0 | JOBS_L1) & (JOBS_L2 | JOBS_L3)) == 0, "every weight job in exactly one group");
__device__ __forceinline__ void ph_prep(CtxP cp, LAS unsigned char* lds, unsigned mask, int wg0, int nwg, int small) {
    CTX_LOAD(cp);
    const int bid_ = obid() - wg0, grid_ = nwg; const int tid = otid(), lane = tid & 63, wave = tid >> 6, gw = bid_ * 8 + wave, NGW = grid_ * 8;
    if (bid_ < 0) return;
    __syncthreads();
    LAS float* scr = (LAS float*)(lds + wave * 16384);
    int base = 0;
    for (int j = 0; j < NJOBS; ++j) { if (!((mask >> j) & 1u)) continue; const TJob J = get_job(c, j); const int n = job_items(J);
        int first = gw - (base % NGW); if (first < 0) first += NGW;
        for (int it = first; it < n; it += NGW) transpose_item(J, it, scr, lane);
        base += n; }
    if (!small) return;
    bf16_t* wskb = WS_PTR(bf16_t, WS_WSKB);
    for (int i = bid_ * 512 + tid; i < 3 * 32 * D; i += grid_ * 512) { const int var = i / (32 * D), r = (i / D) % 32, k = i % D; float v = 0.f;
        if (var < 2) { if (r < 24) v = c.in[I_WINA][(size_t)var * D * INA_W + (size_t)k * INA_W + 6144 + r] * c.in[I_NMIXPRE][var * D + k]; }
        else if (r < 12) v = c.in[I_WKVF][(size_t)k * KVF_W + 3072 + r] * c.in[I_NKV][k];
        wskb[i] = (bf16_t)(pk2(v, 0.f) & 0xffffu); }
}
__device__ __forceinline__ void ph_row2(CtxP cp, int src, int use_delta, int gidx, int gl, int write_y, int first = 0, int wg0 = 0, int nwg = 0) {
    CTX_LOAD(cp);
    const int bid_ = obid() - wg0, grid_ = nwg ? nwg : ogrid();
    if (bid_ < 0 || bid_ >= grid_) return; const int tid = otid(), lane = tid & 63, wave = tid >> 6, gw = bid_ * 8 + wave, NGW = grid_ * 8;
    float* X = WS_PTR(float, WS_X); bf16_t* XN = WS_PTR(bf16_t, WS_XN); const bf16_t* delta = WS_PTR(bf16_t, WS_DELTA); const float* gpost = use_delta ? c.in[gidx] + gl * D : nullptr;
    const int nrows = (src == 2) ? 1024 : M;
#define LD_DELTA(dst, mrow, j) do { const u32x2 t_ = __builtin_nontemporal_load((const u32x2*)(delta + (size_t)(mrow) * D + 4 * lane + 256 * (j))); dst = (f32x4){bflo(t_.x), bfhi(t_.x), bflo(t_.y), bfhi(t_.y)}; } while (0)
    const bool deal2 = (src == 0) && use_delta && (NGW == 2048);
    const int half_gw = gw >> 1, isA = !(gw & 1);
    const int nsteps = deal2 ? (isA ? 4 : 5) : (nrows + 2 * NGW - 1) / (2 * NGW);
    for (int st = 0; st < nsteps; ++st) {
        int m0, m1; bool two;
        if (deal2) { if (isA) { if (st == 0) { m0 = MP + half_gw; m1 = m0; two = false; } else { m0 = half_gw + 1024 * (2 * (st - 1)); m1 = m0 + 1024; two = true; } }
            else { m0 = 6144 + half_gw + 1024 * (2 * st); m1 = m0 + 1024; two = true; } }
        else { m0 = gw + st * 2 * NGW; if (m0 >= nrows) break; const int m1r = m0 + NGW; two = m1r < nrows; m1 = two ? m1r : m0; }
        const bool fromx = (src == 0) && !first;
        const float* xr0 = fromx ? X + (size_t)m0 * D : (src != 2) ? (m0 < MP ? c.in[I_XP] + (size_t)m0 * D : c.in[I_XS] + (size_t)(m0 - MP) * D) : c.in[I_MEMP] + (size_t)m0 * D;
        const float* xr1 = fromx ? X + (size_t)m1 * D : (src != 2) ? (m1 < MP ? c.in[I_XP] + (size_t)m1 * D : c.in[I_XS] + (size_t)(m1 - MP) * D) : c.in[I_MEMP] + (size_t)m1 * D;
        f32x4 v0[8], v1[8];
#pragma unroll
        for (int j = 0; j < 8; ++j) { v0[j] = __builtin_nontemporal_load((const f32x4*)(xr0 + 4 * lane + 256 * j)); v1[j] = two ? __builtin_nontemporal_load((const f32x4*)(xr1 + 4 * lane + 256 * j)) : v0[j]; }
        if (use_delta) { f32x4 d0[8], d1[8]; float s0 = 0.f, s1 = 0.f;
#pragma unroll
            for (int j = 0; j < 8; ++j) {
                if (m0 < MP) LD_DELTA(d0[j], m0, j);
                else { const bf16_t* sp = WS_PTR(bf16_t, WS_SLAB) + (size_t)(m0 - MP) * D + 4 * lane + 256 * j; d0[j] = (f32x4){0.f, 0.f, 0.f, 0.f};
#pragma unroll
                    for (int s8 = 0; s8 < 8; ++s8) { const u32x2 t_ = __builtin_nontemporal_load((const u32x2*)(sp + (size_t)s8 * 1024 * D)); d0[j] = d0[j] + (f32x4){bflo(t_.x), bfhi(t_.x), bflo(t_.y), bfhi(t_.y)}; } }
                if (!two) d1[j] = d0[j];
                else if (m1 < MP) LD_DELTA(d1[j], m1, j);
                else { const bf16_t* sp = WS_PTR(bf16_t, WS_SLAB) + (size_t)(m1 - MP) * D + 4 * lane + 256 * j; d1[j] = (f32x4){0.f, 0.f, 0.f, 0.f};
#pragma unroll
                    for (int s8 = 0; s8 < 8; ++s8) { const u32x2 t_ = __builtin_nontemporal_load((const u32x2*)(sp + (size_t)s8 * 1024 * D)); d1[j] = d1[j] + (f32x4){bflo(t_.x), bfhi(t_.x), bflo(t_.y), bfhi(t_.y)}; } }
                s0 += (d0[j].x * d0[j].x + d0[j].y * d0[j].y) + (d0[j].z * d0[j].z + d0[j].w * d0[j].w); s1 += (d1[j].x * d1[j].x + d1[j].y * d1[j].y) + (d1[j].z * d1[j].z + d1[j].w * d1[j].w); }
            const float r0 = rsqrtf(wave_sum_dpp(s0) * (1.f / D) + EPS), r1 = rsqrtf(wave_sum_dpp(s1) * (1.f / D) + EPS);
#pragma unroll
            for (int j = 0; j < 8; ++j) { const f32x4 g = *(const f32x4*)(gpost + 4 * lane + 256 * j); v0[j] = v0[j] + d0[j] * r0 * g; v1[j] = v1[j] + d1[j] * r1 * g; } }
        if (src == 0 && !write_y) {
#pragma unroll
            for (int j = 0; j < 8; ++j) { __builtin_nontemporal_store(v0[j], (f32x4*)(X + (size_t)m0 * D + 4 * lane + 256 * j)); if (two) __builtin_nontemporal_store(v1[j], (f32x4*)(X + (size_t)m1 * D + 4 * lane + 256 * j)); } }
        if (write_y) {
#pragma unroll
            for (int j = 0; j < 8; ++j) { __builtin_nontemporal_store(v0[j], (f32x4*)(c.out + O_YP + (size_t)m0 * D + 4 * lane + 256 * j)); if (two) __builtin_nontemporal_store(v1[j], (f32x4*)(c.out + O_YP + (size_t)m1 * D + 4 * lane + 256 * j)); }
            continue; }
        float q0 = 0.f, q1 = 0.f;
#pragma unroll
        for (int j = 0; j < 8; ++j) { q0 += (v0[j].x * v0[j].x + v0[j].y * v0[j].y) + (v0[j].z * v0[j].z + v0[j].w * v0[j].w); q1 += (v1[j].x * v1[j].x + v1[j].y * v1[j].y) + (v1[j].z * v1[j].z + v1[j].w * v1[j].w); }
        const float t0 = rsqrtf(wave_sum_dpp(q0) * (1.f / D) + EPS), t1 = rsqrtf(wave_sum_dpp(q1) * (1.f / D) + EPS);
        bf16_t* xn0 = ((src == 2) ? WS_PTR(bf16_t, WS_MEMN) : XN) + (size_t)m0 * D; bf16_t* xn1 = ((src == 2) ? WS_PTR(bf16_t, WS_MEMN) : XN) + (size_t)m1 * D;
#pragma unroll
        for (int j = 0; j < 8; ++j) { u32x2 w0, w1; w0.x = pk2(v0[j].x * t0, v0[j].y * t0); w0.y = pk2(v0[j].z * t0, v0[j].w * t0); w1.x = pk2(v1[j].x * t1, v1[j].y * t1); w1.y = pk2(v1[j].z * t1, v1[j].w * t1);
            *(u32x2*)(xn0 + 4 * lane + 256 * j) = w0; if (two) *(u32x2*)(xn1 + 4 * lane + 256 * j) = w1; }
    }
}
__device__ __forceinline__ void ph_skinny(CtxP cp, int var, LAS unsigned char* lds) {
    CTX_LOAD(cp);
    const int bid_ = obid(), grid_ = ogrid(); const int tid = otid(), lane = tid & 63, wave = tid >> 6, n16 = lane & 15, q = lane >> 4;
    const bf16_t* Wb = WS_PTR(bf16_t, WS_WSKB) + (size_t)var * 32 * D + (size_t)n16 * D + 8 * q + 256 * wave;
    bf16x8s wa[8], wb[8];
#pragma unroll
    for (int ks = 0; ks < 8; ++ks) { wa[ks] = *(const bf16x8s*)(Wb + 32 * ks); wb[ks] = *(const bf16x8s*)(Wb + (size_t)16 * D + 32 * ks); }
    LAS float* P = (LAS float*)lds;
    const bf16_t* xp = WS_PTR(bf16_t, WS_XN) + (size_t)n16 * D + 8 * q + 256 * wave;
    __syncthreads();
    bf16x8s xb[8];
#pragma unroll
    for (int ks = 0; ks < 8; ++ks) xb[ks] = *(const bf16x8s*)(xp + (size_t)(16 * bid_) * D + 32 * ks);
    int nt = 0;
    for (int rt = bid_; rt < M / 16; rt += grid_, ++nt) {
        bf16x8s xn[8]; const int rn = rt + grid_;
        if (rn < M / 16) {
#pragma unroll
            for (int ks = 0; ks < 8; ++ks) xn[ks] = *(const bf16x8s*)(xp + (size_t)(16 * rn) * D + 32 * ks); }
        else {
#pragma unroll
            for (int ks = 0; ks < 8; ++ks) xn[ks] = xb[ks]; }
        f32x4 a0 = {0.f, 0.f, 0.f, 0.f}, a1 = {0.f, 0.f, 0.f, 0.f};
#pragma unroll
        for (int ks = 0; ks < 8; ++ks) { a0 = __builtin_amdgcn_mfma_f32_16x16x32_bf16(wa[ks], xb[ks], a0, 0, 0, 0); a1 = __builtin_amdgcn_mfma_f32_16x16x32_bf16(wb[ks], xb[ks], a1, 0, 0, 0); }
        LAS float* pp = P + (size_t)((nt * 8 + wave) * 8) * 64 + lane;
#pragma unroll
        for (int i = 0; i < 4; ++i) { pp[i * 64] = a0[i]; pp[(4 + i) * 64] = a1[i]; }
#pragma unroll
        for (int ks = 0; ks < 8; ++ks) xb[ks] = xn[ks];
    }
    __syncthreads();
    const int cc = (wave < 4) ? 4 * q + wave : 16 + 4 * q + (wave - 4);
    for (int t = 0; t < nt; ++t) { const int m = 16 * (bid_ + t * grid_) + n16; float s = 0.f;
#pragma unroll
        for (int w = 0; w < 8; ++w) s += P[(size_t)((t * 8 + w) * 8 + wave) * 64 + lane];
        if (var < 2) {
            if (cc < 12) WS_PTR(float, WS_G)[(size_t)m * 12 + cc] = -exp_fast(c.in[I_ALOG][var * 12 + cc]) * softplus_fast(s + c.in[I_DTB][var * 12 + cc]);
            else if (cc < 24) WS_PTR(float, WS_BETA)[(size_t)m * 12 + (cc - 12)] = fast_sigmoid(s); }
        else if (cc < 12) { const float lf = -softplus_fast(-(s + c.in[I_BF][cc])); WS_PTR(float, WS_LOGF)[(size_t)m * 12 + cc] = lf;
            c.out[(m < MP ? O_PLOGF + (size_t)m * 12 : O_SLOGF + (size_t)(m - MP) * 12) + cc] = lf; } }
    __syncthreads();
}
__device__ __forceinline__ void ph_gdn_c(CtxP cp, int l) {
    CTX_LOAD(cp);
    const int bid_ = obid(), grid_ = ogrid(); const int tid = otid(), lane = tid & 63, wave = tid >> 6, gw = bid_ * 8 + wave, NGW = grid_ * 8, sub = lane >> 4, c8 = (lane & 15) * 8;
    const bf16_t* PROJ = WS_PTR(bf16_t, WS_PROJ); const bf16_t* Of = WS_PTR(bf16_t, WS_OF); bf16_t* ACT = WS_PTR(bf16_t, WS_ACT);
    const f32x4 g0 = *(const f32x4*)(c.in[I_GDNN] + l * HD + c8), g1 = *(const f32x4*)(c.in[I_GDNN] + l * HD + c8 + 4);
    for (int it = gw * 4 + sub; it < M * H; it += NGW * 4) { const int m = it / H, h = it % H;
        const u32x4 ou = __builtin_nontemporal_load((const u32x4*)(Of + (size_t)m * TOK + h * HD + c8));
        const f32x4 o0 = {bflo(ou.x), bfhi(ou.x), bflo(ou.y), bfhi(ou.y)}, o1 = {bflo(ou.z), bfhi(ou.z), bflo(ou.w), bfhi(ou.w)};
        const u32x4 zu = __builtin_nontemporal_load((const u32x4*)(PROJ + (size_t)m * PJ + QKV + h * HD + c8));
        float ss = (o0.x * o0.x + o0.y * o0.y) + (o0.z * o0.z + o0.w * o0.w) + (o1.x * o1.x + o1.y * o1.y) + (o1.z * o1.z + o1.w * o1.w);
        ss += __int_as_float(__builtin_amdgcn_update_dpp(0, __float_as_int(ss), 0x111, 0xf, 0xf, true)); ss += __int_as_float(__builtin_amdgcn_update_dpp(0, __float_as_int(ss), 0x112, 0xf, 0xf, true));
        ss += __int_as_float(__builtin_amdgcn_update_dpp(0, __float_as_int(ss), 0x114, 0xf, 0xf, true)); ss += __int_as_float(__builtin_amdgcn_update_dpp(0, __float_as_int(ss), 0x118, 0xf, 0xf, true));
        ss = lane_get(ss, lane | 15);
        const float r = rsqrtf(ss * (1.f / HD) + EPS);
        const float z0 = bflo(zu.x), z1 = bfhi(zu.x), z2 = bflo(zu.y), z3 = bfhi(zu.y), z4 = bflo(zu.z), z5 = bfhi(zu.z), z6 = bflo(zu.w), z7 = bfhi(zu.w);
        u32x4 w4; w4.x = pk2(o0.x * r * g0.x * (z0 * fast_sigmoid(z0)), o0.y * r * g0.y * (z1 * fast_sigmoid(z1))); w4.y = pk2(o0.z * r * g0.z * (z2 * fast_sigmoid(z2)), o0.w * r * g0.w * (z3 * fast_sigmoid(z3)));
        w4.z = pk2(o1.x * r * g1.x * (z4 * fast_sigmoid(z4)), o1.y * r * g1.y * (z5 * fast_sigmoid(z5))); w4.w = pk2(o1.z * r * g1.z * (z6 * fast_sigmoid(z6)), o1.w * r * g1.w * (z7 * fast_sigmoid(z7)));
        *(u32x4*)(ACT + (size_t)m * D + h * HD + c8) = w4; }
}
__device__ __forceinline__ float wave_scan_dpp(float v, int lane, float& total) {
    v += __int_as_float(__builtin_amdgcn_update_dpp(0, __float_as_int(v), 0x111, 0xf, 0xf, true));
    v += __int_as_float(__builtin_amdgcn_update_dpp(0, __float_as_int(v), 0x112, 0xf, 0xf, true));
    v += __int_as_float(__builtin_amdgcn_update_dpp(0, __float_as_int(v), 0x114, 0xf, 0xf, true));
    v += __int_as_float(__builtin_amdgcn_update_dpp(0, __float_as_int(v), 0x118, 0xf, 0xf, true));
    const int iv = __float_as_int(v);
    const float r0 = __int_as_float(__builtin_amdgcn_readlane(iv, 15)), r1 = __int_as_float(__builtin_amdgcn_readlane(iv, 31)), r2 = __int_as_float(__builtin_amdgcn_readlane(iv, 47)), r3 = __int_as_float(__builtin_amdgcn_readlane(iv, 63));
    const int row = lane >> 4; total = ((r0 + r1) + r2) + r3;
    return v + (row == 0 ? 0.f : row == 1 ? r0 : row == 2 ? r0 + r1 : (r0 + r1) + r2);
}
__device__ __forceinline__ void ph_cumsum(CtxP cp) {
    CTX_LOAD(cp);
    const int bid_ = obid(), grid_ = ogrid(); const int tid = otid(), lane = tid & 63, wave = tid >> 6, NGW = grid_ * 8;
    const float* LOGF = WS_PTR(float, WS_LOGF); float* CUMP = WS_PTR(float, WS_CUMP); float* CUMS = WS_PTR(float, WS_CUMS);
    for (int task = bid_ + grid_ * wave; task < 192 + 384; task += NGW) {
        const bool smp = task >= 192; int b, h, jb, n; float carry = 0.f;
        if (!smp) { const int seg = task / 48, ts = task % 48; b = ts / 12; h = ts % 12; jb = seg * 1024; n = jb + 1024; float ps = 0.f;
#pragma unroll 16
            for (int j = lane; j < jb; j += 64) ps += LOGF[(size_t)(b * 4096 + j) * 12 + h];
            carry = wave_sum_dpp(ps); }
        else { const int ts = task - 192; b = ts / 12; h = ts % 12; jb = 0; n = PAST + 32; }
        for (int j0 = jb; j0 < n; j0 += 1024) { float vv[16];
#pragma unroll
            for (int u = 0; u < 16; ++u) { const int j = j0 + 64 * u + lane; vv[u] = 0.f;
                if (j < n) vv[u] = !smp ? LOGF[(size_t)(b * 4096 + j) * 12 + h] : (j < PAST ? c.in[I_CLOGF][(size_t)(b * PAST + j) * 12 + h] : LOGF[(size_t)(MP + b * 32 + j - PAST) * 12 + h]); }
#pragma unroll
            for (int u = 0; u < 16; ++u) { const int j = j0 + 64 * u + lane; float tot; const float v = wave_scan_dpp(vv[u], lane, tot);
                if (j < n) { if (smp) CUMS[(size_t)(b * (PAST + 32) + j) * 12 + h] = carry + v; else { CUMP[(size_t)(b * 4096 + j) * 12 + h] = carry + v;
                        const float cr = (carry + v) * (1.f / SCALE); const unsigned c1 = pk2(cr, 0.f) & 0xffffu; const float r1 = cr - __uint_as_float(c1 << 16); const unsigned c2 = pk2(r1, 0.f) & 0xffffu;
                        const float r2 = r1 - __uint_as_float(c2 << 16); const unsigned c3 = pk2(r2, 0.f) & 0xffffu; const size_t o8 = ((size_t)(b * 12 + h) * 4096 + j) * 8;
                        u32x4 qv, kv; qv.x = c1 | (c2 << 16); qv.y = c3 | 0x3f800000u; qv.z = 0x3f803f80u; qv.w = 0u; kv.x = 0x3f803f80u; kv.y = 0x3f80u | ((c1 ^ 0x8000u) << 16); kv.z = (c2 ^ 0x8000u) | ((c3 ^ 0x8000u) << 16); kv.w = 0u;
                        *(u32x4*)(WS_PTR(bf16_t, WS_QX) + o8) = qv; *(u32x4*)(WS_PTR(bf16_t, WS_KX) + o8) = kv; } }
                carry += tot; } }
    }
}
typedef short bf16x8 __attribute__((ext_vector_type(8)));
typedef float f32x16 __attribute__((ext_vector_type(16)));
constexpr int GT_W = 0, GT_QG = 16384, GT_KG = 32768, GT_AT = 49152, GT_U = 57344, GT_BYTES = 73728;
constexpr int NTASK_P = 4 * 12 * 64, NTASK = NTASK_P + 384;
constexpr size_t WS_GDNBUF = WS_BIG;
static_assert((size_t)NTASK * GT_BYTES <= 306 * MiB, "GDNBUF must not reach WS_OF");
__device__ __forceinline__ int permpos(int x) { return (x & ~31) | (((x >> 2) & 3) << 3) | (((x >> 4) & 1) << 2) | (x & 3); }
__device__ __forceinline__ int crow32(int r, int hi) { return (r & 3) + 8 * (r >> 2) + 4 * hi; }
constexpr int L_KN = 0, L_QN = 17408, L_VBT = 34816, L_KBT = 53248, L_AS = 71680, L_TS = 88320, L_KGT = 97536, L_ATP = 113920, L_GS = 122112, L_BS = 122368, L_TD = 122624, L_CW = 131072;
#define LDS_BARRIER() do { asm volatile("s_waitcnt lgkmcnt(0)" ::: "memory"); __builtin_amdgcn_s_barrier(); asm volatile("" ::: "memory"); } while (0)
__device__ __forceinline__ void ph_gdn_prep(CtxP cp, int l, LAS unsigned char* lds) {
    CTX_LOAD(cp);
    const int bid_ = obid(), grid_ = ogrid(); const int tid0 = otid();
    const bf16_t* PROJ = WS_PTR(bf16_t, WS_PROJ); const float* cw = c.in[I_CONVW] + (size_t)l * 4 * QKV;
    LAS float* Gs = (LAS float*)(lds + L_GS); LAS float* Bs = (LAS float*)(lds + L_BS); LAS float* As = (LAS float*)(lds + L_AS);
    unsigned warm = 0u;
    for (int tk = bid_; tk < NTASK; tk += grid_) {
        asm volatile("" :: "v"(warm));
        int tid = tid0; asm volatile("" : "+v"(tid));
        const int lane = tid & 63, w = __builtin_amdgcn_readfirstlane(tid >> 6);
        int grp, b, h, ch, L, m0, t0;
        if (tk < NTASK_P) { grp = 0; ch = tk & 63; const int bh = tk >> 6; b = bh / 12; h = bh % 12; L = 64; t0 = ch * 64; m0 = b * 4096 + t0; }
        else { grp = 1; ch = 0; const int bh = tk - NTASK_P; b = bh / 12; h = bh % 12; L = 32; t0 = 0; m0 = MP + b * 32; }
        const int T = grp ? 32 : 4096, nb = grp ? 32 : 4;
        unsigned char* gb = c.ws + WS_GDNBUF + (size_t)tk * GT_BYTES;
        if (tid >= 128) { const int e4 = 4 * (tid - 128); *(LAS f32x4*)(lds + L_CW + e4 * 4) = *(const f32x4*)(cw + (size_t)((e4 >> 7) & 3) * QKV + (e4 >> 9) * TOK + h * HD + (e4 & 127)); }
        if (tid < 64) { const bool v = tid < L; float gv = v ? WS_PTR(float, WS_G)[(size_t)(m0 + tid) * 12 + h] : 0.f; const float bv = v ? WS_PTR(float, WS_BETA)[(size_t)(m0 + tid) * 12 + h] : 0.f;
#pragma unroll
            for (int o = 1; o < 64; o <<= 1) { const float n = lane_get(gv, lane - o); if (lane >= o) gv += n; }
            Gs[tid] = gv; Bs[tid] = bv; }
        LDS_BARRIER();
        const int r = tid >> 3, seg = tid & 7; const bool valid = r < L; const int t = t0 + r, m = m0 + r;
        const float gr = Gs[r], eg = expf(gr), egl = expf(Gs[63] - gr), bt = Bs[r]; const int pr = permpos(r);
#pragma unroll
        for (int pi = 0; pi < 3; ++pi) { const int part = (pi == 0) ? 1 : (pi == 1 ? 0 : 2);
            const int col0 = part * TOK + h * HD + 16 * seg; float y[16];
#pragma unroll
            for (int e = 0; e < 16; ++e) y[e] = 0.f;
            if (valid) {
#pragma unroll
                for (int jj = 0; jj < 4; ++jj) { const int tt = t - 3 + jj; float x[16];
                    if (tt >= 0) { const u32x4 a = *(const u32x4*)(PROJ + (size_t)(m - 3 + jj) * PJ + col0), bq = *(const u32x4*)(PROJ + (size_t)(m - 3 + jj) * PJ + col0 + 8);
                        x[0] = bflo(a.x); x[1] = bfhi(a.x); x[2] = bflo(a.y); x[3] = bfhi(a.y); x[4] = bflo(a.z); x[5] = bfhi(a.z); x[6] = bflo(a.w); x[7] = bfhi(a.w);
                        x[8] = bflo(bq.x); x[9] = bfhi(bq.x); x[10] = bflo(bq.y); x[11] = bfhi(bq.y); x[12] = bflo(bq.z); x[13] = bfhi(bq.z); x[14] = bflo(bq.w); x[15] = bfhi(bq.w); }
                    else if (grp) { const float* hp = c.in[I_SCONV] + (size_t)((l * 32 + b) * 3 + (3 + tt)) * QKV + col0;
#pragma unroll
                        for (int i = 0; i < 4; ++i) { const f32x4 a = *(const f32x4*)(hp + 4 * i); x[4 * i] = a.x; x[4 * i + 1] = a.y; x[4 * i + 2] = a.z; x[4 * i + 3] = a.w; } }
                    else {
#pragma unroll
                        for (int e = 0; e < 16; ++e) x[e] = 0.f; }
#pragma unroll
                    for (int i = 0; i < 4; ++i) { const f32x4 wv = *(const LAS f32x4*)(lds + L_CW + ((part * 4 + jj) * 128 + 16 * seg + 4 * i) * 4);
                        y[4 * i] += x[4 * i] * wv.x; y[4 * i + 1] += x[4 * i + 1] * wv.y; y[4 * i + 2] += x[4 * i + 2] * wv.z; y[4 * i + 3] += x[4 * i + 3] * wv.w; } }
                if (t >= T - 3) { const u32x4 a = *(const u32x4*)(PROJ + (size_t)m * PJ + col0), bq = *(const u32x4*)(PROJ + (size_t)m * PJ + col0 + 8);
                    float* dst = c.out + (grp ? O_SCONV : O_PCONV) + (size_t)((l * nb + b) * 3 + (t - (T - 3))) * QKV + col0;
                    *(f32x4*)(dst) = (f32x4){bflo(a.x), bfhi(a.x), bflo(a.y), bfhi(a.y)}; *(f32x4*)(dst + 4) = (f32x4){bflo(a.z), bfhi(a.z), bflo(a.w), bfhi(a.w)};
                    *(f32x4*)(dst + 8) = (f32x4){bflo(bq.x), bfhi(bq.x), bflo(bq.y), bfhi(bq.y)}; *(f32x4*)(dst + 12) = (f32x4){bflo(bq.z), bfhi(bq.z), bflo(bq.w), bfhi(bq.w)}; }
#pragma unroll
                for (int e = 0; e < 16; ++e) y[e] = y[e] * fast_sigmoid(y[e]);
            }
            if (part < 2) { float ss = 0.f;
#pragma unroll
                for (int e = 0; e < 16; ++e) ss += y[e] * y[e];
                ss += lane_get(ss, lane ^ 1); ss += lane_get(ss, lane ^ 2); ss += lane_get(ss, lane ^ 4);
                const float rn = rsqrtf(ss + EPS) * (part == 0 ? SCALE : 1.f);
#pragma unroll
                for (int e = 0; e < 16; ++e) y[e] *= rn;
                u32x4 p0, p1; p0.x = pk2(y[0], y[1]); p0.y = pk2(y[2], y[3]); p0.z = pk2(y[4], y[5]); p0.w = pk2(y[6], y[7]); p1.x = pk2(y[8], y[9]); p1.y = pk2(y[10], y[11]); p1.z = pk2(y[12], y[13]); p1.w = pk2(y[14], y[15]);
                const int dst = (part == 1 ? L_KN : L_QN) + r * 272 + seg * 32;
                *(LAS u32x4*)(lds + dst) = p0; *(LAS u32x4*)(lds + dst + 16) = p1; }
            if (part == 1) {
#pragma unroll
                for (int e = 0; e < 16; ++e) { const int col = 16 * seg + e;
                    *(LAS bf16_t*)(lds + L_KBT + col * 144 + (((r >> 3) ^ seg) << 4) + (r & 7) * 2) = (bf16_t)(pk2(bt * eg * y[e], 0.f) & 0xffffu);
                    *(LAS bf16_t*)(lds + L_KGT + col * 128 + (((pr >> 3) ^ seg) << 4) + (pr & 7) * 2) = (bf16_t)(pk2(egl * y[e], 0.f) & 0xffffu); } }
            else if (part == 0) {
#pragma unroll
                for (int q4 = 0; q4 < 4; ++q4) { u32x2 v2; v2.x = pk2(eg * y[4 * q4], eg * y[4 * q4 + 1]); v2.y = pk2(eg * y[4 * q4 + 2], eg * y[4 * q4 + 3]);
                    __builtin_nontemporal_store(v2, (u32x2*)(gb + GT_QG + r * 256 + (32 * (seg >> 1) + 8 * q4 + 4 * (seg & 1)) * 2)); } }
            else {
#pragma unroll
                for (int e = 0; e < 16; ++e) *(LAS bf16_t*)(lds + L_VBT + (16 * seg + e) * 144 + (((r >> 3) ^ seg) << 4) + (r & 7) * 2) = (bf16_t)(pk2(bt * y[e], 0.f) & 0xffffu); }
            __builtin_amdgcn_sched_barrier(0);
        }
        if (tid == 0) WS_PTR(float, WS_EGL)[tk] = expf(Gs[63]);
        { const int tkn = tk + grid_;
            if (tkn < NTASK && tid < 402) { int m0n, hn; if (tkn < NTASK_P) { const int bh = tkn >> 6; hn = bh % 12; m0n = (bh / 12) * 4096 + (tkn & 63) * 64; } else { const int bh = tkn - NTASK_P; hn = bh % 12; m0n = MP + (bh / 12) * 32; }
                const int row = tid / 6, rem = tid % 6; int mm = m0n - 3 + row; mm = mm < 0 ? 0 : (mm >= M ? M - 1 : mm);
                warm = *(const volatile unsigned*)(PROJ + (size_t)mm * PJ + (rem >> 1) * TOK + hn * HD + (rem & 1) * 64); } }
        LDS_BARRIER();
        { const int r32 = lane & 31, hi = lane >> 5;
            if (w < 6) { const int which = w / 3, tt3 = w % 3, ib = tt3 ? 1 : 0, jb = (tt3 == 2) ? 1 : 0; f32x16 acc = {};
                const int xoff = (which ? L_QN : L_KN) + (ib * 32 + r32) * 272 + hi * 16, koff = L_KN + (jb * 32 + r32) * 272 + hi * 16;
#pragma unroll
                for (int kk = 0; kk < 8; ++kk) { const bf16x8 a = *(const LAS bf16x8*)(lds + xoff + kk * 32), bq = *(const LAS bf16x8*)(lds + koff + kk * 32);
                    acc = __builtin_amdgcn_mfma_f32_32x32x16_bf16(a, bq, acc, 0, 0, 0); }
                const int j = jb * 32 + r32; const float gj = Gs[j]; const int pj = permpos(j);
#pragma unroll
                for (int rr = 0; rr < 16; ++rr) { const int i = ib * 32 + crow32(rr, hi); const float dec = expf(fminf(Gs[i] - gj, 0.f));
                    if (which == 0) As[i * 65 + j] = (i > j) ? Bs[i] * acc[rr] * dec : 0.f;
                    else *(LAS bf16_t*)(lds + L_ATP + i * 128 + pj * 2) = (bf16_t)(pk2((i >= j) ? acc[rr] * dec : 0.f, 0.f) & 0xffffu); } }
            else { const int j = 32 + r32;
#pragma unroll
                for (int rr = 0; rr < 16; ++rr) { const int i = crow32(rr, hi);
                    if (w == 6) As[i * 65 + j] = 0.f; else *(LAS bf16_t*)(lds + L_ATP + i * 128 + permpos(j) * 2) = (bf16_t)0; } } }
        LDS_BARRIER();
        if (w == 0) { const int blk = lane >> 5, col = lane & 31, r32 = col, hi = blk; float x[32];
            const LAS float* Asv = As + blk * (32 * 65 + 32); asm volatile("" : "+v"(Asv));
            LAS float* Td = (LAS float*)(lds + L_TD);
#pragma unroll
            for (int i = 0; i < 32; ++i) { float a = (col == i) ? 1.f : 0.f;
#pragma unroll
                for (int j = 0; j < i; ++j) a -= Asv[i * 65 + j] * x[j];
                x[i] = a; Td[blk * (32 * 33) + i * 33 + col] = a;
                *(LAS bf16_t*)(lds + L_TS + (blk * 32 + i) * 144 + (blk * 32 + col) * 2) = (bf16_t)(pk2(a, 0.f) & 0xffffu);
                if (blk) *(LAS bf16_t*)(lds + L_TS + i * 144 + (32 + col) * 2) = (bf16_t)0;
                if ((i & 7) == 7) __builtin_amdgcn_sched_barrier(0); }
            f32x16 acc = {};
#pragma unroll
            for (int s = 0; s < 16; ++s) acc = __builtin_amdgcn_mfma_f32_32x32x2f32(As[(32 + r32) * 65 + 2 * s + hi], Td[(2 * s + hi) * 33 + r32], acc, 0, 0, 0);
#pragma unroll
            for (int rr = 0; rr < 16; ++rr) Td[crow32(rr, hi) * 33 + r32] = acc[rr];
            f32x16 acc2 = {};
#pragma unroll
            for (int s = 0; s < 16; ++s) acc2 = __builtin_amdgcn_mfma_f32_32x32x2f32(Td[32 * 33 + r32 * 33 + 2 * s + hi], Td[(2 * s + hi) * 33 + r32], acc2, 0, 0, 0);
#pragma unroll
            for (int rr = 0; rr < 16; ++rr) *(LAS bf16_t*)(lds + L_TS + (32 + crow32(rr, hi)) * 144 + r32 * 2) = (bf16_t)(pk2(-acc2[rr], 0.f) & 0xffffu); }
        LDS_BARRIER();
        { const int r32 = lane & 31, hi = lane >> 5; const int src = (w < 4 ? L_VBT : L_KBT) + ((w & 3) * 32 + r32) * 144, sw = (((w & 3) * 32 + r32) >> 4) & 7;
#pragma unroll
            for (int ib = 0; ib < 2; ++ib) { f32x16 acc = {}; const int toff = L_TS + (ib * 32 + r32) * 144 + hi * 16;
#pragma unroll
                for (int kk = 0; kk < 4; ++kk) { if (kk < 2 * (ib + 1)) { const bf16x8 a = *(const LAS bf16x8*)(lds + toff + kk * 32), bq = *(const LAS bf16x8*)(lds + src + (((2 * kk + hi) ^ sw) << 4));
                        acc = __builtin_amdgcn_mfma_f32_32x32x16_bf16(a, bq, acc, 0, 0, 0); } }
                const int col = (w & 3) * 32 + r32;
                if (w < 4) {
#pragma unroll
                    for (int g = 0; g < 4; ++g) { u32x2 v2; v2.x = pk2(acc[4 * g], acc[4 * g + 1]); v2.y = pk2(acc[4 * g + 2], acc[4 * g + 3]);
                        *(LAS u32x2*)(lds + L_QN + col * 128 + (((4 * ib + g) ^ (col & 7)) << 4) + hi * 8) = v2; } }
                else { const int pc = permpos(col);
#pragma unroll
                    for (int rr = 0; rr < 16; ++rr) { const int i = ib * 32 + crow32(rr, hi); *(LAS bf16_t*)(lds + L_KN + i * 256 + pc * 2) = (bf16_t)(pk2(acc[rr], 0.f) & 0xffffu); } } } }
        LDS_BARRIER();
#pragma unroll
        for (int k = 0; k < 7; ++k) { const int u = tid + 512 * k; int lo, go;
            if (k < 2) { lo = L_KN + u * 16; go = GT_W + u * 16; } else if (k < 4) { const int uu = u - 1024, row = uu >> 3; lo = L_QN + row * 128 + (((uu & 7) ^ (row & 7)) << 4); go = GT_U + uu * 16; }
            else if (k < 6) { const int uu = u - 2048, row = uu >> 3; lo = L_KGT + row * 128 + (((uu & 7) ^ ((row >> 4) & 7)) << 4); go = GT_KG + uu * 16; } else { lo = L_ATP + (u - 3072) * 16; go = GT_AT + (u - 3072) * 16; }
            __builtin_nontemporal_store(*(const LAS u32x4*)(lds + lo), (u32x4*)(gb + go)); }
    }
}
constexpr int SC_W = 0, SC_QG = 17408, SC_KG = 34816, SC_AT = 53248, SC_BUF = 62464, SC_OS = 2 * SC_BUF;
__device__ __forceinline__ void ph_gdn_scan(CtxP cp, int l, LAS unsigned char* lds) {
    CTX_LOAD(cp);
    const int bid_ = obid(), grid_ = ogrid(); const int tid = otid(), lane = tid & 63, w = __builtin_amdgcn_readfirstlane(tid >> 6), m16 = lane & 15, q = lane >> 4;
    const float* EGL = WS_PTR(float, WS_EGL);
    const int nsmpwg = grid_ - 96;
    for (int it = 0;; ++it) {
        int grp, bh, half, nch, tk0;
        if (bid_ < 96) { if (it > 0) break; grp = 0; bh = bid_ >> 1; half = bid_ & 1; nch = 64; tk0 = bh * 64; }
        else { const int si = (bid_ - 96) + nsmpwg * it; if (si >= 768) break; grp = 1; bh = si >> 1; half = si & 1; nch = 1; tk0 = NTASK_P + bh; }
        const int b = bh / 12, h = bh % 12, m0 = grp ? MP + b * 32 : b * 4096;
        __syncthreads();
        if (w >= 4) {
            const int lt = tid - 256; u32x4 stA[14], stB[14];
#define SC_LOAD(ST, tk) do { const unsigned char* gsrc = c.ws + WS_GDNBUF + (size_t)(tk) * GT_BYTES; _Pragma("unroll") for (int k = 0; k < 14; ++k) ST[k] = __builtin_nontemporal_load((const u32x4*)(gsrc + (size_t)(lt + 256 * k) * 16)); } while (0)
#define SC_WRITE(ST, bufoff) do { _Pragma("unroll") for (int k = 0; k < 14; ++k) { const int u = lt + 256 * k; int lo; \
            if (k < 4) lo = SC_W + (u >> 4) * 272 + (u & 15) * 16; else if (k < 8) lo = SC_QG + ((u - 1024) >> 4) * 272 + (u & 15) * 16; \
            else if (k < 12) lo = SC_KG + ((u - 2048) >> 3) * 144 + (u & 7) * 16; else lo = SC_AT + ((u - 3072) >> 3) * 144 + (u & 7) * 16; \
            *(LAS u32x4*)(lds + (bufoff) + lo) = ST[k]; } } while (0)
            bf16_t* Ob = WS_PTR(bf16_t, WS_OF) + (size_t)m0 * TOK + h * HD + half * 64; const int nou = grp ? 256 : 512;
#define SC_OUT(ch_) do { _Pragma("unroll") for (int k = 0; k < 2; ++k) { const int u = lt + 256 * k; if (u < nou) \
                *(u32x4*)(Ob + (size_t)((ch_) * 64 + (u >> 3)) * TOK + (u & 7) * 8) = *(const LAS u32x4*)(lds + SC_OS + ((ch_) & 1) * 8192 + u * 16); } } while (0)
            SC_LOAD(stA, tk0); SC_WRITE(stA, 0);
            if (1 < nch) SC_LOAD(stA, tk0 + 1);
            if (2 < nch) SC_LOAD(stB, tk0 + 2);
            LDS_BARRIER();
            for (int ch = 0; ch < nch; ch += 2) {
                if (ch >= 1) SC_OUT(ch - 1);
                if (ch + 1 < nch) SC_WRITE(stA, ((ch + 1) & 1) * SC_BUF);
                if (ch + 3 < nch) SC_LOAD(stA, tk0 + ch + 3);
                LDS_BARRIER();
                if (ch + 1 < nch) {
                    SC_OUT(ch);
                    if (ch + 2 < nch) SC_WRITE(stB, ((ch + 2) & 1) * SC_BUF);
                    if (ch + 4 < nch) SC_LOAD(stB, tk0 + ch + 4);
                    LDS_BARRIER(); }
            }
            SC_OUT(nch - 1);
#undef SC_OUT
#undef SC_LOAD
#undef SC_WRITE
        } else {
            __builtin_amdgcn_s_setprio(2);
            const int c0 = half * 64 + 16 * w;
            f32x4 S[8];
            if (grp) { const float* S0 = c.in[I_SGDN] + (size_t)((l * 32 + b) * 12 + h) * 16384;
#pragma unroll
                for (int dt = 0; dt < 8; ++dt)
#pragma unroll
                    for (int i = 0; i < 4; ++i) S[dt][i] = S0[(16 * dt + 4 * q + i) * 128 + c0 + m16]; }
            else {
#pragma unroll
                for (int dt = 0; dt < 8; ++dt) S[dt] = (f32x4){0.f, 0.f, 0.f, 0.f}; }
            u32x2 un[4]; float egn;
#define UE_LOAD(tk_) do { const unsigned char* ut_ = c.ws + WS_GDNBUF + (size_t)(tk_) * GT_BYTES + GT_U + (c0 + m16) * 128 + 8 * q; \
            _Pragma("unroll") for (int mt = 0; mt < 4; ++mt) un[mt] = *(const u32x2*)(ut_ + 32 * mt); egn = EGL[tk_]; } while (0)
            UE_LOAD(tk0);
            LDS_BARRIER();
            for (int ch = 0; ch < nch; ++ch) { const int bo = (ch & 1) * SC_BUF; const int tk = tk0 + ch;
                u32x2 uc[4]; const float egl = egn;
#pragma unroll
                for (int mt = 0; mt < 4; ++mt) uc[mt] = un[mt];
                if (ch + 1 < nch) UE_LOAD(tk + 1);
                bf16x8 Sb[4];
#pragma unroll
                for (int ks = 0; ks < 4; ++ks) { u32x4 t4; t4.x = pk2(S[2 * ks][0], S[2 * ks][1]); t4.y = pk2(S[2 * ks][2], S[2 * ks][3]); t4.z = pk2(S[2 * ks + 1][0], S[2 * ks + 1][1]); t4.w = pk2(S[2 * ks + 1][2], S[2 * ks + 1][3]);
                    Sb[ks] = __builtin_bit_cast(bf16x8, t4); }
                f32x4 Vn[4], Out[4];
#pragma unroll
                for (int mt = 0; mt < 4; ++mt) { f32x4 a1 = {0.f, 0.f, 0.f, 0.f}, a2 = {0.f, 0.f, 0.f, 0.f};
#pragma unroll
                    for (int ks = 0; ks < 4; ++ks) { const bf16x8 aw = *(const LAS bf16x8*)(lds + bo + SC_W + (16 * mt + m16) * 272 + ks * 64 + q * 16), aq = *(const LAS bf16x8*)(lds + bo + SC_QG + (16 * mt + m16) * 272 + ks * 64 + q * 16);
                        a1 = __builtin_amdgcn_mfma_f32_16x16x32_bf16(aw, Sb[ks], a1, 0, 0, 0); a2 = __builtin_amdgcn_mfma_f32_16x16x32_bf16(aq, Sb[ks], a2, 0, 0, 0); }
                    const u32x2 uu = uc[mt];
                    Vn[mt] = (f32x4){bflo(uu.x) - a1[0], bfhi(uu.x) - a1[1], bflo(uu.y) - a1[2], bfhi(uu.y) - a1[3]}; Out[mt] = a2; }
                bf16x8 Vb[2];
#pragma unroll
                for (int ks = 0; ks < 2; ++ks) { u32x4 t4; t4.x = pk2(Vn[2 * ks][0], Vn[2 * ks][1]); t4.y = pk2(Vn[2 * ks][2], Vn[2 * ks][3]); t4.z = pk2(Vn[2 * ks + 1][0], Vn[2 * ks + 1][1]); t4.w = pk2(Vn[2 * ks + 1][2], Vn[2 * ks + 1][3]);
                    Vb[ks] = __builtin_bit_cast(bf16x8, t4); }
#pragma unroll
                for (int mt = 0; mt < 4; ++mt)
#pragma unroll
                    for (int ks = 0; ks < 2; ++ks) { const bf16x8 aa = *(const LAS bf16x8*)(lds + bo + SC_AT + (16 * mt + m16) * 144 + ks * 64 + q * 16);
                        Out[mt] = __builtin_amdgcn_mfma_f32_16x16x32_bf16(aa, Vb[ks], Out[mt], 0, 0, 0); }
#pragma unroll
                for (int dt = 0; dt < 8; ++dt) { S[dt] = S[dt] * egl;
#pragma unroll
                    for (int ks = 0; ks < 2; ++ks) { const bf16x8 ak = *(const LAS bf16x8*)(lds + bo + SC_KG + (16 * dt + m16) * 144 + ks * 64 + q * 16);
                        S[dt] = __builtin_amdgcn_mfma_f32_16x16x32_bf16(ak, Vb[ks], S[dt], 0, 0, 0); } }
#pragma unroll
                for (int mt = 0; mt < 4; ++mt)
#pragma unroll
                    for (int e = 0; e < 4; ++e) *(LAS bf16_t*)(lds + SC_OS + (ch & 1) * 8192 + (16 * mt + 4 * q + e) * 128 + (16 * w + m16) * 2) = (bf16_t)(pk2(Out[mt][e], 0.f) & 0xffffu);
                LDS_BARRIER();
            }
            float* So = c.out + (grp ? O_SGDN + (size_t)((l * 32 + b) * 12 + h) * 16384 : O_PGDN + (size_t)((l * 4 + b) * 12 + h) * 16384);
#pragma unroll
            for (int dt = 0; dt < 8; ++dt)
#pragma unroll
                for (int i = 0; i < 4; ++i) So[(16 * dt + 4 * q + i) * 128 + c0 + m16] = S[dt][i];
            __builtin_amdgcn_s_setprio(0);
#undef UE_LOAD
        }
    }
}
#undef LDS_BARRIER
#define XB_TMO      128
#define XB_XCNT(j)  (256  + 64 * (j))
#define XB_XSUB(j)  (1280 + 64 * (j))
#define XB_XGEN(j)  (2304 + 64 * (j))
#define XB_TOP      3328
#define XB_TOPGEN   3392
#define XCD_BAR_WORDS 3456
#define XB_SPIN_CAP (1u << 18)

__device__ __forceinline__ unsigned xb_ld(unsigned* p)              { return __hip_atomic_load(p, __ATOMIC_RELAXED, __HIP_MEMORY_SCOPE_AGENT); }
__device__ __forceinline__ unsigned xb_add(unsigned* p, unsigned v) { return __hip_atomic_fetch_add(p, v, __ATOMIC_RELAXED, __HIP_MEMORY_SCOPE_AGENT); }
__device__ __forceinline__ unsigned xb_xcc_id() { return (unsigned)__builtin_amdgcn_s_getreg((3 << 11) | 20) & 0xFu; }
#define XB_SPIN(cond, bar) do { unsigned _sp = 0; while (cond) { __builtin_amdgcn_s_sleep(1); \
    if ((++_sp & 255u) == 0u) { if (xb_ld(&(bar)[XB_TMO])) break; if (_sp > XB_SPIN_CAP) { atomicAdd(&(bar)[XB_TMO], 1u); break; } } } } while (0)
struct XcdBarrier {
    unsigned* bar; unsigned x;
    volatile LAS unsigned* st;
};

__device__ __forceinline__ XcdBarrier xcd_barrier_post(unsigned* bar, volatile LAS unsigned* st) {
    XcdBarrier b; b.bar = bar; b.x = xb_xcc_id(); b.st = st;
    if (threadIdx.x == 0) (void)xb_add(&bar[XB_XCNT(b.x)], 1u);
    return b;
}
__device__ __forceinline__ void xcd_barrier_complete(unsigned* bar, unsigned x, unsigned& nloc, unsigned& nx) {
    const unsigned G = gridDim.x * gridDim.y * gridDim.z;
    unsigned sum, cnt, mine, sp = 0u;
    for (;;) {
        sum = 0u; cnt = 0u; mine = 0u;
#pragma unroll
        for (unsigned j = 0; j < 16; ++j) { const unsigned c = xb_ld(&bar[XB_XCNT(j)]); sum += c; cnt += (c > 0u) ? 1u : 0u; mine = (j == x) ? c : mine; }
        if (sum == G) break;
        __builtin_amdgcn_s_sleep(1);
        if ((++sp & 255u) == 0u) { if (xb_ld(&bar[XB_TMO])) break; if (sp > XB_SPIN_CAP) { atomicAdd(&bar[XB_TMO], 1u); break; } }
    }
    nloc = mine > 0u ? mine : 1u; nx = cnt > 0u ? cnt : 1u;
}

__device__ __forceinline__ void xcd_barrier(const XcdBarrier& b, const bool leader  ) {
    asm volatile("s_waitcnt vmcnt(0)" ::: "memory");
    __syncthreads();
    if (leader) {
        unsigned* bar = b.bar;
        __builtin_amdgcn_s_waitcnt(0);
        unsigned nloc = b.st[0], nx = b.st[1];
        if (nloc == 0u) { xcd_barrier_complete(bar, b.x, nloc, nx); b.st[0] = nloc; b.st[1] = nx; }
        const unsigned old = xb_add(&bar[XB_XSUB(b.x)], 1u);
        const unsigned gen = old / nloc;
        if (old + 1u == (gen + 1u) * nloc) {
            __builtin_amdgcn_fence(__ATOMIC_RELEASE, "agent");
            asm volatile("s_waitcnt vmcnt(0)" ::: "memory");
            const unsigned og = xb_add(&bar[XB_TOP], 1u);
            const unsigned tg = og / nx;
            if (og + 1u == (tg + 1u) * nx) xb_add(&bar[XB_TOPGEN], 1u);
            else XB_SPIN(xb_ld(&bar[XB_TOPGEN]) == tg, bar);
            __builtin_amdgcn_fence(__ATOMIC_ACQUIRE, "agent");
            xb_add(&bar[XB_XGEN(b.x)], 1u);
            asm volatile("s_waitcnt vmcnt(0)" ::: "memory");
        } else {
            XB_SPIN(xb_ld(&bar[XB_XGEN(b.x)]) == gen, bar);
            __builtin_amdgcn_fence(__ATOMIC_ACQUIRE, "agent");
            asm volatile("s_waitcnt vmcnt(0)" ::: "memory");
        }
    }
    __syncthreads();
}
namespace fa {
constexpr int NW = 8, QBLK = 32, KVBLK = 64, QB = NW * QBLK, HDm = 128;
constexpr int SHM_V = KVBLK * HDm * 2, SHM_K = KVBLK * HDm * 2;
constexpr int LDS_BYTES = 2 * SHM_V + 2 * SHM_K + NW * 64 * 4;
constexpr float THR = 8.f;
constexpr int XOFF = LDS_BYTES + 64, XBUF = 2048;
typedef short s16x4 __attribute__((ext_vector_type(4)));
#define KSWZ(row, colB) ((row) * 256 + ((colB) ^ (((row) & 7) << 4)))
#define SBAR() __builtin_amdgcn_sched_barrier(0)
__device__ __forceinline__ int v_st(int k, int c) { const int kk = (k & ~0xC) | ((k & 4) << 1) | ((k & 8) >> 1); return ((kk >> 3) * 4 + (c >> 5)) * 512 + ((kk & 7) * 32 + (c & 31)) * 2; }
__device__ __forceinline__ int v_rd_base(int lane) { return ((lane & 3) << 3) | (((lane >> 2) & 3) << 6) | (((lane >> 4) & 1) << 5) | (((lane >> 5) & 1) << 8); }
constexpr int v_rd_off(int d0, int ks, int half) { return d0 * 512 + ks * 4096 + half * 2048; }
__device__ __forceinline__ int crow(int r, int hi) { return (r & 3) + 8 * (r >> 2) + 4 * hi; }
__device__ __forceinline__ unsigned cvtpk(float lo, float hi) { unsigned r; asm volatile("v_cvt_pk_bf16_f32 %0, %1, %2" : "=v"(r) : "v"(lo), "v"(hi)); return r; }
__device__ __forceinline__ bf16x8 load8(const bf16_t* p) { return *reinterpret_cast<const bf16x8*>(p); }
__device__ __forceinline__ void mask_tile(f32x16& p0, f32x16& p1, int dq, unsigned W) {
    const float NEG = -__builtin_inff();
#pragma unroll
    for (int r = 0; r < 16; ++r) { const int c = (r & 3) + 8 * (r >> 2);
        if ((unsigned)(dq - c) >= W) p0[r] = NEG;
        if ((unsigned)(dq - c - 32) >= W) p1[r] = NEG; }
}
__device__ __forceinline__ void partialSM(f32x16& p0, f32x16& p1, float& m_reg, float& mn, float& alpha) {
    float pmax = p0[0]; for (int r = 1; r < 16; ++r) pmax = fmaxf(pmax, p0[r]); for (int r = 0; r < 16; ++r) pmax = fmaxf(pmax, p1[r]);
    { auto rr = __builtin_amdgcn_permlane32_swap(__float_as_uint(pmax), __float_as_uint(pmax), false, false);
      pmax = fmaxf(__uint_as_float(rr[0]), __uint_as_float(rr[1])); }
    constexpr float C2 = 1.4426950408889634f * SCALE;
    if (__builtin_expect(__all((pmax - m_reg) * SCALE <= THR), 1)) { mn = m_reg; alpha = 1.f; }
    else { mn = fmaxf(m_reg, pmax); alpha = __builtin_amdgcn_exp2f((m_reg - mn) * C2); m_reg = mn; }
    const float mnL = -mn * C2;
    for (int r = 0; r < 16; ++r) p0[r] = fmaf(p0[r], C2, mnL); for (int r = 0; r < 16; ++r) p1[r] = fmaf(p1[r], C2, mnL);
    for (int r = 0; r < 16; ++r) p0[r] = __builtin_amdgcn_exp2f(p0[r]);
}
__device__ __forceinline__ void finishSM(f32x16& p0, f32x16& p1, float alpha, float& l_reg, bf16x8& pa0, bf16x8& pa1, bf16x8& pa2, bf16x8& pa3) {
    for (int r = 0; r < 16; ++r) p1[r] = __builtin_amdgcn_exp2f(p1[r]);
    float ps = 0; for (int r = 0; r < 16; ++r) ps += p0[r]; for (int r = 0; r < 16; ++r) ps += p1[r];
    { auto rr = __builtin_amdgcn_permlane32_swap(__float_as_uint(ps), __float_as_uint(ps), false, false);
      ps = __uint_as_float(rr[0]) + __uint_as_float(rr[1]); }
    l_reg = l_reg * alpha + ps;
#define PK4(P, B_, OUT) do { unsigned a0 = cvtpk(P[B_+0], P[B_+1]), a1 = cvtpk(P[B_+2], P[B_+3]);                          \
        unsigned b0 = cvtpk(P[B_+4], P[B_+5]), b1 = cvtpk(P[B_+6], P[B_+7]);                                             \
        auto r0 = __builtin_amdgcn_permlane32_swap(a0, b0, false, false); auto r1 = __builtin_amdgcn_permlane32_swap(a1, b1, false, false); \
        u32x4 w = {r0[0], r1[0], r0[1], r1[1]}; OUT = *reinterpret_cast<bf16x8*>(&w); } while (0)
    PK4(p0, 0, pa0); PK4(p0, 8, pa1); PK4(p1, 0, pa2); PK4(p1, 8, pa3);
#undef PK4
}
template <int KB, bool BIAS>
__device__ __forceinline__ void qkt(f32x16& p0, f32x16& p1, const char* K_lds, const char* X_lds, int r32, int hi, const bf16x8* qr, bf16x8 qx) {
    p0 = f32x16{}; p1 = f32x16{};
    const char* kb[4];
#pragma unroll
    for (int dd = 0; dd < 4; ++dd) kb[dd] = K_lds + KB * SHM_K + KSWZ(r32, (dd * 16 + hi * 8) * 2);
    if (BIAS) { const bf16x8 kx0 = *reinterpret_cast<const bf16x8*>(X_lds + KB * XBUF + r32 * 32 + hi * 16), kx1 = *reinterpret_cast<const bf16x8*>(X_lds + KB * XBUF + (32 + r32) * 32 + hi * 16);
        p0 = __builtin_amdgcn_mfma_f32_32x32x16_bf16(kx0, qx, p0, 0, 0, 0); p1 = __builtin_amdgcn_mfma_f32_32x32x16_bf16(kx1, qx, p1, 0, 0, 0); }
#pragma unroll
    for (int d0 = 0; d0 < 8; ++d0) { const char* a = kb[d0 & 3] + (d0 >> 2) * 128;
        bf16x8 b0 = *reinterpret_cast<const bf16x8*>(a);
        bf16x8 b1 = *reinterpret_cast<const bf16x8*>(a + 32 * 256);
        p0 = __builtin_amdgcn_mfma_f32_32x32x16_bf16(b0, qr[d0], p0, 0, 0, 0);
        p1 = __builtin_amdgcn_mfma_f32_32x32x16_bf16(b1, qr[d0], p1, 0, 0, 0); }
}
template <int VB>
__device__ __forceinline__ void pv_tile(f32x16* o, int vb0, bf16x8 pa0, bf16x8 pa1, bf16x8 pa2, bf16x8 pa3) {
#define TRRD(dst, off) asm volatile("ds_read_b64_tr_b16 %0, %1 offset:%2" : "=&v"(dst) : "v"(vb0), "i"(off) : "memory")
#define PV_D0(d0) do { s16x4 l0, l1, l2, l3, h0, h1, h2, h3; constexpr int b_ = VB * SHM_V + v_rd_off(d0, 0, 0); \
        TRRD(l0, b_); TRRD(h0, b_ + 2048); TRRD(l1, b_ + 4096); TRRD(h1, b_ + 6144); TRRD(l2, b_ + 8192); TRRD(h2, b_ + 10240); TRRD(l3, b_ + 12288); TRRD(h3, b_ + 14336); \
        asm volatile("s_waitcnt lgkmcnt(0)" ::: "memory"); SBAR();   \
        o[d0] = __builtin_amdgcn_mfma_f32_32x32x16_bf16(pa0, (bf16x8){l0[0], l0[1], l0[2], l0[3], h0[0], h0[1], h0[2], h0[3]}, o[d0], 0, 0, 0);   \
        o[d0] = __builtin_amdgcn_mfma_f32_32x32x16_bf16(pa1, (bf16x8){l1[0], l1[1], l1[2], l1[3], h1[0], h1[1], h1[2], h1[3]}, o[d0], 0, 0, 0);   \
        o[d0] = __builtin_amdgcn_mfma_f32_32x32x16_bf16(pa2, (bf16x8){l2[0], l2[1], l2[2], l2[3], h2[0], h2[1], h2[2], h2[3]}, o[d0], 0, 0, 0);   \
        o[d0] = __builtin_amdgcn_mfma_f32_32x32x16_bf16(pa3, (bf16x8){l3[0], l3[1], l3[2], l3[3], h3[0], h3[1], h3[2], h3[3]}, o[d0], 0, 0, 0); } while (0)
    PV_D0(0); PV_D0(1); PV_D0(2); PV_D0(3);
#undef PV_D0
#undef TRRD
}
struct Ref { int a, b, c; };
struct Seam { bf16x8 qr[8]; bf16x8 qx; bf16x8 st_v0, st_v1, st_k0, st_k1, st_kx; };
__device__ __forceinline__ int swa_jlo(int P0, int W) { const int lowk = P0 - W + 1; return lowk > 0 ? lowk / KVBLK : 0; }
#define ROW(p, k0, rr) ((p) + (size_t)((k0) + (rr)) * KP + sc)
#define VMW() asm volatile("s_waitcnt vmcnt(0)" ::: "memory")
#define VMWN(n) asm volatile("s_waitcnt vmcnt(%0)" :: "i"(n) : "memory")
#define SLOAD_H(Kp, Vp, k0) do { S.st_v0 = load8(ROW(Vp, k0, sr)); S.st_v1 = load8(ROW(Vp, k0, 32 + sr)); S.st_k0 = load8(ROW(Kp, k0, sr)); S.st_k1 = load8(ROW(Kp, k0, 32 + sr)); } while (0)
#define LOADKX(KXp, k0) do { if (BIAS && tid < 64) S.st_kx = load8((KXp) + (size_t)((k0) + tid) * 8); } while (0)
#define SWRITE_HK(bf) do { *(bf16x8*)(K_lds + (bf) * SHM_K + kws) = S.st_k0; *(bf16x8*)(K_lds + (bf) * SHM_K + kws + 32 * 256) = S.st_k1; if (BIAS && tid < 64) *(bf16x8*)(lds + XOFF + (bf) * XBUF + tid * 32) = S.st_kx; } while (0)
#define SWRITE_HV(bf) do { *(bf16x8*)(V_lds + (bf) * SHM_V + vst0) = S.st_v0; *(bf16x8*)(V_lds + (bf) * SHM_V + vst1) = S.st_v1; } while (0)
#define SWRITE_H(bf) do { SWRITE_HV(bf); SWRITE_HK(bf); } while (0)
template <class Lay>
__device__ __forceinline__ void prime(unsigned char* wsb, const Ref& cur, int W, char* lds, Seam& S, int tid) {
    constexpr int QP = Lay::QP, KP = Lay::KP; constexpr bool BIAS = Lay::BIAS;
    const int wid = __builtin_amdgcn_readfirstlane(tid >> 6), lane = tid & 63, r32 = lane & 31, hi = lane >> 5;
    const int sr = tid >> 4, sc = (tid & 15) * 8, kws = KSWZ(sr, sc * 2); char* K_lds = lds + 2 * SHM_V;
    const int kb0 = swa_jlo(Lay::p0(cur), W) * KVBLK; const bf16_t* Qc = Lay::q(wsb, cur);
#pragma unroll
    for (int d0 = 0; d0 < 8; ++d0) S.qr[d0] = load8(Qc + (size_t)(wid * QBLK + r32) * QP + d0 * 16 + hi * 8);
    S.qx = bf16x8{}; S.st_kx = bf16x8{};
    if (BIAS && tid < 128) { unsigned zz = 0u; asm volatile("" : "+v"(zz)); *(u32x4*)(lds + XOFF + (tid >> 6) * XBUF + (tid & 63) * 32 + 16) = (u32x4){zz, zz, zz, zz}; }
    if (BIAS) S.qx = load8(hi ? Lay::z(wsb) : Lay::qx(wsb, cur) + (size_t)(wid * QBLK + r32) * 8);
    { const bf16_t* Kc = Lay::k(wsb, cur); const bf16_t* Vc = Lay::v(wsb, cur); SLOAD_H(Kc, Vc, kb0); LOADKX(Lay::kx(wsb, cur), kb0); } VMW(); SWRITE_HK(0);
    __syncthreads();
}
template <class Lay>
__device__ __forceinline__ void block(unsigned char* wsb, const Ref& cur, const Ref& nxt, int skv, int W, char* lds, Seam& S, int tid) {
    asm volatile("" : "+v"(tid));
    constexpr int QP = Lay::QP, KP = Lay::KP, OP = Lay::OP; constexpr bool BIAS = Lay::BIAS, GATE = Lay::GATE; const int P0c = Lay::p0(cur);
    const int wid = __builtin_amdgcn_readfirstlane(tid >> 6), lane = tid & 63, r32 = lane & 31, hi = lane >> 5;
    const int j_lo = swa_jlo(P0c, W);
    int j_hi = (P0c + QB - 1) / KVBLK + 1; if (j_hi > skv / KVBLK) j_hi = skv / KVBLK;
    const int NT = j_hi - j_lo;
    const int kbn = swa_jlo(Lay::p0(nxt), W) * KVBLK;
    const int qlo = P0c + wid * QBLK, qm = qlo + r32 - 4 * hi;
    char* V_lds = lds; char* K_lds = lds + 2 * SHM_V;
    float* ws = (float*)(lds + 2 * SHM_V + 2 * SHM_K) + wid * 64; float* li_l = ws, * al_l = ws + 32;
    float m_reg = -1e30f, l_reg = 0; f32x16 o[4] = {};
    const int sr = tid >> 4, sc = (tid & 15) * 8, vst0 = v_st(sr, sc), vst1 = v_st(32 + sr, sc), kws = KSWZ(sr, sc * 2);
    const int vb0 = (int)(uintptr_t)V_lds + v_rd_base(lane);
    const bf16_t* Kh = Lay::k(wsb, cur); const bf16_t* Vh = Lay::v(wsb, cur); const bf16_t* KXh = Lay::kx(wsb, cur);
    const char* X_lds = lds + XOFF;
#define RESC(a) do { if (__any((a) < 1.f)) { if (hi == 0) al_l[r32] = (a); asm volatile("s_waitcnt lgkmcnt(0)" ::: "memory");              \
                     for (int d_ = 0; d_ < 4; ++d_) for (int r = 0; r < 16; ++r) o[d_][r] *= al_l[crow(r, hi)]; } } while (0)
#define KBASE(t) ((j_lo + (t)) * KVBLK)
#define MASKT(P0_, P1_, t) do { const int kb_ = KBASE(t); if (kb_ + KVBLK - 1 > qlo || kb_ <= qlo + QBLK - 1 - W) mask_tile(P0_, P1_, qm - kb_, (unsigned)W); } while (0)
    constexpr int NQL = BIAS ? 9 : 8;
#define SEAM_K0() do { VMWN(NQL); SWRITE_HK(0); SBAR(); } while (0)
    f32x16 pA0, pA1, pB0, pB1; float mnA, mnB, alA, alB; bf16x8 pa0, pa1, pa2, pa3;
    SWRITE_HV(0); SBAR();
    if (NT > 1) { SLOAD_H(Kh, Vh, KBASE(1)); LOADKX(KXh, KBASE(1)); }
    SBAR(); qkt<0, BIAS>(pA0, pA1, K_lds, X_lds, r32, hi, S.qr, S.qx);
    MASKT(pA0, pA1, 0); partialSM(pA0, pA1, m_reg, mnA, alA);
    if (NT > 1) { VMW(); SWRITE_H(1); }
    __syncthreads();
#define HALF_STEP(PX0, PX1, mnX, alX, PY0, PY1, alY, t, KB, VB, SB) do {                                                      \
        SBAR(); qkt<KB, BIAS>(PX0, PX1, K_lds, X_lds, r32, hi, S.qr, S.qx);                                             \
        finishSM(PY0, PY1, alY, l_reg, pa0, pa1, pa2, pa3); SBAR();                                                           \
        if ((t) + 1 < NT) { SLOAD_H(Kh, Vh, KBASE((t) + 1)); LOADKX(KXh, KBASE((t) + 1)); SBAR(); }               \
        pv_tile<VB>(o, vb0, pa0, pa1, pa2, pa3); MASKT(PX0, PX1, (t)); partialSM(PX0, PX1, m_reg, mnX, alX);                  \
        __syncthreads();                                                                                                      \
        if ((t) + 1 < NT) { VMW(); SWRITE_H(SB); }                                                                            \
        RESC(alX); __syncthreads(); } while (0)
    for (int t = 1; t + 1 < NT; t += 2) {
        HALF_STEP(pB0, pB1, mnB, alB, pA0, pA1, alA, t, 1, 0, 0);
        HALF_STEP(pA0, pA1, mnA, alA, pB0, pB1, alB, t + 1, 0, 1, 1);
    }
    const bool even = (NT & 1) == 0;
    if (even) { SBAR(); qkt<1, BIAS>(pB0, pB1, K_lds, X_lds, r32, hi, S.qr, S.qx); SBAR(); }
    { const bf16_t* Kn = Lay::k(wsb, nxt); const bf16_t* Vn = Lay::v(wsb, nxt); SLOAD_H(Kn, Vn, kbn); LOADKX(Lay::kx(wsb, nxt), kbn); } SBAR();
    { const bf16_t* Qn = Lay::q(wsb, nxt);
#pragma unroll
    for (int d0 = 0; d0 < 8; ++d0) S.qr[d0] = load8(Qn + (size_t)(wid * QBLK + r32) * QP + d0 * 16 + hi * 8); }
    if (BIAS) S.qx = load8(hi ? Lay::z(wsb) : Lay::qx(wsb, nxt) + (size_t)(wid * QBLK + r32) * 8);
    SBAR();
    finishSM(pA0, pA1, alA, l_reg, pa0, pa1, pa2, pa3); SBAR();
    pv_tile<0>(o, vb0, pa0, pa1, pa2, pa3);
    if (even) { MASKT(pB0, pB1, NT - 1); partialSM(pB0, pB1, m_reg, mnB, alB); __syncthreads(); RESC(alB);
        finishSM(pB0, pB1, alB, l_reg, pa0, pa1, pa2, pa3); SBAR(); pv_tile<1>(o, vb0, pa0, pa1, pa2, pa3); }
    SBAR(); SEAM_K0();
    if (hi == 0) li_l[r32] = l_reg; asm volatile("s_waitcnt lgkmcnt(0)" ::: "memory");
    float rli[16];
#pragma unroll
    for (int r = 0; r < 16; ++r) rli[r] = __builtin_amdgcn_rcpf(li_l[crow(r, hi)]);
    bf16_t* Ow = Lay::o(wsb, cur) + (size_t)(wid * QBLK) * OP; const bf16_t* Gw = Lay::g(wsb, cur) + (size_t)(wid * QBLK) * QP;
#pragma unroll
    for (int r = 0; r < 16; ++r) { const int orow = crow(r, hi);
#pragma unroll
        for (int d0 = 0; d0 < 4; ++d0) { const float v = o[d0][r] * rli[r];
            const float vn = lane_get(v, lane ^ 1);
            if ((r32 & 1) == 0) { float a = v, b = vn;
                if (GATE) { const unsigned gu = *(const unsigned*)(Gw + (size_t)orow * QP + d0 * 32 + r32); a *= fast_sigmoid(bflo(gu)); b *= fast_sigmoid(bfhi(gu)); }
                *(unsigned*)(Ow + (size_t)orow * OP + d0 * 32 + r32) = cvtpk(a, b); } } }
    __syncthreads();
#undef RESC
#undef KBASE
#undef MASKT
#undef SEAM_K0
#undef HALF_STEP
}
#undef ROW
#undef VMW
#undef VMWN
#undef SLOAD_H
#undef LOADKX
#undef SWRITE_HK
#undef SWRITE_HV
#undef SWRITE_H
#undef KSWZ
#undef SBAR
}
struct LayFox {
    static constexpr int QP = PJ, KP = TOK, OP = D; static constexpr bool BIAS = true, GATE = false;
    static __device__ __forceinline__ size_t row0(const fa::Ref& r) { return (size_t)(r.a / 12) * 4096 + r.b * 256; }
    static __device__ __forceinline__ int p0(const fa::Ref& r) { return r.b * 256; }
    static __device__ __forceinline__ const bf16_t* q(unsigned char* ws, const fa::Ref& r) { return (const bf16_t*)(ws + WS_PROJ) + row0(r) * PJ + (r.a % 12) * HD; }
    static __device__ __forceinline__ const bf16_t* g(unsigned char* ws, const fa::Ref& r) { return q(ws, r) + TOK; }
    static __device__ __forceinline__ const bf16_t* k(unsigned char* ws, const fa::Ref& r) { return (const bf16_t*)(ws + WS_KB) + (size_t)(r.a / 12) * 4096 * TOK + (r.a % 12) * HD; }
    static __device__ __forceinline__ const bf16_t* v(unsigned char* ws, const fa::Ref& r) { return (const bf16_t*)(ws + WS_VB) + (size_t)(r.a / 12) * 4096 * TOK + (r.a % 12) * HD; }
    static __device__ __forceinline__ bf16_t* o(unsigned char* ws, const fa::Ref& r) { return (bf16_t*)(ws + WS_ACT) + row0(r) * D + (r.a % 12) * HD; }
    static __device__ __forceinline__ const bf16_t* qx(unsigned char* ws, const fa::Ref& r) { return (const bf16_t*)(ws + WS_QX) + ((size_t)r.a * 4096 + r.b * 256) * 8; }
    static __device__ __forceinline__ const bf16_t* kx(unsigned char* ws, const fa::Ref& r) { return (const bf16_t*)(ws + WS_KX) + (size_t)r.a * 4096 * 8; }
    static __device__ __forceinline__ const bf16_t* z(unsigned char* ws) { return (const bf16_t*)(ws + WS_CTL + CTL_ZROW); }
};
__device__ __forceinline__ void fox_gate_block(unsigned char* ws, const fa::Ref& r, int tid) {
    asm volatile("s_waitcnt vmcnt(0)" ::: "memory"); __syncthreads();
    asm volatile("" : "+v"(tid));
    bf16_t* O = LayFox::o(ws, r); const bf16_t* G = LayFox::g(ws, r);
#pragma unroll
    for (int k = 0; k < 8; ++k) { const int u = tid + 512 * k, row = u >> 4, cu = (u & 15) * 8;
        const u32x4 ov = *(const u32x4*)(O + (size_t)row * D + cu), gv = __builtin_nontemporal_load((const u32x4*)(G + (size_t)row * PJ + cu)); u32x4 w;
        w.x = pk2(bflo(ov.x) * fast_sigmoid(bflo(gv.x)), bfhi(ov.x) * fast_sigmoid(bfhi(gv.x))); w.y = pk2(bflo(ov.y) * fast_sigmoid(bflo(gv.y)), bfhi(ov.y) * fast_sigmoid(bfhi(gv.y)));
        w.z = pk2(bflo(ov.z) * fast_sigmoid(bflo(gv.z)), bfhi(ov.z) * fast_sigmoid(bfhi(gv.z))); w.w = pk2(bflo(ov.w) * fast_sigmoid(bflo(gv.w)), bfhi(ov.w) * fast_sigmoid(bfhi(gv.w)));
        *(u32x4*)(O + (size_t)row * D + cu) = w; }
}
__device__ __forceinline__ void ph_fox_prompt(CtxP cp, int l, char* ldsg, LAS unsigned char* lds) {
    CTX_LOAD(cp);
    const int tid = otid();
    unsigned* qheads = (unsigned*)(c.ws + WS_CTL + CTL_QFOX) + 64 * 8 * l;
    LAS int* slot = (LAS int*)(lds + fa::LDS_BYTES);
    if (tid == 0) { slot[2] = (int)(xb_xcc_id() & 7u); slot[3] = 8; }
#define FOX_FETCH(dst, k) do { if (tid == 0) { int r_ = -1, myq_ = slot[2], qleft_ = slot[3]; while (qleft_ > 0) { const int i_ = (int)__hip_atomic_fetch_add(qheads + 64 * myq_, 1u, __ATOMIC_RELAXED, __HIP_MEMORY_SCOPE_AGENT); \
                if (i_ < 96) { r_ = ((i_ % 6) * 8 + myq_) * 16 + (15 - i_ / 6); break; } myq_ = (myq_ + 1) & 7; --qleft_; } slot[k] = r_; slot[2] = myq_; slot[3] = qleft_; } \
            __syncthreads(); dst = __builtin_amdgcn_readfirstlane(slot[k]); } while (0)
    int idx; FOX_FETCH(idx, 0);
    if (idx >= 0) {
        fa::Ref cur{idx >> 4, idx & 15, 0}, nxt; fa::Seam S;
        fa::prime<LayFox>(c.ws, cur, 1 << 29, ldsg, S, tid);
        for (int k = 1;; k ^= 1) {
            int nidx; FOX_FETCH(nidx, k);
            const bool more = nidx >= 0;
            if (more) nxt = fa::Ref{nidx >> 4, nidx & 15, 0}; else nxt = cur;
            fa::block<LayFox>(c.ws, cur, nxt, 4096, 1 << 29, ldsg, S, tid);
            fox_gate_block(c.ws, cur, tid);
            if (!more) break;
            cur = nxt;
        }
    }
#undef FOX_FETCH
}
struct LayMem {
    static constexpr int QP = PJ, KP = 4096, OP = D; static constexpr bool BIAS = false, GATE = false;
    static __device__ __forceinline__ size_t row0(const fa::Ref& r) { return (size_t)(r.a >> 2) * 4096 + r.b * 256; }
    static __device__ __forceinline__ int p0(const fa::Ref&) { return 256; }
    static __device__ __forceinline__ const bf16_t* q(unsigned char* ws, const fa::Ref& r) { return (const bf16_t*)(ws + WS_PROJ) + row0(r) * PJ + (r.c < 2 ? 6144 : 3072) + (r.a & 3) * HD; }
    static __device__ __forceinline__ const bf16_t* g(unsigned char* ws, const fa::Ref& r) { return q(ws, r); }
    static __device__ __forceinline__ const bf16_t* k(unsigned char* ws, const fa::Ref& r) { return (const bf16_t*)(ws + WS_MEMKVB) + (size_t)(r.a >> 2) * 256 * 4096 + r.c * 1024 + (r.a & 3) * HD; }
    static __device__ __forceinline__ const bf16_t* v(unsigned char* ws, const fa::Ref& r) { return k(ws, r) + 512; }
    static __device__ __forceinline__ bf16_t* o(unsigned char* ws, const fa::Ref& r) { return (bf16_t*)(ws + WS_ACT) + row0(r) * D + TOK + (r.a & 3) * HD; }
    static __device__ __forceinline__ const bf16_t* qx(unsigned char* ws, const fa::Ref& r) { return nullptr; }
    static __device__ __forceinline__ const bf16_t* kx(unsigned char* ws, const fa::Ref& r) { return nullptr; }
    static __device__ __forceinline__ const bf16_t* z(unsigned char* ws) { return nullptr; }
};
__device__ __forceinline__ void ph_mem_prompt(CtxP cp, int l, char* ldsg, int wg0, int nwg) {
    CTX_LOAD(cp);
    const int tid = otid(), bid_ = obid() - wg0, grid_ = nwg;
    int idx = bid_;
    if (idx >= 0 && idx < 256) {
        fa::Ref cur{idx >> 4, idx & 15, l}, nxt; fa::Seam S;
        fa::prime<LayMem>(c.ws, cur, 1 << 29, ldsg, S, tid);
        for (;;) {
            const int nidx = idx + grid_; const bool more = nidx < 256;
            if (more) nxt = fa::Ref{nidx >> 4, nidx & 15, l}; else nxt = cur;
            fa::block<LayMem>(c.ws, cur, nxt, 256, 1 << 29, ldsg, S, tid);
            if (!more) break;
            cur = nxt; idx = nidx;
        }
    }
}
constexpr int SF_REG = 16384, SF_AUX = 8 * SF_REG, SF_Q = SF_AUX + 8 * 512, SF_LDS = SF_Q + 32 * 272;
template <bool FOX>
__device__ __forceinline__ void ph_attn_sample(CtxP cp, int l, LAS unsigned char* lds, int wg0, int nwg) {
    CTX_LOAD(cp);
    const int bid_ = obid() - wg0, grid_ = nwg; const int tid0 = otid();
    if (bid_ < 0) return;
    constexpr int NH = FOX ? 12 : 4, NTASKS = 32 * NH, NTILE = FOX ? 65 : 8, KP = FOX ? TOK : MEMD, NPAST = FOX ? PAST : NMEM;
    constexpr float LOG2E = 1.4426950408889634f, C2 = LOG2E * SCALE;
    for (int task = bid_; task < NTASKS; task += grid_) {
        int tid = tid0; asm volatile("" : "+v"(tid));
        const int lane = tid & 63, w = __builtin_amdgcn_readfirstlane(tid >> 6), r32 = lane & 31, hi = lane >> 5;
        const int b = task / NH, h = task % NH;
        LAS unsigned char* T = lds + w * SF_REG; LAS float* aux = (LAS float*)(lds + SF_AUX + w * 512);
        const float* CUM = WS_PTR(float, WS_CUMS) + (size_t)b * (PAST + 32) * 12 + h;
        const float* Kc = (FOX ? c.in[I_CK] : c.in[I_CMK] + (size_t)l * 32 * NMEM * MEMD) + (size_t)b * NPAST * KP + h * HD; const float* Vc = (FOX ? c.in[I_CV] : c.in[I_CMV] + (size_t)l * 32 * NMEM * MEMD) + (size_t)b * NPAST * KP + h * HD;
        const int qcol = FOX ? h * HD : ((l < 2) ? 6144 : 3072) + h * HD, ocol = FOX ? h * HD : TOK + h * HD;
        float cq2 = 0.f; if (FOX) cq2 = CUM[(size_t)(PAST + r32) * 12] * LOG2E;
        float m_run = -1e30f, l_run = 0.f; f32x16 o[4] = {};
        f32x4 st[16];
        const int lrow = lane >> 5, lcol = (lane & 31) * 4;
        const unsigned voff = (unsigned)(lrow * KP + lcol) * 4u;
#define SF_LOAD(P, j0) do { const char* p_ = (const char*)((P) + (size_t)(j0) * KP);     \
        _Pragma("unroll") for (int i = 0; i < 16; ++i) st[i] = __builtin_nontemporal_load((const f32x4*)(p_ + (size_t)(2 * i) * KP * 4 + voff)); } while (0)
        __syncthreads();
        *(LAS u32x4*)(lds + SF_Q + (tid >> 4) * 272 + (tid & 15) * 16) = *(const u32x4*)(WS_PTR(bf16_t, WS_PROJ) + (size_t)(MP + b * 32 + (tid >> 4)) * PJ + qcol + (tid & 15) * 8);
        int t = w; SF_LOAD(Kc, 32 * t);
        __syncthreads();
        for (; t < NTILE; t += 8) { const bool isnew = FOX && (t == 64); const int j0 = 32 * t;
            if (!isnew) {
#pragma unroll
                for (int i = 0; i < 16; ++i) { u32x2 v2; v2.x = pk2(st[i].x, st[i].y); v2.y = pk2(st[i].z, st[i].w); *(LAS u32x2*)(T + (2 * i + lrow) * 272 + lcol * 2) = v2; }
                SF_LOAD(Vc, j0); }
            else { const char* kp = (const char*)(WS_PTR(bf16_t, WS_KB) + (size_t)(MP + b * 32) * TOK + h * HD);
                int ln = lane; asm volatile("" : "+v"(ln)); const int rw0 = ln >> 4, cc = (ln & 15) * 8; const unsigned vo = (unsigned)(rw0 * TOK + cc) * 2u;
#pragma unroll
                for (int i = 0; i < 8; ++i) *(LAS u32x4*)(T + (4 * i + rw0) * 272 + cc * 2) = *(const u32x4*)(kp + (size_t)(4 * i) * TOK * 2 + vo); }
            if (lane < 32) aux[lane] = FOX ? CUM[(size_t)(j0 + lane) * 12] * LOG2E : 0.f;
            f32x16 p = {};
#pragma unroll
            for (int d0 = 0; d0 < 8; ++d0) p = __builtin_amdgcn_mfma_f32_32x32x16_bf16(*(const LAS bf16x8*)(T + r32 * 272 + d0 * 32 + hi * 16), *(const LAS bf16x8*)(lds + SF_Q + r32 * 272 + d0 * 32 + hi * 16), p, 0, 0, 0);
            float pmax = -__builtin_inff();
#pragma unroll
            for (int g = 0; g < 4; ++g) { const f32x4 ck = *(const LAS f32x4*)(aux + 8 * g + 4 * hi);
#pragma unroll
                for (int e = 0; e < 4; ++e) { const int rr = 4 * g + e; float s = fmaf(p[rr], C2, cq2 - ck[e]);
                    if (isnew && (8 * g + 4 * hi + e) > r32) s = -__builtin_inff();
                    p[rr] = s; pmax = fmaxf(pmax, s); } }
            pmax = fmaxf(pmax, lane_get(pmax, lane ^ 32));
            const float mn = fmaxf(m_run, pmax), alpha = __builtin_amdgcn_exp2f(m_run - mn); m_run = mn;
            float ps = 0.f;
#pragma unroll
            for (int rr = 0; rr < 16; ++rr) { p[rr] = __builtin_amdgcn_exp2f(p[rr] - mn); ps += p[rr]; }
            ps += lane_get(ps, lane ^ 32); l_run = l_run * alpha + ps;
            bf16x8 pa0, pa1;
#define PK4(P, B_, OUT) do { unsigned a0 = pk2(P[B_+0], P[B_+1]), a1 = pk2(P[B_+2], P[B_+3]); unsigned b0 = pk2(P[B_+4], P[B_+5]), b1 = pk2(P[B_+6], P[B_+7]); \
            auto r0 = __builtin_amdgcn_permlane32_swap(a0, b0, false, false); auto r1 = __builtin_amdgcn_permlane32_swap(a1, b1, false, false); \
            u32x4 w4 = {r0[0], r1[0], r0[1], r1[1]}; OUT = __builtin_bit_cast(bf16x8, w4); } while (0)
            PK4(p, 0, pa0); PK4(p, 8, pa1);
#undef PK4
            if (hi == 0) aux[32 + r32] = alpha;
            if (!isnew) {
#pragma unroll
                for (int i = 0; i < 16; ++i) { const int key = 2 * i + lrow;
                    *(LAS bf16_t*)(T + (lcol + 0) * 80 + key * 2) = (bf16_t)(pk2(st[i].x, 0.f) & 0xffffu); *(LAS bf16_t*)(T + (lcol + 1) * 80 + key * 2) = (bf16_t)(pk2(st[i].y, 0.f) & 0xffffu);
                    *(LAS bf16_t*)(T + (lcol + 2) * 80 + key * 2) = (bf16_t)(pk2(st[i].z, 0.f) & 0xffffu); *(LAS bf16_t*)(T + (lcol + 3) * 80 + key * 2) = (bf16_t)(pk2(st[i].w, 0.f) & 0xffffu); }
                if (FOX && t + 8 < 64) SF_LOAD(Kc, j0 + 256); }
            else { const char* vp = (const char*)(WS_PTR(bf16_t, WS_VB) + (size_t)(MP + b * 32) * TOK + h * HD);
                int ln = lane; asm volatile("" : "+v"(ln)); const int rw0 = ln >> 4, cc = (ln & 15) * 8; const unsigned vo = (unsigned)(rw0 * TOK + cc) * 2u;
#pragma unroll
                for (int i = 0; i < 8; ++i) { const int rw = 4 * i + rw0; const u32x4 v4 = *(const u32x4*)(vp + (size_t)(4 * i) * TOK * 2 + vo);
                    *(LAS bf16_t*)(T + (cc + 0) * 80 + rw * 2) = (bf16_t)(v4.x & 0xffffu); *(LAS bf16_t*)(T + (cc + 1) * 80 + rw * 2) = (bf16_t)(v4.x >> 16);
                    *(LAS bf16_t*)(T + (cc + 2) * 80 + rw * 2) = (bf16_t)(v4.y & 0xffffu); *(LAS bf16_t*)(T + (cc + 3) * 80 + rw * 2) = (bf16_t)(v4.y >> 16);
                    *(LAS bf16_t*)(T + (cc + 4) * 80 + rw * 2) = (bf16_t)(v4.z & 0xffffu); *(LAS bf16_t*)(T + (cc + 5) * 80 + rw * 2) = (bf16_t)(v4.z >> 16);
                    *(LAS bf16_t*)(T + (cc + 6) * 80 + rw * 2) = (bf16_t)(v4.w & 0xffffu); *(LAS bf16_t*)(T + (cc + 7) * 80 + rw * 2) = (bf16_t)(v4.w >> 16); } }
            if (__any(alpha < 1.f)) {
#pragma unroll
                for (int g = 0; g < 4; ++g) { const f32x4 al = *(const LAS f32x4*)(aux + 32 + 8 * g + 4 * hi);
#pragma unroll
                    for (int e = 0; e < 4; ++e)
#pragma unroll
                        for (int db = 0; db < 4; ++db) o[db][4 * g + e] *= al[e]; } }
#pragma unroll
            for (int db = 0; db < 4; ++db) {
                o[db] = __builtin_amdgcn_mfma_f32_32x32x16_bf16(pa0, *(const LAS bf16x8*)(T + (db * 32 + r32) * 80 + hi * 16), o[db], 0, 0, 0);
                o[db] = __builtin_amdgcn_mfma_f32_32x32x16_bf16(pa1, *(const LAS bf16x8*)(T + (db * 32 + r32) * 80 + 32 + hi * 16), o[db], 0, 0, 0); }
        }
        asm volatile("s_waitcnt lgkmcnt(0)" ::: "memory");
#pragma unroll
        for (int db = 0; db < 4; ++db)
#pragma unroll
            for (int rr = 0; rr < 16; ++rr) *(LAS float*)(T + crow32(rr, hi) * 512 + (db * 32 + r32) * 4) = o[db][rr];
        if (hi == 0) { aux[64 + r32] = m_run; aux[96 + r32] = l_run; }
        __syncthreads();
        { const int qy = tid >> 4, d0 = (tid & 15) * 8; float M = -1e30f;
#pragma unroll
            for (int ww = 0; ww < 8; ++ww) M = fmaxf(M, *(const LAS float*)(lds + SF_AUX + ww * 512 + (64 + qy) * 4));
            float num[8] = {0.f, 0.f, 0.f, 0.f, 0.f, 0.f, 0.f, 0.f}, den = 0.f;
#pragma unroll
            for (int ww = 0; ww < 8; ++ww) { const float e = __builtin_amdgcn_exp2f(*(const LAS float*)(lds + SF_AUX + ww * 512 + (64 + qy) * 4) - M); den += e * *(const LAS float*)(lds + SF_AUX + ww * 512 + (96 + qy) * 4);
                const f32x4 a = *(const LAS f32x4*)(lds + ww * SF_REG + qy * 512 + d0 * 4), bq = *(const LAS f32x4*)(lds + ww * SF_REG + qy * 512 + d0 * 4 + 16);
                num[0] += e * a.x; num[1] += e * a.y; num[2] += e * a.z; num[3] += e * a.w; num[4] += e * bq.x; num[5] += e * bq.y; num[6] += e * bq.z; num[7] += e * bq.w; }
            const float inv = 1.f / den; const size_t row = (size_t)(MP + b * 32 + qy);
            u32x4 gv = {0x7f007f00u, 0x7f007f00u, 0x7f007f00u, 0x7f007f00u};
            if (FOX) gv = *(const u32x4*)(WS_PTR(bf16_t, WS_PROJ) + row * PJ + TOK + h * HD + d0);
            u32x4 ov;
            ov.x = pk2(num[0] * inv * fast_sigmoid(bflo(gv.x)), num[1] * inv * fast_sigmoid(bfhi(gv.x))); ov.y = pk2(num[2] * inv * fast_sigmoid(bflo(gv.y)), num[3] * inv * fast_sigmoid(bfhi(gv.y)));
            ov.z = pk2(num[4] * inv * fast_sigmoid(bflo(gv.z)), num[5] * inv * fast_sigmoid(bfhi(gv.z))); ov.w = pk2(num[6] * inv * fast_sigmoid(bflo(gv.w)), num[7] * inv * fast_sigmoid(bfhi(gv.w)));
            *(u32x4*)(WS_PTR(bf16_t, WS_ACT) + row * D + ocol + d0) = ov; }
#undef SF_LOAD
    }
}
constexpr int GEMM_LDS = pg8::STAGE_BYTES;
constexpr int LDS_BAR = 147456 - 256, LDS_BYTES = 147456;
static_assert(SF_LDS <= LDS_BAR && GEMM_LDS <= LDS_BAR, "LDS map");
constexpr size_t CTL_ZERO_BYTES = 65536;
__device__ __forceinline__ void ph_gemm(CtxP cp, int which, int l, LAS unsigned char* lds) {
    CTX_LOAD(cp);
    const bf16_t* A = WS_PTR(bf16_t, WS_XN); const bf16_t* Bt; int Mg = M, N, K = D, mode; bf16_t* o16 = nullptr; int ld16 = 0; float* o32 = nullptr; int ld32 = 0;
    if (which == 0) { A = WS_PTR(bf16_t, WS_MEMN); Bt = WS_PTR(bf16_t, WS_WMEM); Mg = 1024; N = 4096; mode = 4; }
    else if (which == 1) { Bt = (l < 2) ? WS_PTR(bf16_t, WS_WINA) + (size_t)l * 6656 * D : (l == 2 ? WS_PTR(bf16_t, WS_WINB0) : WS_PTR(bf16_t, WS_WINB1)); N = (l == 3) ? 3584 : 6656;
        mode = (l == 2) ? 3 : 0; o16 = WS_PTR(bf16_t, WS_PROJ); ld16 = PJ; }
    else if (which == 2) { A = WS_PTR(bf16_t, WS_ACT); Bt = WS_PTR(bf16_t, WS_WO) + (size_t)l * D * D; N = D; mode = 2; o16 = WS_PTR(bf16_t, WS_DELTA); ld16 = D; }
    else if (which == 3) { Bt = WS_PTR(bf16_t, WS_WUP) + (size_t)l * DFF * D; N = DFF; mode = 1; o16 = WS_PTR(bf16_t, WS_UP); ld16 = DFF; }
    else { A = WS_PTR(bf16_t, WS_UP); Bt = WS_PTR(bf16_t, WS_WDN) + (size_t)l * D * DFF; N = D; K = DFF; mode = 2; o16 = WS_PTR(bf16_t, WS_DELTA); ld16 = D; }
    const pg8::Gemm g{A, Bt, Mg, N, K};
    const pg8::Epi E{mode, o16, ld16, o32, ld32, c.ws, c.out, K / pg8::BK, (which == 1) ? (l < 2 ? 4608 : 0) : -1};
    pg8::TailSplit S; if (which == 0) S.init(g.M, g.N, g.K, 64, obid() - (ogrid() - 64), 0); else S.init(g.M, g.N, g.K, ogrid(), obid(), (which == 2 || which == 4) ? 1 : 0);
    pg8::gemm_phase<pg8::Epi, pg8::TailSplit, true, true>(lds, g, S, E, otid());
}
__global__ void __launch_bounds__(512, 2) fwd(Ctx carg) {
    CtxP c = (CtxP)((unsigned long long)__builtin_amdgcn_kernarg_segment_ptr() | (unsigned long long)__builtin_amdgcn_readfirstlane((int)(threadIdx.x >> 6)));
    extern __shared__ __attribute__((aligned(16))) unsigned char lds_raw[];
    LAS unsigned char* lds = (LAS unsigned char*)lds_raw;
    if (threadIdx.x < 4) ((LAS unsigned*)(lds + LDS_BAR))[threadIdx.x] = 0u;
    __syncthreads();
    const XcdBarrier bar = xcd_barrier_post((unsigned*)(((CtxP)((unsigned long long)c & ~7ull))->ws + WS_CTL), (volatile LAS unsigned*)(lds + LDS_BAR));
#define BAR() do { XcdBarrier b2_; b2_.bar = (unsigned*)(((CtxP)((unsigned long long)c & ~7ull))->ws + WS_CTL); b2_.st = bar.st; unsigned bx_ = bar.x; asm volatile("" : "+s"(bx_)); b2_.x = bx_; xcd_barrier(b2_, otid_cp(c) == 0); } while (0)
    ph_prep(c, lds, 0x3u | (0xfu << 19), 0, (int)gridDim.x, 1); ph_row2(c, 2, 0, 0, 0, 0); BAR();
    ph_row2(c, 1, 0, 0, 0, 0, 0, 0, (int)gridDim.x - 64); ph_gemm(c, 0, 0, lds); BAR();
    const bool upt = (gridDim.x == 256);
    for (int l = 0; l < 4; ++l) {
        if (l < 2) ph_skinny(c, l, lds);
        else if (l == 2) { ph_skinny(c, 2, lds); BAR(); ph_cumsum(c); }
        ph_gemm(c, 1, l, lds); BAR();
        if (l < 2) { ph_gdn_prep(c, l, lds); BAR(); ph_gdn_scan(c, l, lds);
            ph_prep(c, lds, (l == 0 ? (JOBS_L1 | (1u << 7) | (1u << 11) | (1u << 15)) : (JOBS_L2 | JOBS_L3)) & ~(upt ? (7u << 12) : 0u), 96, (int)gridDim.x - 96, 0);
            BAR(); ph_gdn_c(c, l); }
        if (l >= 2) { ph_attn_sample<true>(c, l, lds, 0, (int)gridDim.x); __syncthreads(); }
        ph_mem_prompt(c, l, (char*)lds_raw, 0, (int)gridDim.x); ph_attn_sample<false>(c, l, lds, 0, (int)gridDim.x);
        if (l >= 2) { __syncthreads(); ph_fox_prompt(c, l, (char*)lds_raw, lds); }
        BAR();
        ph_gemm(c, 2, l, lds); BAR();
        ph_row2(c, 0, 1, I_NMIXPOST, l, 0, l == 0); BAR();
        ph_gemm(c, 3, l, lds); if (upt && l < 3) ph_prep(c, lds, 1u << (12 + l), 128, 128, 0); BAR();
        ph_gemm(c, 4, l, lds); BAR();
        ph_row2(c, 0, 1, I_NMLPPOST, l, l == 3);
        if (l < 3) BAR();
    }
#undef BAR
}
extern "C" void kernel_launch(void* const* d_in, const int* in_sizes, int n_in, void* d_out, int out_size, void* d_ws, size_t ws_size, hipStream_t stream) {
    static int grid = 0;
    if (grid == 0) {
        if (n_in != 28 || (size_t)out_size != O_END || ws_size < WS_END2) { fprintf(stderr, "kernel_launch: unexpected shapes: n_in %d out %d ws %zu (need %zu)\n", n_in, out_size, ws_size, (size_t)WS_END2); grid = -1; return; }
        int dev = 0, cus = 0, per_cu = 0;
        if (hipGetDevice(&dev) != hipSuccess || hipDeviceGetAttribute(&cus, hipDeviceAttributeMultiprocessorCount, dev) != hipSuccess) { grid = -1; return; }
        if (hipFuncSetAttribute((const void*)fwd, hipFuncAttributeMaxDynamicSharedMemorySize, LDS_BYTES) != hipSuccess) { fprintf(stderr, "kernel_launch: hipFuncSetAttribute failed\n"); grid = -1; return; }
        if (hipOccupancyMaxActiveBlocksPerMultiprocessor(&per_cu, (const void*)fwd, 512, LDS_BYTES) != hipSuccess || per_cu < 1) { fprintf(stderr, "kernel_launch: occupancy query says %d blocks per CU\n", per_cu); grid = -1; return; }
        (void)hipGetLastError();
        grid = cus;
    }
    if (grid < 0) return;
    (void)hipMemsetAsync((char*)d_ws + WS_CTL, 0, CTL_ZERO_BYTES, stream);
    Ctx c{}; for (int i = 0; i < 28; ++i) c.in[i] = (const float*)d_in[i]; c.out = (float*)d_out; c.ws = (unsigned char*)d_ws; c.ph_lo = 0; c.ph_hi = 0;
    hipLaunchKernelGGL(fwd, dim3(grid), dim3(512), LDS_BYTES, stream, c);
}
```

```cpp
#include <hip/hip_runtime.h>
#include <cstdio>
#include <cstdint>
namespace pg8 {
#define PG8_LAS __attribute__((address_space(3)))
typedef unsigned short bf16_t;
typedef short bf16x8 __attribute__((ext_vector_type(8)));
typedef float f32x4 __attribute__((ext_vector_type(4)));
typedef unsigned u32x4 __attribute__((ext_vector_type(4)));
constexpr int BM = 256, BK = 64, HALF = 128, HTB = HALF * BK * 2  , STAGE_BYTES = 8 * HTB, NXCD = 8, WGM = 4;

__host__ __device__ __forceinline__ int lds_byte(int r, int c) { const int st = (r >> 4) * 2 + (c >> 5), rr = r & 15, cc = c & 31, ob = rr * 64 + cc * 2; return st * 1024 + (ob ^ (((ob >> 9) & 1) << 5)); }
__host__ __device__ __forceinline__ void stage_rc(int b, int& R, int& C) { const int st = b / 1024, sb = b % 1024, swz = sb ^ (((sb >> 9) & 1) << 5); R = (st >> 1) * 16 + swz / 64; C = (st & 1) * 32 + (swz % 64) / 2; }
__host__ __device__ __forceinline__ int perm32(int rho) { const int n = rho >> 4, i = rho & 15; return 8 * (i >> 2) + 4 * n + (i & 3); }

struct Unit { int pm, pn, kt0, nt, ks; };
struct Gemm { const bf16_t* A; const bf16_t* Bt; int M, N, K; };

struct StaticOrder {
    int nM, nN, nwg, G, c, ntf;
    __host__ __device__ void init(int M, int N, int K, int G_, int c_) { nM = M / BM; nN = N / BM; nwg = nM * nN; G = G_; c = c_; ntf = K / BK; }
    __host__ __device__ bool next(int i, Unit& u) const {
        const long L = (long)i * G + c; if (L >= nwg) return false;
        int wgid = (int)L; { const int q = nwg / NXCD, r = nwg % NXCD, xcd = wgid % NXCD, off = wgid / NXCD; wgid = (xcd < r ? xcd * (q + 1) : r * (q + 1) + (xcd - r) * q) + off; }
        const int nig = WGM * nN, gid = wgid / nig, fm = gid * WGM, gsz = (nM - fm) < WGM ? (nM - fm) : WGM;
        u.pm = fm + ((wgid % nig) % gsz); u.pn = (wgid % nig) / gsz; u.kt0 = 0; u.nt = ntf; u.ks = 0; return true;
    }
    __device__ __forceinline__ void a_ready(const Unit&) const {}
    __device__ __forceinline__ void done(const Unit&) const {}
};

__device__ __forceinline__ unsigned cvt_pk_bf16(float lo, float hi) { unsigned r; asm volatile("v_cvt_pk_bf16_f32 %0, %1, %2" : "=v"(r) : "v"(lo), "v"(hi)); return r; }
}
#define LAS __attribute__((address_space(3)))
typedef unsigned short bf16_t;
typedef float f32x4 __attribute__((ext_vector_type(4)));
typedef unsigned u32x4 __attribute__((ext_vector_type(4)));
typedef unsigned u32x2 __attribute__((ext_vector_type(2)));
constexpr int D = 2048, MP = 16384, MS = 1024, M = MP + MS;
constexpr int H = 12, HD = 128, TOK = 1536, QKV = 4608, MEMD = 512, MH = 4, NMEM = 256, DFF = 8192, PAST = 2048;
constexpr int INA_W = 6680, INB_W = 3584, KVF_W = 3084;
constexpr int PJ = 6656;
constexpr float EPS = 1e-6f, SCALE = 0.08838834764831845f;
constexpr size_t O_YP = 0, O_YS = O_YP + (size_t)MP * D, O_PGDN = O_YS + (size_t)MS * D, O_PCONV = O_PGDN + (size_t)2 * 4 * 12 * 16384, O_PK = O_PCONV + (size_t)2 * 4 * 3 * 4608,
    O_PV = O_PK + (size_t)MP * TOK, O_PLOGF = O_PV + (size_t)MP * TOK, O_PMK = O_PLOGF + (size_t)MP * 12, O_PMV = O_PMK + (size_t)4 * 4 * 256 * 512, O_SGDN = O_PMV + (size_t)4 * 4 * 256 * 512,
    O_SCONV = O_SGDN + (size_t)2 * 32 * 12 * 16384, O_SK = O_SCONV + (size_t)2 * 32 * 3 * 4608, O_SV = O_SK + (size_t)MS * TOK, O_SLOGF = O_SV + (size_t)MS * TOK, O_END = O_SLOGF + (size_t)MS * 12;
static_assert(O_END == 108683264, "output size");
constexpr size_t MiB = 1u << 20;
constexpr size_t WS_CTL = 0, WS_WINA = 1 * MiB, WS_WINB0 = 53 * MiB, WS_WINB1 = 79 * MiB, WS_WO = 93 * MiB, WS_WUP = 125 * MiB, WS_WDN = 253 * MiB, WS_WMEM = 381 * MiB, WS_WSK = 397 * MiB,
    WS_X = 398 * MiB, WS_XN = 534 * MiB, WS_PROJ = 602 * MiB, WS_ACT = 823 * MiB, WS_DELTA = 891 * MiB, WS_KB = 1027 * MiB, WS_VB = 1078 * MiB, WS_G = 1129 * MiB, WS_BETA = 1130 * MiB,
    WS_LOGF = 1131 * MiB, WS_CUMP = 1132 * MiB, WS_CUMS = 1133 * MiB, WS_MEMN = 1137 * MiB, WS_BIG = 1141 * MiB, WS_QF = WS_BIG, WS_KF = WS_BIG + 102 * MiB, WS_VF = WS_BIG + 204 * MiB,
    WS_OF = WS_BIG + 306 * MiB, WS_UP = WS_BIG, WS_END = WS_BIG + 408 * MiB,
    WS_EGL = WS_END, WS_QX = WS_EGL + 1 * MiB, WS_KX = WS_QX + 3 * MiB, WS_MEMKVB = WS_KX + 3 * MiB, WS_WSKB = WS_MEMKVB + 8 * MiB, WS_END2 = WS_WSKB + 1 * MiB;
constexpr size_t WS_SLAB = WS_PROJ;
constexpr size_t CTL_ZROW = 61440, CTL_QFOX = 32768;
static_assert((size_t)6656 * 2048 * 2 == 26 * MiB && (size_t)M * D * 4 == 136 * MiB && (size_t)M * PJ * 2 == 221 * MiB && (size_t)M * TOK * 2 == 51 * MiB && (size_t)M * TOK * 4 == 102 * MiB && (size_t)M * DFF * 2 == 272 * MiB, "sizes");

struct Ctx { const float* in[28]; float* out; unsigned char* ws; int ph_lo, ph_hi; };
typedef const __attribute__((address_space(4))) Ctx* CtxP;
__device__ __forceinline__ int otid_cp(CtxP cp) {
#if defined(__HIP_DEVICE_COMPILE__)
    unsigned long long a = (unsigned long long)cp; asm volatile("" : "+s"(a));
    int ln; asm volatile("v_mbcnt_lo_u32_b32 %0, -1, 0\n\tv_mbcnt_hi_u32_b32 %0, -1, %0" : "=v"(ln));
    return (int)((unsigned)a & 7u) * 64 + ln;
#else
    (void)cp; return 0;
#endif
}
#define otid() otid_cp(cp)
__device__ __forceinline__ int obid() { int b = blockIdx.x; asm volatile("" : "+s"(b)); return b; }
__device__ __forceinline__ int ogrid() { int g = gridDim.x; asm volatile("" : "+s"(g)); return g; }
__device__ __forceinline__ Ctx ctx_load(CtxP cp) {
#if defined(__HIP_DEVICE_COMPILE__)
    asm volatile("" : "+s"(cp)); cp = (CtxP)((unsigned long long)cp & ~7ull); Ctx r; __builtin_memcpy(&r, cp, sizeof(Ctx)); return r;
#else
    (void)cp; return Ctx{};
#endif
}
#define CTX_LOAD(cp) const Ctx c = ctx_load(cp)
enum { I_XP = 0, I_XS, I_SGDN, I_SCONV, I_CK, I_CV, I_CLOGF, I_CMK, I_CMV, I_MEMP, I_NMIXPRE, I_NMIXPOST, I_NMLPPRE, I_NMLPPOST, I_WINA, I_CONVW, I_ALOG, I_DTB, I_GDNN, I_WINB, I_NKV, I_WKVF, I_BF, I_NMEM, I_WMEMKV, I_WO, I_WUP, I_WDN };

__device__ __forceinline__ float bf2f(bf16_t b) { return __uint_as_float(((unsigned)b) << 16); }
__device__ __forceinline__ float bflo(unsigned u) { return __uint_as_float(u << 16); }
__device__ __forceinline__ float bfhi(unsigned u) { return __uint_as_float(u & 0xffff0000u); }
__device__ __forceinline__ unsigned pk2(float lo, float hi) { return pg8::cvt_pk_bf16(lo, hi); }
__device__ __forceinline__ float lane_get(float v, int src_lane) { return __int_as_float(__builtin_amdgcn_ds_bpermute(src_lane << 2, __float_as_int(v))); }
__device__ __forceinline__ float wave_sum(float v, int lane) {
#pragma unroll
    for (int o = 1; o < 64; o <<= 1) v += lane_get(v, lane ^ o);
    return v; }
__device__ __forceinline__ float wave_max(float v, int lane) {
#pragma unroll
    for (int o = 1; o < 64; o <<= 1) v = fmaxf(v, lane_get(v, lane ^ o));
    return v; }
__device__ __forceinline__ float wave_sum_dpp(float v) {
    v += __int_as_float(__builtin_amdgcn_update_dpp(0, __float_as_int(v), 0x111, 0xf, 0xf, true));
    v += __int_as_float(__builtin_amdgcn_update_dpp(0, __float_as_int(v), 0x112, 0xf, 0xf, true));
    v += __int_as_float(__builtin_amdgcn_update_dpp(0, __float_as_int(v), 0x114, 0xf, 0xf, true));
    v += __int_as_float(__builtin_amdgcn_update_dpp(0, __float_as_int(v), 0x118, 0xf, 0xf, true));
    const int iv = __float_as_int(v);
    return (__int_as_float(__builtin_amdgcn_readlane(iv, 15)) + __int_as_float(__builtin_amdgcn_readlane(iv, 31))) + (__int_as_float(__builtin_amdgcn_readlane(iv, 47)) + __int_as_float(__builtin_amdgcn_readlane(iv, 63)));
}
__device__ __forceinline__ float sigmoidf_(float x) { return 1.f / (1.f + expf(-x)); }
__device__ __forceinline__ float softplusf_(float x) { return fmaxf(x, 0.f) + log1pf(expf(-fabsf(x))); }
__device__ __forceinline__ float softplus_fast(float x) { return fmaxf(x, 0.f) + 0.6931471805599453f * __builtin_amdgcn_logf(1.f + __builtin_amdgcn_exp2f(-1.4426950408889634f * fabsf(x))); }
__device__ __forceinline__ float fast_sigmoid(float x) { return __builtin_amdgcn_rcpf(1.f + __builtin_amdgcn_exp2f(-1.4426950408889634f * x)); }
__device__ __forceinline__ float exp_fast(float x) { return __builtin_amdgcn_exp2f(1.4426950408889634f * x); }
struct RowInfo { int grp, b, t, T, nb; };
__device__ __forceinline__ RowInfo rowinfo(int m) { RowInfo r; if (m < MP) { r.grp = 0; r.b = m >> 12; r.t = m & 4095; r.T = 4096; r.nb = 4; } else { const int ms = m - MP; r.grp = 1; r.b = ms >> 5; r.t = ms & 31; r.T = 32; r.nb = 32; } return r; }
namespace pg8 {
struct Epi {
    static constexpr bool PERM = true, AFTER_DRAIN = false;
    int mode;
    bf16_t* o16; int ld16; float* o32; int ld32;
    unsigned char* ws; float* out;
    int ntfull;
    int ntcol;
    __device__ __forceinline__ void operator()(const f32x4 (&acc)[2][2][4][2], const Unit& u, int wr, int wc, int fr, int fq) const {
        const int row0 = u.pm * BM + wr * 64 + fr, colt = u.pn * BM, cl = wc * 32 + 8 * fq;
        bf16_t* d16 = nullptr; size_t l16 = 0; float* d32 = nullptr; size_t l32 = 0; int radj = 0; const bool sq = (mode == 1);
        bool nt16 = false;
        if (mode == 0 || mode == 1) { d16 = o16 + colt; l16 = (size_t)ld16; nt16 = (mode == 0) && (ntcol >= 0) && (colt >= ntcol); }
        else if (mode == 2) {
            if (u.nt != ntfull) { d16 = (bf16_t*)(ws + WS_SLAB) + (size_t)u.ks * 1024 * 2048 + colt - (size_t)16384 * 2048; l16 = 2048; }
            else { d16 = o16 + colt; l16 = (size_t)ld16; } }
        else if (mode == 3) {
            if (colt < 3584) { d16 = o16 + colt; l16 = (size_t)ld16; nt16 = true; }
            else { const bool isv = colt >= 5120; const int cc = colt - (isv ? 5120 : 3584); const bool smp = u.pm >= 64;
                d16 = (bf16_t*)(ws + (isv ? WS_VB : WS_KB)) + cc; l16 = 1536; d32 = out + (smp ? (isv ? O_SV : O_SK) : (isv ? O_PV : O_PK)) + cc; l32 = 1536; radj = smp ? 16384 : 0; }
        } else { const int l = colt >> 10, within = colt & 1023; d32 = out + ((within >= 512) ? O_PMV : O_PMK) + (size_t)l * 1024 * 512 + (within & 511); l32 = 512;  d16 = (bf16_t*)(ws + WS_MEMKVB) + colt; l16 = 4096; }
#pragma unroll
        for (int ai = 0; ai < 2; ++ai)
#pragma unroll
            for (int m = 0; m < 4; ++m) { const int row = row0 + ai * HALF + m * 16;
#pragma unroll
                for (int bj = 0; bj < 2; ++bj) { f32x4 v0 = acc[ai][bj][m][0], v1 = acc[ai][bj][m][1]; const int col = cl + bj * HALF;
                    if (sq) {
#pragma unroll
                        for (int j = 0; j < 4; ++j) { const float a = v0[j] > 0.f ? v0[j] : 0.f, b = v1[j] > 0.f ? v1[j] : 0.f; v0[j] = a * a; v1[j] = b * b; } }
                    if (d16) { u32x4 w; w.x = cvt_pk_bf16(v0[0], v0[1]); w.y = cvt_pk_bf16(v0[2], v0[3]); w.z = cvt_pk_bf16(v1[0], v1[1]); w.w = cvt_pk_bf16(v1[2], v1[3]);
                        if (nt16) __builtin_nontemporal_store(w, (u32x4*)(d16 + (size_t)row * l16 + col)); else *(u32x4*)(d16 + (size_t)row * l16 + col) = w; }
                    if (d32) { float* p = d32 + (size_t)(row - radj) * l32 + col;
                        if (mode >= 3) { __builtin_nontemporal_store(v0, (f32x4*)p); __builtin_nontemporal_store(v1, (f32x4*)(p + 4)); }
                        else { *(f32x4*)p = v0; *(f32x4*)(p + 4) = v1; } } } }
    }
};
struct TailSplit {
    StaticOrder full; int nF, nN, nsl, nts, G, c, split;
    __device__ void init(int M, int N, int K, int G_, int c_, int split_) { split = split_; full.init(split_ ? 64 * BM : M, N, K, G_, c_); nN = N / BM; nF = 64 * nN; nsl = 8; nts = K / BK / nsl; G = G_; c = c_; }
    __device__ __forceinline__ bool next(int i, Unit& u) const {
        const long L = (long)i * G + c; int pm = 0, pn = 0, kt0 = 0, nt = full.ntf, ks = 0; bool ok; if (c < 0) { u.pm = 0; u.pn = 0; u.kt0 = 0; u.nt = nt; u.ks = 0; return false; }
        if (!split || L < nF) { Unit t; ok = full.next(i, t); pm = t.pm; pn = t.pn; }
        else { const int Ls = (int)(L - nF); ok = Ls < 4 * nN * nsl; pn = Ls % nN; const int rest = Ls / nN; pm = 64 + (rest & 3); ks = rest >> 2; kt0 = ks * nts; nt = nts; }
        u.pm = pm; u.pn = pn; u.kt0 = kt0; u.nt = nt; u.ks = ks; return ok;
    }
    __device__ __forceinline__ void a_ready(const Unit&) const {}
    __device__ __forceinline__ void done(const Unit&) const {}
};
}
namespace pg8 {
template <class Epi, class Sched, bool ALIGN_EPI = false, bool SP2 = false>
__device__ __forceinline__ void gemm_phase(PG8_LAS unsigned char* lds, const Gemm g, const Sched& S, const Epi& E, const int tid) {
    const int wid = __builtin_amdgcn_readfirstlane(tid >> 6), lane = tid & 63, wr = wid >> 2, wc = wid & 3, fr = lane & 15, fq = lane >> 4;
    const int K = g.K;
    unsigned voffA[2], voffB[2];
#pragma unroll
    for (int i = 0; i < 2; ++i) { int R, C; stage_rc(tid * 16 + i * 8192, R, C); const int Rb = Epi::PERM ? ((R & ~31) + perm32(R & 31)) : R;
        voffA[i] = (unsigned)(R * K + C) * 2u; voffB[i] = (unsigned)(Rb * K + C) * 2u; }
    const size_t kstep = (size_t)(BK * 2);
    const size_t hstep = (size_t)HALF * K * 2;
    const size_t tstep = 2 * hstep;
    const unsigned ldsw = (unsigned)wid * 1024u;
    const int aoff = lds_byte(wr * 64 + fr, fq * 8), boff = lds_byte(wc * 32 + fr, fq * 8);
#define PG8_SA(b, h) (((b) * 2 + (h)) * HTB)
#define PG8_SB(b, h) ((4 + (b) * 2 + (h)) * HTB)
#define PG8_STAGE(bufoff, gbase, voff) do { _Pragma("unroll") for (int _i = 0; _i < 2; ++_i) \
        __builtin_amdgcn_global_load_lds((const unsigned*)((const char*)(gbase) + (voff)[_i]), (PG8_LAS unsigned*)(lds + (bufoff) + ldsw + _i * 8192), 16, 0, 0); } while (0)
#define PG8_LDA(dst, b, h) do { _Pragma("unroll") for (int m = 0; m < 4; ++m) _Pragma("unroll") for (int k = 0; k < 2; ++k) dst[m][k] = *(const PG8_LAS bf16x8*)(lds + PG8_SA(b, h) + aoff + m * 2048 + k * 1024); } while (0)
#define PG8_LDB(dst, b, h) do { _Pragma("unroll") for (int n = 0; n < 2; ++n) _Pragma("unroll") for (int k = 0; k < 2; ++k) dst[n][k] = *(const PG8_LAS bf16x8*)(lds + PG8_SB(b, h) + boff + n * 2048 + k * 1024); } while (0)
#define PG8_MMA(ai, bj, At, Bt) do { __builtin_amdgcn_s_setprio(1); _Pragma("unroll") for (int m = 0; m < 4; ++m) _Pragma("unroll") for (int n = 0; n < 2; ++n) _Pragma("unroll") for (int k = 0; k < 2; ++k) \
        acc[ai][bj][m][n] = __builtin_amdgcn_mfma_f32_16x16x32_bf16(Bt[n][k], At[m][k], acc[ai][bj][m][n], 0, 0, 0); __builtin_amdgcn_s_setprio(0); } while (0)
#define PG8_WAIT_V(n) asm volatile("s_waitcnt vmcnt(" #n ")" ::: "memory")
#define PG8_WAIT_L(n) asm volatile("s_waitcnt lgkmcnt(" #n ")" ::: "memory")
#define PG8_BAR __builtin_amdgcn_s_barrier()
#define PG8_SCHED __builtin_amdgcn_sched_barrier(0)
    Unit cur, nxt; int ui = 0;
    if (!S.next(0, cur)) return;
    f32x4 acc[2][2][4][2];
#pragma unroll
    for (int a = 0; a < 2; ++a)
#pragma unroll
        for (int b = 0; b < 2; ++b)
#pragma unroll
            for (int m = 0; m < 4; ++m)
#pragma unroll
                for (int n = 0; n < 2; ++n) acc[a][b][m][n] = (f32x4){0.f, 0.f, 0.f, 0.f};
    bf16x8 At[4][2], B0[2][2], B1[2][2];
    const char* cA = (const char*)g.A + (size_t)cur.pm * tstep + (size_t)cur.kt0 * kstep; const char* cB = (const char*)g.Bt + (size_t)cur.pn * tstep + (size_t)cur.kt0 * kstep;
    S.a_ready(cur);
    if constexpr (SP2) {
        PG8_STAGE(PG8_SB(0, 0), cB, voffB); PG8_STAGE(PG8_SB(0, 1), cB + hstep, voffB); PG8_STAGE(PG8_SA(0, 0), cA, voffA); PG8_STAGE(PG8_SA(0, 1), cA + hstep, voffA);
        if (wr == 1) PG8_BAR;
        PG8_WAIT_V(2); PG8_BAR;
        PG8_STAGE(PG8_SB(1, 0), cB + kstep, voffB); PG8_STAGE(PG8_SA(1, 0), cA + kstep, voffA); PG8_STAGE(PG8_SB(1, 1), cB + hstep + kstep, voffB);
        PG8_WAIT_V(6); PG8_BAR;
    } else {
        PG8_STAGE(PG8_SB(0, 0), cB, voffB); PG8_STAGE(PG8_SA(0, 0), cA, voffA); PG8_STAGE(PG8_SB(0, 1), cB + hstep, voffB); PG8_STAGE(PG8_SA(0, 1), cA + hstep, voffA);
        if (wr == 1) PG8_BAR;
        PG8_WAIT_V(4); PG8_BAR;
        PG8_STAGE(PG8_SB(1, 0), cB + kstep, voffB); PG8_STAGE(PG8_SA(1, 0), cA + kstep, voffA); PG8_STAGE(PG8_SB(1, 1), cB + hstep + kstep, voffB);
        PG8_WAIT_V(6); PG8_BAR;
    }
    for (;;) {
        const bool has_next = S.next(ui + 1, nxt);
        const char* nA = has_next ? (const char*)g.A + (size_t)nxt.pm * tstep + (size_t)nxt.kt0 * kstep : cA; const char* nB = has_next ? (const char*)g.Bt + (size_t)nxt.pn * tstep + (size_t)nxt.kt0 * kstep : cB;
        const int nt = cur.nt;
        for (int t = 0; t < nt; t += 2) {
            const bool last = (t == nt - 2);
            const char* a1 = cA + (size_t)(t + 1) * kstep;
            const char* a2 = last ? nA : cA + (size_t)(t + 2) * kstep; const char* b2 = last ? nB : cB + (size_t)(t + 2) * kstep;
            const char* a3 = a2 + kstep; const char* b3 = b2 + kstep;
            if (last && has_next) S.a_ready(nxt);
            if constexpr (SP2) {
            PG8_LDB(B0, 0, 0); PG8_LDB(B1, 0, 1); PG8_SCHED; PG8_LDA(At, 0, 0); PG8_STAGE(PG8_SA(1, 1), a1 + hstep, voffA);
            PG8_WAIT_V(8); PG8_WAIT_L(0); PG8_BAR; PG8_MMA(0, 0, At, B0); PG8_MMA(0, 1, At, B1); PG8_BAR; PG8_SCHED;
            PG8_LDA(At, 0, 1); PG8_STAGE(PG8_SB(0, 0), b2, voffB); PG8_STAGE(PG8_SB(0, 1), b2 + hstep, voffB); PG8_STAGE(PG8_SA(0, 0), a2, voffA);
            PG8_WAIT_V(8); PG8_WAIT_L(0); PG8_BAR; PG8_MMA(1, 0, At, B0); PG8_MMA(1, 1, At, B1); PG8_BAR; PG8_SCHED;
            PG8_LDB(B0, 1, 0); PG8_LDB(B1, 1, 1); PG8_SCHED; PG8_LDA(At, 1, 0); PG8_STAGE(PG8_SA(0, 1), a2 + hstep, voffA);
            PG8_WAIT_V(8); PG8_WAIT_L(0); PG8_BAR; PG8_MMA(0, 0, At, B0); PG8_MMA(0, 1, At, B1); PG8_BAR; PG8_SCHED;
            PG8_LDA(At, 1, 1); PG8_STAGE(PG8_SB(1, 0), b3, voffB); PG8_STAGE(PG8_SB(1, 1), b3 + hstep, voffB); PG8_STAGE(PG8_SA(1, 0), a3, voffA);
            PG8_WAIT_V(8); PG8_WAIT_L(0); PG8_BAR; PG8_MMA(1, 0, At, B0); PG8_MMA(1, 1, At, B1); PG8_BAR; PG8_SCHED;
            } else {
            PG8_LDB(B0, 0, 0); PG8_SCHED; PG8_LDA(At, 0, 0); PG8_STAGE(PG8_SA(1, 1), a1 + hstep, voffA);
            PG8_WAIT_L(8); PG8_BAR; PG8_WAIT_L(0); PG8_MMA(0, 0, At, B0); PG8_BAR; PG8_SCHED;
            PG8_LDB(B1, 0, 1); PG8_STAGE(PG8_SB(0, 0), b2, voffB);
            PG8_BAR; PG8_WAIT_L(0); PG8_MMA(0, 1, At, B1); PG8_BAR;
            PG8_LDA(At, 0, 1); PG8_STAGE(PG8_SA(0, 0), a2, voffA);
            PG8_BAR; PG8_WAIT_L(0); PG8_MMA(1, 0, At, B0); PG8_BAR; PG8_SCHED;
            PG8_STAGE(PG8_SB(0, 1), b2 + hstep, voffB);
            PG8_WAIT_V(6); PG8_BAR; PG8_MMA(1, 1, At, B1); PG8_BAR;
            PG8_LDB(B0, 1, 0); PG8_SCHED; PG8_LDA(At, 1, 0); PG8_STAGE(PG8_SA(0, 1), a2 + hstep, voffA);
            PG8_WAIT_L(8); PG8_BAR; PG8_WAIT_L(0); PG8_MMA(0, 0, At, B0); PG8_BAR; PG8_SCHED;
            PG8_LDB(B1, 1, 1); PG8_STAGE(PG8_SB(1, 0), b3, voffB);
            PG8_BAR; PG8_WAIT_L(0); PG8_MMA(0, 1, At, B1); PG8_BAR;
            PG8_LDA(At, 1, 1); PG8_STAGE(PG8_SA(1, 0), a3, voffA);
            PG8_BAR; PG8_WAIT_L(0); PG8_MMA(1, 0, At, B0); PG8_BAR; PG8_SCHED;
            PG8_STAGE(PG8_SB(1, 1), b3 + hstep, voffB);
            PG8_WAIT_V(6); PG8_BAR; PG8_MMA(1, 1, At, B1); PG8_BAR;
            }
        }
        if constexpr (ALIGN_EPI) { if (wr == 0) PG8_BAR; }
        if constexpr (!Epi::AFTER_DRAIN) { E(acc, cur, wr, wc, fr, fq); S.done(cur); }
        if (!has_next) break;
#pragma unroll
        for (int a = 0; a < 2; ++a)
#pragma unroll
            for (int b = 0; b < 2; ++b)
#pragma unroll
                for (int m = 0; m < 4; ++m)
#pragma unroll
                    for (int n = 0; n < 2; ++n) acc[a][b][m][n] = (f32x4){0.f, 0.f, 0.f, 0.f};
        cur = nxt; cA = nA; cB = nB; ++ui;
        if constexpr (ALIGN_EPI) { if (wr == 1) PG8_BAR; }
    }
    PG8_WAIT_V(0);
    if constexpr (!ALIGN_EPI) { if (wr == 0) PG8_BAR; }
    PG8_BAR;
    if constexpr (Epi::AFTER_DRAIN) { E.fused(acc, cur, wr, wc, fr, fq, lds, wid, lane); S.done(cur); }
#undef PG8_SA
#undef PG8_SB
#undef PG8_STAGE
#undef PG8_LDA
#undef PG8_LDB
#undef PG8_MMA
#undef PG8_WAIT_V
#undef PG8_WAIT_L
#undef PG8_BAR
#undef PG8_SCHED
}
}
typedef short bf16x8s __attribute__((ext_vector_type(8)));
#define WS_PTR(T, off) ((T*)(c.ws + (off)))
struct TJob { const float* W; int ldw, K; const float* gain; bf16_t* WT; int src0, dst0, ncols; };
__device__ __forceinline__ TJob get_job(const Ctx& c, int j) {
    TJob J; J.gain = nullptr; J.src0 = 0; J.dst0 = 0; J.K = D;
    if (j < 4) { const int l = j >> 1, p = j & 1; J.W = c.in[I_WINA] + (size_t)l * D * INA_W; J.ldw = INA_W; J.gain = c.in[I_NMIXPRE] + l * D; J.WT = WS_PTR(bf16_t, WS_WINA) + (size_t)l * 6656 * D;
        if (p == 0) { J.ncols = 6144; } else { J.src0 = 6168; J.dst0 = 6144; J.ncols = 512; } }
    else if (j == 4) { J.W = c.in[I_WINB]; J.ldw = INB_W; J.gain = c.in[I_NMIXPRE] + 2 * D; J.WT = WS_PTR(bf16_t, WS_WINB0); J.ncols = 3584; }
    else if (j == 5) { J.W = c.in[I_WKVF]; J.ldw = KVF_W; J.gain = c.in[I_NKV]; J.WT = WS_PTR(bf16_t, WS_WINB0); J.dst0 = 3584; J.ncols = 3072; }
    else if (j == 6) { J.W = c.in[I_WINB] + (size_t)D * INB_W; J.ldw = INB_W; J.gain = c.in[I_NMIXPRE] + 3 * D; J.WT = WS_PTR(bf16_t, WS_WINB1); J.ncols = 3584; }
    else if (j < 11) { const int l = j - 7; J.W = c.in[I_WO] + (size_t)l * D * D; J.ldw = D; J.WT = WS_PTR(bf16_t, WS_WO) + (size_t)l * D * D; J.ncols = D; }
    else if (j < 15) { const int l = j - 11; J.W = c.in[I_WUP] + (size_t)l * D * DFF; J.ldw = DFF; J.gain = c.in[I_NMLPPRE] + l * D; J.WT = WS_PTR(bf16_t, WS_WUP) + (size_t)l * DFF * D; J.ncols = DFF; }
    else if (j < 19) { const int l = j - 15; J.W = c.in[I_WDN] + (size_t)l * DFF * D; J.ldw = D; J.K = DFF; J.WT = WS_PTR(bf16_t, WS_WDN) + (size_t)l * D * DFF; J.ncols = D; }
    else { const int l = j - 19; J.W = c.in[I_WMEMKV] + (size_t)l * D * 1024; J.ldw = 1024; J.gain = c.in[I_NMEM] + l * D; J.WT = WS_PTR(bf16_t, WS_WMEM); J.dst0 = l * 1024; J.ncols = 1024; }
    return J;
}
constexpr int NJOBS = 23;
__device__ __forceinline__ int job_items(const TJob& J) { return (J.K / 64) * (J.ncols / 32); }
__device__ __forceinline__ void transpose_item(const TJob& J, int item, LAS float* scr, int lane) {
    const int nblk = J.ncols / 32, kb = item / nblk, nb = item % nblk, k0 = 64 * kb, n0 = 32 * nb;
    float wv[32];
#pragma unroll
    for (int i = 0; i < 32; ++i) wv[i] = __builtin_nontemporal_load(J.W + (size_t)(k0 + 2 * i + (lane >> 5)) * J.ldw + J.src0 + n0 + (lane & 31));
#pragma unroll
    for (int i = 0; i < 32; ++i) { const int kk = 2 * i + (lane >> 5); float w = wv[i]; if (J.gain) w *= J.gain[k0 + kk]; scr[kk * 33 + (lane & 31)] = w; }
    asm volatile("s_waitcnt lgkmcnt(0)" ::: "memory");
    const int cc = lane & 7;
#pragma unroll
    for (int j = 0; j < 4; ++j) { const int n = (lane >> 3) + 8 * j; const LAS float* s = scr + (8 * cc) * 33 + n;
        u32x4 o; o.x = pk2(s[0 * 33], s[1 * 33]); o.y = pk2(s[2 * 33], s[3 * 33]); o.z = pk2(s[4 * 33], s[5 * 33]); o.w = pk2(s[6 * 33], s[7 * 33]);
        __builtin_nontemporal_store(o, (u32x4*)(J.WT + (size_t)(J.dst0 + n0 + n) * J.K + k0 + 8 * cc)); }
    asm volatile("s_waitcnt lgkmcnt(0)" ::: "memory");
}
constexpr unsigned JOBS_L0 = 0x3u | (1u << 7) | (1u << 11) | (1u << 15) | (0xfu << 19), JOBS_L1 = 0xcu | (1u << 8) | (1u << 12) | (1u << 16), JOBS_L2 = 0x30u | (1u << 9) | (1u << 13) | (1u << 17), JOBS_L3 = 0x40u | (1u << 10) | (1u << 14) | (1u << 18);
static_assert((JOBS_L0 | JOBS_L1 | JOBS_L2 | JOBS_L3) == (1u << 23) - 1 && (JOBS_L0 & JOBS_L1) == 0 && (JOBS_L2 & JOBS_L3) == 0 && ((JOBS_L0 | JOBS_L1) & (JOBS_L2 | JOBS_L3)) == 0, "every weight job in exactly one group");
__device__ __forceinline__ void ph_prep(CtxP cp, LAS unsigned char* lds, unsigned mask, int wg0, int nwg, int small) {
    CTX_LOAD(cp);
    const int bid_ = obid() - wg0, grid_ = nwg; const int tid = otid(), lane = tid & 63, wave = tid >> 6, gw = bid_ * 8 + wave, NGW = grid_ * 8;
    if (bid_ < 0) return;
    __syncthreads();
    LAS float* scr = (LAS float*)(lds + wave * 16384);
    int base = 0;
    for (int j = 0; j < NJOBS; ++j) { if (!((mask >> j) & 1u)) continue; const TJob J = get_job(c, j); const int n = job_items(J);
        int first = gw - (base % NGW); if (first < 0) first += NGW;
        for (int it = first; it < n; it += NGW) transpose_item(J, it, scr, lane);
        base += n; }
    if (!small) return;
    bf16_t* wskb = WS_PTR(bf16_t, WS_WSKB);
    for (int i = bid_ * 512 + tid; i < 3 * 32 * D; i += grid_ * 512) { const int var = i / (32 * D), r = (i / D) % 32, k = i % D; float v = 0.f;
        if (var < 2) { if (r < 24) v = c.in[I_WINA][(size_t)var * D * INA_W + (size_t)k * INA_W + 6144 + r] * c.in[I_NMIXPRE][var * D + k]; }
        else if (r < 12) v = c.in[I_WKVF][(size_t)k * KVF_W + 3072 + r] * c.in[I_NKV][k];
        wskb[i] = (bf16_t)(pk2(v, 0.f) & 0xffffu); }
}
__device__ __forceinline__ f32x4 x24_unpack(unsigned hx, unsigned hy, unsigned l) {
    return (f32x4){__uint_as_float((hx << 16) | ((l & 0xffu) << 8)), __uint_as_float((hx & 0xffff0000u) | (l & 0xff00u)), __uint_as_float((hy << 16) | ((l >> 8) & 0xff00u)), __uint_as_float((hy & 0xffff0000u) | ((l >> 16) & 0xff00u))}; }
__device__ __forceinline__ void x24_pack(const f32x4 v, unsigned& hx, unsigned& hy, unsigned& l) {
    const unsigned b0 = __float_as_uint(v.x) + 0x80u, b1 = __float_as_uint(v.y) + 0x80u, b2 = __float_as_uint(v.z) + 0x80u, b3 = __float_as_uint(v.w) + 0x80u;
    hx = (b0 >> 16) | (b1 & 0xffff0000u); hy = (b2 >> 16) | (b3 & 0xffff0000u); l = ((b0 >> 8) & 0xffu) | (b1 & 0xff00u) | ((b2 << 8) & 0xff0000u) | ((b3 << 16) & 0xff000000u); }
__device__ __forceinline__ void ph_row2(CtxP cp, int src, int use_delta, int gidx, int gl, int write_y, int first = 0, int wg0 = 0, int nwg = 0) {
    CTX_LOAD(cp);
    const int bid_ = obid() - wg0, grid_ = nwg ? nwg : ogrid();
    if (bid_ < 0 || bid_ >= grid_) return; const int tid = otid(), lane = tid & 63, wave = tid >> 6, gw = bid_ * 8 + wave, NGW = grid_ * 8;
    const bf16_t* XH = WS_PTR(bf16_t, WS_X); const unsigned char* XL = c.ws + WS_X + (size_t)M * D * 2; bf16_t* XN = WS_PTR(bf16_t, WS_XN); const bf16_t* delta = WS_PTR(bf16_t, WS_DELTA); const float* gpost = use_delta ? c.in[gidx] + gl * D : nullptr;
    const int nrows = (src == 2) ? 1024 : M;
#define EO(j) (8 * lane + 512 * ((j) >> 1) + 4 * ((j) & 1))
#define EB(jj) (8 * lane + 512 * (jj))
#define LD_BF8(dlo, dhi, ptr) do { const u32x4 t_ = __builtin_nontemporal_load((const u32x4*)(ptr)); dlo = (f32x4){bflo(t_.x), bfhi(t_.x), bflo(t_.y), bfhi(t_.y)}; dhi = (f32x4){bflo(t_.z), bfhi(t_.z), bflo(t_.w), bfhi(t_.w)}; } while (0)
#define ADD_BF8(dlo, dhi, ptr) do { const u32x4 t_ = __builtin_nontemporal_load((const u32x4*)(ptr)); dlo = dlo + (f32x4){bflo(t_.x), bfhi(t_.x), bflo(t_.y), bfhi(t_.y)}; dhi = dhi + (f32x4){bflo(t_.z), bfhi(t_.z), bflo(t_.w), bfhi(t_.w)}; } while (0)
#define X24_LD2(vlo, vhi, mrow, jj) do { const u32x4 h_ = __builtin_nontemporal_load((const u32x4*)(XH + (size_t)(mrow) * D + EB(jj))); const u32x2 l_ = __builtin_nontemporal_load((const u32x2*)(XL + (size_t)(mrow) * D + EB(jj))); \
        vlo = x24_unpack(h_.x, h_.y, l_.x); vhi = x24_unpack(h_.z, h_.w, l_.y); } while (0)
#define X24_ST2(vlo, vhi, mrow, jj) do { unsigned ha_, hb_, hc_, hd_, la_, lb_; x24_pack(vlo, ha_, hb_, la_); x24_pack(vhi, hc_, hd_, lb_); const u32x4 h_ = {ha_, hb_, hc_, hd_}; const u32x2 l_ = {la_, lb_}; \
        __builtin_nontemporal_store(h_, (u32x4*)((bf16_t*)XH + (size_t)(mrow) * D + EB(jj))); __builtin_nontemporal_store(l_, (u32x2*)((unsigned char*)XL + (size_t)(mrow) * D + EB(jj))); } while (0)
    const bool deal2 = (src == 0) && use_delta && (NGW == 2048);
    const int half_gw = gw >> 1, isA = !(gw & 1);
    const int nsteps = deal2 ? (isA ? 4 : 5) : (nrows + 2 * NGW - 1) / (2 * NGW);
    for (int st = 0; st < nsteps; ++st) {
        int m0, m1; bool two;
        if (deal2) { if (isA) { if (st == 0) { m0 = MP + half_gw; m1 = m0; two = false; } else { m0 = half_gw + 1024 * (2 * (st - 1)); m1 = m0 + 1024; two = true; } }
            else { m0 = 6144 + half_gw + 1024 * (2 * st); m1 = m0 + 1024; two = true; } }
        else { m0 = gw + st * 2 * NGW; if (m0 >= nrows) break; const int m1r = m0 + NGW; two = m1r < nrows; m1 = two ? m1r : m0; }
        const bool fromx = (src == 0) && !first;
        const float* xr0 = (src != 2) ? (m0 < MP ? c.in[I_XP] + (size_t)m0 * D : c.in[I_XS] + (size_t)(m0 - MP) * D) : c.in[I_MEMP] + (size_t)m0 * D;
        const float* xr1 = (src != 2) ? (m1 < MP ? c.in[I_XP] + (size_t)m1 * D : c.in[I_XS] + (size_t)(m1 - MP) * D) : c.in[I_MEMP] + (size_t)m1 * D;
        f32x4 v0[8], v1[8];
        if (fromx) {
#pragma unroll
            for (int jj = 0; jj < 4; ++jj) { X24_LD2(v0[2 * jj], v0[2 * jj + 1], m0, jj); if (two) X24_LD2(v1[2 * jj], v1[2 * jj + 1], m1, jj); else { v1[2 * jj] = v0[2 * jj]; v1[2 * jj + 1] = v0[2 * jj + 1]; } } }
        else {
#pragma unroll
            for (int j = 0; j < 8; ++j) { v0[j] = __builtin_nontemporal_load((const f32x4*)(xr0 + EO(j))); v1[j] = two ? __builtin_nontemporal_load((const f32x4*)(xr1 + EO(j))) : v0[j]; } }
        if (use_delta) { f32x4 d0[8], d1[8]; float s0 = 0.f, s1 = 0.f;
#pragma unroll
            for (int jj = 0; jj < 4; ++jj) {
                if (m0 < MP) LD_BF8(d0[2 * jj], d0[2 * jj + 1], delta + (size_t)m0 * D + EB(jj));
                else { const bf16_t* sp = WS_PTR(bf16_t, WS_SLAB) + (size_t)(m0 - MP) * D + EB(jj); LD_BF8(d0[2 * jj], d0[2 * jj + 1], sp);
#pragma unroll
                    for (int s8 = 1; s8 < 8; ++s8) ADD_BF8(d0[2 * jj], d0[2 * jj + 1], sp + (size_t)s8 * 1024 * D); }
                if (!two) { d1[2 * jj] = d0[2 * jj]; d1[2 * jj + 1] = d0[2 * jj + 1]; }
                else if (m1 < MP) LD_BF8(d1[2 * jj], d1[2 * jj + 1], delta + (size_t)m1 * D + EB(jj));
                else { const bf16_t* sp = WS_PTR(bf16_t, WS_SLAB) + (size_t)(m1 - MP) * D + EB(jj); LD_BF8(d1[2 * jj], d1[2 * jj + 1], sp);
#pragma unroll
                    for (int s8 = 1; s8 < 8; ++s8) ADD_BF8(d1[2 * jj], d1[2 * jj + 1], sp + (size_t)s8 * 1024 * D); } }
#pragma unroll
            for (int j = 0; j < 8; ++j) { s0 += (d0[j].x * d0[j].x + d0[j].y * d0[j].y) + (d0[j].z * d0[j].z + d0[j].w * d0[j].w); s1 += (d1[j].x * d1[j].x + d1[j].y * d1[j].y) + (d1[j].z * d1[j].z + d1[j].w * d1[j].w); }
            const float r0 = rsqrtf(wave_sum_dpp(s0) * (1.f / D) + EPS), r1 = rsqrtf(wave_sum_dpp(s1) * (1.f / D) + EPS);
#pragma unroll
            for (int j = 0; j < 8; ++j) { const f32x4 g = *(const f32x4*)(gpost + EO(j)); v0[j] = v0[j] + d0[j] * r0 * g; v1[j] = v1[j] + d1[j] * r1 * g; } }
        if (src == 0 && !write_y) {
#pragma unroll
            for (int jj = 0; jj < 4; ++jj) { X24_ST2(v0[2 * jj], v0[2 * jj + 1], m0, jj); if (two) X24_ST2(v1[2 * jj], v1[2 * jj + 1], m1, jj); } }
        if (write_y) {
#pragma unroll
            for (int j = 0; j < 8; ++j) { __builtin_nontemporal_store(v0[j], (f32x4*)(c.out + O_YP + (size_t)m0 * D + EO(j))); if (two) __builtin_nontemporal_store(v1[j], (f32x4*)(c.out + O_YP + (size_t)m1 * D + EO(j))); }
            continue; }
        float q0 = 0.f, q1 = 0.f;
#pragma unroll
        for (int j = 0; j < 8; ++j) { q0 += (v0[j].x * v0[j].x + v0[j].y * v0[j].y) + (v0[j].z * v0[j].z + v0[j].w * v0[j].w); q1 += (v1[j].x * v1[j].x + v1[j].y * v1[j].y) + (v1[j].z * v1[j].z + v1[j].w * v1[j].w); }
        const float t0 = rsqrtf(wave_sum_dpp(q0) * (1.f / D) + EPS), t1 = rsqrtf(wave_sum_dpp(q1) * (1.f / D) + EPS);
        bf16_t* xn0 = ((src == 2) ? WS_PTR(bf16_t, WS_MEMN) : XN) + (size_t)m0 * D; bf16_t* xn1 = ((src == 2) ? WS_PTR(bf16_t, WS_MEMN) : XN) + (size_t)m1 * D;
#pragma unroll
        for (int jj = 0; jj < 4; ++jj) { const f32x4 a0 = v0[2 * jj], b0 = v0[2 * jj + 1], a1 = v1[2 * jj], b1 = v1[2 * jj + 1]; u32x4 w0, w1;
            w0.x = pk2(a0.x * t0, a0.y * t0); w0.y = pk2(a0.z * t0, a0.w * t0); w0.z = pk2(b0.x * t0, b0.y * t0); w0.w = pk2(b0.z * t0, b0.w * t0);
            w1.x = pk2(a1.x * t1, a1.y * t1); w1.y = pk2(a1.z * t1, a1.w * t1); w1.z = pk2(b1.x * t1, b1.y * t1); w1.w = pk2(b1.z * t1, b1.w * t1);
            *(u32x4*)(xn0 + EB(jj)) = w0; if (two) *(u32x4*)(xn1 + EB(jj)) = w1; }
    }
#undef EO
#undef EB
#undef LD_BF8
#undef ADD_BF8
#undef X24_LD2
#undef X24_ST2
}
__device__ __forceinline__ void ph_skinny(CtxP cp, int var, LAS unsigned char* lds) {
    CTX_LOAD(cp);
    const int bid_ = obid(), grid_ = ogrid(); const int tid = otid(), lane = tid & 63, wave = tid >> 6, n16 = lane & 15, q = lane >> 4;
    const bf16_t* Wb = WS_PTR(bf16_t, WS_WSKB) + (size_t)var * 32 * D + (size_t)n16 * D + 8 * q + 256 * wave;
    bf16x8s wa[8], wb[8];
#pragma unroll
    for (int ks = 0; ks < 8; ++ks) { wa[ks] = *(const bf16x8s*)(Wb + 32 * ks); wb[ks] = *(const bf16x8s*)(Wb + (size_t)16 * D + 32 * ks); }
    LAS float* P = (LAS float*)lds;
    const bf16_t* xp = WS_PTR(bf16_t, WS_XN) + (size_t)n16 * D + 8 * q + 256 * wave;
    __syncthreads();
    bf16x8s xb[8];
#pragma unroll
    for (int ks = 0; ks < 8; ++ks) xb[ks] = *(const bf16x8s*)(xp + (size_t)(16 * bid_) * D + 32 * ks);
    int nt = 0;
    for (int rt = bid_; rt < M / 16; rt += grid_, ++nt) {
        bf16x8s xn[8]; const int rn = rt + grid_;
        if (rn < M / 16) {
#pragma unroll
            for (int ks = 0; ks < 8; ++ks) xn[ks] = *(const bf16x8s*)(xp + (size_t)(16 * rn) * D + 32 * ks); }
        else {
#pragma unroll
            for (int ks = 0; ks < 8; ++ks) xn[ks] = xb[ks]; }
        f32x4 a0 = {0.f, 0.f, 0.f, 0.f}, a1 = {0.f, 0.f, 0.f, 0.f};
#pragma unroll
        for (int ks = 0; ks < 8; ++ks) { a0 = __builtin_amdgcn_mfma_f32_16x16x32_bf16(wa[ks], xb[ks], a0, 0, 0, 0); a1 = __builtin_amdgcn_mfma_f32_16x16x32_bf16(wb[ks], xb[ks], a1, 0, 0, 0); }
        LAS float* pp = P + (size_t)((nt * 8 + wave) * 8) * 64 + lane;
#pragma unroll
        for (int i = 0; i < 4; ++i) { pp[i * 64] = a0[i]; pp[(4 + i) * 64] = a1[i]; }
#pragma unroll
        for (int ks = 0; ks < 8; ++ks) xb[ks] = xn[ks];
    }
    __syncthreads();
    const int cc = (wave < 4) ? 4 * q + wave : 16 + 4 * q + (wave - 4);
    for (int t = 0; t < nt; ++t) { const int m = 16 * (bid_ + t * grid_) + n16; float s = 0.f;
#pragma unroll
        for (int w = 0; w < 8; ++w) s += P[(size_t)((t * 8 + w) * 8 + wave) * 64 + lane];
        if (var < 2) {
            if (cc < 12) WS_PTR(float, WS_G)[(size_t)m * 12 + cc] = -exp_fast(c.in[I_ALOG][var * 12 + cc]) * softplus_fast(s + c.in[I_DTB][var * 12 + cc]);
            else if (cc < 24) WS_PTR(float, WS_BETA)[(size_t)m * 12 + (cc - 12)] = fast_sigmoid(s); }
        else if (cc < 12) { const float lf = -softplus_fast(-(s + c.in[I_BF][cc])); WS_PTR(float, WS_LOGF)[(size_t)m * 12 + cc] = lf;
            c.out[(m < MP ? O_PLOGF + (size_t)m * 12 : O_SLOGF + (size_t)(m - MP) * 12) + cc] = lf; } }
    __syncthreads();
}
__device__ __forceinline__ void ph_gdn_c(CtxP cp, int l) {
    CTX_LOAD(cp);
    const int bid_ = obid(), grid_ = ogrid(); const int tid = otid(), lane = tid & 63, wave = tid >> 6, gw = bid_ * 8 + wave, NGW = grid_ * 8, sub = lane >> 4, c8 = (lane & 15) * 8;
    const bf16_t* PROJ = WS_PTR(bf16_t, WS_PROJ); const bf16_t* Of = WS_PTR(bf16_t, WS_OF); bf16_t* ACT = WS_PTR(bf16_t, WS_ACT);
    const f32x4 g0 = *(const f32x4*)(c.in[I_GDNN] + l * HD + c8), g1 = *(const f32x4*)(c.in[I_GDNN] + l * HD + c8 + 4);
    for (int it = gw * 4 + sub; it < M * H; it += NGW * 4) { const int m = it / H, h = it % H;
        const u32x4 ou = __builtin_nontemporal_load((const u32x4*)(Of + (size_t)m * TOK + h * HD + c8));
        const f32x4 o0 = {bflo(ou.x), bfhi(ou.x), bflo(ou.y), bfhi(ou.y)}, o1 = {bflo(ou.z), bfhi(ou.z), bflo(ou.w), bfhi(ou.w)};
        const u32x4 zu = __builtin_nontemporal_load((const u32x4*)(PROJ + (size_t)m * PJ + QKV + h * HD + c8));
        float ss = (o0.x * o0.x + o0.y * o0.y) + (o0.z * o0.z + o0.w * o0.w) + (o1.x * o1.x + o1.y * o1.y) + (o1.z * o1.z + o1.w * o1.w);
        ss += __int_as_float(__builtin_amdgcn_update_dpp(0, __float_as_int(ss), 0x111, 0xf, 0xf, true)); ss += __int_as_float(__builtin_amdgcn_update_dpp(0, __float_as_int(ss), 0x112, 0xf, 0xf, true));
        ss += __int_as_float(__builtin_amdgcn_update_dpp(0, __float_as_int(ss), 0x114, 0xf, 0xf, true)); ss += __int_as_float(__builtin_amdgcn_update_dpp(0, __float_as_int(ss), 0x118, 0xf, 0xf, true));
        ss = lane_get(ss, lane | 15);
        const float r = rsqrtf(ss * (1.f / HD) + EPS);
        const float z0 = bflo(zu.x), z1 = bfhi(zu.x), z2 = bflo(zu.y), z3 = bfhi(zu.y), z4 = bflo(zu.z), z5 = bfhi(zu.z), z6 = bflo(zu.w), z7 = bfhi(zu.w);
        u32x4 w4; w4.x = pk2(o0.x * r * g0.x * (z0 * fast_sigmoid(z0)), o0.y * r * g0.y * (z1 * fast_sigmoid(z1))); w4.y = pk2(o0.z * r * g0.z * (z2 * fast_sigmoid(z2)), o0.w * r * g0.w * (z3 * fast_sigmoid(z3)));
        w4.z = pk2(o1.x * r * g1.x * (z4 * fast_sigmoid(z4)), o1.y * r * g1.y * (z5 * fast_sigmoid(z5))); w4.w = pk2(o1.z * r * g1.z * (z6 * fast_sigmoid(z6)), o1.w * r * g1.w * (z7 * fast_sigmoid(z7)));
        *(u32x4*)(ACT + (size_t)m * D + h * HD + c8) = w4; }
}
__device__ __forceinline__ float wave_scan_dpp(float v, int lane, float& total) {
    v += __int_as_float(__builtin_amdgcn_update_dpp(0, __float_as_int(v), 0x111, 0xf, 0xf, true));
    v += __int_as_float(__builtin_amdgcn_update_dpp(0, __float_as_int(v), 0x112, 0xf, 0xf, true));
    v += __int_as_float(__builtin_amdgcn_update_dpp(0, __float_as_int(v), 0x114, 0xf, 0xf, true));
    v += __int_as_float(__builtin_amdgcn_update_dpp(0, __float_as_int(v), 0x118, 0xf, 0xf, true));
    const int iv = __float_as_int(v);
    const float r0 = __int_as_float(__builtin_amdgcn_readlane(iv, 15)), r1 = __int_as_float(__builtin_amdgcn_readlane(iv, 31)), r2 = __int_as_float(__builtin_amdgcn_readlane(iv, 47)), r3 = __int_as_float(__builtin_amdgcn_readlane(iv, 63));
    const int row = lane >> 4; total = ((r0 + r1) + r2) + r3;
    return v + (row == 0 ? 0.f : row == 1 ? r0 : row == 2 ? r0 + r1 : (r0 + r1) + r2);
}
__device__ __forceinline__ void ph_cumsum(CtxP cp) {
    CTX_LOAD(cp);
    const int bid_ = obid(), grid_ = ogrid(); const int tid = otid(), lane = tid & 63, wave = tid >> 6, NGW = grid_ * 8;
    const float* LOGF = WS_PTR(float, WS_LOGF); float* CUMP = WS_PTR(float, WS_CUMP); float* CUMS = WS_PTR(float, WS_CUMS);
    for (int task = bid_ + grid_ * wave; task < 192 + 384; task += NGW) {
        const bool smp = task >= 192; int b, h, jb, n; float carry = 0.f;
        if (!smp) { const int seg = task / 48, ts = task % 48; b = ts / 12; h = ts % 12; jb = seg * 1024; n = jb + 1024; float ps = 0.f;
#pragma unroll 16
            for (int j = lane; j < jb; j += 64) ps += LOGF[(size_t)(b * 4096 + j) * 12 + h];
            carry = wave_sum_dpp(ps); }
        else { const int ts = task - 192; b = ts / 12; h = ts % 12; jb = 0; n = PAST + 32; }
        for (int j0 = jb; j0 < n; j0 += 1024) { float vv[16];
#pragma unroll
            for (int u = 0; u < 16; ++u) { const int j = j0 + 64 * u + lane; vv[u] = 0.f;
                if (j < n) vv[u] = !smp ? LOGF[(size_t)(b * 4096 + j) * 12 + h] : (j < PAST ? c.in[I_CLOGF][(size_t)(b * PAST + j) * 12 + h] : LOGF[(size_t)(MP + b * 32 + j - PAST) * 12 + h]); }
#pragma unroll
            for (int u = 0; u < 16; ++u) { const int j = j0 + 64 * u + lane; float tot; const float v = wave_scan_dpp(vv[u], lane, tot);
                if (j < n) { if (smp) CUMS[(size_t)(b * (PAST + 32) + j) * 12 + h] = carry + v; else { CUMP[(size_t)(b * 4096 + j) * 12 + h] = carry + v;
                        const float cr = (carry + v) * (1.f / SCALE); const unsigned c1 = pk2(cr, 0.f) & 0xffffu; const float r1 = cr - __uint_as_float(c1 << 16); const unsigned c2 = pk2(r1, 0.f) & 0xffffu;
                        const float r2 = r1 - __uint_as_float(c2 << 16); const unsigned c3 = pk2(r2, 0.f) & 0xffffu; const size_t o8 = ((size_t)(b * 12 + h) * 4096 + j) * 8;
                        u32x4 qv, kv; qv.x = c1 | (c2 << 16); qv.y = c3 | 0x3f800000u; qv.z = 0x3f803f80u; qv.w = 0u; kv.x = 0x3f803f80u; kv.y = 0x3f80u | ((c1 ^ 0x8000u) << 16); kv.z = (c2 ^ 0x8000u) | ((c3 ^ 0x8000u) << 16); kv.w = 0u;
                        *(u32x4*)(WS_PTR(bf16_t, WS_QX) + o8) = qv; *(u32x4*)(WS_PTR(bf16_t, WS_KX) + o8) = kv; } }
                carry += tot; } }
    }
}
typedef short bf16x8 __attribute__((ext_vector_type(8)));
typedef float f32x16 __attribute__((ext_vector_type(16)));
constexpr int GT_W = 0, GT_QG = 16384, GT_KG = 32768, GT_AT = 49152, GT_U = 57344, GT_BYTES = 73728;
constexpr int NTASK_P = 4 * 12 * 64, NTASK = NTASK_P + 384;
constexpr size_t WS_GDNBUF = WS_BIG;
static_assert((size_t)NTASK * GT_BYTES <= 306 * MiB, "GDNBUF must not reach WS_OF");
__device__ __forceinline__ int permpos(int x) { return (x & ~31) | (((x >> 2) & 3) << 3) | (((x >> 4) & 1) << 2) | (x & 3); }
__device__ __forceinline__ int crow32(int r, int hi) { return (r & 3) + 8 * (r >> 2) + 4 * hi; }
constexpr int L_KN = 0, L_QN = 17408, L_VBT = 34816, L_KBT = 53248, L_AS = 71680, L_TS = 88320, L_KGT = 97536, L_ATP = 113920, L_GS = 122112, L_BS = 122368, L_TD = 122624, L_CW = 131072;
#define LDS_BARRIER() do { asm volatile("s_waitcnt lgkmcnt(0)" ::: "memory"); __builtin_amdgcn_s_barrier(); asm volatile("" ::: "memory"); } while (0)
__device__ __forceinline__ void ph_gdn_prep(CtxP cp, int l, LAS unsigned char* lds) {
    CTX_LOAD(cp);
    const int bid_ = obid(), grid_ = ogrid(); const int tid0 = otid();
    const bf16_t* PROJ = WS_PTR(bf16_t, WS_PROJ); const float* cw = c.in[I_CONVW] + (size_t)l * 4 * QKV;
    LAS float* Gs = (LAS float*)(lds + L_GS); LAS float* Bs = (LAS float*)(lds + L_BS); LAS float* As = (LAS float*)(lds + L_AS);
    unsigned warm = 0u;
    for (int tk = bid_; tk < NTASK; tk += grid_) {
        asm volatile("" :: "v"(warm));
        int tid = tid0; asm volatile("" : "+v"(tid));
        const int lane = tid & 63, w = __builtin_amdgcn_readfirstlane(tid >> 6);
        int grp, b, h, ch, L, m0, t0;
        if (tk < NTASK_P) { grp = 0; ch = tk & 63; const int bh = tk >> 6; b = bh / 12; h = bh % 12; L = 64; t0 = ch * 64; m0 = b * 4096 + t0; }
        else { grp = 1; ch = 0; const int bh = tk - NTASK_P; b = bh / 12; h = bh % 12; L = 32; t0 = 0; m0 = MP + b * 32; }
        const int T = grp ? 32 : 4096, nb = grp ? 32 : 4;
        unsigned char* gb = c.ws + WS_GDNBUF + (size_t)tk * GT_BYTES;
        if (tid >= 128) { const int e4 = 4 * (tid - 128); *(LAS f32x4*)(lds + L_CW + e4 * 4) = *(const f32x4*)(cw + (size_t)((e4 >> 7) & 3) * QKV + (e4 >> 9) * TOK + h * HD + (e4 & 127)); }
        if (tid < 64) { const bool v = tid < L; float gv = v ? WS_PTR(float, WS_G)[(size_t)(m0 + tid) * 12 + h] : 0.f; const float bv = v ? WS_PTR(float, WS_BETA)[(size_t)(m0 + tid) * 12 + h] : 0.f;
#pragma unroll
            for (int o = 1; o < 64; o <<= 1) { const float n = lane_get(gv, lane - o); if (lane >= o) gv += n; }
            Gs[tid] = gv; Bs[tid] = bv; }
        LDS_BARRIER();
        const int r = tid >> 3, seg = tid & 7; const bool valid = r < L; const int t = t0 + r, m = m0 + r;
        const float gr = Gs[r], eg = expf(gr), egl = expf(Gs[63] - gr), bt = Bs[r]; const int pr = permpos(r);
#pragma unroll
        for (int pi = 0; pi < 3; ++pi) { const int part = (pi == 0) ? 1 : (pi == 1 ? 0 : 2);
            const int col0 = part * TOK + h * HD + 16 * seg; float y[16];
#pragma unroll
            for (int e = 0; e < 16; ++e) y[e] = 0.f;
            if (valid) {
#pragma unroll
                for (int jj = 0; jj < 4; ++jj) { const int tt = t - 3 + jj; float x[16];
                    if (tt >= 0) { const u32x4 a = *(const u32x4*)(PROJ + (size_t)(m - 3 + jj) * PJ + col0), bq = *(const u32x4*)(PROJ + (size_t)(m - 3 + jj) * PJ + col0 + 8);
                        x[0] = bflo(a.x); x[1] = bfhi(a.x); x[2] = bflo(a.y); x[3] = bfhi(a.y); x[4] = bflo(a.z); x[5] = bfhi(a.z); x[6] = bflo(a.w); x[7] = bfhi(a.w);
                        x[8] = bflo(bq.x); x[9] = bfhi(bq.x); x[10] = bflo(bq.y); x[11] = bfhi(bq.y); x[12] = bflo(bq.z); x[13] = bfhi(bq.z); x[14] = bflo(bq.w); x[15] = bfhi(bq.w); }
                    else if (grp) { const float* hp = c.in[I_SCONV] + (size_t)((l * 32 + b) * 3 + (3 + tt)) * QKV + col0;
#pragma unroll
                        for (int i = 0; i < 4; ++i) { const f32x4 a = *(const f32x4*)(hp + 4 * i); x[4 * i] = a.x; x[4 * i + 1] = a.y; x[4 * i + 2] = a.z; x[4 * i + 3] = a.w; } }
                    else {
#pragma unroll
                        for (int e = 0; e < 16; ++e) x[e] = 0.f; }
#pragma unroll
                    for (int i = 0; i < 4; ++i) { const f32x4 wv = *(const LAS f32x4*)(lds + L_CW + ((part * 4 + jj) * 128 + 16 * seg + 4 * i) * 4);
                        y[4 * i] += x[4 * i] * wv.x; y[4 * i + 1] += x[4 * i + 1] * wv.y; y[4 * i + 2] += x[4 * i + 2] * wv.z; y[4 * i + 3] += x[4 * i + 3] * wv.w; } }
                if (t >= T - 3) { const u32x4 a = *(const u32x4*)(PROJ + (size_t)m * PJ + col0), bq = *(const u32x4*)(PROJ + (size_t)m * PJ + col0 + 8);
                    float* dst = c.out + (grp ? O_SCONV : O_PCONV) + (size_t)((l * nb + b) * 3 + (t - (T - 3))) * QKV + col0;
                    *(f32x4*)(dst) = (f32x4){bflo(a.x), bfhi(a.x), bflo(a.y), bfhi(a.y)}; *(f32x4*)(dst + 4) = (f32x4){bflo(a.z), bfhi(a.z), bflo(a.w), bfhi(a.w)};
                    *(f32x4*)(dst + 8) = (f32x4){bflo(bq.x), bfhi(bq.x), bflo(bq.y), bfhi(bq.y)}; *(f32x4*)(dst + 12) = (f32x4){bflo(bq.z), bfhi(bq.z), bflo(bq.w), bfhi(bq.w)}; }
#pragma unroll
                for (int e = 0; e < 16; ++e) y[e] = y[e] * fast_sigmoid(y[e]);
            }
            if (part < 2) { float ss = 0.f;
#pragma unroll
                for (int e = 0; e < 16; ++e) ss += y[e] * y[e];
                ss += lane_get(ss, lane ^ 1); ss += lane_get(ss, lane ^ 2); ss += lane_get(ss, lane ^ 4);
                const float rn = rsqrtf(ss + EPS) * (part == 0 ? SCALE : 1.f);
#pragma unroll
                for (int e = 0; e < 16; ++e) y[e] *= rn;
                u32x4 p0, p1; p0.x = pk2(y[0], y[1]); p0.y = pk2(y[2], y[3]); p0.z = pk2(y[4], y[5]); p0.w = pk2(y[6], y[7]); p1.x = pk2(y[8], y[9]); p1.y = pk2(y[10], y[11]); p1.z = pk2(y[12], y[13]); p1.w = pk2(y[14], y[15]);
                const int dst = (part == 1 ? L_KN : L_QN) + r * 272 + seg * 32;
                *(LAS u32x4*)(lds + dst) = p0; *(LAS u32x4*)(lds + dst + 16) = p1; }
            if (part == 1) {
#pragma unroll
                for (int e = 0; e < 16; ++e) { const int col = 16 * seg + e;
                    *(LAS bf16_t*)(lds + L_KBT + col * 144 + (((r >> 3) ^ seg) << 4) + (r & 7) * 2) = (bf16_t)(pk2(bt * eg * y[e], 0.f) & 0xffffu);
                    *(LAS bf16_t*)(lds + L_KGT + col * 128 + (((pr >> 3) ^ seg) << 4) + (pr & 7) * 2) = (bf16_t)(pk2(egl * y[e], 0.f) & 0xffffu); } }
            else if (part == 0) {
#pragma unroll
                for (int q4 = 0; q4 < 4; ++q4) { u32x2 v2; v2.x = pk2(eg * y[4 * q4], eg * y[4 * q4 + 1]); v2.y = pk2(eg * y[4 * q4 + 2], eg * y[4 * q4 + 3]);
                    __builtin_nontemporal_store(v2, (u32x2*)(gb + GT_QG + r * 256 + (32 * (seg >> 1) + 8 * q4 + 4 * (seg & 1)) * 2)); } }
            else {
#pragma unroll
                for (int e = 0; e < 16; ++e) *(LAS bf16_t*)(lds + L_VBT + (16 * seg + e) * 144 + (((r >> 3) ^ seg) << 4) + (r & 7) * 2) = (bf16_t)(pk2(bt * y[e], 0.f) & 0xffffu); }
            __builtin_amdgcn_sched_barrier(0);
        }
        if (tid == 0) WS_PTR(float, WS_EGL)[tk] = expf(Gs[63]);
        { const int tkn = tk + grid_;
            if (tkn < NTASK && tid < 402) { int m0n, hn; if (tkn < NTASK_P) { const int bh = tkn >> 6; hn = bh % 12; m0n = (bh / 12) * 4096 + (tkn & 63) * 64; } else { const int bh = tkn - NTASK_P; hn = bh % 12; m0n = MP + (bh / 12) * 32; }
                const int row = tid / 6, rem = tid % 6; int mm = m0n - 3 + row; mm = mm < 0 ? 0 : (mm >= M ? M - 1 : mm);
                warm = *(const volatile unsigned*)(PROJ + (size_t)mm * PJ + (rem >> 1) * TOK + hn * HD + (rem & 1) * 64); } }
        LDS_BARRIER();
        { const int r32 = lane & 31, hi = lane >> 5;
            if (w < 6) { const int which = w / 3, tt3 = w % 3, ib = tt3 ? 1 : 0, jb = (tt3 == 2) ? 1 : 0; f32x16 acc = {};
                const int xoff = (which ? L_QN : L_KN) + (ib * 32 + r32) * 272 + hi * 16, koff = L_KN + (jb * 32 + r32) * 272 + hi * 16;
#pragma unroll
                for (int kk = 0; kk < 8; ++kk) { const bf16x8 a = *(const LAS bf16x8*)(lds + xoff + kk * 32), bq = *(const LAS bf16x8*)(lds + koff + kk * 32);
                    acc = __builtin_amdgcn_mfma_f32_32x32x16_bf16(a, bq, acc, 0, 0, 0); }
                const int j = jb * 32 + r32; const float gj = Gs[j]; const int pj = permpos(j);
#pragma unroll
                for (int rr = 0; rr < 16; ++rr) { const int i = ib * 32 + crow32(rr, hi); const float dec = expf(fminf(Gs[i] - gj, 0.f));
                    if (which == 0) As[i * 65 + j] = (i > j) ? Bs[i] * acc[rr] * dec : 0.f;
                    else *(LAS bf16_t*)(lds + L_ATP + i * 128 + pj * 2) = (bf16_t)(pk2((i >= j) ? acc[rr] * dec : 0.f, 0.f) & 0xffffu); } }
            else { const int j = 32 + r32;
#pragma unroll
                for (int rr = 0; rr < 16; ++rr) { const int i = crow32(rr, hi);
                    if (w == 6) As[i * 65 + j] = 0.f; else *(LAS bf16_t*)(lds + L_ATP + i * 128 + permpos(j) * 2) = (bf16_t)0; } } }
        LDS_BARRIER();
        if (w == 0) { const int blk = lane >> 5, col = lane & 31, r32 = col, hi = blk; float x[32];
            const LAS float* Asv = As + blk * (32 * 65 + 32); asm volatile("" : "+v"(Asv));
            LAS float* Td = (LAS float*)(lds + L_TD);
#pragma unroll
            for (int i = 0; i < 32; ++i) { float a = (col == i) ? 1.f : 0.f;
#pragma unroll
                for (int j = 0; j < i; ++j) a -= Asv[i * 65 + j] * x[j];
                x[i] = a; Td[blk * (32 * 33) + i * 33 + col] = a;
                *(LAS bf16_t*)(lds + L_TS + (blk * 32 + i) * 144 + (blk * 32 + col) * 2) = (bf16_t)(pk2(a, 0.f) & 0xffffu);
                if (blk) *(LAS bf16_t*)(lds + L_TS + i * 144 + (32 + col) * 2) = (bf16_t)0;
                if ((i & 7) == 7) __builtin_amdgcn_sched_barrier(0); }
            f32x16 acc = {};
#pragma unroll
            for (int s = 0; s < 16; ++s) acc = __builtin_amdgcn_mfma_f32_32x32x2f32(As[(32 + r32) * 65 + 2 * s + hi], Td[(2 * s + hi) * 33 + r32], acc, 0, 0, 0);
#pragma unroll
            for (int rr = 0; rr < 16; ++rr) Td[crow32(rr, hi) * 33 + r32] = acc[rr];
            f32x16 acc2 = {};
#pragma unroll
            for (int s = 0; s < 16; ++s) acc2 = __builtin_amdgcn_mfma_f32_32x32x2f32(Td[32 * 33 + r32 * 33 + 2 * s + hi], Td[(2 * s + hi) * 33 + r32], acc2, 0, 0, 0);
#pragma unroll
            for (int rr = 0; rr < 16; ++rr) *(LAS bf16_t*)(lds + L_TS + (32 + crow32(rr, hi)) * 144 + r32 * 2) = (bf16_t)(pk2(-acc2[rr], 0.f) & 0xffffu); }
        LDS_BARRIER();
        { const int r32 = lane & 31, hi = lane >> 5; const int src = (w < 4 ? L_VBT : L_KBT) + ((w & 3) * 32 + r32) * 144, sw = (((w & 3) * 32 + r32) >> 4) & 7;
#pragma unroll
            for (int ib = 0; ib < 2; ++ib) { f32x16 acc = {}; const int toff = L_TS + (ib * 32 + r32) * 144 + hi * 16;
#pragma unroll
                for (int kk = 0; kk < 4; ++kk) { if (kk < 2 * (ib + 1)) { const bf16x8 a = *(const LAS bf16x8*)(lds + toff + kk * 32), bq = *(const LAS bf16x8*)(lds + src + (((2 * kk + hi) ^ sw) << 4));
                        acc = __builtin_amdgcn_mfma_f32_32x32x16_bf16(a, bq, acc, 0, 0, 0); } }
                const int col = (w & 3) * 32 + r32;
                if (w < 4) {
#pragma unroll
                    for (int g = 0; g < 4; ++g) { u32x2 v2; v2.x = pk2(acc[4 * g], acc[4 * g + 1]); v2.y = pk2(acc[4 * g + 2], acc[4 * g + 3]);
                        *(LAS u32x2*)(lds + L_QN + col * 128 + (((4 * ib + g) ^ (col & 7)) << 4) + hi * 8) = v2; } }
                else { const int pc = permpos(col);
#pragma unroll
                    for (int rr = 0; rr < 16; ++rr) { const int i = ib * 32 + crow32(rr, hi); *(LAS bf16_t*)(lds + L_KN + i * 256 + pc * 2) = (bf16_t)(pk2(acc[rr], 0.f) & 0xffffu); } } } }
        LDS_BARRIER();
#pragma unroll
        for (int k = 0; k < 7; ++k) { const int u = tid + 512 * k; int lo, go;
            if (k < 2) { lo = L_KN + u * 16; go = GT_W + u * 16; } else if (k < 4) { const int uu = u - 1024, row = uu >> 3; lo = L_QN + row * 128 + (((uu & 7) ^ (row & 7)) << 4); go = GT_U + uu * 16; }
            else if (k < 6) { const int uu = u - 2048, row = uu >> 3; lo = L_KGT + row * 128 + (((uu & 7) ^ ((row >> 4) & 7)) << 4); go = GT_KG + uu * 16; } else { lo = L_ATP + (u - 3072) * 16; go = GT_AT + (u - 3072) * 16; }
            __builtin_nontemporal_store(*(const LAS u32x4*)(lds + lo), (u32x4*)(gb + go)); }
    }
}
constexpr int SC_W = 0, SC_QG = 17408, SC_KG = 34816, SC_AT = 53248, SC_BUF = 62464, SC_OS = 2 * SC_BUF;
__device__ __forceinline__ void ph_gdn_scan(CtxP cp, int l, LAS unsigned char* lds) {
    CTX_LOAD(cp);
    const int bid_ = obid(), grid_ = ogrid(); const int tid = otid(), lane = tid & 63, w = __builtin_amdgcn_readfirstlane(tid >> 6), m16 = lane & 15, q = lane >> 4;
    const float* EGL = WS_PTR(float, WS_EGL);
    const int nsmpwg = grid_ - 96;
    for (int it = 0;; ++it) {
        int grp, bh, half, nch, tk0;
        if (bid_ < 96) { if (it > 0) break; grp = 0; bh = bid_ >> 1; half = bid_ & 1; nch = 64; tk0 = bh * 64; }
        else { const int si = (bid_ - 96) + nsmpwg * it; if (si >= 768) break; grp = 1; bh = si >> 1; half = si & 1; nch = 1; tk0 = NTASK_P + bh; }
        const int b = bh / 12, h = bh % 12, m0 = grp ? MP + b * 32 : b * 4096;
        __syncthreads();
        if (w >= 4) {
            const int lt = tid - 256; u32x4 stA[14], stB[14];
#define SC_LOAD(ST, tk) do { const unsigned char* gsrc = c.ws + WS_GDNBUF + (size_t)(tk) * GT_BYTES; _Pragma("unroll") for (int k = 0; k < 14; ++k) ST[k] = __builtin_nontemporal_load((const u32x4*)(gsrc + (size_t)(lt + 256 * k) * 16)); } while (0)
#define SC_WRITE(ST, bufoff) do { _Pragma("unroll") for (int k = 0; k < 14; ++k) { const int u = lt + 256 * k; int lo; \
            if (k < 4) lo = SC_W + (u >> 4) * 272 + (u & 15) * 16; else if (k < 8) lo = SC_QG + ((u - 1024) >> 4) * 272 + (u & 15) * 16; \
            else if (k < 12) lo = SC_KG + ((u - 2048) >> 3) * 144 + (u & 7) * 16; else lo = SC_AT + ((u - 3072) >> 3) * 144 + (u & 7) * 16; \
            *(LAS u32x4*)(lds + (bufoff) + lo) = ST[k]; } } while (0)
            bf16_t* Ob = WS_PTR(bf16_t, WS_OF) + (size_t)m0 * TOK + h * HD + half * 64; const int nou = grp ? 256 : 512;
#define SC_OUT(ch_) do { _Pragma("unroll") for (int k = 0; k < 2; ++k) { const int u = lt + 256 * k; if (u < nou) \
                *(u32x4*)(Ob + (size_t)((ch_) * 64 + (u >> 3)) * TOK + (u & 7) * 8) = *(const LAS u32x4*)(lds + SC_OS + ((ch_) & 1) * 8192 + u * 16); } } while (0)
            SC_LOAD(stA, tk0); SC_WRITE(stA, 0);
            if (1 < nch) SC_LOAD(stA, tk0 + 1);
            if (2 < nch) SC_LOAD(stB, tk0 + 2);
            LDS_BARRIER();
            for (int ch = 0; ch < nch; ch += 2) {
                if (ch >= 1) SC_OUT(ch - 1);
                if (ch + 1 < nch) SC_WRITE(stA, ((ch + 1) & 1) * SC_BUF);
                if (ch + 3 < nch) SC_LOAD(stA, tk0 + ch + 3);
                LDS_BARRIER();
                if (ch + 1 < nch) {
                    SC_OUT(ch);
                    if (ch + 2 < nch) SC_WRITE(stB, ((ch + 2) & 1) * SC_BUF);
                    if (ch + 4 < nch) SC_LOAD(stB, tk0 + ch + 4);
                    LDS_BARRIER(); }
            }
            SC_OUT(nch - 1);
#undef SC_OUT
#undef SC_LOAD
#undef SC_WRITE
        } else {
            __builtin_amdgcn_s_setprio(2);
            const int c0 = half * 64 + 16 * w;
            f32x4 S[8];
            if (grp) { const float* S0 = c.in[I_SGDN] + (size_t)((l * 32 + b) * 12 + h) * 16384;
#pragma unroll
                for (int dt = 0; dt < 8; ++dt)
#pragma unroll
                    for (int i = 0; i < 4; ++i) S[dt][i] = S0[(16 * dt + 4 * q + i) * 128 + c0 + m16]; }
            else {
#pragma unroll
                for (int dt = 0; dt < 8; ++dt) S[dt] = (f32x4){0.f, 0.f, 0.f, 0.f}; }
            u32x2 un[4]; float egn;
#define UE_LOAD(tk_) do { const unsigned char* ut_ = c.ws + WS_GDNBUF + (size_t)(tk_) * GT_BYTES + GT_U + (c0 + m16) * 128 + 8 * q; \
            _Pragma("unroll") for (int mt = 0; mt < 4; ++mt) un[mt] = *(const u32x2*)(ut_ + 32 * mt); egn = EGL[tk_]; } while (0)
            UE_LOAD(tk0);
            LDS_BARRIER();
            for (int ch = 0; ch < nch; ++ch) { const int bo = (ch & 1) * SC_BUF; const int tk = tk0 + ch;
                u32x2 uc[4]; const float egl = egn;
#pragma unroll
                for (int mt = 0; mt < 4; ++mt) uc[mt] = un[mt];
                if (ch + 1 < nch) UE_LOAD(tk + 1);
                bf16x8 Sb[4];
#pragma unroll
                for (int ks = 0; ks < 4; ++ks) { u32x4 t4; t4.x = pk2(S[2 * ks][0], S[2 * ks][1]); t4.y = pk2(S[2 * ks][2], S[2 * ks][3]); t4.z = pk2(S[2 * ks + 1][0], S[2 * ks + 1][1]); t4.w = pk2(S[2 * ks + 1][2], S[2 * ks + 1][3]);
                    Sb[ks] = __builtin_bit_cast(bf16x8, t4); }
                f32x4 Vn[4], Out[4];
#pragma unroll
                for (int mt = 0; mt < 4; ++mt) { f32x4 a1 = {0.f, 0.f, 0.f, 0.f}, a2 = {0.f, 0.f, 0.f, 0.f};
#pragma unroll
                    for (int ks = 0; ks < 4; ++ks) { const bf16x8 aw = *(const LAS bf16x8*)(lds + bo + SC_W + (16 * mt + m16) * 272 + ks * 64 + q * 16), aq = *(const LAS bf16x8*)(lds + bo + SC_QG + (16 * mt + m16) * 272 + ks * 64 + q * 16);
                        a1 = __builtin_amdgcn_mfma_f32_16x16x32_bf16(aw, Sb[ks], a1, 0, 0, 0); a2 = __builtin_amdgcn_mfma_f32_16x16x32_bf16(aq, Sb[ks], a2, 0, 0, 0); }
                    const u32x2 uu = uc[mt];
                    Vn[mt] = (f32x4){bflo(uu.x) - a1[0], bfhi(uu.x) - a1[1], bflo(uu.y) - a1[2], bfhi(uu.y) - a1[3]}; Out[mt] = a2; }
                bf16x8 Vb[2];
#pragma unroll
                for (int ks = 0; ks < 2; ++ks) { u32x4 t4; t4.x = pk2(Vn[2 * ks][0], Vn[2 * ks][1]); t4.y = pk2(Vn[2 * ks][2], Vn[2 * ks][3]); t4.z = pk2(Vn[2 * ks + 1][0], Vn[2 * ks + 1][1]); t4.w = pk2(Vn[2 * ks + 1][2], Vn[2 * ks + 1][3]);
                    Vb[ks] = __builtin_bit_cast(bf16x8, t4); }
#pragma unroll
                for (int mt = 0; mt < 4; ++mt)
#pragma unroll
                    for (int ks = 0; ks < 2; ++ks) { const bf16x8 aa = *(const LAS bf16x8*)(lds + bo + SC_AT + (16 * mt + m16) * 144 + ks * 64 + q * 16);
                        Out[mt] = __builtin_amdgcn_mfma_f32_16x16x32_bf16(aa, Vb[ks], Out[mt], 0, 0, 0); }
#pragma unroll
                for (int dt = 0; dt < 8; ++dt) { S[dt] = S[dt] * egl;
#pragma unroll
                    for (int ks = 0; ks < 2; ++ks) { const bf16x8 ak = *(const LAS bf16x8*)(lds + bo + SC_KG + (16 * dt + m16) * 144 + ks * 64 + q * 16);
                        S[dt] = __builtin_amdgcn_mfma_f32_16x16x32_bf16(ak, Vb[ks], S[dt], 0, 0, 0); } }
#pragma unroll
                for (int mt = 0; mt < 4; ++mt)
#pragma unroll
                    for (int e = 0; e < 4; ++e) *(LAS bf16_t*)(lds + SC_OS + (ch & 1) * 8192 + (16 * mt + 4 * q + e) * 128 + (16 * w + m16) * 2) = (bf16_t)(pk2(Out[mt][e], 0.f) & 0xffffu);
                LDS_BARRIER();
            }
            float* So = c.out + (grp ? O_SGDN + (size_t)((l * 32 + b) * 12 + h) * 16384 : O_PGDN + (size_t)((l * 4 + b) * 12 + h) * 16384);
#pragma unroll
            for (int dt = 0; dt < 8; ++dt)
#pragma unroll
                for (int i = 0; i < 4; ++i) So[(16 * dt + 4 * q + i) * 128 + c0 + m16] = S[dt][i];
            __builtin_amdgcn_s_setprio(0);
#undef UE_LOAD
        }
    }
}
#undef LDS_BARRIER
#define XB_TMO      128
#define XB_XCNT(j)  (256  + 64 * (j))
#define XB_XSUB(j)  (1280 + 64 * (j))
#define XB_XGEN(j)  (2304 + 64 * (j))
#define XB_TOP      3328
#define XB_TOPGEN   3392
#define XCD_BAR_WORDS 3456
#define XB_SPIN_CAP (1u << 18)

__device__ __forceinline__ unsigned xb_ld(unsigned* p)              { return __hip_atomic_load(p, __ATOMIC_RELAXED, __HIP_MEMORY_SCOPE_AGENT); }
__device__ __forceinline__ unsigned xb_add(unsigned* p, unsigned v) { return __hip_atomic_fetch_add(p, v, __ATOMIC_RELAXED, __HIP_MEMORY_SCOPE_AGENT); }
__device__ __forceinline__ unsigned xb_xcc_id() { return (unsigned)__builtin_amdgcn_s_getreg((3 << 11) | 20) & 0xFu; }
#define XB_SPIN(cond, bar) do { unsigned _sp = 0; while (cond) { __builtin_amdgcn_s_sleep(1); \
    if ((++_sp & 255u) == 0u) { if (xb_ld(&(bar)[XB_TMO])) break; if (_sp > XB_SPIN_CAP) { atomicAdd(&(bar)[XB_TMO], 1u); break; } } } } while (0)
struct XcdBarrier {
    unsigned* bar; unsigned x;
    volatile LAS unsigned* st;
};

__device__ __forceinline__ XcdBarrier xcd_barrier_post(unsigned* bar, volatile LAS unsigned* st) {
    XcdBarrier b; b.bar = bar; b.x = xb_xcc_id(); b.st = st;
    if (threadIdx.x == 0) (void)xb_add(&bar[XB_XCNT(b.x)], 1u);
    return b;
}
__device__ __forceinline__ void xcd_barrier_complete(unsigned* bar, unsigned x, unsigned& nloc, unsigned& nx) {
    const unsigned G = gridDim.x * gridDim.y * gridDim.z;
    unsigned sum, cnt, mine, sp = 0u;
    for (;;) {
        sum = 0u; cnt = 0u; mine = 0u;
#pragma unroll
        for (unsigned j = 0; j < 16; ++j) { const unsigned c = xb_ld(&bar[XB_XCNT(j)]); sum += c; cnt += (c > 0u) ? 1u : 0u; mine = (j == x) ? c : mine; }
        if (sum == G) break;
        __builtin_amdgcn_s_sleep(1);
        if ((++sp & 255u) == 0u) { if (xb_ld(&bar[XB_TMO])) break; if (sp > XB_SPIN_CAP) { atomicAdd(&bar[XB_TMO], 1u); break; } }
    }
    nloc = mine > 0u ? mine : 1u; nx = cnt > 0u ? cnt : 1u;
}

__device__ __forceinline__ void xcd_barrier(const XcdBarrier& b, const bool leader  ) {
    asm volatile("s_waitcnt vmcnt(0)" ::: "memory");
    __syncthreads();
    if (leader) {
        unsigned* bar = b.bar;
        __builtin_amdgcn_s_waitcnt(0);
        unsigned nloc = b.st[0], nx = b.st[1];
        if (nloc == 0u) { xcd_barrier_complete(bar, b.x, nloc, nx); b.st[0] = nloc; b.st[1] = nx; }
        const unsigned old = xb_add(&bar[XB_XSUB(b.x)], 1u);
        const unsigned gen = old / nloc;
        if (old + 1u == (gen + 1u) * nloc) {
            __builtin_amdgcn_fence(__ATOMIC_RELEASE, "agent");
            asm volatile("s_waitcnt vmcnt(0)" ::: "memory");
            const unsigned og = xb_add(&bar[XB_TOP], 1u);
            const unsigned tg = og / nx;
            if (og + 1u == (tg + 1u) * nx) xb_add(&bar[XB_TOPGEN], 1u);
            else XB_SPIN(xb_ld(&bar[XB_TOPGEN]) == tg, bar);
            __builtin_amdgcn_fence(__ATOMIC_ACQUIRE, "agent");
            xb_add(&bar[XB_XGEN(b.x)], 1u);
            asm volatile("s_waitcnt vmcnt(0)" ::: "memory");
        } else {
            XB_SPIN(xb_ld(&bar[XB_XGEN(b.x)]) == gen, bar);
            __builtin_amdgcn_fence(__ATOMIC_ACQUIRE, "agent");
            asm volatile("s_waitcnt vmcnt(0)" ::: "memory");
        }
    }
    __syncthreads();
}
namespace fa {
constexpr int NW = 8, QBLK = 32, KVBLK = 64, QB = NW * QBLK, HDm = 128;
constexpr int SHM_V = KVBLK * HDm * 2, SHM_K = KVBLK * HDm * 2;
constexpr int LDS_BYTES = 2 * SHM_V + 2 * SHM_K + NW * 64 * 4;
constexpr float THR = 8.f;
constexpr int XOFF = LDS_BYTES + 64, XBUF = 2048;
typedef short s16x4 __attribute__((ext_vector_type(4)));
#define KSWZ(row, colB) ((row) * 256 + ((colB) ^ (((row) & 7) << 4)))
#define SBAR() __builtin_amdgcn_sched_barrier(0)
__device__ __forceinline__ int v_st(int k, int c) { const int kk = (k & ~0xC) | ((k & 4) << 1) | ((k & 8) >> 1); return ((kk >> 3) * 4 + (c >> 5)) * 512 + ((kk & 7) * 32 + (c & 31)) * 2; }
__device__ __forceinline__ int v_rd_base(int lane) { return ((lane & 3) << 3) | (((lane >> 2) & 3) << 6) | (((lane >> 4) & 1) << 5) | (((lane >> 5) & 1) << 8); }
constexpr int v_rd_off(int d0, int ks, int half) { return d0 * 512 + ks * 4096 + half * 2048; }
__device__ __forceinline__ int crow(int r, int hi) { return (r & 3) + 8 * (r >> 2) + 4 * hi; }
__device__ __forceinline__ unsigned cvtpk(float lo, float hi) { unsigned r; asm volatile("v_cvt_pk_bf16_f32 %0, %1, %2" : "=v"(r) : "v"(lo), "v"(hi)); return r; }
__device__ __forceinline__ bf16x8 load8(const bf16_t* p) { return *reinterpret_cast<const bf16x8*>(p); }
__device__ __forceinline__ void mask_tile(f32x16& p0, f32x16& p1, int dq, unsigned W) {
    const float NEG = -__builtin_inff();
#pragma unroll
    for (int r = 0; r < 16; ++r) { const int c = (r & 3) + 8 * (r >> 2);
        if ((unsigned)(dq - c) >= W) p0[r] = NEG;
        if ((unsigned)(dq - c - 32) >= W) p1[r] = NEG; }
}
__device__ __forceinline__ void partialSM(f32x16& p0, f32x16& p1, float& m_reg, float& mn, float& alpha) {
    float pmax = p0[0]; for (int r = 1; r < 16; ++r) pmax = fmaxf(pmax, p0[r]); for (int r = 0; r < 16; ++r) pmax = fmaxf(pmax, p1[r]);
    { auto rr = __builtin_amdgcn_permlane32_swap(__float_as_uint(pmax), __float_as_uint(pmax), false, false);
      pmax = fmaxf(__uint_as_float(rr[0]), __uint_as_float(rr[1])); }
    constexpr float C2 = 1.4426950408889634f * SCALE;
    if (__builtin_expect(__all((pmax - m_reg) * SCALE <= THR), 1)) { mn = m_reg; alpha = 1.f; }
    else { mn = fmaxf(m_reg, pmax); alpha = __builtin_amdgcn_exp2f((m_reg - mn) * C2); m_reg = mn; }
    const float mnL = -mn * C2;
    for (int r = 0; r < 16; ++r) p0[r] = fmaf(p0[r], C2, mnL); for (int r = 0; r < 16; ++r) p1[r] = fmaf(p1[r], C2, mnL);
    for (int r = 0; r < 16; ++r) p0[r] = __builtin_amdgcn_exp2f(p0[r]);
}
__device__ __forceinline__ void finishSM(f32x16& p0, f32x16& p1, float alpha, float& l_reg, bf16x8& pa0, bf16x8& pa1, bf16x8& pa2, bf16x8& pa3) {
    for (int r = 0; r < 16; ++r) p1[r] = __builtin_amdgcn_exp2f(p1[r]);
    float ps = 0; for (int r = 0; r < 16; ++r) ps += p0[r]; for (int r = 0; r < 16; ++r) ps += p1[r];
    { auto rr = __builtin_amdgcn_permlane32_swap(__float_as_uint(ps), __float_as_uint(ps), false, false);
      ps = __uint_as_float(rr[0]) + __uint_as_float(rr[1]); }
    l_reg = l_reg * alpha + ps;
#define PK4(P, B_, OUT) do { unsigned a0 = cvtpk(P[B_+0], P[B_+1]), a1 = cvtpk(P[B_+2], P[B_+3]);                          \
        unsigned b0 = cvtpk(P[B_+4], P[B_+5]), b1 = cvtpk(P[B_+6], P[B_+7]);                                             \
        auto r0 = __builtin_amdgcn_permlane32_swap(a0, b0, false, false); auto r1 = __builtin_amdgcn_permlane32_swap(a1, b1, false, false); \
        u32x4 w = {r0[0], r1[0], r0[1], r1[1]}; OUT = *reinterpret_cast<bf16x8*>(&w); } while (0)
    PK4(p0, 0, pa0); PK4(p0, 8, pa1); PK4(p1, 0, pa2); PK4(p1, 8, pa3);
#undef PK4
}
template <int KB, bool BIAS>
__device__ __forceinline__ void qkt(f32x16& p0, f32x16& p1, const char* K_lds, const char* X_lds, int r32, int hi, const bf16x8* qr, bf16x8 qx) {
    p0 = f32x16{}; p1 = f32x16{};
    const char* kb[4];
#pragma unroll
    for (int dd = 0; dd < 4; ++dd) kb[dd] = K_lds + KB * SHM_K + KSWZ(r32, (dd * 16 + hi * 8) * 2);
    if (BIAS) { const bf16x8 kx0 = *reinterpret_cast<const bf16x8*>(X_lds + KB * XBUF + r32 * 32 + hi * 16), kx1 = *reinterpret_cast<const bf16x8*>(X_lds + KB * XBUF + (32 + r32) * 32 + hi * 16);
        p0 = __builtin_amdgcn_mfma_f32_32x32x16_bf16(kx0, qx, p0, 0, 0, 0); p1 = __builtin_amdgcn_mfma_f32_32x32x16_bf16(kx1, qx, p1, 0, 0, 0); }
#pragma unroll
    for (int d0 = 0; d0 < 8; ++d0) { const char* a = kb[d0 & 3] + (d0 >> 2) * 128;
        bf16x8 b0 = *reinterpret_cast<const bf16x8*>(a);
        bf16x8 b1 = *reinterpret_cast<const bf16x8*>(a + 32 * 256);
        p0 = __builtin_amdgcn_mfma_f32_32x32x16_bf16(b0, qr[d0], p0, 0, 0, 0);
        p1 = __builtin_amdgcn_mfma_f32_32x32x16_bf16(b1, qr[d0], p1, 0, 0, 0); }
}
template <int VB>
__device__ __forceinline__ void pv_tile(f32x16* o, int vb0, bf16x8 pa0, bf16x8 pa1, bf16x8 pa2, bf16x8 pa3) {
#define TRRD(dst, off) asm volatile("ds_read_b64_tr_b16 %0, %1 offset:%2" : "=&v"(dst) : "v"(vb0), "i"(off) : "memory")
#define PV_D0(d0) do { s16x4 l0, l1, l2, l3, h0, h1, h2, h3; constexpr int b_ = VB * SHM_V + v_rd_off(d0, 0, 0); \
        TRRD(l0, b_); TRRD(h0, b_ + 2048); TRRD(l1, b_ + 4096); TRRD(h1, b_ + 6144); TRRD(l2, b_ + 8192); TRRD(h2, b_ + 10240); TRRD(l3, b_ + 12288); TRRD(h3, b_ + 14336); \
        asm volatile("s_waitcnt lgkmcnt(0)" ::: "memory"); SBAR();   \
        o[d0] = __builtin_amdgcn_mfma_f32_32x32x16_bf16(pa0, (bf16x8){l0[0], l0[1], l0[2], l0[3], h0[0], h0[1], h0[2], h0[3]}, o[d0], 0, 0, 0);   \
        o[d0] = __builtin_amdgcn_mfma_f32_32x32x16_bf16(pa1, (bf16x8){l1[0], l1[1], l1[2], l1[3], h1[0], h1[1], h1[2], h1[3]}, o[d0], 0, 0, 0);   \
        o[d0] = __builtin_amdgcn_mfma_f32_32x32x16_bf16(pa2, (bf16x8){l2[0], l2[1], l2[2], l2[3], h2[0], h2[1], h2[2], h2[3]}, o[d0], 0, 0, 0);   \
        o[d0] = __builtin_amdgcn_mfma_f32_32x32x16_bf16(pa3, (bf16x8){l3[0], l3[1], l3[2], l3[3], h3[0], h3[1], h3[2], h3[3]}, o[d0], 0, 0, 0); } while (0)
    PV_D0(0); PV_D0(1); PV_D0(2); PV_D0(3);
#undef PV_D0
#undef TRRD
}
struct Ref { int a, b, c; };
struct Seam { bf16x8 qr[8]; bf16x8 qx; bf16x8 st_v0, st_v1, st_k0, st_k1, st_kx; };
__device__ __forceinline__ int swa_jlo(int P0, int W) { const int lowk = P0 - W + 1; return lowk > 0 ? lowk / KVBLK : 0; }
#define ROW(p, k0, rr) ((p) + (size_t)((k0) + (rr)) * KP + sc)
#define VMW() asm volatile("s_waitcnt vmcnt(0)" ::: "memory")
#define VMWN(n) asm volatile("s_waitcnt vmcnt(%0)" :: "i"(n) : "memory")
#define SLOAD_H(Kp, Vp, k0) do { S.st_v0 = load8(ROW(Vp, k0, sr)); S.st_v1 = load8(ROW(Vp, k0, 32 + sr)); S.st_k0 = load8(ROW(Kp, k0, sr)); S.st_k1 = load8(ROW(Kp, k0, 32 + sr)); } while (0)
#define LOADKX(KXp, k0) do { if (BIAS && tid < 64) S.st_kx = load8((KXp) + (size_t)((k0) + tid) * 8); } while (0)
#define SWRITE_HK(bf) do { *(bf16x8*)(K_lds + (bf) * SHM_K + kws) = S.st_k0; *(bf16x8*)(K_lds + (bf) * SHM_K + kws + 32 * 256) = S.st_k1; if (BIAS && tid < 64) *(bf16x8*)(lds + XOFF + (bf) * XBUF + tid * 32) = S.st_kx; } while (0)
#define SWRITE_HV(bf) do { *(bf16x8*)(V_lds + (bf) * SHM_V + vst0) = S.st_v0; *(bf16x8*)(V_lds + (bf) * SHM_V + vst1) = S.st_v1; } while (0)
#define SWRITE_H(bf) do { SWRITE_HV(bf); SWRITE_HK(bf); } while (0)
template <class Lay>
__device__ __forceinline__ void prime(unsigned char* wsb, const Ref& cur, int W, char* lds, Seam& S, int tid) {
    constexpr int QP = Lay::QP, KP = Lay::KP; constexpr bool BIAS = Lay::BIAS;
    const int wid = __builtin_amdgcn_readfirstlane(tid >> 6), lane = tid & 63, r32 = lane & 31, hi = lane >> 5;
    const int sr = tid >> 4, sc = (tid & 15) * 8, kws = KSWZ(sr, sc * 2); char* K_lds = lds + 2 * SHM_V;
    const int kb0 = swa_jlo(Lay::p0(cur), W) * KVBLK; const bf16_t* Qc = Lay::q(wsb, cur);
#pragma unroll
    for (int d0 = 0; d0 < 8; ++d0) S.qr[d0] = load8(Qc + (size_t)(wid * QBLK + r32) * QP + d0 * 16 + hi * 8);
    S.qx = bf16x8{}; S.st_kx = bf16x8{};
    if (BIAS && tid < 128) { unsigned zz = 0u; asm volatile("" : "+v"(zz)); *(u32x4*)(lds + XOFF + (tid >> 6) * XBUF + (tid & 63) * 32 + 16) = (u32x4){zz, zz, zz, zz}; }
    if (BIAS) S.qx = load8(hi ? Lay::z(wsb) : Lay::qx(wsb, cur) + (size_t)(wid * QBLK + r32) * 8);
    { const bf16_t* Kc = Lay::k(wsb, cur); const bf16_t* Vc = Lay::v(wsb, cur); SLOAD_H(Kc, Vc, kb0); LOADKX(Lay::kx(wsb, cur), kb0); } VMW(); SWRITE_HK(0);
    __syncthreads();
}
template <class Lay>
__device__ __forceinline__ void block(unsigned char* wsb, const Ref& cur, const Ref& nxt, int skv, int W, char* lds, Seam& S, int tid) {
    asm volatile("" : "+v"(tid));
    constexpr int QP = Lay::QP, KP = Lay::KP, OP = Lay::OP; constexpr bool BIAS = Lay::BIAS, GATE = Lay::GATE; const int P0c = Lay::p0(cur);
    const int wid = __builtin_amdgcn_readfirstlane(tid >> 6), lane = tid & 63, r32 = lane & 31, hi = lane >> 5;
    const int j_lo = swa_jlo(P0c, W);
    int j_hi = (P0c + QB - 1) / KVBLK + 1; if (j_hi > skv / KVBLK) j_hi = skv / KVBLK;
    const int NT = j_hi - j_lo;
    const int kbn = swa_jlo(Lay::p0(nxt), W) * KVBLK;
    const int qlo = P0c + wid * QBLK, qm = qlo + r32 - 4 * hi;
    char* V_lds = lds; char* K_lds = lds + 2 * SHM_V;
    float* ws = (float*)(lds + 2 * SHM_V + 2 * SHM_K) + wid * 64; float* li_l = ws, * al_l = ws + 32;
    float m_reg = -1e30f, l_reg = 0; f32x16 o[4] = {};
    const int sr = tid >> 4, sc = (tid & 15) * 8, vst0 = v_st(sr, sc), vst1 = v_st(32 + sr, sc), kws = KSWZ(sr, sc * 2);
    const int vb0 = (int)(uintptr_t)V_lds + v_rd_base(lane);
    const bf16_t* Kh = Lay::k(wsb, cur); const bf16_t* Vh = Lay::v(wsb, cur); const bf16_t* KXh = Lay::kx(wsb, cur);
    const char* X_lds = lds + XOFF;
#define RESC(a) do { if (__any((a) < 1.f)) { if (hi == 0) al_l[r32] = (a); asm volatile("s_waitcnt lgkmcnt(0)" ::: "memory");              \
                     for (int d_ = 0; d_ < 4; ++d_) for (int r = 0; r < 16; ++r) o[d_][r] *= al_l[crow(r, hi)]; } } while (0)
#define KBASE(t) ((j_lo + (t)) * KVBLK)
#define MASKT(P0_, P1_, t) do { const int kb_ = KBASE(t); if (kb_ + KVBLK - 1 > qlo || kb_ <= qlo + QBLK - 1 - W) mask_tile(P0_, P1_, qm - kb_, (unsigned)W); } while (0)
    constexpr int NQL = BIAS ? 9 : 8;
#define SEAM_K0() do { VMWN(NQL); SWRITE_HK(0); SBAR(); } while (0)
    f32x16 pA0, pA1, pB0, pB1; float mnA, mnB, alA, alB; bf16x8 pa0, pa1, pa2, pa3;
    SWRITE_HV(0); SBAR();
    if (NT > 1) { SLOAD_H(Kh, Vh, KBASE(1)); LOADKX(KXh, KBASE(1)); }
    SBAR(); qkt<0, BIAS>(pA0, pA1, K_lds, X_lds, r32, hi, S.qr, S.qx);
    MASKT(pA0, pA1, 0); partialSM(pA0, pA1, m_reg, mnA, alA);
    if (NT > 1) { VMW(); SWRITE_H(1); }
    __syncthreads();
#define HALF_STEP(PX0, PX1, mnX, alX, PY0, PY1, alY, t, KB, VB, SB) do {                                                      \
        SBAR(); qkt<KB, BIAS>(PX0, PX1, K_lds, X_lds, r32, hi, S.qr, S.qx);                                             \
        finishSM(PY0, PY1, alY, l_reg, pa0, pa1, pa2, pa3); SBAR();                                                           \
        if ((t) + 1 < NT) { SLOAD_H(Kh, Vh, KBASE((t) + 1)); LOADKX(KXh, KBASE((t) + 1)); SBAR(); }               \
        pv_tile<VB>(o, vb0, pa0, pa1, pa2, pa3); MASKT(PX0, PX1, (t)); partialSM(PX0, PX1, m_reg, mnX, alX);                  \
        __syncthreads();                                                                                                      \
        if ((t) + 1 < NT) { VMW(); SWRITE_H(SB); }                                                                            \
        RESC(alX); __syncthreads(); } while (0)
    for (int t = 1; t + 1 < NT; t += 2) {
        HALF_STEP(pB0, pB1, mnB, alB, pA0, pA1, alA, t, 1, 0, 0);
        HALF_STEP(pA0, pA1, mnA, alA, pB0, pB1, alB, t + 1, 0, 1, 1);
    }
    const bool even = (NT & 1) == 0;
    if (even) { SBAR(); qkt<1, BIAS>(pB0, pB1, K_lds, X_lds, r32, hi, S.qr, S.qx); SBAR(); }
    { const bf16_t* Kn = Lay::k(wsb, nxt); const bf16_t* Vn = Lay::v(wsb, nxt); SLOAD_H(Kn, Vn, kbn); LOADKX(Lay::kx(wsb, nxt), kbn); } SBAR();
    { const bf16_t* Qn = Lay::q(wsb, nxt);
#pragma unroll
    for (int d0 = 0; d0 < 8; ++d0) S.qr[d0] = load8(Qn + (size_t)(wid * QBLK + r32) * QP + d0 * 16 + hi * 8); }
    if (BIAS) S.qx = load8(hi ? Lay::z(wsb) : Lay::qx(wsb, nxt) + (size_t)(wid * QBLK + r32) * 8);
    SBAR();
    finishSM(pA0, pA1, alA, l_reg, pa0, pa1, pa2, pa3); SBAR();
    pv_tile<0>(o, vb0, pa0, pa1, pa2, pa3);
    if (even) { MASKT(pB0, pB1, NT - 1); partialSM(pB0, pB1, m_reg, mnB, alB); __syncthreads(); RESC(alB);
        finishSM(pB0, pB1, alB, l_reg, pa0, pa1, pa2, pa3); SBAR(); pv_tile<1>(o, vb0, pa0, pa1, pa2, pa3); }
    SBAR(); SEAM_K0();
    if (hi == 0) li_l[r32] = l_reg; asm volatile("s_waitcnt lgkmcnt(0)" ::: "memory");
    float rli[16];
#pragma unroll
    for (int r = 0; r < 16; ++r) rli[r] = __builtin_amdgcn_rcpf(li_l[crow(r, hi)]);
    bf16_t* Ow = Lay::o(wsb, cur) + (size_t)(wid * QBLK) * OP; const bf16_t* Gw = Lay::g(wsb, cur) + (size_t)(wid * QBLK) * QP;
#pragma unroll
    for (int r = 0; r < 16; ++r) { const int orow = crow(r, hi);
#pragma unroll
        for (int d0 = 0; d0 < 4; ++d0) { const float v = o[d0][r] * rli[r];
            const float vn = lane_get(v, lane ^ 1);
            if ((r32 & 1) == 0) { float a = v, b = vn;
                if (GATE) { const unsigned gu = *(const unsigned*)(Gw + (size_t)orow * QP + d0 * 32 + r32); a *= fast_sigmoid(bflo(gu)); b *= fast_sigmoid(bfhi(gu)); }
                *(unsigned*)(Ow + (size_t)orow * OP + d0 * 32 + r32) = cvtpk(a, b); } } }
    __syncthreads();
#undef RESC
#undef KBASE
#undef MASKT
#undef SEAM_K0
#undef HALF_STEP
}
#undef ROW
#undef VMW
#undef VMWN
#undef SLOAD_H
#undef LOADKX
#undef SWRITE_HK
#undef SWRITE_HV
#undef SWRITE_H
#undef KSWZ
#undef SBAR
}
struct LayFox {
    static constexpr int QP = PJ, KP = TOK, OP = D; static constexpr bool BIAS = true, GATE = false;
    static __device__ __forceinline__ size_t row0(const fa::Ref& r) { return (size_t)(r.a / 12) * 4096 + r.b * 256; }
    static __device__ __forceinline__ int p0(const fa::Ref& r) { return r.b * 256; }
    static __device__ __forceinline__ const bf16_t* q(unsigned char* ws, const fa::Ref& r) { return (const bf16_t*)(ws + WS_PROJ) + row0(r) * PJ + (r.a % 12) * HD; }
    static __device__ __forceinline__ const bf16_t* g(unsigned char* ws, const fa::Ref& r) { return q(ws, r) + TOK; }
    static __device__ __forceinline__ const bf16_t* k(unsigned char* ws, const fa::Ref& r) { return (const bf16_t*)(ws + WS_KB) + (size_t)(r.a / 12) * 4096 * TOK + (r.a % 12) * HD; }
    static __device__ __forceinline__ const bf16_t* v(unsigned char* ws, const fa::Ref& r) { return (const bf16_t*)(ws + WS_VB) + (size_t)(r.a / 12) * 4096 * TOK + (r.a % 12) * HD; }
    static __device__ __forceinline__ bf16_t* o(unsigned char* ws, const fa::Ref& r) { return (bf16_t*)(ws + WS_ACT) + row0(r) * D + (r.a % 12) * HD; }
    static __device__ __forceinline__ const bf16_t* qx(unsigned char* ws, const fa::Ref& r) { return (const bf16_t*)(ws + WS_QX) + ((size_t)r.a * 4096 + r.b * 256) * 8; }
    static __device__ __forceinline__ const bf16_t* kx(unsigned char* ws, const fa::Ref& r) { return (const bf16_t*)(ws + WS_KX) + (size_t)r.a * 4096 * 8; }
    static __device__ __forceinline__ const bf16_t* z(unsigned char* ws) { return (const bf16_t*)(ws + WS_CTL + CTL_ZROW); }
};
__device__ __forceinline__ void fox_gate_block(unsigned char* ws, const fa::Ref& r, int tid) {
    asm volatile("s_waitcnt vmcnt(0)" ::: "memory"); __syncthreads();
    asm volatile("" : "+v"(tid));
    bf16_t* O = LayFox::o(ws, r); const bf16_t* G = LayFox::g(ws, r);
#pragma unroll
    for (int k = 0; k < 8; ++k) { const int u = tid + 512 * k, row = u >> 4, cu = (u & 15) * 8;
        const u32x4 ov = *(const u32x4*)(O + (size_t)row * D + cu), gv = __builtin_nontemporal_load((const u32x4*)(G + (size_t)row * PJ + cu)); u32x4 w;
        w.x = pk2(bflo(ov.x) * fast_sigmoid(bflo(gv.x)), bfhi(ov.x) * fast_sigmoid(bfhi(gv.x))); w.y = pk2(bflo(ov.y) * fast_sigmoid(bflo(gv.y)), bfhi(ov.y) * fast_sigmoid(bfhi(gv.y)));
        w.z = pk2(bflo(ov.z) * fast_sigmoid(bflo(gv.z)), bfhi(ov.z) * fast_sigmoid(bfhi(gv.z))); w.w = pk2(bflo(ov.w) * fast_sigmoid(bflo(gv.w)), bfhi(ov.w) * fast_sigmoid(bfhi(gv.w)));
        *(u32x4*)(O + (size_t)row * D + cu) = w; }
}
__device__ __forceinline__ void ph_fox_prompt(CtxP cp, int l, char* ldsg, LAS unsigned char* lds) {
    CTX_LOAD(cp);
    const int tid = otid();
    unsigned* qheads = (unsigned*)(c.ws + WS_CTL + CTL_QFOX) + 64 * 8 * l;
    LAS int* slot = (LAS int*)(lds + fa::LDS_BYTES);
    if (tid == 0) { slot[2] = (int)(xb_xcc_id() & 7u); slot[3] = 8; }
#define FOX_FETCH(dst, k) do { if (tid == 0) { int r_ = -1, myq_ = slot[2], qleft_ = slot[3]; while (qleft_ > 0) { const int i_ = (int)__hip_atomic_fetch_add(qheads + 64 * myq_, 1u, __ATOMIC_RELAXED, __HIP_MEMORY_SCOPE_AGENT); \
                if (i_ < 96) { r_ = ((i_ % 6) * 8 + myq_) * 16 + (15 - i_ / 6); break; } myq_ = (myq_ + 1) & 7; --qleft_; } slot[k] = r_; slot[2] = myq_; slot[3] = qleft_; } \
            __syncthreads(); dst = __builtin_amdgcn_readfirstlane(slot[k]); } while (0)
    int idx; FOX_FETCH(idx, 0);
    if (idx >= 0) {
        fa::Ref cur{idx >> 4, idx & 15, 0}, nxt; fa::Seam S;
        fa::prime<LayFox>(c.ws, cur, 1 << 29, ldsg, S, tid);
        for (int k = 1;; k ^= 1) {
            int nidx; FOX_FETCH(nidx, k);
            const bool more = nidx >= 0;
            if (more) nxt = fa::Ref{nidx >> 4, nidx & 15, 0}; else nxt = cur;
            fa::block<LayFox>(c.ws, cur, nxt, 4096, 1 << 29, ldsg, S, tid);
            fox_gate_block(c.ws, cur, tid);
            if (!more) break;
            cur = nxt;
        }
    }
#undef FOX_FETCH
}
struct LayMem {
    static constexpr int QP = PJ, KP = 4096, OP = D; static constexpr bool BIAS = false, GATE = false;
    static __device__ __forceinline__ size_t row0(const fa::Ref& r) { return (size_t)(r.a >> 2) * 4096 + r.b * 256; }
    static __device__ __forceinline__ int p0(const fa::Ref&) { return 256; }
    static __device__ __forceinline__ const bf16_t* q(unsigned char* ws, const fa::Ref& r) { return (const bf16_t*)(ws + WS_PROJ) + row0(r) * PJ + (r.c < 2 ? 6144 : 3072) + (r.a & 3) * HD; }
    static __device__ __forceinline__ const bf16_t* g(unsigned char* ws, const fa::Ref& r) { return q(ws, r); }
    static __device__ __forceinline__ const bf16_t* k(unsigned char* ws, const fa::Ref& r) { return (const bf16_t*)(ws + WS_MEMKVB) + (size_t)(r.a >> 2) * 256 * 4096 + r.c * 1024 + (r.a & 3) * HD; }
    static __device__ __forceinline__ const bf16_t* v(unsigned char* ws, const fa::Ref& r) { return k(ws, r) + 512; }
    static __device__ __forceinline__ bf16_t* o(unsigned char* ws, const fa::Ref& r) { return (bf16_t*)(ws + WS_ACT) + row0(r) * D + TOK + (r.a & 3) * HD; }
    static __device__ __forceinline__ const bf16_t* qx(unsigned char* ws, const fa::Ref& r) { return nullptr; }
    static __device__ __forceinline__ const bf16_t* kx(unsigned char* ws, const fa::Ref& r) { return nullptr; }
    static __device__ __forceinline__ const bf16_t* z(unsigned char* ws) { return nullptr; }
};
__device__ __forceinline__ void ph_mem_prompt(CtxP cp, int l, char* ldsg, int wg0, int nwg) {
    CTX_LOAD(cp);
    const int tid = otid(), bid_ = obid() - wg0, grid_ = nwg;
    int idx = bid_;
    if (idx >= 0 && idx < 256) {
        fa::Ref cur{idx >> 4, idx & 15, l}, nxt; fa::Seam S;
        fa::prime<LayMem>(c.ws, cur, 1 << 29, ldsg, S, tid);
        for (;;) {
            const int nidx = idx + grid_; const bool more = nidx < 256;
            if (more) nxt = fa::Ref{nidx >> 4, nidx & 15, l}; else nxt = cur;
            fa::block<LayMem>(c.ws, cur, nxt, 256, 1 << 29, ldsg, S, tid);
            if (!more) break;
            cur = nxt; idx = nidx;
        }
    }
}
constexpr int SF_REG = 16384, SF_AUX = 8 * SF_REG, SF_Q = SF_AUX + 8 * 512, SF_LDS = SF_Q + 32 * 272;
template <bool FOX>
__device__ __forceinline__ void ph_attn_sample(CtxP cp, int l, LAS unsigned char* lds, int wg0, int nwg) {
    CTX_LOAD(cp);
    const int bid_ = obid() - wg0, grid_ = nwg; const int tid0 = otid();
    if (bid_ < 0) return;
    constexpr int NH = FOX ? 12 : 4, NTASKS = 32 * NH, NTILE = FOX ? 65 : 8, KP = FOX ? TOK : MEMD, NPAST = FOX ? PAST : NMEM;
    constexpr float LOG2E = 1.4426950408889634f, C2 = LOG2E * SCALE;
    for (int task = bid_; task < NTASKS; task += grid_) {
        int tid = tid0; asm volatile("" : "+v"(tid));
        const int lane = tid & 63, w = __builtin_amdgcn_readfirstlane(tid >> 6), r32 = lane & 31, hi = lane >> 5;
        const int b = task / NH, h = task % NH;
        LAS unsigned char* T = lds + w * SF_REG; LAS float* aux = (LAS float*)(lds + SF_AUX + w * 512);
        const float* CUM = WS_PTR(float, WS_CUMS) + (size_t)b * (PAST + 32) * 12 + h;
        const float* Kc = (FOX ? c.in[I_CK] : c.in[I_CMK] + (size_t)l * 32 * NMEM * MEMD) + (size_t)b * NPAST * KP + h * HD; const float* Vc = (FOX ? c.in[I_CV] : c.in[I_CMV] + (size_t)l * 32 * NMEM * MEMD) + (size_t)b * NPAST * KP + h * HD;
        const int qcol = FOX ? h * HD : ((l < 2) ? 6144 : 3072) + h * HD, ocol = FOX ? h * HD : TOK + h * HD;
        float cq2 = 0.f; if (FOX) cq2 = CUM[(size_t)(PAST + r32) * 12] * LOG2E;
        float m_run = -1e30f, l_run = 0.f; f32x16 o[4] = {};
        f32x4 st[16];
        const int lrow = lane >> 5, lcol = (lane & 31) * 4;
        const unsigned voff = (unsigned)(lrow * KP + lcol) * 4u;
#define SF_LOAD(P, j0) do { const char* p_ = (const char*)((P) + (size_t)(j0) * KP);     \
        _Pragma("unroll") for (int i = 0; i < 16; ++i) st[i] = __builtin_nontemporal_load((const f32x4*)(p_ + (size_t)(2 * i) * KP * 4 + voff)); } while (0)
        __syncthreads();
        *(LAS u32x4*)(lds + SF_Q + (tid >> 4) * 272 + (tid & 15) * 16) = *(const u32x4*)(WS_PTR(bf16_t, WS_PROJ) + (size_t)(MP + b * 32 + (tid >> 4)) * PJ + qcol + (tid & 15) * 8);
        int t = w; SF_LOAD(Kc, 32 * t);
        __syncthreads();
        for (; t < NTILE; t += 8) { const bool isnew = FOX && (t == 64); const int j0 = 32 * t;
            if (!isnew) {
#pragma unroll
                for (int i = 0; i < 16; ++i) { u32x2 v2; v2.x = pk2(st[i].x, st[i].y); v2.y = pk2(st[i].z, st[i].w); *(LAS u32x2*)(T + (2 * i + lrow) * 272 + lcol * 2) = v2; }
                SF_LOAD(Vc, j0); }
            else { const char* kp = (const char*)(WS_PTR(bf16_t, WS_KB) + (size_t)(MP + b * 32) * TOK + h * HD);
                int ln = lane; asm volatile("" : "+v"(ln)); const int rw0 = ln >> 4, cc = (ln & 15) * 8; const unsigned vo = (unsigned)(rw0 * TOK + cc) * 2u;
#pragma unroll
                for (int i = 0; i < 8; ++i) *(LAS u32x4*)(T + (4 * i + rw0) * 272 + cc * 2) = *(const u32x4*)(kp + (size_t)(4 * i) * TOK * 2 + vo); }
            if (lane < 32) aux[lane] = FOX ? CUM[(size_t)(j0 + lane) * 12] * LOG2E : 0.f;
            f32x16 p = {};
#pragma unroll
            for (int d0 = 0; d0 < 8; ++d0) p = __builtin_amdgcn_mfma_f32_32x32x16_bf16(*(const LAS bf16x8*)(T + r32 * 272 + d0 * 32 + hi * 16), *(const LAS bf16x8*)(lds + SF_Q + r32 * 272 + d0 * 32 + hi * 16), p, 0, 0, 0);
            float pmax = -__builtin_inff();
#pragma unroll
            for (int g = 0; g < 4; ++g) { const f32x4 ck = *(const LAS f32x4*)(aux + 8 * g + 4 * hi);
#pragma unroll
                for (int e = 0; e < 4; ++e) { const int rr = 4 * g + e; float s = fmaf(p[rr], C2, cq2 - ck[e]);
                    if (isnew && (8 * g + 4 * hi + e) > r32) s = -__builtin_inff();
                    p[rr] = s; pmax = fmaxf(pmax, s); } }
            pmax = fmaxf(pmax, lane_get(pmax, lane ^ 32));
            const float mn = fmaxf(m_run, pmax), alpha = __builtin_amdgcn_exp2f(m_run - mn); m_run = mn;
            float ps = 0.f;
#pragma unroll
            for (int rr = 0; rr < 16; ++rr) { p[rr] = __builtin_amdgcn_exp2f(p[rr] - mn); ps += p[rr]; }
            ps += lane_get(ps, lane ^ 32); l_run = l_run * alpha + ps;
            bf16x8 pa0, pa1;
#define PK4(P, B_, OUT) do { unsigned a0 = pk2(P[B_+0], P[B_+1]), a1 = pk2(P[B_+2], P[B_+3]); unsigned b0 = pk2(P[B_+4], P[B_+5]), b1 = pk2(P[B_+6], P[B_+7]); \
            auto r0 = __builtin_amdgcn_permlane32_swap(a0, b0, false, false); auto r1 = __builtin_amdgcn_permlane32_swap(a1, b1, false, false); \
            u32x4 w4 = {r0[0], r1[0], r0[1], r1[1]}; OUT = __builtin_bit_cast(bf16x8, w4); } while (0)
            PK4(p, 0, pa0); PK4(p, 8, pa1);
#undef PK4
            if (hi == 0) aux[32 + r32] = alpha;
            if (!isnew) {
#pragma unroll
                for (int i = 0; i < 16; ++i) { const int key = 2 * i + lrow;
                    *(LAS bf16_t*)(T + (lcol + 0) * 80 + key * 2) = (bf16_t)(pk2(st[i].x, 0.f) & 0xffffu); *(LAS bf16_t*)(T + (lcol + 1) * 80 + key * 2) = (bf16_t)(pk2(st[i].y, 0.f) & 0xffffu);
                    *(LAS bf16_t*)(T + (lcol + 2) * 80 + key * 2) = (bf16_t)(pk2(st[i].z, 0.f) & 0xffffu); *(LAS bf16_t*)(T + (lcol + 3) * 80 + key * 2) = (bf16_t)(pk2(st[i].w, 0.f) & 0xffffu); }
                if (FOX && t + 8 < 64) SF_LOAD(Kc, j0 + 256); }
            else { const char* vp = (const char*)(WS_PTR(bf16_t, WS_VB) + (size_t)(MP + b * 32) * TOK + h * HD);
                int ln = lane; asm volatile("" : "+v"(ln)); const int rw0 = ln >> 4, cc = (ln & 15) * 8; const unsigned vo = (unsigned)(rw0 * TOK + cc) * 2u;
#pragma unroll
                for (int i = 0; i < 8; ++i) { const int rw = 4 * i + rw0; const u32x4 v4 = *(const u32x4*)(vp + (size_t)(4 * i) * TOK * 2 + vo);
                    *(LAS bf16_t*)(T + (cc + 0) * 80 + rw * 2) = (bf16_t)(v4.x & 0xffffu); *(LAS bf16_t*)(T + (cc + 1) * 80 + rw * 2) = (bf16_t)(v4.x >> 16);
                    *(LAS bf16_t*)(T + (cc + 2) * 80 + rw * 2) = (bf16_t)(v4.y & 0xffffu); *(LAS bf16_t*)(T + (cc + 3) * 80 + rw * 2) = (bf16_t)(v4.y >> 16);
                    *(LAS bf16_t*)(T + (cc + 4) * 80 + rw * 2) = (bf16_t)(v4.z & 0xffffu); *(LAS bf16_t*)(T + (cc + 5) * 80 + rw * 2) = (bf16_t)(v4.z >> 16);
                    *(LAS bf16_t*)(T + (cc + 6) * 80 + rw * 2) = (bf16_t)(v4.w & 0xffffu); *(LAS bf16_t*)(T + (cc + 7) * 80 + rw * 2) = (bf16_t)(v4.w >> 16); } }
            if (__any(alpha < 1.f)) {
#pragma unroll
                for (int g = 0; g < 4; ++g) { const f32x4 al = *(const LAS f32x4*)(aux + 32 + 8 * g + 4 * hi);
#pragma unroll
                    for (int e = 0; e < 4; ++e)
#pragma unroll
                        for (int db = 0; db < 4; ++db) o[db][4 * g + e] *= al[e]; } }
#pragma unroll
            for (int db = 0; db < 4; ++db) {
                o[db] = __builtin_amdgcn_mfma_f32_32x32x16_bf16(pa0, *(const LAS bf16x8*)(T + (db * 32 + r32) * 80 + hi * 16), o[db], 0, 0, 0);
                o[db] = __builtin_amdgcn_mfma_f32_32x32x16_bf16(pa1, *(const LAS bf16x8*)(T + (db * 32 + r32) * 80 + 32 + hi * 16), o[db], 0, 0, 0); }
        }
        asm volatile("s_waitcnt lgkmcnt(0)" ::: "memory");
#pragma unroll
        for (int db = 0; db < 4; ++db)
#pragma unroll
            for (int rr = 0; rr < 16; ++rr) *(LAS float*)(T + crow32(rr, hi) * 512 + (db * 32 + r32) * 4) = o[db][rr];
        if (hi == 0) { aux[64 + r32] = m_run; aux[96 + r32] = l_run; }
        __syncthreads();
        { const int qy = tid >> 4, d0 = (tid & 15) * 8; float M = -1e30f;
#pragma unroll
            for (int ww = 0; ww < 8; ++ww) M = fmaxf(M, *(const LAS float*)(lds + SF_AUX + ww * 512 + (64 + qy) * 4));
            float num[8] = {0.f, 0.f, 0.f, 0.f, 0.f, 0.f, 0.f, 0.f}, den = 0.f;
#pragma unroll
            for (int ww = 0; ww < 8; ++ww) { const float e = __builtin_amdgcn_exp2f(*(const LAS float*)(lds + SF_AUX + ww * 512 + (64 + qy) * 4) - M); den += e * *(const LAS float*)(lds + SF_AUX + ww * 512 + (96 + qy) * 4);
                const f32x4 a = *(const LAS f32x4*)(lds + ww * SF_REG + qy * 512 + d0 * 4), bq = *(const LAS f32x4*)(lds + ww * SF_REG + qy * 512 + d0 * 4 + 16);
                num[0] += e * a.x; num[1] += e * a.y; num[2] += e * a.z; num[3] += e * a.w; num[4] += e * bq.x; num[5] += e * bq.y; num[6] += e * bq.z; num[7] += e * bq.w; }
            const float inv = 1.f / den; const size_t row = (size_t)(MP + b * 32 + qy);
            u32x4 gv = {0x7f007f00u, 0x7f007f00u, 0x7f007f00u, 0x7f007f00u};
            if (FOX) gv = *(const u32x4*)(WS_PTR(bf16_t, WS_PROJ) + row * PJ + TOK + h * HD + d0);
            u32x4 ov;
            ov.x = pk2(num[0] * inv * fast_sigmoid(bflo(gv.x)), num[1] * inv * fast_sigmoid(bfhi(gv.x))); ov.y = pk2(num[2] * inv * fast_sigmoid(bflo(gv.y)), num[3] * inv * fast_sigmoid(bfhi(gv.y)));
            ov.z = pk2(num[4] * inv * fast_sigmoid(bflo(gv.z)), num[5] * inv * fast_sigmoid(bfhi(gv.z))); ov.w = pk2(num[6] * inv * fast_sigmoid(bflo(gv.w)), num[7] * inv * fast_sigmoid(bfhi(gv.w)));
            *(u32x4*)(WS_PTR(bf16_t, WS_ACT) + row * D + ocol + d0) = ov; }
#undef SF_LOAD
    }
}
constexpr int GEMM_LDS = pg8::STAGE_BYTES;
constexpr int LDS_BAR = 147456 - 256, LDS_BYTES = 147456;
static_assert(SF_LDS <= LDS_BAR && GEMM_LDS <= LDS_BAR, "LDS map");
constexpr size_t CTL_ZERO_BYTES = 65536;
__device__ __forceinline__ void ph_gemm(CtxP cp, int which, int l, LAS unsigned char* lds) {
    CTX_LOAD(cp);
    const bf16_t* A = WS_PTR(bf16_t, WS_XN); const bf16_t* Bt; int Mg = M, N, K = D, mode; bf16_t* o16 = nullptr; int ld16 = 0; float* o32 = nullptr; int ld32 = 0;
    if (which == 0) { A = WS_PTR(bf16_t, WS_MEMN); Bt = WS_PTR(bf16_t, WS_WMEM); Mg = 1024; N = 4096; mode = 4; }
    else if (which == 1) { Bt = (l < 2) ? WS_PTR(bf16_t, WS_WINA) + (size_t)l * 6656 * D : (l == 2 ? WS_PTR(bf16_t, WS_WINB0) : WS_PTR(bf16_t, WS_WINB1)); N = (l == 3) ? 3584 : 6656;
        mode = (l == 2) ? 3 : 0; o16 = WS_PTR(bf16_t, WS_PROJ); ld16 = PJ; }
    else if (which == 2) { A = WS_PTR(bf16_t, WS_ACT); Bt = WS_PTR(bf16_t, WS_WO) + (size_t)l * D * D; N = D; mode = 2; o16 = WS_PTR(bf16_t, WS_DELTA); ld16 = D; }
    else if (which == 3) { Bt = WS_PTR(bf16_t, WS_WUP) + (size_t)l * DFF * D; N = DFF; mode = 1; o16 = WS_PTR(bf16_t, WS_UP); ld16 = DFF; }
    else { A = WS_PTR(bf16_t, WS_UP); Bt = WS_PTR(bf16_t, WS_WDN) + (size_t)l * D * DFF; N = D; K = DFF; mode = 2; o16 = WS_PTR(bf16_t, WS_DELTA); ld16 = D; }
    const pg8::Gemm g{A, Bt, Mg, N, K};
    const pg8::Epi E{mode, o16, ld16, o32, ld32, c.ws, c.out, K / pg8::BK, (which == 1) ? (l < 2 ? 4608 : 0) : -1};
    pg8::TailSplit S; if (which == 0) S.init(g.M, g.N, g.K, 64, obid() - (ogrid() - 64), 0); else S.init(g.M, g.N, g.K, ogrid(), obid(), (which == 2 || which == 4) ? 1 : 0);
    pg8::gemm_phase<pg8::Epi, pg8::TailSplit, true, true>(lds, g, S, E, otid());
}
__global__ void __launch_bounds__(512, 2) fwd(Ctx carg) {
    CtxP c = (CtxP)((unsigned long long)__builtin_amdgcn_kernarg_segment_ptr() | (unsigned long long)__builtin_amdgcn_readfirstlane((int)(threadIdx.x >> 6)));
    extern __shared__ __attribute__((aligned(16))) unsigned char lds_raw[];
    LAS unsigned char* lds = (LAS unsigned char*)lds_raw;
    if (threadIdx.x < 4) ((LAS unsigned*)(lds + LDS_BAR))[threadIdx.x] = 0u;
    __syncthreads();
    const XcdBarrier bar = xcd_barrier_post((unsigned*)(((CtxP)((unsigned long long)c & ~7ull))->ws + WS_CTL), (volatile LAS unsigned*)(lds + LDS_BAR));
#define BAR() do { XcdBarrier b2_; b2_.bar = (unsigned*)(((CtxP)((unsigned long long)c & ~7ull))->ws + WS_CTL); b2_.st = bar.st; unsigned bx_ = bar.x; asm volatile("" : "+s"(bx_)); b2_.x = bx_; xcd_barrier(b2_, otid_cp(c) == 0); } while (0)
    ph_prep(c, lds, 0x3u | (0xfu << 19), 0, (int)gridDim.x, 1); ph_row2(c, 2, 0, 0, 0, 0); BAR();
    ph_row2(c, 1, 0, 0, 0, 0, 0, 0, (int)gridDim.x - 64); ph_gemm(c, 0, 0, lds); BAR();
    const bool upt = (gridDim.x == 256);
    for (int l = 0; l < 4; ++l) {
        if (l < 2) ph_skinny(c, l, lds);
        else if (l == 2) { ph_skinny(c, 2, lds); BAR(); ph_cumsum(c); }
        ph_gemm(c, 1, l, lds); BAR();
        if (l < 2) { ph_gdn_prep(c, l, lds); BAR(); ph_gdn_scan(c, l, lds);
            ph_prep(c, lds, (l == 0 ? (JOBS_L1 | (1u << 7) | (1u << 11) | (1u << 15)) : (JOBS_L2 | JOBS_L3)) & ~(upt ? (7u << 12) : 0u), 96, (int)gridDim.x - 96, 0);
            BAR(); ph_gdn_c(c, l); }
        if (l >= 2) { ph_attn_sample<true>(c, l, lds, 0, (int)gridDim.x); __syncthreads(); }
        ph_mem_prompt(c, l, (char*)lds_raw, 0, (int)gridDim.x); ph_attn_sample<false>(c, l, lds, 0, (int)gridDim.x);
        if (l >= 2) { __syncthreads(); ph_fox_prompt(c, l, (char*)lds_raw, lds); }
        BAR();
        ph_gemm(c, 2, l, lds); BAR();
        ph_row2(c, 0, 1, I_NMIXPOST, l, 0, l == 0); BAR();
        ph_gemm(c, 3, l, lds); if (upt && l < 3) ph_prep(c, lds, 1u << (12 + l), 128, 128, 0); BAR();
        ph_gemm(c, 4, l, lds); BAR();
        ph_row2(c, 0, 1, I_NMLPPOST, l, l == 3);
        if (l < 3) BAR();
    }
#undef BAR
}
extern "C" void kernel_launch(void* const* d_in, const int* in_sizes, int n_in, void* d_out, int out_size, void* d_ws, size_t ws_size, hipStream_t stream) {
    static int grid = 0;
    if (grid == 0) {
        if (n_in != 28 || (size_t)out_size != O_END || ws_size < WS_END2) { fprintf(stderr, "kernel_launch: unexpected shapes: n_in %d out %d ws %zu (need %zu)\n", n_in, out_size, ws_size, (size_t)WS_END2); grid = -1; return; }
        int dev = 0, cus = 0, per_cu = 0;
        if (hipGetDevice(&dev) != hipSuccess || hipDeviceGetAttribute(&cus, hipDeviceAttributeMultiprocessorCount, dev) != hipSuccess) { grid = -1; return; }
        if (hipFuncSetAttribute((const void*)fwd, hipFuncAttributeMaxDynamicSharedMemorySize, LDS_BYTES) != hipSuccess) { fprintf(stderr, "kernel_launch: hipFuncSetAttribute failed\n"); grid = -1; return; }
        if (hipOccupancyMaxActiveBlocksPerMultiprocessor(&per_cu, (const void*)fwd, 512, LDS_BYTES) != hipSuccess || per_cu < 1) { fprintf(stderr, "kernel_launch: occupancy query says %d blocks per CU\n", per_cu); grid = -1; return; }
        (void)hipGetLastError();
        grid = cus;
    }
    if (grid < 0) return;
    (void)hipMemsetAsync((char*)d_ws + WS_CTL, 0, CTL_ZERO_BYTES, stream);
    Ctx c{}; for (int i = 0; i < 28; ++i) c.in[i] = (const float*)d_in[i]; c.out = (float*)d_out; c.ws = (unsigned char*)d_ws; c.ph_lo = 0; c.ph_hi = 0;
    hipLaunchKernelGGL(fwd, dim3(grid), dim3(512), LDS_BYTES, stream, c);
}
```

```cpp
#include <hip/hip_runtime.h>
#include <cstdio>
#include <cstdint>
namespace pg8 {
#define PG8_LAS __attribute__((address_space(3)))
typedef unsigned short bf16_t;
typedef short bf16x8 __attribute__((ext_vector_type(8)));
typedef float f32x4 __attribute__((ext_vector_type(4)));
typedef unsigned u32x4 __attribute__((ext_vector_type(4)));
constexpr int BM = 256, BK = 64, HALF = 128, HTB = HALF * BK * 2  , STAGE_BYTES = 8 * HTB, NXCD = 8, WGM = 4;

__host__ __device__ __forceinline__ int lds_byte(int r, int c) { const int st = (r >> 4) * 2 + (c >> 5), rr = r & 15, cc = c & 31, ob = rr * 64 + cc * 2; return st * 1024 + (ob ^ (((ob >> 9) & 1) << 5)); }
__host__ __device__ __forceinline__ void stage_rc(int b, int& R, int& C) { const int st = b / 1024, sb = b % 1024, swz = sb ^ (((sb >> 9) & 1) << 5); R = (st >> 1) * 16 + swz / 64; C = (st & 1) * 32 + (swz % 64) / 2; }
__host__ __device__ __forceinline__ int perm32(int rho) { const int n = rho >> 4, i = rho & 15; return 8 * (i >> 2) + 4 * n + (i & 3); }

struct Unit { int pm, pn, kt0, nt, ks; };
struct Gemm { const bf16_t* A; const bf16_t* Bt; int M, N, K; };

struct StaticOrder {
    int nM, nN, nwg, G, c, ntf;
    __host__ __device__ void init(int M, int N, int K, int G_, int c_) { nM = M / BM; nN = N / BM; nwg = nM * nN; G = G_; c = c_; ntf = K / BK; }
    __host__ __device__ bool next(int i, Unit& u) const {
        const long L = (long)i * G + c; if (L >= nwg) return false;
        int wgid = (int)L; { const int q = nwg / NXCD, r = nwg % NXCD, xcd = wgid % NXCD, off = wgid / NXCD; wgid = (xcd < r ? xcd * (q + 1) : r * (q + 1) + (xcd - r) * q) + off; }
        const int nig = WGM * nN, gid = wgid / nig, fm = gid * WGM, gsz = (nM - fm) < WGM ? (nM - fm) : WGM;
        u.pm = fm + ((wgid % nig) % gsz); u.pn = (wgid % nig) / gsz; u.kt0 = 0; u.nt = ntf; u.ks = 0; return true;
    }
    __device__ __forceinline__ void a_ready(const Unit&) const {}
    __device__ __forceinline__ void done(const Unit&) const {}
};

__device__ __forceinline__ unsigned cvt_pk_bf16(float lo, float hi) { unsigned r; asm volatile("v_cvt_pk_bf16_f32 %0, %1, %2" : "=v"(r) : "v"(lo), "v"(hi)); return r; }
}
#define LAS __attribute__((address_space(3)))
typedef unsigned short bf16_t;
typedef float f32x4 __attribute__((ext_vector_type(4)));
typedef unsigned u32x4 __attribute__((ext_vector_type(4)));
typedef unsigned u32x2 __attribute__((ext_vector_type(2)));
constexpr int D = 2048, MP = 16384, MS = 1024, M = MP + MS;
constexpr int H = 12, HD = 128, TOK = 1536, QKV = 4608, MEMD = 512, MH = 4, NMEM = 256, DFF = 8192, PAST = 2048;
constexpr int INA_W = 6680, INB_W = 3584, KVF_W = 3084;
constexpr int PJ = 6656;
constexpr float EPS = 1e-6f, SCALE = 0.08838834764831845f;
constexpr size_t O_YP = 0, O_YS = O_YP + (size_t)MP * D, O_PGDN = O_YS + (size_t)MS * D, O_PCONV = O_PGDN + (size_t)2 * 4 * 12 * 16384, O_PK = O_PCONV + (size_t)2 * 4 * 3 * 4608,
    O_PV = O_PK + (size_t)MP * TOK, O_PLOGF = O_PV + (size_t)MP * TOK, O_PMK = O_PLOGF + (size_t)MP * 12, O_PMV = O_PMK + (size_t)4 * 4 * 256 * 512, O_SGDN = O_PMV + (size_t)4 * 4 * 256 * 512,
    O_SCONV = O_SGDN + (size_t)2 * 32 * 12 * 16384, O_SK = O_SCONV + (size_t)2 * 32 * 3 * 4608, O_SV = O_SK + (size_t)MS * TOK, O_SLOGF = O_SV + (size_t)MS * TOK, O_END = O_SLOGF + (size_t)MS * 12;
static_assert(O_END == 108683264, "output size");
constexpr size_t MiB = 1u << 20;
constexpr size_t WS_CTL = 0, WS_WINA = 1 * MiB, WS_WINB0 = 53 * MiB, WS_WINB1 = 79 * MiB, WS_WO = 93 * MiB, WS_WUP = 125 * MiB, WS_WDN = 253 * MiB, WS_WMEM = 381 * MiB, WS_WSK = 397 * MiB,
    WS_X = 398 * MiB, WS_XN = 534 * MiB, WS_PROJ = 602 * MiB, WS_ACT = 823 * MiB, WS_DELTA = 891 * MiB, WS_KB = 1027 * MiB, WS_VB = 1078 * MiB, WS_G = 1129 * MiB, WS_BETA = 1130 * MiB,
    WS_LOGF = 1131 * MiB, WS_CUMP = 1132 * MiB, WS_CUMS = 1133 * MiB, WS_MEMN = 1137 * MiB, WS_BIG = 1141 * MiB, WS_QF = WS_BIG, WS_KF = WS_BIG + 102 * MiB, WS_VF = WS_BIG + 204 * MiB,
    WS_OF = WS_BIG + 306 * MiB, WS_UP = WS_BIG, WS_END = WS_BIG + 408 * MiB,
    WS_EGL = WS_END, WS_QX = WS_EGL + 1 * MiB, WS_KX = WS_QX + 3 * MiB, WS_MEMKVB = WS_KX + 3 * MiB, WS_WSKB = WS_MEMKVB + 8 * MiB, WS_END2 = WS_WSKB + 1 * MiB;
constexpr size_t WS_SLAB = WS_PROJ;
constexpr size_t CTL_ZROW = 61440, CTL_QFOX = 32768;
static_assert((size_t)6656 * 2048 * 2 == 26 * MiB && (size_t)M * D * 4 == 136 * MiB && (size_t)M * PJ * 2 == 221 * MiB && (size_t)M * TOK * 2 == 51 * MiB && (size_t)M * TOK * 4 == 102 * MiB && (size_t)M * DFF * 2 == 272 * MiB, "sizes");

struct Ctx { const float* in[28]; float* out; unsigned char* ws; int ph_lo, ph_hi; };
typedef const __attribute__((address_space(4))) Ctx* CtxP;
__device__ __forceinline__ int otid_cp(CtxP cp) {
#if defined(__HIP_DEVICE_COMPILE__)
    unsigned long long a = (unsigned long long)cp; asm volatile("" : "+s"(a));
    int ln; asm volatile("v_mbcnt_lo_u32_b32 %0, -1, 0\n\tv_mbcnt_hi_u32_b32 %0, -1, %0" : "=v"(ln));
    return (int)((unsigned)a & 7u) * 64 + ln;
#else
    (void)cp; return 0;
#endif
}
#define otid() otid_cp(cp)
__device__ __forceinline__ int obid() { int b = blockIdx.x; asm volatile("" : "+s"(b)); return b; }
__device__ __forceinline__ int ogrid() { int g = gridDim.x; asm volatile("" : "+s"(g)); return g; }
__device__ __forceinline__ Ctx ctx_load(CtxP cp) {
#if defined(__HIP_DEVICE_COMPILE__)
    asm volatile("" : "+s"(cp)); cp = (CtxP)((unsigned long long)cp & ~7ull); Ctx r; __builtin_memcpy(&r, cp, sizeof(Ctx)); return r;
#else
    (void)cp; return Ctx{};
#endif
}
#define CTX_LOAD(cp) const Ctx c = ctx_load(cp)
enum { I_XP = 0, I_XS, I_SGDN, I_SCONV, I_CK, I_CV, I_CLOGF, I_CMK, I_CMV, I_MEMP, I_NMIXPRE, I_NMIXPOST, I_NMLPPRE, I_NMLPPOST, I_WINA, I_CONVW, I_ALOG, I_DTB, I_GDNN, I_WINB, I_NKV, I_WKVF, I_BF, I_NMEM, I_WMEMKV, I_WO, I_WUP, I_WDN };

__device__ __forceinline__ float bf2f(bf16_t b) { return __uint_as_float(((unsigned)b) << 16); }
__device__ __forceinline__ float bflo(unsigned u) { return __uint_as_float(u << 16); }
__device__ __forceinline__ float bfhi(unsigned u) { return __uint_as_float(u & 0xffff0000u); }
__device__ __forceinline__ unsigned pk2(float lo, float hi) { return pg8::cvt_pk_bf16(lo, hi); }
__device__ __forceinline__ float lane_get(float v, int src_lane) { return __int_as_float(__builtin_amdgcn_ds_bpermute(src_lane << 2, __float_as_int(v))); }
__device__ __forceinline__ float wave_sum(float v, int lane) {
#pragma unroll
    for (int o = 1; o < 64; o <<= 1) v += lane_get(v, lane ^ o);
    return v; }
__device__ __forceinline__ float wave_max(float v, int lane) {
#pragma unroll
    for (int o = 1; o < 64; o <<= 1) v = fmaxf(v, lane_get(v, lane ^ o));
    return v; }
__device__ __forceinline__ float wave_sum_dpp(float v) {
    v += __int_as_float(__builtin_amdgcn_update_dpp(0, __float_as_int(v), 0x111, 0xf, 0xf, true));
    v += __int_as_float(__builtin_amdgcn_update_dpp(0, __float_as_int(v), 0x112, 0xf, 0xf, true));
    v += __int_as_float(__builtin_amdgcn_update_dpp(0, __float_as_int(v), 0x114, 0xf, 0xf, true));
    v += __int_as_float(__builtin_amdgcn_update_dpp(0, __float_as_int(v), 0x118, 0xf, 0xf, true));
    const int iv = __float_as_int(v);
    return (__int_as_float(__builtin_amdgcn_readlane(iv, 15)) + __int_as_float(__builtin_amdgcn_readlane(iv, 31))) + (__int_as_float(__builtin_amdgcn_readlane(iv, 47)) + __int_as_float(__builtin_amdgcn_readlane(iv, 63)));
}
__device__ __forceinline__ float sigmoidf_(float x) { return 1.f / (1.f + expf(-x)); }
__device__ __forceinline__ float softplusf_(float x) { return fmaxf(x, 0.f) + log1pf(expf(-fabsf(x))); }
__device__ __forceinline__ float softplus_fast(float x) { return fmaxf(x, 0.f) + 0.6931471805599453f * __builtin_amdgcn_logf(1.f + __builtin_amdgcn_exp2f(-1.4426950408889634f * fabsf(x))); }
__device__ __forceinline__ float fast_sigmoid(float x) { return __builtin_amdgcn_rcpf(1.f + __builtin_amdgcn_exp2f(-1.4426950408889634f * x)); }
__device__ __forceinline__ float exp_fast(float x) { return __builtin_amdgcn_exp2f(1.4426950408889634f * x); }
struct RowInfo { int grp, b, t, T, nb; };
__device__ __forceinline__ RowInfo rowinfo(int m) { RowInfo r; if (m < MP) { r.grp = 0; r.b = m >> 12; r.t = m & 4095; r.T = 4096; r.nb = 4; } else { const int ms = m - MP; r.grp = 1; r.b = ms >> 5; r.t = ms & 31; r.T = 32; r.nb = 32; } return r; }
namespace pg8 {
struct Epi {
    static constexpr bool PERM = true, AFTER_DRAIN = false;
    int mode;
    bf16_t* o16; int ld16; float* o32; int ld32;
    unsigned char* ws; float* out;
    int ntfull;
    int ntcol;
    __device__ __forceinline__ void operator()(const f32x4 (&acc)[2][2][4][2], const Unit& u, int wr, int wc, int fr, int fq) const {
        const int row0 = u.pm * BM + wr * 64 + fr, colt = u.pn * BM, cl = wc * 32 + 8 * fq;
        bf16_t* d16 = nullptr; size_t l16 = 0; float* d32 = nullptr; size_t l32 = 0; int radj = 0; const bool sq = (mode == 1);
        bool nt16 = false;
        if (mode == 0 || mode == 1) { d16 = o16 + colt; l16 = (size_t)ld16; nt16 = (mode == 0) && (ntcol >= 0) && (colt >= ntcol); }
        else if (mode == 2) {
            if (u.nt != ntfull) { d16 = (bf16_t*)(ws + WS_SLAB) + (size_t)u.ks * 1024 * 2048 + colt - (size_t)16384 * 2048; l16 = 2048; }
            else { d16 = o16 + colt; l16 = (size_t)ld16; } }
        else if (mode == 3) {
            if (colt < 3584) { d16 = o16 + colt; l16 = (size_t)ld16; nt16 = true; }
            else { const bool isv = colt >= 5120; const int cc = colt - (isv ? 5120 : 3584); const bool smp = u.pm >= 64;
                d16 = (bf16_t*)(ws + (isv ? WS_VB : WS_KB)) + cc; l16 = 1536; d32 = out + (smp ? (isv ? O_SV : O_SK) : (isv ? O_PV : O_PK)) + cc; l32 = 1536; radj = smp ? 16384 : 0; }
        } else { const int l = colt >> 10, within = colt & 1023; d32 = out + ((within >= 512) ? O_PMV : O_PMK) + (size_t)l * 1024 * 512 + (within & 511); l32 = 512;  d16 = (bf16_t*)(ws + WS_MEMKVB) + colt; l16 = 4096; }
#pragma unroll
        for (int ai = 0; ai < 2; ++ai)
#pragma unroll
            for (int m = 0; m < 4; ++m) { const int row = row0 + ai * HALF + m * 16;
#pragma unroll
                for (int bj = 0; bj < 2; ++bj) { f32x4 v0 = acc[ai][bj][m][0], v1 = acc[ai][bj][m][1]; const int col = cl + bj * HALF;
                    if (sq) {
#pragma unroll
                        for (int j = 0; j < 4; ++j) { const float a = v0[j] > 0.f ? v0[j] : 0.f, b = v1[j] > 0.f ? v1[j] : 0.f; v0[j] = a * a; v1[j] = b * b; } }
                    if (d16) { u32x4 w; w.x = cvt_pk_bf16(v0[0], v0[1]); w.y = cvt_pk_bf16(v0[2], v0[3]); w.z = cvt_pk_bf16(v1[0], v1[1]); w.w = cvt_pk_bf16(v1[2], v1[3]);
                        if (nt16) __builtin_nontemporal_store(w, (u32x4*)(d16 + (size_t)row * l16 + col)); else *(u32x4*)(d16 + (size_t)row * l16 + col) = w; }
                    if (d32) { float* p = d32 + (size_t)(row - radj) * l32 + col;
                        if (mode >= 3) { __builtin_nontemporal_store(v0, (f32x4*)p); __builtin_nontemporal_store(v1, (f32x4*)(p + 4)); }
                        else { *(f32x4*)p = v0; *(f32x4*)(p + 4) = v1; } } } }
    }
};
struct TailSplit {
    StaticOrder full; int nF, nN, nsl, nts, G, c, split;
    __device__ void init(int M, int N, int K, int G_, int c_, int split_, int nsl_ = 8) { split = split_; full.init(split_ ? 64 * BM : M, N, K, G_, c_); nN = N / BM; nF = 64 * nN; nsl = nsl_; nts = K / BK / nsl; G = G_; c = c_; }
    __device__ __forceinline__ bool next(int i, Unit& u) const {
        const long L = (long)i * G + c; int pm = 0, pn = 0, kt0 = 0, nt = full.ntf, ks = 0; bool ok; if (c < 0) { u.pm = 0; u.pn = 0; u.kt0 = 0; u.nt = nt; u.ks = 0; return false; }
        if (!split || L < nF) { Unit t; ok = full.next(i, t); pm = t.pm; pn = t.pn; }
        else { const int Ls = (int)(L - nF); ok = Ls < 4 * nN * nsl; pn = Ls % nN; const int rest = Ls / nN; pm = 64 + (rest & 3); ks = rest >> 2; kt0 = ks * nts; nt = nts; }
        u.pm = pm; u.pn = pn; u.kt0 = kt0; u.nt = nt; u.ks = ks; return ok;
    }
    __device__ __forceinline__ void a_ready(const Unit&) const {}
    __device__ __forceinline__ void done(const Unit&) const {}
};
}
namespace pg8 {
template <class Epi, class Sched, bool ALIGN_EPI = false, bool SP2 = false>
__device__ __forceinline__ void gemm_phase(PG8_LAS unsigned char* lds, const Gemm g, const Sched& S, const Epi& E, const int tid) {
    const int wid = __builtin_amdgcn_readfirstlane(tid >> 6), lane = tid & 63, wr = wid >> 2, wc = wid & 3, fr = lane & 15, fq = lane >> 4;
    const int K = g.K;
    unsigned voffA[2], voffB[2];
#pragma unroll
    for (int i = 0; i < 2; ++i) { int R, C; stage_rc(tid * 16 + i * 8192, R, C); const int Rb = Epi::PERM ? ((R & ~31) + perm32(R & 31)) : R;
        voffA[i] = (unsigned)(R * K + C) * 2u; voffB[i] = (unsigned)(Rb * K + C) * 2u; }
    const size_t kstep = (size_t)(BK * 2);
    const size_t hstep = (size_t)HALF * K * 2;
    const size_t tstep = 2 * hstep;
    const unsigned ldsw = (unsigned)wid * 1024u;
    const int aoff = lds_byte(wr * 64 + fr, fq * 8), boff = lds_byte(wc * 32 + fr, fq * 8);
#define PG8_SA(b, h) (((b) * 2 + (h)) * HTB)
#define PG8_SB(b, h) ((4 + (b) * 2 + (h)) * HTB)
#define PG8_STAGE(bufoff, gbase, voff) do { _Pragma("unroll") for (int _i = 0; _i < 2; ++_i) \
        __builtin_amdgcn_global_load_lds((const unsigned*)((const char*)(gbase) + (voff)[_i]), (PG8_LAS unsigned*)(lds + (bufoff) + ldsw + _i * 8192), 16, 0, 0); } while (0)
#define PG8_LDA(dst, b, h) do { _Pragma("unroll") for (int m = 0; m < 4; ++m) _Pragma("unroll") for (int k = 0; k < 2; ++k) dst[m][k] = *(const PG8_LAS bf16x8*)(lds + PG8_SA(b, h) + aoff + m * 2048 + k * 1024); } while (0)
#define PG8_LDB(dst, b, h) do { _Pragma("unroll") for (int n = 0; n < 2; ++n) _Pragma("unroll") for (int k = 0; k < 2; ++k) dst[n][k] = *(const PG8_LAS bf16x8*)(lds + PG8_SB(b, h) + boff + n * 2048 + k * 1024); } while (0)
#define PG8_MMA(ai, bj, At, Bt) do { __builtin_amdgcn_s_setprio(1); _Pragma("unroll") for (int m = 0; m < 4; ++m) _Pragma("unroll") for (int n = 0; n < 2; ++n) _Pragma("unroll") for (int k = 0; k < 2; ++k) \
        acc[ai][bj][m][n] = __builtin_amdgcn_mfma_f32_16x16x32_bf16(Bt[n][k], At[m][k], acc[ai][bj][m][n], 0, 0, 0); __builtin_amdgcn_s_setprio(0); } while (0)
#define PG8_WAIT_V(n) asm volatile("s_waitcnt vmcnt(" #n ")" ::: "memory")
#define PG8_WAIT_L(n) asm volatile("s_waitcnt lgkmcnt(" #n ")" ::: "memory")
#define PG8_BAR __builtin_amdgcn_s_barrier()
#define PG8_SCHED __builtin_amdgcn_sched_barrier(0)
    Unit cur, nxt; int ui = 0;
    if (!S.next(0, cur)) return;
    f32x4 acc[2][2][4][2];
#pragma unroll
    for (int a = 0; a < 2; ++a)
#pragma unroll
        for (int b = 0; b < 2; ++b)
#pragma unroll
            for (int m = 0; m < 4; ++m)
#pragma unroll
                for (int n = 0; n < 2; ++n) acc[a][b][m][n] = (f32x4){0.f, 0.f, 0.f, 0.f};
    bf16x8 At[4][2], B0[2][2], B1[2][2];
    const char* cA = (const char*)g.A + (size_t)cur.pm * tstep + (size_t)cur.kt0 * kstep; const char* cB = (const char*)g.Bt + (size_t)cur.pn * tstep + (size_t)cur.kt0 * kstep;
    S.a_ready(cur);
    if constexpr (SP2) {
        PG8_STAGE(PG8_SB(0, 0), cB, voffB); PG8_STAGE(PG8_SB(0, 1), cB + hstep, voffB); PG8_STAGE(PG8_SA(0, 0), cA, voffA); PG8_STAGE(PG8_SA(0, 1), cA + hstep, voffA);
        if (wr == 1) PG8_BAR;
        PG8_WAIT_V(2); PG8_BAR;
        PG8_STAGE(PG8_SB(1, 0), cB + kstep, voffB); PG8_STAGE(PG8_SA(1, 0), cA + kstep, voffA); PG8_STAGE(PG8_SB(1, 1), cB + hstep + kstep, voffB);
        PG8_WAIT_V(6); PG8_BAR;
    } else {
        PG8_STAGE(PG8_SB(0, 0), cB, voffB); PG8_STAGE(PG8_SA(0, 0), cA, voffA); PG8_STAGE(PG8_SB(0, 1), cB + hstep, voffB); PG8_STAGE(PG8_SA(0, 1), cA + hstep, voffA);
        if (wr == 1) PG8_BAR;
        PG8_WAIT_V(4); PG8_BAR;
        PG8_STAGE(PG8_SB(1, 0), cB + kstep, voffB); PG8_STAGE(PG8_SA(1, 0), cA + kstep, voffA); PG8_STAGE(PG8_SB(1, 1), cB + hstep + kstep, voffB);
        PG8_WAIT_V(6); PG8_BAR;
    }
    for (;;) {
        const bool has_next = S.next(ui + 1, nxt);
        const char* nA = has_next ? (const char*)g.A + (size_t)nxt.pm * tstep + (size_t)nxt.kt0 * kstep : cA; const char* nB = has_next ? (const char*)g.Bt + (size_t)nxt.pn * tstep + (size_t)nxt.kt0 * kstep : cB;
        const int nt = cur.nt;
        for (int t = 0; t < nt; t += 2) {
            const bool last = (t == nt - 2);
            const char* a1 = cA + (size_t)(t + 1) * kstep;
            const char* a2 = last ? nA : cA + (size_t)(t + 2) * kstep; const char* b2 = last ? nB : cB + (size_t)(t + 2) * kstep;
            const char* a3 = a2 + kstep; const char* b3 = b2 + kstep;
            if (last && has_next) S.a_ready(nxt);
            if constexpr (SP2) {
            PG8_LDB(B0, 0, 0); PG8_LDB(B1, 0, 1); PG8_SCHED; PG8_LDA(At, 0, 0); PG8_STAGE(PG8_SA(1, 1), a1 + hstep, voffA);
            PG8_WAIT_V(8); PG8_WAIT_L(0); PG8_BAR; PG8_MMA(0, 0, At, B0); PG8_MMA(0, 1, At, B1); PG8_BAR; PG8_SCHED;
            PG8_LDA(At, 0, 1); PG8_STAGE(PG8_SB(0, 0), b2, voffB); PG8_STAGE(PG8_SB(0, 1), b2 + hstep, voffB); PG8_STAGE(PG8_SA(0, 0), a2, voffA);
            PG8_WAIT_V(8); PG8_WAIT_L(0); PG8_BAR; PG8_MMA(1, 0, At, B0); PG8_MMA(1, 1, At, B1); PG8_BAR; PG8_SCHED;
            PG8_LDB(B0, 1, 0); PG8_LDB(B1, 1, 1); PG8_SCHED; PG8_LDA(At, 1, 0); PG8_STAGE(PG8_SA(0, 1), a2 + hstep, voffA);
            PG8_WAIT_V(8); PG8_WAIT_L(0); PG8_BAR; PG8_MMA(0, 0, At, B0); PG8_MMA(0, 1, At, B1); PG8_BAR; PG8_SCHED;
            PG8_LDA(At, 1, 1); PG8_STAGE(PG8_SB(1, 0), b3, voffB); PG8_STAGE(PG8_SB(1, 1), b3 + hstep, voffB); PG8_STAGE(PG8_SA(1, 0), a3, voffA);
            PG8_WAIT_V(8); PG8_WAIT_L(0); PG8_BAR; PG8_MMA(1, 0, At, B0); PG8_MMA(1, 1, At, B1); PG8_BAR; PG8_SCHED;
            } else {
            PG8_LDB(B0, 0, 0); PG8_SCHED; PG8_LDA(At, 0, 0); PG8_STAGE(PG8_SA(1, 1), a1 + hstep, voffA);
            PG8_WAIT_L(8); PG8_BAR; PG8_WAIT_L(0); PG8_MMA(0, 0, At, B0); PG8_BAR; PG8_SCHED;
            PG8_LDB(B1, 0, 1); PG8_STAGE(PG8_SB(0, 0), b2, voffB);
            PG8_BAR; PG8_WAIT_L(0); PG8_MMA(0, 1, At, B1); PG8_BAR;
            PG8_LDA(At, 0, 1); PG8_STAGE(PG8_SA(0, 0), a2, voffA);
            PG8_BAR; PG8_WAIT_L(0); PG8_MMA(1, 0, At, B0); PG8_BAR; PG8_SCHED;
            PG8_STAGE(PG8_SB(0, 1), b2 + hstep, voffB);
            PG8_WAIT_V(6); PG8_BAR; PG8_MMA(1, 1, At, B1); PG8_BAR;
            PG8_LDB(B0, 1, 0); PG8_SCHED; PG8_LDA(At, 1, 0); PG8_STAGE(PG8_SA(0, 1), a2 + hstep, voffA);
            PG8_WAIT_L(8); PG8_BAR; PG8_WAIT_L(0); PG8_MMA(0, 0, At, B0); PG8_BAR; PG8_SCHED;
            PG8_LDB(B1, 1, 1); PG8_STAGE(PG8_SB(1, 0), b3, voffB);
            PG8_BAR; PG8_WAIT_L(0); PG8_MMA(0, 1, At, B1); PG8_BAR;
            PG8_LDA(At, 1, 1); PG8_STAGE(PG8_SA(1, 0), a3, voffA);
            PG8_BAR; PG8_WAIT_L(0); PG8_MMA(1, 0, At, B0); PG8_BAR; PG8_SCHED;
            PG8_STAGE(PG8_SB(1, 1), b3 + hstep, voffB);
            PG8_WAIT_V(6); PG8_BAR; PG8_MMA(1, 1, At, B1); PG8_BAR;
            }
        }
        if constexpr (ALIGN_EPI) { if (wr == 0) PG8_BAR; }
        if constexpr (!Epi::AFTER_DRAIN) { E(acc, cur, wr, wc, fr, fq); S.done(cur); }
        if (!has_next) break;
#pragma unroll
        for (int a = 0; a < 2; ++a)
#pragma unroll
            for (int b = 0; b < 2; ++b)
#pragma unroll
                for (int m = 0; m < 4; ++m)
#pragma unroll
                    for (int n = 0; n < 2; ++n) acc[a][b][m][n] = (f32x4){0.f, 0.f, 0.f, 0.f};
        cur = nxt; cA = nA; cB = nB; ++ui;
        if constexpr (ALIGN_EPI) { if (wr == 1) PG8_BAR; }
    }
    PG8_WAIT_V(0);
    if constexpr (!ALIGN_EPI) { if (wr == 0) PG8_BAR; }
    PG8_BAR;
    if constexpr (Epi::AFTER_DRAIN) { E.fused(acc, cur, wr, wc, fr, fq, lds, wid, lane); S.done(cur); }
#undef PG8_SA
#undef PG8_SB
#undef PG8_STAGE
#undef PG8_LDA
#undef PG8_LDB
#undef PG8_MMA
#undef PG8_WAIT_V
#undef PG8_WAIT_L
#undef PG8_BAR
#undef PG8_SCHED
}
}
typedef short bf16x8s __attribute__((ext_vector_type(8)));
#define WS_PTR(T, off) ((T*)(c.ws + (off)))
struct TJob { const float* W; int ldw, K; const float* gain; bf16_t* WT; int src0, dst0, ncols; };
__device__ __forceinline__ TJob get_job(const Ctx& c, int j) {
    TJob J; J.gain = nullptr; J.src0 = 0; J.dst0 = 0; J.K = D;
    if (j < 4) { const int l = j >> 1, p = j & 1; J.W = c.in[I_WINA] + (size_t)l * D * INA_W; J.ldw = INA_W; J.gain = c.in[I_NMIXPRE] + l * D; J.WT = WS_PTR(bf16_t, WS_WINA) + (size_t)l * 6656 * D;
        if (p == 0) { J.ncols = 6144; } else { J.src0 = 6168; J.dst0 = 6144; J.ncols = 512; } }
    else if (j == 4) { J.W = c.in[I_WINB]; J.ldw = INB_W; J.gain = c.in[I_NMIXPRE] + 2 * D; J.WT = WS_PTR(bf16_t, WS_WINB0); J.ncols = 3584; }
    else if (j == 5) { J.W = c.in[I_WKVF]; J.ldw = KVF_W; J.gain = c.in[I_NKV]; J.WT = WS_PTR(bf16_t, WS_WINB0); J.dst0 = 3584; J.ncols = 3072; }
    else if (j == 6) { J.W = c.in[I_WINB] + (size_t)D * INB_W; J.ldw = INB_W; J.gain = c.in[I_NMIXPRE] + 3 * D; J.WT = WS_PTR(bf16_t, WS_WINB1); J.ncols = 3584; }
    else if (j < 11) { const int l = j - 7; J.W = c.in[I_WO] + (size_t)l * D * D; J.ldw = D; J.WT = WS_PTR(bf16_t, WS_WO) + (size_t)l * D * D; J.ncols = D; }
    else if (j < 15) { const int l = j - 11; J.W = c.in[I_WUP] + (size_t)l * D * DFF; J.ldw = DFF; J.gain = c.in[I_NMLPPRE] + l * D; J.WT = WS_PTR(bf16_t, WS_WUP) + (size_t)l * DFF * D; J.ncols = DFF; }
    else if (j < 19) { const int l = j - 15; J.W = c.in[I_WDN] + (size_t)l * DFF * D; J.ldw = D; J.K = DFF; J.WT = WS_PTR(bf16_t, WS_WDN) + (size_t)l * D * DFF; J.ncols = D; }
    else { const int l = j - 19; J.W = c.in[I_WMEMKV] + (size_t)l * D * 1024; J.ldw = 1024; J.gain = c.in[I_NMEM] + l * D; J.WT = WS_PTR(bf16_t, WS_WMEM); J.dst0 = l * 1024; J.ncols = 1024; }
    return J;
}
constexpr int NJOBS = 23;
__device__ __forceinline__ int job_items(const TJob& J) { return (J.K / 64) * (J.ncols / 32); }
__device__ __forceinline__ void transpose_item(const TJob& J, int item, LAS float* scr, int lane) {
    const int nblk = J.ncols / 32, kb = item / nblk, nb = item % nblk, k0 = 64 * kb, n0 = 32 * nb;
    float wv[32];
#pragma unroll
    for (int i = 0; i < 32; ++i) wv[i] = __builtin_nontemporal_load(J.W + (size_t)(k0 + 2 * i + (lane >> 5)) * J.ldw + J.src0 + n0 + (lane & 31));
#pragma unroll
    for (int i = 0; i < 32; ++i) { const int kk = 2 * i + (lane >> 5); float w = wv[i]; if (J.gain) w *= J.gain[k0 + kk]; scr[kk * 33 + (lane & 31)] = w; }
    asm volatile("s_waitcnt lgkmcnt(0)" ::: "memory");
    const int cc = lane & 7;
#pragma unroll
    for (int j = 0; j < 4; ++j) { const int n = (lane >> 3) + 8 * j; const LAS float* s = scr + (8 * cc) * 33 + n;
        u32x4 o; o.x = pk2(s[0 * 33], s[1 * 33]); o.y = pk2(s[2 * 33], s[3 * 33]); o.z = pk2(s[4 * 33], s[5 * 33]); o.w = pk2(s[6 * 33], s[7 * 33]);
        __builtin_nontemporal_store(o, (u32x4*)(J.WT + (size_t)(J.dst0 + n0 + n) * J.K + k0 + 8 * cc)); }
    asm volatile("s_waitcnt lgkmcnt(0)" ::: "memory");
}
constexpr unsigned JOBS_L0 = 0x3u | (1u << 7) | (1u << 11) | (1u << 15) | (0xfu << 19), JOBS_L1 = 0xcu | (1u << 8) | (1u << 12) | (1u << 16), JOBS_L2 = 0x30u | (1u << 9) | (1u << 13) | (1u << 17), JOBS_L3 = 0x40u | (1u << 10) | (1u << 14) | (1u << 18);
static_assert((JOBS_L0 | JOBS_L1 | JOBS_L2 | JOBS_L3) == (1u << 23) - 1 && (JOBS_L0 & JOBS_L1) == 0 && (JOBS_L2 & JOBS_L3) == 0 && ((JOBS_L0 | JOBS_L1) & (JOBS_L2 | JOBS_L3)) == 0, "every weight job in exactly one group");
__device__ __forceinline__ void ph_prep(CtxP cp, LAS unsigned char* lds, unsigned mask, int wg0, int nwg, int small) {
    CTX_LOAD(cp);
    const int bid_ = obid() - wg0, grid_ = nwg; const int tid = otid(), lane = tid & 63, wave = tid >> 6, gw = bid_ * 8 + wave, NGW = grid_ * 8;
    if (bid_ < 0) return;
    __syncthreads();
    LAS float* scr = (LAS float*)(lds + wave * 16384);
    int base = 0;
    for (int j = 0; j < NJOBS; ++j) { if (!((mask >> j) & 1u)) continue; const TJob J = get_job(c, j); const int n = job_items(J);
        int first = gw - (base % NGW); if (first < 0) first += NGW;
        for (int it = first; it < n; it += NGW) transpose_item(J, it, scr, lane);
        base += n; }
    if (!small) return;
    bf16_t* wskb = WS_PTR(bf16_t, WS_WSKB);
    for (int i = bid_ * 512 + tid; i < 3 * 32 * D; i += grid_ * 512) { const int var = i / (32 * D), r = (i / D) % 32, k = i % D; float v = 0.f;
        if (var < 2) { if (r < 24) v = c.in[I_WINA][(size_t)var * D * INA_W + (size_t)k * INA_W + 6144 + r] * c.in[I_NMIXPRE][var * D + k]; }
        else if (r < 12) v = c.in[I_WKVF][(size_t)k * KVF_W + 3072 + r] * c.in[I_NKV][k];
        wskb[i] = (bf16_t)(pk2(v, 0.f) & 0xffffu); }
}
__device__ __forceinline__ f32x4 x24_unpack(unsigned hx, unsigned hy, unsigned l) {
    return (f32x4){__uint_as_float((hx << 16) | ((l & 0xffu) << 8)), __uint_as_float((hx & 0xffff0000u) | (l & 0xff00u)), __uint_as_float((hy << 16) | ((l >> 8) & 0xff00u)), __uint_as_float((hy & 0xffff0000u) | ((l >> 16) & 0xff00u))}; }
__device__ __forceinline__ void x24_pack(const f32x4 v, unsigned& hx, unsigned& hy, unsigned& l) {
    const unsigned b0 = __float_as_uint(v.x) + 0x80u, b1 = __float_as_uint(v.y) + 0x80u, b2 = __float_as_uint(v.z) + 0x80u, b3 = __float_as_uint(v.w) + 0x80u;
    hx = (b0 >> 16) | (b1 & 0xffff0000u); hy = (b2 >> 16) | (b3 & 0xffff0000u); l = ((b0 >> 8) & 0xffu) | (b1 & 0xff00u) | ((b2 << 8) & 0xff0000u) | ((b3 << 16) & 0xff000000u); }
__device__ __forceinline__ void ph_row2(CtxP cp, int src, int use_delta, int gidx, int gl, int write_y, int first = 0, int wg0 = 0, int nwg = 0) {
    CTX_LOAD(cp);
    const int bid_ = obid() - wg0, grid_ = nwg ? nwg : ogrid();
    if (bid_ < 0 || bid_ >= grid_) return; const int tid = otid(), lane = tid & 63, wave = tid >> 6, gw = bid_ * 8 + wave, NGW = grid_ * 8;
    const bf16_t* XH = WS_PTR(bf16_t, WS_X); const unsigned char* XL = c.ws + WS_X + (size_t)M * D * 2; bf16_t* XN = WS_PTR(bf16_t, WS_XN); const bf16_t* delta = WS_PTR(bf16_t, WS_DELTA); const float* gpost = use_delta ? c.in[gidx] + gl * D : nullptr;
    const int nrows = (src == 2) ? 1024 : M, nslab = (gidx == I_NMIXPOST) ? 4 : 8;
#define EO(j) (8 * lane + 512 * ((j) >> 1) + 4 * ((j) & 1))
#define EB(jj) (8 * lane + 512 * (jj))
#define LD_BF8(dlo, dhi, ptr) do { const u32x4 t_ = __builtin_nontemporal_load((const u32x4*)(ptr)); dlo = (f32x4){bflo(t_.x), bfhi(t_.x), bflo(t_.y), bfhi(t_.y)}; dhi = (f32x4){bflo(t_.z), bfhi(t_.z), bflo(t_.w), bfhi(t_.w)}; } while (0)
#define ADD_BF8(dlo, dhi, ptr) do { const u32x4 t_ = __builtin_nontemporal_load((const u32x4*)(ptr)); dlo = dlo + (f32x4){bflo(t_.x), bfhi(t_.x), bflo(t_.y), bfhi(t_.y)}; dhi = dhi + (f32x4){bflo(t_.z), bfhi(t_.z), bflo(t_.w), bfhi(t_.w)}; } while (0)
#define X24_LD2(vlo, vhi, mrow, jj) do { const u32x4 h_ = __builtin_nontemporal_load((const u32x4*)(XH + (size_t)(mrow) * D + EB(jj))); const u32x2 l_ = __builtin_nontemporal_load((const u32x2*)(XL + (size_t)(mrow) * D + EB(jj))); \
        vlo = x24_unpack(h_.x, h_.y, l_.x); vhi = x24_unpack(h_.z, h_.w, l_.y); } while (0)
#define X24_ST2(vlo, vhi, mrow, jj) do { unsigned ha_, hb_, hc_, hd_, la_, lb_; x24_pack(vlo, ha_, hb_, la_); x24_pack(vhi, hc_, hd_, lb_); const u32x4 h_ = {ha_, hb_, hc_, hd_}; const u32x2 l_ = {la_, lb_}; \
        __builtin_nontemporal_store(h_, (u32x4*)((bf16_t*)XH + (size_t)(mrow) * D + EB(jj))); __builtin_nontemporal_store(l_, (u32x2*)((unsigned char*)XL + (size_t)(mrow) * D + EB(jj))); } while (0)
    const bool deal2 = (src == 0) && use_delta && (NGW == 2048);
    const int half_gw = gw >> 1, isA = !(gw & 1);
    const int nsteps = deal2 ? (isA ? 4 : 5) : (nrows + 2 * NGW - 1) / (2 * NGW);
    for (int st = 0; st < nsteps; ++st) {
        int m0, m1; bool two;
        if (deal2) { if (isA) { if (st == 0) { m0 = MP + half_gw; m1 = m0; two = false; } else { m0 = half_gw + 1024 * (2 * (st - 1)); m1 = m0 + 1024; two = true; } }
            else { m0 = 6144 + half_gw + 1024 * (2 * st); m1 = m0 + 1024; two = true; } }
        else { m0 = gw + st * 2 * NGW; if (m0 >= nrows) break; const int m1r = m0 + NGW; two = m1r < nrows; m1 = two ? m1r : m0; }
        const bool fromx = (src == 0) && !first;
        const float* xr0 = (src != 2) ? (m0 < MP ? c.in[I_XP] + (size_t)m0 * D : c.in[I_XS] + (size_t)(m0 - MP) * D) : c.in[I_MEMP] + (size_t)m0 * D;
        const float* xr1 = (src != 2) ? (m1 < MP ? c.in[I_XP] + (size_t)m1 * D : c.in[I_XS] + (size_t)(m1 - MP) * D) : c.in[I_MEMP] + (size_t)m1 * D;
        f32x4 v0[8], v1[8];
        if (fromx) {
#pragma unroll
            for (int jj = 0; jj < 4; ++jj) { X24_LD2(v0[2 * jj], v0[2 * jj + 1], m0, jj); if (two) X24_LD2(v1[2 * jj], v1[2 * jj + 1], m1, jj); else { v1[2 * jj] = v0[2 * jj]; v1[2 * jj + 1] = v0[2 * jj + 1]; } } }
        else {
#pragma unroll
            for (int j = 0; j < 8; ++j) { v0[j] = __builtin_nontemporal_load((const f32x4*)(xr0 + EO(j))); v1[j] = two ? __builtin_nontemporal_load((const f32x4*)(xr1 + EO(j))) : v0[j]; } }
        if (use_delta) { f32x4 d0[8], d1[8]; float s0 = 0.f, s1 = 0.f;
#pragma unroll
            for (int jj = 0; jj < 4; ++jj) {
                if (m0 < MP) LD_BF8(d0[2 * jj], d0[2 * jj + 1], delta + (size_t)m0 * D + EB(jj));
                else { const bf16_t* sp = WS_PTR(bf16_t, WS_SLAB) + (size_t)(m0 - MP) * D + EB(jj); LD_BF8(d0[2 * jj], d0[2 * jj + 1], sp);
#pragma unroll
                    for (int s8 = 1; s8 < 8; ++s8) if (s8 < nslab) ADD_BF8(d0[2 * jj], d0[2 * jj + 1], sp + (size_t)s8 * 1024 * D); }
                if (!two) { d1[2 * jj] = d0[2 * jj]; d1[2 * jj + 1] = d0[2 * jj + 1]; }
                else if (m1 < MP) LD_BF8(d1[2 * jj], d1[2 * jj + 1], delta + (size_t)m1 * D + EB(jj));
                else { const bf16_t* sp = WS_PTR(bf16_t, WS_SLAB) + (size_t)(m1 - MP) * D + EB(jj); LD_BF8(d1[2 * jj], d1[2 * jj + 1], sp);
#pragma unroll
                    for (int s8 = 1; s8 < 8; ++s8) if (s8 < nslab) ADD_BF8(d1[2 * jj], d1[2 * jj + 1], sp + (size_t)s8 * 1024 * D); } }
#pragma unroll
            for (int j = 0; j < 8; ++j) { s0 += (d0[j].x * d0[j].x + d0[j].y * d0[j].y) + (d0[j].z * d0[j].z + d0[j].w * d0[j].w); s1 += (d1[j].x * d1[j].x + d1[j].y * d1[j].y) + (d1[j].z * d1[j].z + d1[j].w * d1[j].w); }
            const float r0 = rsqrtf(wave_sum_dpp(s0) * (1.f / D) + EPS), r1 = rsqrtf(wave_sum_dpp(s1) * (1.f / D) + EPS);
#pragma unroll
            for (int j = 0; j < 8; ++j) { const f32x4 g = *(const f32x4*)(gpost + EO(j)); v0[j] = v0[j] + d0[j] * r0 * g; v1[j] = v1[j] + d1[j] * r1 * g; } }
        if (src == 0 && !write_y) {
#pragma unroll
            for (int jj = 0; jj < 4; ++jj) { X24_ST2(v0[2 * jj], v0[2 * jj + 1], m0, jj); if (two) X24_ST2(v1[2 * jj], v1[2 * jj + 1], m1, jj); } }
        if (write_y) {
#pragma unroll
            for (int j = 0; j < 8; ++j) { __builtin_nontemporal_store(v0[j], (f32x4*)(c.out + O_YP + (size_t)m0 * D + EO(j))); if (two) __builtin_nontemporal_store(v1[j], (f32x4*)(c.out + O_YP + (size_t)m1 * D + EO(j))); }
            continue; }
        float q0 = 0.f, q1 = 0.f;
#pragma unroll
        for (int j = 0; j < 8; ++j) { q0 += (v0[j].x * v0[j].x + v0[j].y * v0[j].y) + (v0[j].z * v0[j].z + v0[j].w * v0[j].w); q1 += (v1[j].x * v1[j].x + v1[j].y * v1[j].y) + (v1[j].z * v1[j].z + v1[j].w * v1[j].w); }
        const float t0 = rsqrtf(wave_sum_dpp(q0) * (1.f / D) + EPS), t1 = rsqrtf(wave_sum_dpp(q1) * (1.f / D) + EPS);
        bf16_t* xn0 = ((src == 2) ? WS_PTR(bf16_t, WS_MEMN) : XN) + (size_t)m0 * D; bf16_t* xn1 = ((src == 2) ? WS_PTR(bf16_t, WS_MEMN) : XN) + (size_t)m1 * D;
#pragma unroll
        for (int jj = 0; jj < 4; ++jj) { const f32x4 a0 = v0[2 * jj], b0 = v0[2 * jj + 1], a1 = v1[2 * jj], b1 = v1[2 * jj + 1]; u32x4 w0, w1;
            w0.x = pk2(a0.x * t0, a0.y * t0); w0.y = pk2(a0.z * t0, a0.w * t0); w0.z = pk2(b0.x * t0, b0.y * t0); w0.w = pk2(b0.z * t0, b0.w * t0);
            w1.x = pk2(a1.x * t1, a1.y * t1); w1.y = pk2(a1.z * t1, a1.w * t1); w1.z = pk2(b1.x * t1, b1.y * t1); w1.w = pk2(b1.z * t1, b1.w * t1);
            *(u32x4*)(xn0 + EB(jj)) = w0; if (two) *(u32x4*)(xn1 + EB(jj)) = w1; }
    }
#undef EO
#undef EB
#undef LD_BF8
#undef ADD_BF8
#undef X24_LD2
#undef X24_ST2
}
__device__ __forceinline__ void ph_skinny(CtxP cp, int var, LAS unsigned char* lds) {
    CTX_LOAD(cp);
    const int bid_ = obid(), grid_ = ogrid(); const int tid = otid(), lane = tid & 63, wave = tid >> 6, n16 = lane & 15, q = lane >> 4;
    const bf16_t* Wb = WS_PTR(bf16_t, WS_WSKB) + (size_t)var * 32 * D + (size_t)n16 * D + 8 * q + 256 * wave;
    bf16x8s wa[8], wb[8];
#pragma unroll
    for (int ks = 0; ks < 8; ++ks) { wa[ks] = *(const bf16x8s*)(Wb + 32 * ks); wb[ks] = *(const bf16x8s*)(Wb + (size_t)16 * D + 32 * ks); }
    LAS float* P = (LAS float*)lds;
    const bf16_t* xp = WS_PTR(bf16_t, WS_XN) + (size_t)n16 * D + 8 * q + 256 * wave;
    __syncthreads();
    bf16x8s xb[8];
#pragma unroll
    for (int ks = 0; ks < 8; ++ks) xb[ks] = *(const bf16x8s*)(xp + (size_t)(16 * bid_) * D + 32 * ks);
    int nt = 0;
    for (int rt = bid_; rt < M / 16; rt += grid_, ++nt) {
        bf16x8s xn[8]; const int rn = rt + grid_;
        if (rn < M / 16) {
#pragma unroll
            for (int ks = 0; ks < 8; ++ks) xn[ks] = *(const bf16x8s*)(xp + (size_t)(16 * rn) * D + 32 * ks); }
        else {
#pragma unroll
            for (int ks = 0; ks < 8; ++ks) xn[ks] = xb[ks]; }
        f32x4 a0 = {0.f, 0.f, 0.f, 0.f}, a1 = {0.f, 0.f, 0.f, 0.f};
#pragma unroll
        for (int ks = 0; ks < 8; ++ks) { a0 = __builtin_amdgcn_mfma_f32_16x16x32_bf16(wa[ks], xb[ks], a0, 0, 0, 0); a1 = __builtin_amdgcn_mfma_f32_16x16x32_bf16(wb[ks], xb[ks], a1, 0, 0, 0); }
        LAS float* pp = P + (size_t)((nt * 8 + wave) * 8) * 64 + lane;
#pragma unroll
        for (int i = 0; i < 4; ++i) { pp[i * 64] = a0[i]; pp[(4 + i) * 64] = a1[i]; }
#pragma unroll
        for (int ks = 0; ks < 8; ++ks) xb[ks] = xn[ks];
    }
    __syncthreads();
    const int cc = (wave < 4) ? 4 * q + wave : 16 + 4 * q + (wave - 4);
    for (int t = 0; t < nt; ++t) { const int m = 16 * (bid_ + t * grid_) + n16; float s = 0.f;
#pragma unroll
        for (int w = 0; w < 8; ++w) s += P[(size_t)((t * 8 + w) * 8 + wave) * 64 + lane];
        if (var < 2) {
            if (cc < 12) WS_PTR(float, WS_G)[(size_t)m * 12 + cc] = -exp_fast(c.in[I_ALOG][var * 12 + cc]) * softplus_fast(s + c.in[I_DTB][var * 12 + cc]);
            else if (cc < 24) WS_PTR(float, WS_BETA)[(size_t)m * 12 + (cc - 12)] = fast_sigmoid(s); }
        else if (cc < 12) { const float lf = -softplus_fast(-(s + c.in[I_BF][cc])); WS_PTR(float, WS_LOGF)[(size_t)m * 12 + cc] = lf;
            c.out[(m < MP ? O_PLOGF + (size_t)m * 12 : O_SLOGF + (size_t)(m - MP) * 12) + cc] = lf; } }
    __syncthreads();
}
__device__ __forceinline__ void ph_gdn_c(CtxP cp, int l) {
    CTX_LOAD(cp);
    const int bid_ = obid(), grid_ = ogrid(); const int tid = otid(), lane = tid & 63, wave = tid >> 6, gw = bid_ * 8 + wave, NGW = grid_ * 8, sub = lane >> 4, c8 = (lane & 15) * 8;
    const bf16_t* PROJ = WS_PTR(bf16_t, WS_PROJ); const bf16_t* Of = WS_PTR(bf16_t, WS_OF); bf16_t* ACT = WS_PTR(bf16_t, WS_ACT);
    const f32x4 g0 = *(const f32x4*)(c.in[I_GDNN] + l * HD + c8), g1 = *(const f32x4*)(c.in[I_GDNN] + l * HD + c8 + 4);
    for (int it = gw * 4 + sub; it < M * H; it += NGW * 4) { const int m = it / H, h = it % H;
        const u32x4 ou = __builtin_nontemporal_load((const u32x4*)(Of + (size_t)m * TOK + h * HD + c8));
        const f32x4 o0 = {bflo(ou.x), bfhi(ou.x), bflo(ou.y), bfhi(ou.y)}, o1 = {bflo(ou.z), bfhi(ou.z), bflo(ou.w), bfhi(ou.w)};
        const u32x4 zu = __builtin_nontemporal_load((const u32x4*)(PROJ + (size_t)m * PJ + QKV + h * HD + c8));
        float ss = (o0.x * o0.x + o0.y * o0.y) + (o0.z * o0.z + o0.w * o0.w) + (o1.x * o1.x + o1.y * o1.y) + (o1.z * o1.z + o1.w * o1.w);
        ss += __int_as_float(__builtin_amdgcn_update_dpp(0, __float_as_int(ss), 0x111, 0xf, 0xf, true)); ss += __int_as_float(__builtin_amdgcn_update_dpp(0, __float_as_int(ss), 0x112, 0xf, 0xf, true));
        ss += __int_as_float(__builtin_amdgcn_update_dpp(0, __float_as_int(ss), 0x114, 0xf, 0xf, true)); ss += __int_as_float(__builtin_amdgcn_update_dpp(0, __float_as_int(ss), 0x118, 0xf, 0xf, true));
        ss = lane_get(ss, lane | 15);
        const float r = rsqrtf(ss * (1.f / HD) + EPS);
        const float z0 = bflo(zu.x), z1 = bfhi(zu.x), z2 = bflo(zu.y), z3 = bfhi(zu.y), z4 = bflo(zu.z), z5 = bfhi(zu.z), z6 = bflo(zu.w), z7 = bfhi(zu.w);
        u32x4 w4; w4.x = pk2(o0.x * r * g0.x * (z0 * fast_sigmoid(z0)), o0.y * r * g0.y * (z1 * fast_sigmoid(z1))); w4.y = pk2(o0.z * r * g0.z * (z2 * fast_sigmoid(z2)), o0.w * r * g0.w * (z3 * fast_sigmoid(z3)));
        w4.z = pk2(o1.x * r * g1.x * (z4 * fast_sigmoid(z4)), o1.y * r * g1.y * (z5 * fast_sigmoid(z5))); w4.w = pk2(o1.z * r * g1.z * (z6 * fast_sigmoid(z6)), o1.w * r * g1.w * (z7 * fast_sigmoid(z7)));
        *(u32x4*)(ACT + (size_t)m * D + h * HD + c8) = w4; }
}
__device__ __forceinline__ float wave_scan_dpp(float v, int lane, float& total) {
    v += __int_as_float(__builtin_amdgcn_update_dpp(0, __float_as_int(v), 0x111, 0xf, 0xf, true));
    v += __int_as_float(__builtin_amdgcn_update_dpp(0, __float_as_int(v), 0x112, 0xf, 0xf, true));
    v += __int_as_float(__builtin_amdgcn_update_dpp(0, __float_as_int(v), 0x114, 0xf, 0xf, true));
    v += __int_as_float(__builtin_amdgcn_update_dpp(0, __float_as_int(v), 0x118, 0xf, 0xf, true));
    const int iv = __float_as_int(v);
    const float r0 = __int_as_float(__builtin_amdgcn_readlane(iv, 15)), r1 = __int_as_float(__builtin_amdgcn_readlane(iv, 31)), r2 = __int_as_float(__builtin_amdgcn_readlane(iv, 47)), r3 = __int_as_float(__builtin_amdgcn_readlane(iv, 63));
    const int row = lane >> 4; total = ((r0 + r1) + r2) + r3;
    return v + (row == 0 ? 0.f : row == 1 ? r0 : row == 2 ? r0 + r1 : (r0 + r1) + r2);
}
__device__ __forceinline__ void ph_cumsum(CtxP cp) {
    CTX_LOAD(cp);
    const int bid_ = obid(), grid_ = ogrid(); const int tid = otid(), lane = tid & 63, wave = tid >> 6, NGW = grid_ * 8;
    const float* LOGF = WS_PTR(float, WS_LOGF); float* CUMP = WS_PTR(float, WS_CUMP); float* CUMS = WS_PTR(float, WS_CUMS);
    for (int task = bid_ + grid_ * wave; task < 192 + 384; task += NGW) {
        const bool smp = task >= 192; int b, h, jb, n; float carry = 0.f;
        if (!smp) { const int seg = task / 48, ts = task % 48; b = ts / 12; h = ts % 12; jb = seg * 1024; n = jb + 1024; float ps = 0.f;
#pragma unroll 16
            for (int j = lane; j < jb; j += 64) ps += LOGF[(size_t)(b * 4096 + j) * 12 + h];
            carry = wave_sum_dpp(ps); }
        else { const int ts = task - 192; b = ts / 12; h = ts % 12; jb = 0; n = PAST + 32; }
        for (int j0 = jb; j0 < n; j0 += 1024) { float vv[16];
#pragma unroll
            for (int u = 0; u < 16; ++u) { const int j = j0 + 64 * u + lane; vv[u] = 0.f;
                if (j < n) vv[u] = !smp ? LOGF[(size_t)(b * 4096 + j) * 12 + h] : (j < PAST ? c.in[I_CLOGF][(size_t)(b * PAST + j) * 12 + h] : LOGF[(size_t)(MP + b * 32 + j - PAST) * 12 + h]); }
#pragma unroll
            for (int u = 0; u < 16; ++u) { const int j = j0 + 64 * u + lane; float tot; const float v = wave_scan_dpp(vv[u], lane, tot);
                if (j < n) { if (smp) CUMS[(size_t)(b * (PAST + 32) + j) * 12 + h] = carry + v; else { CUMP[(size_t)(b * 4096 + j) * 12 + h] = carry + v;
                        const float cr = (carry + v) * (1.f / SCALE); const unsigned c1 = pk2(cr, 0.f) & 0xffffu; const float r1 = cr - __uint_as_float(c1 << 16); const unsigned c2 = pk2(r1, 0.f) & 0xffffu;
                        const float r2 = r1 - __uint_as_float(c2 << 16); const unsigned c3 = pk2(r2, 0.f) & 0xffffu; const size_t o8 = ((size_t)(b * 12 + h) * 4096 + j) * 8;
                        u32x4 qv, kv; qv.x = c1 | (c2 << 16); qv.y = c3 | 0x3f800000u; qv.z = 0x3f803f80u; qv.w = 0u; kv.x = 0x3f803f80u; kv.y = 0x3f80u | ((c1 ^ 0x8000u) << 16); kv.z = (c2 ^ 0x8000u) | ((c3 ^ 0x8000u) << 16); kv.w = 0u;
                        *(u32x4*)(WS_PTR(bf16_t, WS_QX) + o8) = qv; *(u32x4*)(WS_PTR(bf16_t, WS_KX) + o8) = kv; } }
                carry += tot; } }
    }
}
typedef short bf16x8 __attribute__((ext_vector_type(8)));
typedef float f32x16 __attribute__((ext_vector_type(16)));
constexpr int GT_W = 0, GT_QG = 16384, GT_KG = 32768, GT_AT = 49152, GT_U = 57344, GT_BYTES = 73728;
constexpr int NTASK_P = 4 * 12 * 64, NTASK = NTASK_P + 384;
constexpr size_t WS_GDNBUF = WS_BIG;
static_assert((size_t)NTASK * GT_BYTES <= 306 * MiB, "GDNBUF must not reach WS_OF");
__device__ __forceinline__ int permpos(int x) { return (x & ~31) | (((x >> 2) & 3) << 3) | (((x >> 4) & 1) << 2) | (x & 3); }
__device__ __forceinline__ int crow32(int r, int hi) { return (r & 3) + 8 * (r >> 2) + 4 * hi; }
constexpr int L_KN = 0, L_QN = 17408, L_VBT = 34816, L_KBT = 53248, L_AS = 71680, L_TS = 88320, L_KGT = 97536, L_ATP = 113920, L_GS = 122112, L_BS = 122368, L_TD = 122624, L_CW = 131072;
#define LDS_BARRIER() do { asm volatile("s_waitcnt lgkmcnt(0)" ::: "memory"); __builtin_amdgcn_s_barrier(); asm volatile("" ::: "memory"); } while (0)
__device__ __forceinline__ void ph_gdn_prep(CtxP cp, int l, LAS unsigned char* lds) {
    CTX_LOAD(cp);
    const int bid_ = obid(), grid_ = ogrid(); const int tid0 = otid();
    const bf16_t* PROJ = WS_PTR(bf16_t, WS_PROJ); const float* cw = c.in[I_CONVW] + (size_t)l * 4 * QKV;
    LAS float* Gs = (LAS float*)(lds + L_GS); LAS float* Bs = (LAS float*)(lds + L_BS); LAS float* As = (LAS float*)(lds + L_AS);
    unsigned warm = 0u;
    for (int tk = bid_; tk < NTASK; tk += grid_) {
        asm volatile("" :: "v"(warm));
        int tid = tid0; asm volatile("" : "+v"(tid));
        const int lane = tid & 63, w = __builtin_amdgcn_readfirstlane(tid >> 6);
        int grp, b, h, ch, L, m0, t0;
        if (tk < NTASK_P) { grp = 0; ch = tk & 63; const int bh = tk >> 6; b = bh / 12; h = bh % 12; L = 64; t0 = ch * 64; m0 = b * 4096 + t0; }
        else { grp = 1; ch = 0; const int bh = tk - NTASK_P; b = bh / 12; h = bh % 12; L = 32; t0 = 0; m0 = MP + b * 32; }
        const int T = grp ? 32 : 4096, nb = grp ? 32 : 4;
        unsigned char* gb = c.ws + WS_GDNBUF + (size_t)tk * GT_BYTES;
        if (tid >= 128) { const int e4 = 4 * (tid - 128); *(LAS f32x4*)(lds + L_CW + e4 * 4) = *(const f32x4*)(cw + (size_t)((e4 >> 7) & 3) * QKV + (e4 >> 9) * TOK + h * HD + (e4 & 127)); }
        if (tid < 64) { const bool v = tid < L; float gv = v ? WS_PTR(float, WS_G)[(size_t)(m0 + tid) * 12 + h] : 0.f; const float bv = v ? WS_PTR(float, WS_BETA)[(size_t)(m0 + tid) * 12 + h] : 0.f;
#pragma unroll
            for (int o = 1; o < 64; o <<= 1) { const float n = lane_get(gv, lane - o); if (lane >= o) gv += n; }
            Gs[tid] = gv; Bs[tid] = bv; }
        LDS_BARRIER();
        const int r = tid >> 3, seg = tid & 7; const bool valid = r < L; const int t = t0 + r, m = m0 + r;
        const float gr = Gs[r], eg = expf(gr), egl = expf(Gs[63] - gr), bt = Bs[r]; const int pr = permpos(r);
#pragma unroll
        for (int pi = 0; pi < 3; ++pi) { const int part = (pi == 0) ? 1 : (pi == 1 ? 0 : 2);
            const int col0 = part * TOK + h * HD + 16 * seg; float y[16];
#pragma unroll
            for (int e = 0; e < 16; ++e) y[e] = 0.f;
            if (valid) {
#pragma unroll
                for (int jj = 0; jj < 4; ++jj) { const int tt = t - 3 + jj; float x[16];
                    if (tt >= 0) { const u32x4 a = *(const u32x4*)(PROJ + (size_t)(m - 3 + jj) * PJ + col0), bq = *(const u32x4*)(PROJ + (size_t)(m - 3 + jj) * PJ + col0 + 8);
                        x[0] = bflo(a.x); x[1] = bfhi(a.x); x[2] = bflo(a.y); x[3] = bfhi(a.y); x[4] = bflo(a.z); x[5] = bfhi(a.z); x[6] = bflo(a.w); x[7] = bfhi(a.w);
                        x[8] = bflo(bq.x); x[9] = bfhi(bq.x); x[10] = bflo(bq.y); x[11] = bfhi(bq.y); x[12] = bflo(bq.z); x[13] = bfhi(bq.z); x[14] = bflo(bq.w); x[15] = bfhi(bq.w); }
                    else if (grp) { const float* hp = c.in[I_SCONV] + (size_t)((l * 32 + b) * 3 + (3 + tt)) * QKV + col0;
#pragma unroll
                        for (int i = 0; i < 4; ++i) { const f32x4 a = *(const f32x4*)(hp + 4 * i); x[4 * i] = a.x; x[4 * i + 1] = a.y; x[4 * i + 2] = a.z; x[4 * i + 3] = a.w; } }
                    else {
#pragma unroll
                        for (int e = 0; e < 16; ++e) x[e] = 0.f; }
#pragma unroll
                    for (int i = 0; i < 4; ++i) { const f32x4 wv = *(const LAS f32x4*)(lds + L_CW + ((part * 4 + jj) * 128 + 16 * seg + 4 * i) * 4);
                        y[4 * i] += x[4 * i] * wv.x; y[4 * i + 1] += x[4 * i + 1] * wv.y; y[4 * i + 2] += x[4 * i + 2] * wv.z; y[4 * i + 3] += x[4 * i + 3] * wv.w; } }
                if (t >= T - 3) { const u32x4 a = *(const u32x4*)(PROJ + (size_t)m * PJ + col0), bq = *(const u32x4*)(PROJ + (size_t)m * PJ + col0 + 8);
                    float* dst = c.out + (grp ? O_SCONV : O_PCONV) + (size_t)((l * nb + b) * 3 + (t - (T - 3))) * QKV + col0;
                    *(f32x4*)(dst) = (f32x4){bflo(a.x), bfhi(a.x), bflo(a.y), bfhi(a.y)}; *(f32x4*)(dst + 4) = (f32x4){bflo(a.z), bfhi(a.z), bflo(a.w), bfhi(a.w)};
                    *(f32x4*)(dst + 8) = (f32x4){bflo(bq.x), bfhi(bq.x), bflo(bq.y), bfhi(bq.y)}; *(f32x4*)(dst + 12) = (f32x4){bflo(bq.z), bfhi(bq.z), bflo(bq.w), bfhi(bq.w)}; }
#pragma unroll
                for (int e = 0; e < 16; ++e) y[e] = y[e] * fast_sigmoid(y[e]);
            }
            if (part < 2) { float ss = 0.f;
#pragma unroll
                for (int e = 0; e < 16; ++e) ss += y[e] * y[e];
                ss += lane_get(ss, lane ^ 1); ss += lane_get(ss, lane ^ 2); ss += lane_get(ss, lane ^ 4);
                const float rn = rsqrtf(ss + EPS) * (part == 0 ? SCALE : 1.f);
#pragma unroll
                for (int e = 0; e < 16; ++e) y[e] *= rn;
                u32x4 p0, p1; p0.x = pk2(y[0], y[1]); p0.y = pk2(y[2], y[3]); p0.z = pk2(y[4], y[5]); p0.w = pk2(y[6], y[7]); p1.x = pk2(y[8], y[9]); p1.y = pk2(y[10], y[11]); p1.z = pk2(y[12], y[13]); p1.w = pk2(y[14], y[15]);
                const int dst = (part == 1 ? L_KN : L_QN) + r * 272 + seg * 32;
                *(LAS u32x4*)(lds + dst) = p0; *(LAS u32x4*)(lds + dst + 16) = p1; }
            if (part == 1) {
#pragma unroll
                for (int e = 0; e < 16; ++e) { const int col = 16 * seg + e;
                    *(LAS bf16_t*)(lds + L_KBT + col * 144 + (((r >> 3) ^ seg) << 4) + (r & 7) * 2) = (bf16_t)(pk2(bt * eg * y[e], 0.f) & 0xffffu);
                    *(LAS bf16_t*)(lds + L_KGT + col * 128 + (((pr >> 3) ^ seg) << 4) + (pr & 7) * 2) = (bf16_t)(pk2(egl * y[e], 0.f) & 0xffffu); } }
            else if (part == 0) {
#pragma unroll
                for (int q4 = 0; q4 < 4; ++q4) { u32x2 v2; v2.x = pk2(eg * y[4 * q4], eg * y[4 * q4 + 1]); v2.y = pk2(eg * y[4 * q4 + 2], eg * y[4 * q4 + 3]);
                    __builtin_nontemporal_store(v2, (u32x2*)(gb + GT_QG + r * 256 + (32 * (seg >> 1) + 8 * q4 + 4 * (seg & 1)) * 2)); } }
            else {
#pragma unroll
                for (int e = 0; e < 16; ++e) *(LAS bf16_t*)(lds + L_VBT + (16 * seg + e) * 144 + (((r >> 3) ^ seg) << 4) + (r & 7) * 2) = (bf16_t)(pk2(bt * y[e], 0.f) & 0xffffu); }
            __builtin_amdgcn_sched_barrier(0);
        }
        if (tid == 0) WS_PTR(float, WS_EGL)[tk] = expf(Gs[63]);
        { const int tkn = tk + grid_;
            if (tkn < NTASK && tid < 402) { int m0n, hn; if (tkn < NTASK_P) { const int bh = tkn >> 6; hn = bh % 12; m0n = (bh / 12) * 4096 + (tkn & 63) * 64; } else { const int bh = tkn - NTASK_P; hn = bh % 12; m0n = MP + (bh / 12) * 32; }
                const int row = tid / 6, rem = tid % 6; int mm = m0n - 3 + row; mm = mm < 0 ? 0 : (mm >= M ? M - 1 : mm);
                warm = *(const volatile unsigned*)(PROJ + (size_t)mm * PJ + (rem >> 1) * TOK + hn * HD + (rem & 1) * 64); } }
        LDS_BARRIER();
        { const int r32 = lane & 31, hi = lane >> 5;
            if (w < 6) { const int which = w / 3, tt3 = w % 3, ib = tt3 ? 1 : 0, jb = (tt3 == 2) ? 1 : 0; f32x16 acc = {};
                const int xoff = (which ? L_QN : L_KN) + (ib * 32 + r32) * 272 + hi * 16, koff = L_KN + (jb * 32 + r32) * 272 + hi * 16;
#pragma unroll
                for (int kk = 0; kk < 8; ++kk) { const bf16x8 a = *(const LAS bf16x8*)(lds + xoff + kk * 32), bq = *(const LAS bf16x8*)(lds + koff + kk * 32);
                    acc = __builtin_amdgcn_mfma_f32_32x32x16_bf16(a, bq, acc, 0, 0, 0); }
                const int j = jb * 32 + r32; const float gj = Gs[j]; const int pj = permpos(j);
#pragma unroll
                for (int rr = 0; rr < 16; ++rr) { const int i = ib * 32 + crow32(rr, hi); const float dec = expf(fminf(Gs[i] - gj, 0.f));
                    if (which == 0) As[i * 65 + j] = (i > j) ? Bs[i] * acc[rr] * dec : 0.f;
                    else *(LAS bf16_t*)(lds + L_ATP + i * 128 + pj * 2) = (bf16_t)(pk2((i >= j) ? acc[rr] * dec : 0.f, 0.f) & 0xffffu); } }
            else { const int j = 32 + r32;
#pragma unroll
                for (int rr = 0; rr < 16; ++rr) { const int i = crow32(rr, hi);
                    if (w == 6) As[i * 65 + j] = 0.f; else *(LAS bf16_t*)(lds + L_ATP + i * 128 + permpos(j) * 2) = (bf16_t)0; } } }
        LDS_BARRIER();
        if (w == 0) { const int blk = lane >> 5, col = lane & 31, r32 = col, hi = blk; float x[32];
            const LAS float* Asv = As + blk * (32 * 65 + 32); asm volatile("" : "+v"(Asv));
            LAS float* Td = (LAS float*)(lds + L_TD);
#pragma unroll
            for (int i = 0; i < 32; ++i) { float a = (col == i) ? 1.f : 0.f;
#pragma unroll
                for (int j = 0; j < i; ++j) a -= Asv[i * 65 + j] * x[j];
                x[i] = a; Td[blk * (32 * 33) + i * 33 + col] = a;
                *(LAS bf16_t*)(lds + L_TS + (blk * 32 + i) * 144 + (blk * 32 + col) * 2) = (bf16_t)(pk2(a, 0.f) & 0xffffu);
                if (blk) *(LAS bf16_t*)(lds + L_TS + i * 144 + (32 + col) * 2) = (bf16_t)0;
                if ((i & 7) == 7) __builtin_amdgcn_sched_barrier(0); }
            f32x16 acc = {};
#pragma unroll
            for (int s = 0; s < 16; ++s) acc = __builtin_amdgcn_mfma_f32_32x32x2f32(As[(32 + r32) * 65 + 2 * s + hi], Td[(2 * s + hi) * 33 + r32], acc, 0, 0, 0);
#pragma unroll
            for (int rr = 0; rr < 16; ++rr) Td[crow32(rr, hi) * 33 + r32] = acc[rr];
            f32x16 acc2 = {};
#pragma unroll
            for (int s = 0; s < 16; ++s) acc2 = __builtin_amdgcn_mfma_f32_32x32x2f32(Td[32 * 33 + r32 * 33 + 2 * s + hi], Td[(2 * s + hi) * 33 + r32], acc2, 0, 0, 0);
#pragma unroll
            for (int rr = 0; rr < 16; ++rr) *(LAS bf16_t*)(lds + L_TS + (32 + crow32(rr, hi)) * 144 + r32 * 2) = (bf16_t)(pk2(-acc2[rr], 0.f) & 0xffffu); }
        LDS_BARRIER();
        { const int r32 = lane & 31, hi = lane >> 5; const int src = (w < 4 ? L_VBT : L_KBT) + ((w & 3) * 32 + r32) * 144, sw = (((w & 3) * 32 + r32) >> 4) & 7;
#pragma unroll
            for (int ib = 0; ib < 2; ++ib) { f32x16 acc = {}; const int toff = L_TS + (ib * 32 + r32) * 144 + hi * 16;
#pragma unroll
                for (int kk = 0; kk < 4; ++kk) { if (kk < 2 * (ib + 1)) { const bf16x8 a = *(const LAS bf16x8*)(lds + toff + kk * 32), bq = *(const LAS bf16x8*)(lds + src + (((2 * kk + hi) ^ sw) << 4));
                        acc = __builtin_amdgcn_mfma_f32_32x32x16_bf16(a, bq, acc, 0, 0, 0); } }
                const int col = (w & 3) * 32 + r32;
                if (w < 4) {
#pragma unroll
                    for (int g = 0; g < 4; ++g) { u32x2 v2; v2.x = pk2(acc[4 * g], acc[4 * g + 1]); v2.y = pk2(acc[4 * g + 2], acc[4 * g + 3]);
                        *(LAS u32x2*)(lds + L_QN + col * 128 + (((4 * ib + g) ^ (col & 7)) << 4) + hi * 8) = v2; } }
                else { const int pc = permpos(col);
#pragma unroll
                    for (int rr = 0; rr < 16; ++rr) { const int i = ib * 32 + crow32(rr, hi); *(LAS bf16_t*)(lds + L_KN + i * 256 + pc * 2) = (bf16_t)(pk2(acc[rr], 0.f) & 0xffffu); } } } }
        LDS_BARRIER();
#pragma unroll
        for (int k = 0; k < 7; ++k) { const int u = tid + 512 * k; int lo, go;
            if (k < 2) { lo = L_KN + u * 16; go = GT_W + u * 16; } else if (k < 4) { const int uu = u - 1024, row = uu >> 3; lo = L_QN + row * 128 + (((uu & 7) ^ (row & 7)) << 4); go = GT_U + uu * 16; }
            else if (k < 6) { const int uu = u - 2048, row = uu >> 3; lo = L_KGT + row * 128 + (((uu & 7) ^ ((row >> 4) & 7)) << 4); go = GT_KG + uu * 16; } else { lo = L_ATP + (u - 3072) * 16; go = GT_AT + (u - 3072) * 16; }
            __builtin_nontemporal_store(*(const LAS u32x4*)(lds + lo), (u32x4*)(gb + go)); }
    }
}
constexpr int SC_W = 0, SC_QG = 17408, SC_KG = 34816, SC_AT = 53248, SC_BUF = 62464, SC_OS = 2 * SC_BUF;
__device__ __forceinline__ void ph_gdn_scan(CtxP cp, int l, LAS unsigned char* lds) {
    CTX_LOAD(cp);
    const int bid_ = obid(), grid_ = ogrid(); const int tid = otid(), lane = tid & 63, w = __builtin_amdgcn_readfirstlane(tid >> 6), m16 = lane & 15, q = lane >> 4;
    const float* EGL = WS_PTR(float, WS_EGL);
    const int nsmpwg = grid_ - 96;
    for (int it = 0;; ++it) {
        int grp, bh, half, nch, tk0;
        if (bid_ < 96) { if (it > 0) break; grp = 0; bh = bid_ >> 1; half = bid_ & 1; nch = 64; tk0 = bh * 64; }
        else { const int si = (bid_ - 96) + nsmpwg * it; if (si >= 768) break; grp = 1; bh = si >> 1; half = si & 1; nch = 1; tk0 = NTASK_P + bh; }
        const int b = bh / 12, h = bh % 12, m0 = grp ? MP + b * 32 : b * 4096;
        __syncthreads();
        if (w >= 4) {
            const int lt = tid - 256; u32x4 stA[14], stB[14];
#define SC_LOAD(ST, tk) do { const unsigned char* gsrc = c.ws + WS_GDNBUF + (size_t)(tk) * GT_BYTES; _Pragma("unroll") for (int k = 0; k < 14; ++k) ST[k] = __builtin_nontemporal_load((const u32x4*)(gsrc + (size_t)(lt + 256 * k) * 16)); } while (0)
#define SC_WRITE(ST, bufoff) do { _Pragma("unroll") for (int k = 0; k < 14; ++k) { const int u = lt + 256 * k; int lo; \
            if (k < 4) lo = SC_W + (u >> 4) * 272 + (u & 15) * 16; else if (k < 8) lo = SC_QG + ((u - 1024) >> 4) * 272 + (u & 15) * 16; \
            else if (k < 12) lo = SC_KG + ((u - 2048) >> 3) * 144 + (u & 7) * 16; else lo = SC_AT + ((u - 3072) >> 3) * 144 + (u & 7) * 16; \
            *(LAS u32x4*)(lds + (bufoff) + lo) = ST[k]; } } while (0)
            bf16_t* Ob = WS_PTR(bf16_t, WS_OF) + (size_t)m0 * TOK + h * HD + half * 64; const int nou = grp ? 256 : 512;
#define SC_OUT(ch_) do { _Pragma("unroll") for (int k = 0; k < 2; ++k) { const int u = lt + 256 * k; if (u < nou) \
                *(u32x4*)(Ob + (size_t)((ch_) * 64 + (u >> 3)) * TOK + (u & 7) * 8) = *(const LAS u32x4*)(lds + SC_OS + ((ch_) & 1) * 8192 + u * 16); } } while (0)
            SC_LOAD(stA, tk0); SC_WRITE(stA, 0);
            if (1 < nch) SC_LOAD(stA, tk0 + 1);
            if (2 < nch) SC_LOAD(stB, tk0 + 2);
            LDS_BARRIER();
            for (int ch = 0; ch < nch; ch += 2) {
                if (ch >= 1) SC_OUT(ch - 1);
                if (ch + 1 < nch) SC_WRITE(stA, ((ch + 1) & 1) * SC_BUF);
                if (ch + 3 < nch) SC_LOAD(stA, tk0 + ch + 3);
                LDS_BARRIER();
                if (ch + 1 < nch) {
                    SC_OUT(ch);
                    if (ch + 2 < nch) SC_WRITE(stB, ((ch + 2) & 1) * SC_BUF);
                    if (ch + 4 < nch) SC_LOAD(stB, tk0 + ch + 4);
                    LDS_BARRIER(); }
            }
            SC_OUT(nch - 1);
#undef SC_OUT
#undef SC_LOAD
#undef SC_WRITE
        } else {
            __builtin_amdgcn_s_setprio(2);
            const int c0 = half * 64 + 16 * w;
            f32x4 S[8];
            if (grp) { const float* S0 = c.in[I_SGDN] + (size_t)((l * 32 + b) * 12 + h) * 16384;
#pragma unroll
                for (int dt = 0; dt < 8; ++dt)
#pragma unroll
                    for (int i = 0; i < 4; ++i) S[dt][i] = S0[(16 * dt + 4 * q + i) * 128 + c0 + m16]; }
            else {
#pragma unroll
                for (int dt = 0; dt < 8; ++dt) S[dt] = (f32x4){0.f, 0.f, 0.f, 0.f}; }
            u32x2 un[4]; float egn;
#define UE_LOAD(tk_) do { const unsigned char* ut_ = c.ws + WS_GDNBUF + (size_t)(tk_) * GT_BYTES + GT_U + (c0 + m16) * 128 + 8 * q; \
            _Pragma("unroll") for (int mt = 0; mt < 4; ++mt) un[mt] = *(const u32x2*)(ut_ + 32 * mt); egn = EGL[tk_]; } while (0)
            UE_LOAD(tk0);
            LDS_BARRIER();
            for (int ch = 0; ch < nch; ++ch) { const int bo = (ch & 1) * SC_BUF; const int tk = tk0 + ch;
                u32x2 uc[4]; const float egl = egn;
#pragma unroll
                for (int mt = 0; mt < 4; ++mt) uc[mt] = un[mt];
                if (ch + 1 < nch) UE_LOAD(tk + 1);
                bf16x8 Sb[4];
#pragma unroll
                for (int ks = 0; ks < 4; ++ks) { u32x4 t4; t4.x = pk2(S[2 * ks][0], S[2 * ks][1]); t4.y = pk2(S[2 * ks][2], S[2 * ks][3]); t4.z = pk2(S[2 * ks + 1][0], S[2 * ks + 1][1]); t4.w = pk2(S[2 * ks + 1][2], S[2 * ks + 1][3]);
                    Sb[ks] = __builtin_bit_cast(bf16x8, t4); }
                f32x4 Vn[4], Out[4];
#pragma unroll
                for (int mt = 0; mt < 4; ++mt) { f32x4 a1 = {0.f, 0.f, 0.f, 0.f}, a2 = {0.f, 0.f, 0.f, 0.f};
#pragma unroll
                    for (int ks = 0; ks < 4; ++ks) { const bf16x8 aw = *(const LAS bf16x8*)(lds + bo + SC_W + (16 * mt + m16) * 272 + ks * 64 + q * 16), aq = *(const LAS bf16x8*)(lds + bo + SC_QG + (16 * mt + m16) * 272 + ks * 64 + q * 16);
                        a1 = __builtin_amdgcn_mfma_f32_16x16x32_bf16(aw, Sb[ks], a1, 0, 0, 0); a2 = __builtin_amdgcn_mfma_f32_16x16x32_bf16(aq, Sb[ks], a2, 0, 0, 0); }
                    const u32x2 uu = uc[mt];
                    Vn[mt] = (f32x4){bflo(uu.x) - a1[0], bfhi(uu.x) - a1[1], bflo(uu.y) - a1[2], bfhi(uu.y) - a1[3]}; Out[mt] = a2; }
                bf16x8 Vb[2];
#pragma unroll
                for (int ks = 0; ks < 2; ++ks) { u32x4 t4; t4.x = pk2(Vn[2 * ks][0], Vn[2 * ks][1]); t4.y = pk2(Vn[2 * ks][2], Vn[2 * ks][3]); t4.z = pk2(Vn[2 * ks + 1][0], Vn[2 * ks + 1][1]); t4.w = pk2(Vn[2 * ks + 1][2], Vn[2 * ks + 1][3]);
                    Vb[ks] = __builtin_bit_cast(bf16x8, t4); }
#pragma unroll
                for (int mt = 0; mt < 4; ++mt)
#pragma unroll
                    for (int ks = 0; ks < 2; ++ks) { const bf16x8 aa = *(const LAS bf16x8*)(lds + bo + SC_AT + (16 * mt + m16) * 144 + ks * 64 + q * 16);
                        Out[mt] = __builtin_amdgcn_mfma_f32_16x16x32_bf16(aa, Vb[ks], Out[mt], 0, 0, 0); }
#pragma unroll
                for (int dt = 0; dt < 8; ++dt) { S[dt] = S[dt] * egl;
#pragma unroll
                    for (int ks = 0; ks < 2; ++ks) { const bf16x8 ak = *(const LAS bf16x8*)(lds + bo + SC_KG + (16 * dt + m16) * 144 + ks * 64 + q * 16);
                        S[dt] = __builtin_amdgcn_mfma_f32_16x16x32_bf16(ak, Vb[ks], S[dt], 0, 0, 0); } }
#pragma unroll
                for (int mt = 0; mt < 4; ++mt)
#pragma unroll
                    for (int e = 0; e < 4; ++e) *(LAS bf16_t*)(lds + SC_OS + (ch & 1) * 8192 + (16 * mt + 4 * q + e) * 128 + (16 * w + m16) * 2) = (bf16_t)(pk2(Out[mt][e], 0.f) & 0xffffu);
                LDS_BARRIER();
            }
            float* So = c.out + (grp ? O_SGDN + (size_t)((l * 32 + b) * 12 + h) * 16384 : O_PGDN + (size_t)((l * 4 + b) * 12 + h) * 16384);
#pragma unroll
            for (int dt = 0; dt < 8; ++dt)
#pragma unroll
                for (int i = 0; i < 4; ++i) So[(16 * dt + 4 * q + i) * 128 + c0 + m16] = S[dt][i];
            __builtin_amdgcn_s_setprio(0);
#undef UE_LOAD
        }
    }
}
#undef LDS_BARRIER
#define XB_TMO      128
#define XB_XCNT(j)  (256  + 64 * (j))
#define XB_XSUB(j)  (1280 + 64 * (j))
#define XB_XGEN(j)  (2304 + 64 * (j))
#define XB_TOP      3328
#define XB_TOPGEN   3392
#define XCD_BAR_WORDS 3456
#define XB_SPIN_CAP (1u << 18)

__device__ __forceinline__ unsigned xb_ld(unsigned* p)              { return __hip_atomic_load(p, __ATOMIC_RELAXED, __HIP_MEMORY_SCOPE_AGENT); }
__device__ __forceinline__ unsigned xb_add(unsigned* p, unsigned v) { return __hip_atomic_fetch_add(p, v, __ATOMIC_RELAXED, __HIP_MEMORY_SCOPE_AGENT); }
__device__ __forceinline__ unsigned xb_xcc_id() { return (unsigned)__builtin_amdgcn_s_getreg((3 << 11) | 20) & 0xFu; }
#define XB_SPIN(cond, bar) do { unsigned _sp = 0; while (cond) { __builtin_amdgcn_s_sleep(1); \
    if ((++_sp & 255u) == 0u) { if (xb_ld(&(bar)[XB_TMO])) break; if (_sp > XB_SPIN_CAP) { atomicAdd(&(bar)[XB_TMO], 1u); break; } } } } while (0)
struct XcdBarrier {
    unsigned* bar; unsigned x;
    volatile LAS unsigned* st;
};

__device__ __forceinline__ XcdBarrier xcd_barrier_post(unsigned* bar, volatile LAS unsigned* st) {
    XcdBarrier b; b.bar = bar; b.x = xb_xcc_id(); b.st = st;
    if (threadIdx.x == 0) (void)xb_add(&bar[XB_XCNT(b.x)], 1u);
    return b;
}
__device__ __forceinline__ void xcd_barrier_complete(unsigned* bar, unsigned x, unsigned& nloc, unsigned& nx) {
    const unsigned G = gridDim.x * gridDim.y * gridDim.z;
    unsigned sum, cnt, mine, sp = 0u;
    for (;;) {
        sum = 0u; cnt = 0u; mine = 0u;
#pragma unroll
        for (unsigned j = 0; j < 16; ++j) { const unsigned c = xb_ld(&bar[XB_XCNT(j)]); sum += c; cnt += (c > 0u) ? 1u : 0u; mine = (j == x) ? c : mine; }
        if (sum == G) break;
        __builtin_amdgcn_s_sleep(1);
        if ((++sp & 255u) == 0u) { if (xb_ld(&bar[XB_TMO])) break; if (sp > XB_SPIN_CAP) { atomicAdd(&bar[XB_TMO], 1u); break; } }
    }
    nloc = mine > 0u ? mine : 1u; nx = cnt > 0u ? cnt : 1u;
}

__device__ __forceinline__ void xcd_barrier(const XcdBarrier& b, const bool leader  ) {
    asm volatile("s_waitcnt vmcnt(0)" ::: "memory");
    __syncthreads();
    if (leader) {
        unsigned* bar = b.bar;
        __builtin_amdgcn_s_waitcnt(0);
        unsigned nloc = b.st[0], nx = b.st[1];
        if (nloc == 0u) { xcd_barrier_complete(bar, b.x, nloc, nx); b.st[0] = nloc; b.st[1] = nx; }
        const unsigned old = xb_add(&bar[XB_XSUB(b.x)], 1u);
        const unsigned gen = old / nloc;
        if (old + 1u == (gen + 1u) * nloc) {
            __builtin_amdgcn_fence(__ATOMIC_RELEASE, "agent");
            asm volatile("s_waitcnt vmcnt(0)" ::: "memory");
            const unsigned og = xb_add(&bar[XB_TOP], 1u);
            const unsigned tg = og / nx;
            if (og + 1u == (tg + 1u) * nx) xb_add(&bar[XB_TOPGEN], 1u);
            else XB_SPIN(xb_ld(&bar[XB_TOPGEN]) == tg, bar);
            __builtin_amdgcn_fence(__ATOMIC_ACQUIRE, "agent");
            xb_add(&bar[XB_XGEN(b.x)], 1u);
            asm volatile("s_waitcnt vmcnt(0)" ::: "memory");
        } else {
            XB_SPIN(xb_ld(&bar[XB_XGEN(b.x)]) == gen, bar);
            __builtin_amdgcn_fence(__ATOMIC_ACQUIRE, "agent");
            asm volatile("s_waitcnt vmcnt(0)" ::: "memory");
        }
    }
    __syncthreads();
}
namespace fa {
constexpr int NW = 8, QBLK = 32, KVBLK = 64, QB = NW * QBLK, HDm = 128;
constexpr int SHM_V = KVBLK * HDm * 2, SHM_K = KVBLK * HDm * 2;
constexpr int LDS_BYTES = 2 * SHM_V + 2 * SHM_K + NW * 64 * 4;
constexpr float THR = 8.f;
constexpr int XOFF = LDS_BYTES + 64, XBUF = 2048;
typedef short s16x4 __attribute__((ext_vector_type(4)));
#define KSWZ(row, colB) ((row) * 256 + ((colB) ^ (((row) & 7) << 4)))
#define SBAR() __builtin_amdgcn_sched_barrier(0)
__device__ __forceinline__ int v_st(int k, int c) { const int kk = (k & ~0xC) | ((k & 4) << 1) | ((k & 8) >> 1); return ((kk >> 3) * 4 + (c >> 5)) * 512 + ((kk & 7) * 32 + (c & 31)) * 2; }
__device__ __forceinline__ int v_rd_base(int lane) { return ((lane & 3) << 3) | (((lane >> 2) & 3) << 6) | (((lane >> 4) & 1) << 5) | (((lane >> 5) & 1) << 8); }
constexpr int v_rd_off(int d0, int ks, int half) { return d0 * 512 + ks * 4096 + half * 2048; }
__device__ __forceinline__ int crow(int r, int hi) { return (r & 3) + 8 * (r >> 2) + 4 * hi; }
__device__ __forceinline__ unsigned cvtpk(float lo, float hi) { unsigned r; asm volatile("v_cvt_pk_bf16_f32 %0, %1, %2" : "=v"(r) : "v"(lo), "v"(hi)); return r; }
__device__ __forceinline__ bf16x8 load8(const bf16_t* p) { return *reinterpret_cast<const bf16x8*>(p); }
__device__ __forceinline__ void mask_tile(f32x16& p0, f32x16& p1, int dq, unsigned W) {
    const float NEG = -__builtin_inff();
#pragma unroll
    for (int r = 0; r < 16; ++r) { const int c = (r & 3) + 8 * (r >> 2);
        if ((unsigned)(dq - c) >= W) p0[r] = NEG;
        if ((unsigned)(dq - c - 32) >= W) p1[r] = NEG; }
}
__device__ __forceinline__ void partialSM(f32x16& p0, f32x16& p1, float& m_reg, float& mn, float& alpha) {
    float pmax = p0[0]; for (int r = 1; r < 16; ++r) pmax = fmaxf(pmax, p0[r]); for (int r = 0; r < 16; ++r) pmax = fmaxf(pmax, p1[r]);
    { auto rr = __builtin_amdgcn_permlane32_swap(__float_as_uint(pmax), __float_as_uint(pmax), false, false);
      pmax = fmaxf(__uint_as_float(rr[0]), __uint_as_float(rr[1])); }
    constexpr float C2 = 1.4426950408889634f * SCALE;
    if (__builtin_expect(__all((pmax - m_reg) * SCALE <= THR), 1)) { mn = m_reg; alpha = 1.f; }
    else { mn = fmaxf(m_reg, pmax); alpha = __builtin_amdgcn_exp2f((m_reg - mn) * C2); m_reg = mn; }
    const float mnL = -mn * C2;
    for (int r = 0; r < 16; ++r) p0[r] = fmaf(p0[r], C2, mnL); for (int r = 0; r < 16; ++r) p1[r] = fmaf(p1[r], C2, mnL);
    for (int r = 0; r < 16; ++r) p0[r] = __builtin_amdgcn_exp2f(p0[r]);
}
__device__ __forceinline__ void finishSM(f32x16& p0, f32x16& p1, float alpha, float& l_reg, bf16x8& pa0, bf16x8& pa1, bf16x8& pa2, bf16x8& pa3) {
    for (int r = 0; r < 16; ++r) p1[r] = __builtin_amdgcn_exp2f(p1[r]);
    float ps = 0; for (int r = 0; r < 16; ++r) ps += p0[r]; for (int r = 0; r < 16; ++r) ps += p1[r];
    { auto rr = __builtin_amdgcn_permlane32_swap(__float_as_uint(ps), __float_as_uint(ps), false, false);
      ps = __uint_as_float(rr[0]) + __uint_as_float(rr[1]); }
    l_reg = l_reg * alpha + ps;
#define PK4(P, B_, OUT) do { unsigned a0 = cvtpk(P[B_+0], P[B_+1]), a1 = cvtpk(P[B_+2], P[B_+3]);                          \
        unsigned b0 = cvtpk(P[B_+4], P[B_+5]), b1 = cvtpk(P[B_+6], P[B_+7]);                                             \
        auto r0 = __builtin_amdgcn_permlane32_swap(a0, b0, false, false); auto r1 = __builtin_amdgcn_permlane32_swap(a1, b1, false, false); \
        u32x4 w = {r0[0], r1[0], r0[1], r1[1]}; OUT = *reinterpret_cast<bf16x8*>(&w); } while (0)
    PK4(p0, 0, pa0); PK4(p0, 8, pa1); PK4(p1, 0, pa2); PK4(p1, 8, pa3);
#undef PK4
}
template <int KB, bool BIAS>
__device__ __forceinline__ void qkt(f32x16& p0, f32x16& p1, const char* K_lds, const char* X_lds, int r32, int hi, const bf16x8* qr, bf16x8 qx) {
    p0 = f32x16{}; p1 = f32x16{};
    const char* kb[4];
#pragma unroll
    for (int dd = 0; dd < 4; ++dd) kb[dd] = K_lds + KB * SHM_K + KSWZ(r32, (dd * 16 + hi * 8) * 2);
    if (BIAS) { const bf16x8 kx0 = *reinterpret_cast<const bf16x8*>(X_lds + KB * XBUF + r32 * 32 + hi * 16), kx1 = *reinterpret_cast<const bf16x8*>(X_lds + KB * XBUF + (32 + r32) * 32 + hi * 16);
        p0 = __builtin_amdgcn_mfma_f32_32x32x16_bf16(kx0, qx, p0, 0, 0, 0); p1 = __builtin_amdgcn_mfma_f32_32x32x16_bf16(kx1, qx, p1, 0, 0, 0); }
#pragma unroll
    for (int d0 = 0; d0 < 8; ++d0) { const char* a = kb[d0 & 3] + (d0 >> 2) * 128;
        bf16x8 b0 = *reinterpret_cast<const bf16x8*>(a);
        bf16x8 b1 = *reinterpret_cast<const bf16x8*>(a + 32 * 256);
        p0 = __builtin_amdgcn_mfma_f32_32x32x16_bf16(b0, qr[d0], p0, 0, 0, 0);
        p1 = __builtin_amdgcn_mfma_f32_32x32x16_bf16(b1, qr[d0], p1, 0, 0, 0); }
}
template <int VB>
__device__ __forceinline__ void pv_tile(f32x16* o, int vb0, bf16x8 pa0, bf16x8 pa1, bf16x8 pa2, bf16x8 pa3) {
#define TRRD(dst, off) asm volatile("ds_read_b64_tr_b16 %0, %1 offset:%2" : "=&v"(dst) : "v"(vb0), "i"(off) : "memory")
#define PV_D0(d0) do { s16x4 l0, l1, l2, l3, h0, h1, h2, h3; constexpr int b_ = VB * SHM_V + v_rd_off(d0, 0, 0); \
        TRRD(l0, b_); TRRD(h0, b_ + 2048); TRRD(l1, b_ + 4096); TRRD(h1, b_ + 6144); TRRD(l2, b_ + 8192); TRRD(h2, b_ + 10240); TRRD(l3, b_ + 12288); TRRD(h3, b_ + 14336); \
        asm volatile("s_waitcnt lgkmcnt(0)" ::: "memory"); SBAR();   \
        o[d0] = __builtin_amdgcn_mfma_f32_32x32x16_bf16(pa0, (bf16x8){l0[0], l0[1], l0[2], l0[3], h0[0], h0[1], h0[2], h0[3]}, o[d0], 0, 0, 0);   \
        o[d0] = __builtin_amdgcn_mfma_f32_32x32x16_bf16(pa1, (bf16x8){l1[0], l1[1], l1[2], l1[3], h1[0], h1[1], h1[2], h1[3]}, o[d0], 0, 0, 0);   \
        o[d0] = __builtin_amdgcn_mfma_f32_32x32x16_bf16(pa2, (bf16x8){l2[0], l2[1], l2[2], l2[3], h2[0], h2[1], h2[2], h2[3]}, o[d0], 0, 0, 0);   \
        o[d0] = __builtin_amdgcn_mfma_f32_32x32x16_bf16(pa3, (bf16x8){l3[0], l3[1], l3[2], l3[3], h3[0], h3[1], h3[2], h3[3]}, o[d0], 0, 0, 0); } while (0)
    PV_D0(0); PV_D0(1); PV_D0(2); PV_D0(3);
#undef PV_D0
#undef TRRD
}
struct Ref { int a, b, c; };
struct Seam { bf16x8 qr[8]; bf16x8 qx; bf16x8 st_v0, st_v1, st_k0, st_k1, st_kx; };
__device__ __forceinline__ int swa_jlo(int P0, int W) { const int lowk = P0 - W + 1; return lowk > 0 ? lowk / KVBLK : 0; }
#define ROW(p, k0, rr) ((p) + (size_t)((k0) + (rr)) * KP + sc)
#define VMW() asm volatile("s_waitcnt vmcnt(0)" ::: "memory")
#define VMWN(n) asm volatile("s_waitcnt vmcnt(%0)" :: "i"(n) : "memory")
#define SLOAD_H(Kp, Vp, k0) do { S.st_v0 = load8(ROW(Vp, k0, sr)); S.st_v1 = load8(ROW(Vp, k0, 32 + sr)); S.st_k0 = load8(ROW(Kp, k0, sr)); S.st_k1 = load8(ROW(Kp, k0, 32 + sr)); } while (0)
#define LOADKX(KXp, k0) do { if (BIAS && tid < 64) S.st_kx = load8((KXp) + (size_t)((k0) + tid) * 8); } while (0)
#define SWRITE_HK(bf) do { *(bf16x8*)(K_lds + (bf) * SHM_K + kws) = S.st_k0; *(bf16x8*)(K_lds + (bf) * SHM_K + kws + 32 * 256) = S.st_k1; if (BIAS && tid < 64) *(bf16x8*)(lds + XOFF + (bf) * XBUF + tid * 32) = S.st_kx; } while (0)
#define SWRITE_HV(bf) do { *(bf16x8*)(V_lds + (bf) * SHM_V + vst0) = S.st_v0; *(bf16x8*)(V_lds + (bf) * SHM_V + vst1) = S.st_v1; } while (0)
#define SWRITE_H(bf) do { SWRITE_HV(bf); SWRITE_HK(bf); } while (0)
template <class Lay>
__device__ __forceinline__ void prime(unsigned char* wsb, const Ref& cur, int W, char* lds, Seam& S, int tid) {
    constexpr int QP = Lay::QP, KP = Lay::KP; constexpr bool BIAS = Lay::BIAS;
    const int wid = __builtin_amdgcn_readfirstlane(tid >> 6), lane = tid & 63, r32 = lane & 31, hi = lane >> 5;
    const int sr = tid >> 4, sc = (tid & 15) * 8, kws = KSWZ(sr, sc * 2); char* K_lds = lds + 2 * SHM_V;
    const int kb0 = swa_jlo(Lay::p0(cur), W) * KVBLK; const bf16_t* Qc = Lay::q(wsb, cur);
#pragma unroll
    for (int d0 = 0; d0 < 8; ++d0) S.qr[d0] = load8(Qc + (size_t)(wid * QBLK + r32) * QP + d0 * 16 + hi * 8);
    S.qx = bf16x8{}; S.st_kx = bf16x8{};
    if (BIAS && tid < 128) { unsigned zz = 0u; asm volatile("" : "+v"(zz)); *(u32x4*)(lds + XOFF + (tid >> 6) * XBUF + (tid & 63) * 32 + 16) = (u32x4){zz, zz, zz, zz}; }
    if (BIAS) S.qx = load8(hi ? Lay::z(wsb) : Lay::qx(wsb, cur) + (size_t)(wid * QBLK + r32) * 8);
    { const bf16_t* Kc = Lay::k(wsb, cur); const bf16_t* Vc = Lay::v(wsb, cur); SLOAD_H(Kc, Vc, kb0); LOADKX(Lay::kx(wsb, cur), kb0); } VMW(); SWRITE_HK(0);
    __syncthreads();
}
template <class Lay>
__device__ __forceinline__ void block(unsigned char* wsb, const Ref& cur, const Ref& nxt, int skv, int W, char* lds, Seam& S, int tid) {
    asm volatile("" : "+v"(tid));
    constexpr int QP = Lay::QP, KP = Lay::KP, OP = Lay::OP; constexpr bool BIAS = Lay::BIAS, GATE = Lay::GATE; const int P0c = Lay::p0(cur);
    const int wid = __builtin_amdgcn_readfirstlane(tid >> 6), lane = tid & 63, r32 = lane & 31, hi = lane >> 5;
    const int j_lo = swa_jlo(P0c, W);
    int j_hi = (P0c + QB - 1) / KVBLK + 1; if (j_hi > skv / KVBLK) j_hi = skv / KVBLK;
    const int NT = j_hi - j_lo;
    const int kbn = swa_jlo(Lay::p0(nxt), W) * KVBLK;
    const int qlo = P0c + wid * QBLK, qm = qlo + r32 - 4 * hi;
    char* V_lds = lds; char* K_lds = lds + 2 * SHM_V;
    float* ws = (float*)(lds + 2 * SHM_V + 2 * SHM_K) + wid * 64; float* li_l = ws, * al_l = ws + 32;
    float m_reg = -1e30f, l_reg = 0; f32x16 o[4] = {};
    const int sr = tid >> 4, sc = (tid & 15) * 8, vst0 = v_st(sr, sc), vst1 = v_st(32 + sr, sc), kws = KSWZ(sr, sc * 2);
    const int vb0 = (int)(uintptr_t)V_lds + v_rd_base(lane);
    const bf16_t* Kh = Lay::k(wsb, cur); const bf16_t* Vh = Lay::v(wsb, cur); const bf16_t* KXh = Lay::kx(wsb, cur);
    const char* X_lds = lds + XOFF;
#define RESC(a) do { if (__any((a) < 1.f)) { if (hi == 0) al_l[r32] = (a); asm volatile("s_waitcnt lgkmcnt(0)" ::: "memory");              \
                     for (int d_ = 0; d_ < 4; ++d_) for (int r = 0; r < 16; ++r) o[d_][r] *= al_l[crow(r, hi)]; } } while (0)
#define KBASE(t) ((j_lo + (t)) * KVBLK)
#define MASKT(P0_, P1_, t) do { const int kb_ = KBASE(t); if (kb_ + KVBLK - 1 > qlo || kb_ <= qlo + QBLK - 1 - W) mask_tile(P0_, P1_, qm - kb_, (unsigned)W); } while (0)
    constexpr int NQL = BIAS ? 9 : 8;
#define SEAM_K0() do { VMWN(NQL); SWRITE_HK(0); SBAR(); } while (0)
    f32x16 pA0, pA1, pB0, pB1; float mnA, mnB, alA, alB; bf16x8 pa0, pa1, pa2, pa3;
    SWRITE_HV(0); SBAR();
    if (NT > 1) { SLOAD_H(Kh, Vh, KBASE(1)); LOADKX(KXh, KBASE(1)); }
    SBAR(); qkt<0, BIAS>(pA0, pA1, K_lds, X_lds, r32, hi, S.qr, S.qx);
    MASKT(pA0, pA1, 0); partialSM(pA0, pA1, m_reg, mnA, alA);
    if (NT > 1) { VMW(); SWRITE_H(1); }
    __syncthreads();
#define HALF_STEP(PX0, PX1, mnX, alX, PY0, PY1, alY, t, KB, VB, SB) do {                                                      \
        SBAR(); qkt<KB, BIAS>(PX0, PX1, K_lds, X_lds, r32, hi, S.qr, S.qx);                                             \
        finishSM(PY0, PY1, alY, l_reg, pa0, pa1, pa2, pa3); SBAR();                                                           \
        if ((t) + 1 < NT) { SLOAD_H(Kh, Vh, KBASE((t) + 1)); LOADKX(KXh, KBASE((t) + 1)); SBAR(); }               \
        pv_tile<VB>(o, vb0, pa0, pa1, pa2, pa3); MASKT(PX0, PX1, (t)); partialSM(PX0, PX1, m_reg, mnX, alX);                  \
        __syncthreads();                                                                                                      \
        if ((t) + 1 < NT) { VMW(); SWRITE_H(SB); }                                                                            \
        RESC(alX); __syncthreads(); } while (0)
    for (int t = 1; t + 1 < NT; t += 2) {
        HALF_STEP(pB0, pB1, mnB, alB, pA0, pA1, alA, t, 1, 0, 0);
        HALF_STEP(pA0, pA1, mnA, alA, pB0, pB1, alB, t + 1, 0, 1, 1);
    }
    const bool even = (NT & 1) == 0;
    if (even) { SBAR(); qkt<1, BIAS>(pB0, pB1, K_lds, X_lds, r32, hi, S.qr, S.qx); SBAR(); }
    { const bf16_t* Kn = Lay::k(wsb, nxt); const bf16_t* Vn = Lay::v(wsb, nxt); SLOAD_H(Kn, Vn, kbn); LOADKX(Lay::kx(wsb, nxt), kbn); } SBAR();
    { const bf16_t* Qn = Lay::q(wsb, nxt);
#pragma unroll
    for (int d0 = 0; d0 < 8; ++d0) S.qr[d0] = load8(Qn + (size_t)(wid * QBLK + r32) * QP + d0 * 16 + hi * 8); }
    if (BIAS) S.qx = load8(hi ? Lay::z(wsb) : Lay::qx(wsb, nxt) + (size_t)(wid * QBLK + r32) * 8);
    SBAR();
    finishSM(pA0, pA1, alA, l_reg, pa0, pa1, pa2, pa3); SBAR();
    pv_tile<0>(o, vb0, pa0, pa1, pa2, pa3);
    if (even) { MASKT(pB0, pB1, NT - 1); partialSM(pB0, pB1, m_reg, mnB, alB); __syncthreads(); RESC(alB);
        finishSM(pB0, pB1, alB, l_reg, pa0, pa1, pa2, pa3); SBAR(); pv_tile<1>(o, vb0, pa0, pa1, pa2, pa3); }
    SBAR(); SEAM_K0();
    if (hi == 0) li_l[r32] = l_reg; asm volatile("s_waitcnt lgkmcnt(0)" ::: "memory");
    float rli[16];
#pragma unroll
    for (int r = 0; r < 16; ++r) rli[r] = __builtin_amdgcn_rcpf(li_l[crow(r, hi)]);
    bf16_t* Ow = Lay::o(wsb, cur) + (size_t)(wid * QBLK) * OP; const bf16_t* Gw = Lay::g(wsb, cur) + (size_t)(wid * QBLK) * QP;
#pragma unroll
    for (int r = 0; r < 16; ++r) { const int orow = crow(r, hi);
#pragma unroll
        for (int d0 = 0; d0 < 4; ++d0) { const float v = o[d0][r] * rli[r];
            const float vn = lane_get(v, lane ^ 1);
            if ((r32 & 1) == 0) { float a = v, b = vn;
                if (GATE) { const unsigned gu = *(const unsigned*)(Gw + (size_t)orow * QP + d0 * 32 + r32); a *= fast_sigmoid(bflo(gu)); b *= fast_sigmoid(bfhi(gu)); }
                *(unsigned*)(Ow + (size_t)orow * OP + d0 * 32 + r32) = cvtpk(a, b); } } }
    __syncthreads();
#undef RESC
#undef KBASE
#undef MASKT
#undef SEAM_K0
#undef HALF_STEP
}
#undef ROW
#undef VMW
#undef VMWN
#undef SLOAD_H
#undef LOADKX
#undef SWRITE_HK
#undef SWRITE_HV
#undef SWRITE_H
#undef KSWZ
#undef SBAR
}
struct LayFox {
    static constexpr int QP = PJ, KP = TOK, OP = D; static constexpr bool BIAS = true, GATE = false;
    static __device__ __forceinline__ size_t row0(const fa::Ref& r) { return (size_t)(r.a / 12) * 4096 + r.b * 256; }
    static __device__ __forceinline__ int p0(const fa::Ref& r) { return r.b * 256; }
    static __device__ __forceinline__ const bf16_t* q(unsigned char* ws, const fa::Ref& r) { return (const bf16_t*)(ws + WS_PROJ) + row0(r) * PJ + (r.a % 12) * HD; }
    static __device__ __forceinline__ const bf16_t* g(unsigned char* ws, const fa::Ref& r) { return q(ws, r) + TOK; }
    static __device__ __forceinline__ const bf16_t* k(unsigned char* ws, const fa::Ref& r) { return (const bf16_t*)(ws + WS_KB) + (size_t)(r.a / 12) * 4096 * TOK + (r.a % 12) * HD; }
    static __device__ __forceinline__ const bf16_t* v(unsigned char* ws, const fa::Ref& r) { return (const bf16_t*)(ws + WS_VB) + (size_t)(r.a / 12) * 4096 * TOK + (r.a % 12) * HD; }
    static __device__ __forceinline__ bf16_t* o(unsigned char* ws, const fa::Ref& r) { return (bf16_t*)(ws + WS_ACT) + row0(r) * D + (r.a % 12) * HD; }
    static __device__ __forceinline__ const bf16_t* qx(unsigned char* ws, const fa::Ref& r) { return (const bf16_t*)(ws + WS_QX) + ((size_t)r.a * 4096 + r.b * 256) * 8; }
    static __device__ __forceinline__ const bf16_t* kx(unsigned char* ws, const fa::Ref& r) { return (const bf16_t*)(ws + WS_KX) + (size_t)r.a * 4096 * 8; }
    static __device__ __forceinline__ const bf16_t* z(unsigned char* ws) { return (const bf16_t*)(ws + WS_CTL + CTL_ZROW); }
};
__device__ __forceinline__ void fox_gate_block(unsigned char* ws, const fa::Ref& r, int tid) {
    asm volatile("s_waitcnt vmcnt(0)" ::: "memory"); __syncthreads();
    asm volatile("" : "+v"(tid));
    bf16_t* O = LayFox::o(ws, r); const bf16_t* G = LayFox::g(ws, r);
#pragma unroll
    for (int k = 0; k < 8; ++k) { const int u = tid + 512 * k, row = u >> 4, cu = (u & 15) * 8;
        const u32x4 ov = *(const u32x4*)(O + (size_t)row * D + cu), gv = __builtin_nontemporal_load((const u32x4*)(G + (size_t)row * PJ + cu)); u32x4 w;
        w.x = pk2(bflo(ov.x) * fast_sigmoid(bflo(gv.x)), bfhi(ov.x) * fast_sigmoid(bfhi(gv.x))); w.y = pk2(bflo(ov.y) * fast_sigmoid(bflo(gv.y)), bfhi(ov.y) * fast_sigmoid(bfhi(gv.y)));
        w.z = pk2(bflo(ov.z) * fast_sigmoid(bflo(gv.z)), bfhi(ov.z) * fast_sigmoid(bfhi(gv.z))); w.w = pk2(bflo(ov.w) * fast_sigmoid(bflo(gv.w)), bfhi(ov.w) * fast_sigmoid(bfhi(gv.w)));
        *(u32x4*)(O + (size_t)row * D + cu) = w; }
}
__device__ __forceinline__ void ph_fox_prompt(CtxP cp, int l, char* ldsg, LAS unsigned char* lds) {
    CTX_LOAD(cp);
    const int tid = otid();
    unsigned* qheads = (unsigned*)(c.ws + WS_CTL + CTL_QFOX) + 64 * 8 * l;
    LAS int* slot = (LAS int*)(lds + fa::LDS_BYTES);
    if (tid == 0) { slot[2] = (int)(xb_xcc_id() & 7u); slot[3] = 8; }
#define FOX_FETCH(dst, k) do { if (tid == 0) { int r_ = -1, myq_ = slot[2], qleft_ = slot[3]; while (qleft_ > 0) { const int i_ = (int)__hip_atomic_fetch_add(qheads + 64 * myq_, 1u, __ATOMIC_RELAXED, __HIP_MEMORY_SCOPE_AGENT); \
                if (i_ < 96) { r_ = ((i_ % 6) * 8 + myq_) * 16 + (15 - i_ / 6); break; } myq_ = (myq_ + 1) & 7; --qleft_; } slot[k] = r_; slot[2] = myq_; slot[3] = qleft_; } \
            __syncthreads(); dst = __builtin_amdgcn_readfirstlane(slot[k]); } while (0)
    int idx; FOX_FETCH(idx, 0);
    if (idx >= 0) {
        fa::Ref cur{idx >> 4, idx & 15, 0}, nxt; fa::Seam S;
        fa::prime<LayFox>(c.ws, cur, 1 << 29, ldsg, S, tid);
        for (int k = 1;; k ^= 1) {
            int nidx; FOX_FETCH(nidx, k);
            const bool more = nidx >= 0;
            if (more) nxt = fa::Ref{nidx >> 4, nidx & 15, 0}; else nxt = cur;
            fa::block<LayFox>(c.ws, cur, nxt, 4096, 1 << 29, ldsg, S, tid);
            fox_gate_block(c.ws, cur, tid);
            if (!more) break;
            cur = nxt;
        }
    }
#undef FOX_FETCH
}
struct LayMem {
    static constexpr int QP = PJ, KP = 4096, OP = D; static constexpr bool BIAS = false, GATE = false;
    static __device__ __forceinline__ size_t row0(const fa::Ref& r) { return (size_t)(r.a >> 2) * 4096 + r.b * 256; }
    static __device__ __forceinline__ int p0(const fa::Ref&) { return 256; }
    static __device__ __forceinline__ const bf16_t* q(unsigned char* ws, const fa::Ref& r) { return (const bf16_t*)(ws + WS_PROJ) + row0(r) * PJ + (r.c < 2 ? 6144 : 3072) + (r.a & 3) * HD; }
    static __device__ __forceinline__ const bf16_t* g(unsigned char* ws, const fa::Ref& r) { return q(ws, r); }
    static __device__ __forceinline__ const bf16_t* k(unsigned char* ws, const fa::Ref& r) { return (const bf16_t*)(ws + WS_MEMKVB) + (size_t)(r.a >> 2) * 256 * 4096 + r.c * 1024 + (r.a & 3) * HD; }
    static __device__ __forceinline__ const bf16_t* v(unsigned char* ws, const fa::Ref& r) { return k(ws, r) + 512; }
    static __device__ __forceinline__ bf16_t* o(unsigned char* ws, const fa::Ref& r) { return (bf16_t*)(ws + WS_ACT) + row0(r) * D + TOK + (r.a & 3) * HD; }
    static __device__ __forceinline__ const bf16_t* qx(unsigned char* ws, const fa::Ref& r) { return nullptr; }
    static __device__ __forceinline__ const bf16_t* kx(unsigned char* ws, const fa::Ref& r) { return nullptr; }
    static __device__ __forceinline__ const bf16_t* z(unsigned char* ws) { return nullptr; }
};
__device__ __forceinline__ void ph_mem_prompt(CtxP cp, int l, char* ldsg, int wg0, int nwg) {
    CTX_LOAD(cp);
    const int tid = otid(), bid_ = obid() - wg0, grid_ = nwg;
    int idx = bid_;
    if (idx >= 0 && idx < 256) {
        fa::Ref cur{idx >> 4, idx & 15, l}, nxt; fa::Seam S;
        fa::prime<LayMem>(c.ws, cur, 1 << 29, ldsg, S, tid);
        for (;;) {
            const int nidx = idx + grid_; const bool more = nidx < 256;
            if (more) nxt = fa::Ref{nidx >> 4, nidx & 15, l}; else nxt = cur;
            fa::block<LayMem>(c.ws, cur, nxt, 256, 1 << 29, ldsg, S, tid);
            if (!more) break;
            cur = nxt; idx = nidx;
        }
    }
}
constexpr int SF_REG = 16384, SF_AUX = 8 * SF_REG, SF_Q = SF_AUX + 8 * 512, SF_LDS = SF_Q + 32 * 272;
template <bool FOX>
__device__ __forceinline__ void ph_attn_sample(CtxP cp, int l, LAS unsigned char* lds, int wg0, int nwg) {
    CTX_LOAD(cp);
    const int bid_ = obid() - wg0, grid_ = nwg; const int tid0 = otid();
    if (bid_ < 0) return;
    constexpr int NH = FOX ? 12 : 4, NTASKS = 32 * NH, NTILE = FOX ? 65 : 8, KP = FOX ? TOK : MEMD, NPAST = FOX ? PAST : NMEM;
    constexpr float LOG2E = 1.4426950408889634f, C2 = LOG2E * SCALE;
    for (int task = bid_; task < NTASKS; task += grid_) {
        int tid = tid0; asm volatile("" : "+v"(tid));
        const int lane = tid & 63, w = __builtin_amdgcn_readfirstlane(tid >> 6), r32 = lane & 31, hi = lane >> 5;
        const int b = task / NH, h = task % NH;
        LAS unsigned char* T = lds + w * SF_REG; LAS float* aux = (LAS float*)(lds + SF_AUX + w * 512);
        const float* CUM = WS_PTR(float, WS_CUMS) + (size_t)b * (PAST + 32) * 12 + h;
        const float* Kc = (FOX ? c.in[I_CK] : c.in[I_CMK] + (size_t)l * 32 * NMEM * MEMD) + (size_t)b * NPAST * KP + h * HD; const float* Vc = (FOX ? c.in[I_CV] : c.in[I_CMV] + (size_t)l * 32 * NMEM * MEMD) + (size_t)b * NPAST * KP + h * HD;
        const int qcol = FOX ? h * HD : ((l < 2) ? 6144 : 3072) + h * HD, ocol = FOX ? h * HD : TOK + h * HD;
        float cq2 = 0.f; if (FOX) cq2 = CUM[(size_t)(PAST + r32) * 12] * LOG2E;
        float m_run = -1e30f, l_run = 0.f; f32x16 o[4] = {};
        f32x4 st[16];
        const int lrow = lane >> 5, lcol = (lane & 31) * 4;
        const unsigned voff = (unsigned)(lrow * KP + lcol) * 4u;
#define SF_LOAD(P, j0) do { const char* p_ = (const char*)((P) + (size_t)(j0) * KP);     \
        _Pragma("unroll") for (int i = 0; i < 16; ++i) st[i] = __builtin_nontemporal_load((const f32x4*)(p_ + (size_t)(2 * i) * KP * 4 + voff)); } while (0)
        __syncthreads();
        *(LAS u32x4*)(lds + SF_Q + (tid >> 4) * 272 + (tid & 15) * 16) = *(const u32x4*)(WS_PTR(bf16_t, WS_PROJ) + (size_t)(MP + b * 32 + (tid >> 4)) * PJ + qcol + (tid & 15) * 8);
        int t = w; SF_LOAD(Kc, 32 * t);
        __syncthreads();
        for (; t < NTILE; t += 8) { const bool isnew = FOX && (t == 64); const int j0 = 32 * t;
            if (!isnew) {
#pragma unroll
                for (int i = 0; i < 16; ++i) { u32x2 v2; v2.x = pk2(st[i].x, st[i].y); v2.y = pk2(st[i].z, st[i].w); *(LAS u32x2*)(T + (2 * i + lrow) * 272 + lcol * 2) = v2; }
                SF_LOAD(Vc, j0); }
            else { const char* kp = (const char*)(WS_PTR(bf16_t, WS_KB) + (size_t)(MP + b * 32) * TOK + h * HD);
                int ln = lane; asm volatile("" : "+v"(ln)); const int rw0 = ln >> 4, cc = (ln & 15) * 8; const unsigned vo = (unsigned)(rw0 * TOK + cc) * 2u;
#pragma unroll
                for (int i = 0; i < 8; ++i) *(LAS u32x4*)(T + (4 * i + rw0) * 272 + cc * 2) = *(const u32x4*)(kp + (size_t)(4 * i) * TOK * 2 + vo); }
            if (lane < 32) aux[lane] = FOX ? CUM[(size_t)(j0 + lane) * 12] * LOG2E : 0.f;
            f32x16 p = {};
#pragma unroll
            for (int d0 = 0; d0 < 8; ++d0) p = __builtin_amdgcn_mfma_f32_32x32x16_bf16(*(const LAS bf16x8*)(T + r32 * 272 + d0 * 32 + hi * 16), *(const LAS bf16x8*)(lds + SF_Q + r32 * 272 + d0 * 32 + hi * 16), p, 0, 0, 0);
            float pmax = -__builtin_inff();
#pragma unroll
            for (int g = 0; g < 4; ++g) { const f32x4 ck = *(const LAS f32x4*)(aux + 8 * g + 4 * hi);
#pragma unroll
                for (int e = 0; e < 4; ++e) { const int rr = 4 * g + e; float s = fmaf(p[rr], C2, cq2 - ck[e]);
                    if (isnew && (8 * g + 4 * hi + e) > r32) s = -__builtin_inff();
                    p[rr] = s; pmax = fmaxf(pmax, s); } }
            pmax = fmaxf(pmax, lane_get(pmax, lane ^ 32));
            const float mn = fmaxf(m_run, pmax), alpha = __builtin_amdgcn_exp2f(m_run - mn); m_run = mn;
            float ps = 0.f;
#pragma unroll
            for (int rr = 0; rr < 16; ++rr) { p[rr] = __builtin_amdgcn_exp2f(p[rr] - mn); ps += p[rr]; }
            ps += lane_get(ps, lane ^ 32); l_run = l_run * alpha + ps;
            bf16x8 pa0, pa1;
#define PK4(P, B_, OUT) do { unsigned a0 = pk2(P[B_+0], P[B_+1]), a1 = pk2(P[B_+2], P[B_+3]); unsigned b0 = pk2(P[B_+4], P[B_+5]), b1 = pk2(P[B_+6], P[B_+7]); \
            auto r0 = __builtin_amdgcn_permlane32_swap(a0, b0, false, false); auto r1 = __builtin_amdgcn_permlane32_swap(a1, b1, false, false); \
            u32x4 w4 = {r0[0], r1[0], r0[1], r1[1]}; OUT = __builtin_bit_cast(bf16x8, w4); } while (0)
            PK4(p, 0, pa0); PK4(p, 8, pa1);
#undef PK4
            if (hi == 0) aux[32 + r32] = alpha;
            if (!isnew) {
#pragma unroll
                for (int i = 0; i < 16; ++i) { const int key = 2 * i + lrow;
                    *(LAS bf16_t*)(T + (lcol + 0) * 80 + key * 2) = (bf16_t)(pk2(st[i].x, 0.f) & 0xffffu); *(LAS bf16_t*)(T + (lcol + 1) * 80 + key * 2) = (bf16_t)(pk2(st[i].y, 0.f) & 0xffffu);
                    *(LAS bf16_t*)(T + (lcol + 2) * 80 + key * 2) = (bf16_t)(pk2(st[i].z, 0.f) & 0xffffu); *(LAS bf16_t*)(T + (lcol + 3) * 80 + key * 2) = (bf16_t)(pk2(st[i].w, 0.f) & 0xffffu); }
                if (FOX && t + 8 < 64) SF_LOAD(Kc, j0 + 256); }
            else { const char* vp = (const char*)(WS_PTR(bf16_t, WS_VB) + (size_t)(MP + b * 32) * TOK + h * HD);
                int ln = lane; asm volatile("" : "+v"(ln)); const int rw0 = ln >> 4, cc = (ln & 15) * 8; const unsigned vo = (unsigned)(rw0 * TOK + cc) * 2u;
#pragma unroll
                for (int i = 0; i < 8; ++i) { const int rw = 4 * i + rw0; const u32x4 v4 = *(const u32x4*)(vp + (size_t)(4 * i) * TOK * 2 + vo);
                    *(LAS bf16_t*)(T + (cc + 0) * 80 + rw * 2) = (bf16_t)(v4.x & 0xffffu); *(LAS bf16_t*)(T + (cc + 1) * 80 + rw * 2) = (bf16_t)(v4.x >> 16);
                    *(LAS bf16_t*)(T + (cc + 2) * 80 + rw * 2) = (bf16_t)(v4.y & 0xffffu); *(LAS bf16_t*)(T + (cc + 3) * 80 + rw * 2) = (bf16_t)(v4.y >> 16);
                    *(LAS bf16_t*)(T + (cc + 4) * 80 + rw * 2) = (bf16_t)(v4.z & 0xffffu); *(LAS bf16_t*)(T + (cc + 5) * 80 + rw * 2) = (bf16_t)(v4.z >> 16);
                    *(LAS bf16_t*)(T + (cc + 6) * 80 + rw * 2) = (bf16_t)(v4.w & 0xffffu); *(LAS bf16_t*)(T + (cc + 7) * 80 + rw * 2) = (bf16_t)(v4.w >> 16); } }
            if (__any(alpha < 1.f)) {
#pragma unroll
                for (int g = 0; g < 4; ++g) { const f32x4 al = *(const LAS f32x4*)(aux + 32 + 8 * g + 4 * hi);
#pragma unroll
                    for (int e = 0; e < 4; ++e)
#pragma unroll
                        for (int db = 0; db < 4; ++db) o[db][4 * g + e] *= al[e]; } }
#pragma unroll
            for (int db = 0; db < 4; ++db) {
                o[db] = __builtin_amdgcn_mfma_f32_32x32x16_bf16(pa0, *(const LAS bf16x8*)(T + (db * 32 + r32) * 80 + hi * 16), o[db], 0, 0, 0);
                o[db] = __builtin_amdgcn_mfma_f32_32x32x16_bf16(pa1, *(const LAS bf16x8*)(T + (db * 32 + r32) * 80 + 32 + hi * 16), o[db], 0, 0, 0); }
        }
        asm volatile("s_waitcnt lgkmcnt(0)" ::: "memory");
#pragma unroll
        for (int db = 0; db < 4; ++db)
#pragma unroll
            for (int rr = 0; rr < 16; ++rr) *(LAS float*)(T + crow32(rr, hi) * 512 + (db * 32 + r32) * 4) = o[db][rr];
        if (hi == 0) { aux[64 + r32] = m_run; aux[96 + r32] = l_run; }
        __syncthreads();
        { const int qy = tid >> 4, d0 = (tid & 15) * 8; float M = -1e30f;
#pragma unroll
            for (int ww = 0; ww < 8; ++ww) M = fmaxf(M, *(const LAS float*)(lds + SF_AUX + ww * 512 + (64 + qy) * 4));
            float num[8] = {0.f, 0.f, 0.f, 0.f, 0.f, 0.f, 0.f, 0.f}, den = 0.f;
#pragma unroll
            for (int ww = 0; ww < 8; ++ww) { const float e = __builtin_amdgcn_exp2f(*(const LAS float*)(lds + SF_AUX + ww * 512 + (64 + qy) * 4) - M); den += e * *(const LAS float*)(lds + SF_AUX + ww * 512 + (96 + qy) * 4);
                const f32x4 a = *(const LAS f32x4*)(lds + ww * SF_REG + qy * 512 + d0 * 4), bq = *(const LAS f32x4*)(lds + ww * SF_REG + qy * 512 + d0 * 4 + 16);
                num[0] += e * a.x; num[1] += e * a.y; num[2] += e * a.z; num[3] += e * a.w; num[4] += e * bq.x; num[5] += e * bq.y; num[6] += e * bq.z; num[7] += e * bq.w; }
            const float inv = 1.f / den; const size_t row = (size_t)(MP + b * 32 + qy);
            u32x4 gv = {0x7f007f00u, 0x7f007f00u, 0x7f007f00u, 0x7f007f00u};
            if (FOX) gv = *(const u32x4*)(WS_PTR(bf16_t, WS_PROJ) + row * PJ + TOK + h * HD + d0);
            u32x4 ov;
            ov.x = pk2(num[0] * inv * fast_sigmoid(bflo(gv.x)), num[1] * inv * fast_sigmoid(bfhi(gv.x))); ov.y = pk2(num[2] * inv * fast_sigmoid(bflo(gv.y)), num[3] * inv * fast_sigmoid(bfhi(gv.y)));
            ov.z = pk2(num[4] * inv * fast_sigmoid(bflo(gv.z)), num[5] * inv * fast_sigmoid(bfhi(gv.z))); ov.w = pk2(num[6] * inv * fast_sigmoid(bflo(gv.w)), num[7] * inv * fast_sigmoid(bfhi(gv.w)));
            *(u32x4*)(WS_PTR(bf16_t, WS_ACT) + row * D + ocol + d0) = ov; }
#undef SF_LOAD
    }
}
constexpr int GEMM_LDS = pg8::STAGE_BYTES;
constexpr int LDS_BAR = 147456 - 256, LDS_BYTES = 147456;
static_assert(SF_LDS <= LDS_BAR && GEMM_LDS <= LDS_BAR, "LDS map");
constexpr size_t CTL_ZERO_BYTES = 65536;
__device__ __forceinline__ void ph_gemm(CtxP cp, int which, int l, LAS unsigned char* lds) {
    CTX_LOAD(cp);
    const bf16_t* A = WS_PTR(bf16_t, WS_XN); const bf16_t* Bt; int Mg = M, N, K = D, mode; bf16_t* o16 = nullptr; int ld16 = 0; float* o32 = nullptr; int ld32 = 0;
    if (which == 0) { A = WS_PTR(bf16_t, WS_MEMN); Bt = WS_PTR(bf16_t, WS_WMEM); Mg = 1024; N = 4096; mode = 4; }
    else if (which == 1) { Bt = (l < 2) ? WS_PTR(bf16_t, WS_WINA) + (size_t)l * 6656 * D : (l == 2 ? WS_PTR(bf16_t, WS_WINB0) : WS_PTR(bf16_t, WS_WINB1)); N = (l == 3) ? 3584 : 6656;
        mode = (l == 2) ? 3 : 0; o16 = WS_PTR(bf16_t, WS_PROJ); ld16 = PJ; }
    else if (which == 2) { A = WS_PTR(bf16_t, WS_ACT); Bt = WS_PTR(bf16_t, WS_WO) + (size_t)l * D * D; N = D; mode = 2; o16 = WS_PTR(bf16_t, WS_DELTA); ld16 = D; }
    else if (which == 3) { Bt = WS_PTR(bf16_t, WS_WUP) + (size_t)l * DFF * D; N = DFF; mode = 1; o16 = WS_PTR(bf16_t, WS_UP); ld16 = DFF; }
    else { A = WS_PTR(bf16_t, WS_UP); Bt = WS_PTR(bf16_t, WS_WDN) + (size_t)l * D * DFF; N = D; K = DFF; mode = 2; o16 = WS_PTR(bf16_t, WS_DELTA); ld16 = D; }
    const pg8::Gemm g{A, Bt, Mg, N, K};
    const pg8::Epi E{mode, o16, ld16, o32, ld32, c.ws, c.out, K / pg8::BK, (which == 1) ? (l < 2 ? 4608 : 0) : -1};
    pg8::TailSplit S; if (which == 0) S.init(g.M, g.N, g.K, 64, obid() - (ogrid() - 64), 0); else S.init(g.M, g.N, g.K, ogrid(), obid(), (which == 2 || which == 4) ? 1 : 0, which == 2 ? 4 : 8);
    pg8::gemm_phase<pg8::Epi, pg8::TailSplit, true, true>(lds, g, S, E, otid());
}
__global__ void __launch_bounds__(512, 2) fwd(Ctx carg) {
    CtxP c = (CtxP)((unsigned long long)__builtin_amdgcn_kernarg_segment_ptr() | (unsigned long long)__builtin_amdgcn_readfirstlane((int)(threadIdx.x >> 6)));
    extern __shared__ __attribute__((aligned(16))) unsigned char lds_raw[];
    LAS unsigned char* lds = (LAS unsigned char*)lds_raw;
    if (threadIdx.x < 4) ((LAS unsigned*)(lds + LDS_BAR))[threadIdx.x] = 0u;
    __syncthreads();
    const XcdBarrier bar = xcd_barrier_post((unsigned*)(((CtxP)((unsigned long long)c & ~7ull))->ws + WS_CTL), (volatile LAS unsigned*)(lds + LDS_BAR));
#define BAR() do { XcdBarrier b2_; b2_.bar = (unsigned*)(((CtxP)((unsigned long long)c & ~7ull))->ws + WS_CTL); b2_.st = bar.st; unsigned bx_ = bar.x; asm volatile("" : "+s"(bx_)); b2_.x = bx_; xcd_barrier(b2_, otid_cp(c) == 0); } while (0)
    ph_prep(c, lds, 0x3u | (0xfu << 19), 0, (int)gridDim.x, 1); ph_row2(c, 2, 0, 0, 0, 0); BAR();
    ph_row2(c, 1, 0, 0, 0, 0, 0, 0, (int)gridDim.x - 64); ph_gemm(c, 0, 0, lds); BAR();
    const bool upt = (gridDim.x == 256);
    for (int l = 0; l < 4; ++l) {
        if (l < 2) ph_skinny(c, l, lds);
        else if (l == 2) { ph_skinny(c, 2, lds); BAR(); ph_cumsum(c); }
        ph_gemm(c, 1, l, lds); BAR();
        if (l < 2) { ph_gdn_prep(c, l, lds); BAR(); ph_gdn_scan(c, l, lds);
            ph_prep(c, lds, (l == 0 ? (JOBS_L1 | (1u << 7) | (1u << 11) | (1u << 15)) : (JOBS_L2 | JOBS_L3)) & ~(upt ? (7u << 12) : 0u), 96, (int)gridDim.x - 96, 0);
            BAR(); ph_gdn_c(c, l); }
        if (l >= 2) { ph_attn_sample<true>(c, l, lds, 0, (int)gridDim.x); __syncthreads(); }
        ph_mem_prompt(c, l, (char*)lds_raw, 0, (int)gridDim.x); ph_attn_sample<false>(c, l, lds, 0, (int)gridDim.x);
        if (l >= 2) { __syncthreads(); ph_fox_prompt(c, l, (char*)lds_raw, lds); }
        BAR();
        ph_gemm(c, 2, l, lds); BAR();
        ph_row2(c, 0, 1, I_NMIXPOST, l, 0, l == 0); BAR();
        ph_gemm(c, 3, l, lds); if (upt && l < 3) ph_prep(c, lds, 1u << (12 + l), 128, 128, 0); BAR();
        ph_gemm(c, 4, l, lds); BAR();
        ph_row2(c, 0, 1, I_NMLPPOST, l, l == 3);
        if (l < 3) BAR();
    }
#undef BAR
}
extern "C" void kernel_launch(void* const* d_in, const int* in_sizes, int n_in, void* d_out, int out_size, void* d_ws, size_t ws_size, hipStream_t stream) {
    static int grid = 0;
    if (grid == 0) {
        if (n_in != 28 || (size_t)out_size != O_END || ws_size < WS_END2) { fprintf(stderr, "kernel_launch: unexpected shapes: n_in %d out %d ws %zu (need %zu)\n", n_in, out_size, ws_size, (size_t)WS_END2); grid = -1; return; }
        int dev = 0, cus = 0, per_cu = 0;
        if (hipGetDevice(&dev) != hipSuccess || hipDeviceGetAttribute(&cus, hipDeviceAttributeMultiprocessorCount, dev) != hipSuccess) { grid = -1; return; }
        if (hipFuncSetAttribute((const void*)fwd, hipFuncAttributeMaxDynamicSharedMemorySize, LDS_BYTES) != hipSuccess) { fprintf(stderr, "kernel_launch: hipFuncSetAttribute failed\n"); grid = -1; return; }
        if (hipOccupancyMaxActiveBlocksPerMultiprocessor(&per_cu, (const void*)fwd, 512, LDS_BYTES) != hipSuccess || per_cu < 1) { fprintf(stderr, "kernel_launch: occupancy query says %d blocks per CU\n", per_cu); grid = -1; return; }
        (void)hipGetLastError();
        grid = cus;
    }
    if (grid < 0) return;
    (void)hipMemsetAsync((char*)d_ws + WS_CTL, 0, CTL_ZERO_BYTES, stream);
    Ctx c{}; for (int i = 0; i < 28; ++i) c.in[i] = (const float*)d_in[i]; c.out = (float*)d_out; c.ws = (unsigned char*)d_ws; c.ph_lo = 0; c.ph_hi = 0;
    hipLaunchKernelGGL(fwd, dim3(grid), dim3(512), LDS_BYTES, stream, c);
}
```

```cpp
#include <hip/hip_runtime.h>
#include <cstdio>
#include <cstdint>
namespace pg8 {
#define PG8_LAS __attribute__((address_space(3)))
typedef unsigned short bf16_t;
typedef short bf16x8 __attribute__((ext_vector_type(8)));
typedef float f32x4 __attribute__((ext_vector_type(4)));
typedef unsigned u32x4 __attribute__((ext_vector_type(4)));
constexpr int BM = 256, BK = 64, HALF = 128, HTB = HALF * BK * 2  , STAGE_BYTES = 8 * HTB, NXCD = 8, WGM = 4;

__host__ __device__ __forceinline__ int lds_byte(int r, int c) { const int st = (r >> 4) * 2 + (c >> 5), rr = r & 15, cc = c & 31, ob = rr * 64 + cc * 2; return st * 1024 + (ob ^ (((ob >> 9) & 1) << 5)); }
__host__ __device__ __forceinline__ void stage_rc(int b, int& R, int& C) { const int st = b / 1024, sb = b % 1024, swz = sb ^ (((sb >> 9) & 1) << 5); R = (st >> 1) * 16 + swz / 64; C = (st & 1) * 32 + (swz % 64) / 2; }
__host__ __device__ __forceinline__ int perm32(int rho) { const int n = rho >> 4, i = rho & 15; return 8 * (i >> 2) + 4 * n + (i & 3); }

struct Unit { int pm, pn, kt0, nt, ks; };
struct Gemm { const bf16_t* A; const bf16_t* Bt; int M, N, K; };

struct StaticOrder {
    int nM, nN, nwg, G, c, ntf;
    __host__ __device__ void init(int M, int N, int K, int G_, int c_) { nM = M / BM; nN = N / BM; nwg = nM * nN; G = G_; c = c_; ntf = K / BK; }
    __host__ __device__ bool next(int i, Unit& u) const {
        const long L = (long)i * G + c; if (L >= nwg) return false;
        int wgid = (int)L; { const int q = nwg / NXCD, r = nwg % NXCD, xcd = wgid % NXCD, off = wgid / NXCD; wgid = (xcd < r ? xcd * (q + 1) : r * (q + 1) + (xcd - r) * q) + off; }
        const int nig = WGM * nN, gid = wgid / nig, fm = gid * WGM, gsz = (nM - fm) < WGM ? (nM - fm) : WGM;
        u.pm = fm + ((wgid % nig) % gsz); u.pn = (wgid % nig) / gsz; u.kt0 = 0; u.nt = ntf; u.ks = 0; return true;
    }
    __device__ __forceinline__ void a_ready(const Unit&) const {}
    __device__ __forceinline__ void done(const Unit&) const {}
};

__device__ __forceinline__ unsigned cvt_pk_bf16(float lo, float hi) { unsigned r; asm volatile("v_cvt_pk_bf16_f32 %0, %1, %2" : "=v"(r) : "v"(lo), "v"(hi)); return r; }
}
#define LAS __attribute__((address_space(3)))
typedef unsigned short bf16_t;
typedef float f32x4 __attribute__((ext_vector_type(4)));
typedef unsigned u32x4 __attribute__((ext_vector_type(4)));
typedef unsigned u32x2 __attribute__((ext_vector_type(2)));
constexpr int D = 2048, MP = 16384, MS = 1024, M = MP + MS;
constexpr int H = 12, HD = 128, TOK = 1536, QKV = 4608, MEMD = 512, MH = 4, NMEM = 256, DFF = 8192, PAST = 2048;
constexpr int INA_W = 6680, INB_W = 3584, KVF_W = 3084;
constexpr int PJ = 6656;
constexpr float EPS = 1e-6f, SCALE = 0.08838834764831845f;
constexpr size_t O_YP = 0, O_YS = O_YP + (size_t)MP * D, O_PGDN = O_YS + (size_t)MS * D, O_PCONV = O_PGDN + (size_t)2 * 4 * 12 * 16384, O_PK = O_PCONV + (size_t)2 * 4 * 3 * 4608,
    O_PV = O_PK + (size_t)MP * TOK, O_PLOGF = O_PV + (size_t)MP * TOK, O_PMK = O_PLOGF + (size_t)MP * 12, O_PMV = O_PMK + (size_t)4 * 4 * 256 * 512, O_SGDN = O_PMV + (size_t)4 * 4 * 256 * 512,
    O_SCONV = O_SGDN + (size_t)2 * 32 * 12 * 16384, O_SK = O_SCONV + (size_t)2 * 32 * 3 * 4608, O_SV = O_SK + (size_t)MS * TOK, O_SLOGF = O_SV + (size_t)MS * TOK, O_END = O_SLOGF + (size_t)MS * 12;
static_assert(O_END == 108683264, "output size");
constexpr size_t MiB = 1u << 20;
constexpr size_t WS_CTL = 0, WS_WINA = 1 * MiB, WS_WINB0 = 53 * MiB, WS_WINB1 = 79 * MiB, WS_WO = 93 * MiB, WS_WUP = 125 * MiB, WS_WDN = 253 * MiB, WS_WMEM = 381 * MiB, WS_WSK = 397 * MiB,
    WS_X = 398 * MiB, WS_XN = 534 * MiB, WS_PROJ = 602 * MiB, WS_ACT = 823 * MiB, WS_DELTA = 891 * MiB, WS_KB = 1027 * MiB, WS_VB = 1078 * MiB, WS_G = 1129 * MiB, WS_BETA = 1130 * MiB,
    WS_LOGF = 1131 * MiB, WS_CUMP = 1132 * MiB, WS_CUMS = 1133 * MiB, WS_MEMN = 1137 * MiB, WS_BIG = 1141 * MiB, WS_QF = WS_BIG, WS_KF = WS_BIG + 102 * MiB, WS_VF = WS_BIG + 204 * MiB,
    WS_OF = WS_BIG + 306 * MiB, WS_UP = WS_BIG, WS_END = WS_BIG + 408 * MiB,
    WS_EGL = WS_END, WS_QX = WS_EGL + 1 * MiB, WS_KX = WS_QX + 3 * MiB, WS_MEMKVB = WS_KX + 3 * MiB, WS_WSKB = WS_MEMKVB + 8 * MiB, WS_END2 = WS_WSKB + 1 * MiB;
constexpr size_t WS_SLAB = WS_PROJ;
constexpr size_t CTL_ZROW = 61440, CTL_QFOX = 32768;
static_assert((size_t)6656 * 2048 * 2 == 26 * MiB && (size_t)M * D * 4 == 136 * MiB && (size_t)M * PJ * 2 == 221 * MiB && (size_t)M * TOK * 2 == 51 * MiB && (size_t)M * TOK * 4 == 102 * MiB && (size_t)M * DFF * 2 == 272 * MiB, "sizes");

struct Ctx { const float* in[28]; float* out; unsigned char* ws; int ph_lo, ph_hi; };
typedef const __attribute__((address_space(4))) Ctx* CtxP;
__device__ __forceinline__ int otid_cp(CtxP cp) {
#if defined(__HIP_DEVICE_COMPILE__)
    unsigned long long a = (unsigned long long)cp; asm volatile("" : "+s"(a));
    int ln; asm volatile("v_mbcnt_lo_u32_b32 %0, -1, 0\n\tv_mbcnt_hi_u32_b32 %0, -1, %0" : "=v"(ln));
    return (int)((unsigned)a & 7u) * 64 + ln;
#else
    (void)cp; return 0;
#endif
}
#define otid() otid_cp(cp)
__device__ __forceinline__ int obid() { int b = blockIdx.x; asm volatile("" : "+s"(b)); return b; }
__device__ __forceinline__ int ogrid() { int g = gridDim.x; asm volatile("" : "+s"(g)); return g; }
__device__ __forceinline__ Ctx ctx_load(CtxP cp) {
#if defined(__HIP_DEVICE_COMPILE__)
    asm volatile("" : "+s"(cp)); cp = (CtxP)((unsigned long long)cp & ~7ull); Ctx r; __builtin_memcpy(&r, cp, sizeof(Ctx)); return r;
#else
    (void)cp; return Ctx{};
#endif
}
#define CTX_LOAD(cp) const Ctx c = ctx_load(cp)
enum { I_XP = 0, I_XS, I_SGDN, I_SCONV, I_CK, I_CV, I_CLOGF, I_CMK, I_CMV, I_MEMP, I_NMIXPRE, I_NMIXPOST, I_NMLPPRE, I_NMLPPOST, I_WINA, I_CONVW, I_ALOG, I_DTB, I_GDNN, I_WINB, I_NKV, I_WKVF, I_BF, I_NMEM, I_WMEMKV, I_WO, I_WUP, I_WDN };

__device__ __forceinline__ float bf2f(bf16_t b) { return __uint_as_float(((unsigned)b) << 16); }
__device__ __forceinline__ float bflo(unsigned u) { return __uint_as_float(u << 16); }
__device__ __forceinline__ float bfhi(unsigned u) { return __uint_as_float(u & 0xffff0000u); }
__device__ __forceinline__ unsigned pk2(float lo, float hi) { return pg8::cvt_pk_bf16(lo, hi); }
__device__ __forceinline__ float lane_get(float v, int src_lane) { return __int_as_float(__builtin_amdgcn_ds_bpermute(src_lane << 2, __float_as_int(v))); }
__device__ __forceinline__ float wave_sum(float v, int lane) {
#pragma unroll
    for (int o = 1; o < 64; o <<= 1) v += lane_get(v, lane ^ o);
    return v; }
__device__ __forceinline__ float wave_max(float v, int lane) {
#pragma unroll
    for (int o = 1; o < 64; o <<= 1) v = fmaxf(v, lane_get(v, lane ^ o));
    return v; }
__device__ __forceinline__ float wave_sum_dpp(float v) {
    v += __int_as_float(__builtin_amdgcn_update_dpp(0, __float_as_int(v), 0x111, 0xf, 0xf, true));
    v += __int_as_float(__builtin_amdgcn_update_dpp(0, __float_as_int(v), 0x112, 0xf, 0xf, true));
    v += __int_as_float(__builtin_amdgcn_update_dpp(0, __float_as_int(v), 0x114, 0xf, 0xf, true));
    v += __int_as_float(__builtin_amdgcn_update_dpp(0, __float_as_int(v), 0x118, 0xf, 0xf, true));
    const int iv = __float_as_int(v);
    return (__int_as_float(__builtin_amdgcn_readlane(iv, 15)) + __int_as_float(__builtin_amdgcn_readlane(iv, 31))) + (__int_as_float(__builtin_amdgcn_readlane(iv, 47)) + __int_as_float(__builtin_amdgcn_readlane(iv, 63)));
}
__device__ __forceinline__ float sigmoidf_(float x) { return 1.f / (1.f + expf(-x)); }
__device__ __forceinline__ float softplusf_(float x) { return fmaxf(x, 0.f) + log1pf(expf(-fabsf(x))); }
__device__ __forceinline__ float softplus_fast(float x) { return fmaxf(x, 0.f) + 0.6931471805599453f * __builtin_amdgcn_logf(1.f + __builtin_amdgcn_exp2f(-1.4426950408889634f * fabsf(x))); }
__device__ __forceinline__ float fast_sigmoid(float x) { return __builtin_amdgcn_rcpf(1.f + __builtin_amdgcn_exp2f(-1.4426950408889634f * x)); }
__device__ __forceinline__ float exp_fast(float x) { return __builtin_amdgcn_exp2f(1.4426950408889634f * x); }
struct RowInfo { int grp, b, t, T, nb; };
__device__ __forceinline__ RowInfo rowinfo(int m) { RowInfo r; if (m < MP) { r.grp = 0; r.b = m >> 12; r.t = m & 4095; r.T = 4096; r.nb = 4; } else { const int ms = m - MP; r.grp = 1; r.b = ms >> 5; r.t = ms & 31; r.T = 32; r.nb = 32; } return r; }
namespace pg8 {
struct Epi {
    static constexpr bool PERM = true, AFTER_DRAIN = false;
    int mode;
    bf16_t* o16; int ld16; float* o32; int ld32;
    unsigned char* ws; float* out;
    int ntfull;
    int ntcol;
    __device__ __forceinline__ void operator()(const f32x4 (&acc)[2][2][4][2], const Unit& u, int wr, int wc, int fr, int fq) const {
        const int row0 = u.pm * BM + wr * 64 + fr, colt = u.pn * BM, cl = wc * 32 + 8 * fq;
        bf16_t* d16 = nullptr; size_t l16 = 0; float* d32 = nullptr; size_t l32 = 0; int radj = 0; const bool sq = (mode == 1);
        bool nt16 = false;
        if (mode == 0 || mode == 1) { d16 = o16 + colt; l16 = (size_t)ld16; nt16 = (mode == 0) && (ntcol >= 0) && (colt >= ntcol); }
        else if (mode == 2) {
            if (u.nt != ntfull) { d16 = (bf16_t*)(ws + WS_SLAB) + (size_t)u.ks * 1024 * 2048 + colt - (size_t)16384 * 2048; l16 = 2048; }
            else { d16 = o16 + colt; l16 = (size_t)ld16; } }
        else if (mode == 3) {
            if (colt < 3584) { d16 = o16 + colt; l16 = (size_t)ld16; nt16 = true; }
            else { const bool isv = colt >= 5120; const int cc = colt - (isv ? 5120 : 3584); const bool smp = u.pm >= 64;
                d16 = (bf16_t*)(ws + (isv ? WS_VB : WS_KB)) + cc; l16 = 1536; d32 = out + (smp ? (isv ? O_SV : O_SK) : (isv ? O_PV : O_PK)) + cc; l32 = 1536; radj = smp ? 16384 : 0; }
        } else { const int l = colt >> 10, within = colt & 1023; d32 = out + ((within >= 512) ? O_PMV : O_PMK) + (size_t)l * 1024 * 512 + (within & 511); l32 = 512;  d16 = (bf16_t*)(ws + WS_MEMKVB) + colt; l16 = 4096; }
#pragma unroll
        for (int ai = 0; ai < 2; ++ai)
#pragma unroll
            for (int m = 0; m < 4; ++m) { const int row = row0 + ai * HALF + m * 16;
#pragma unroll
                for (int bj = 0; bj < 2; ++bj) { f32x4 v0 = acc[ai][bj][m][0], v1 = acc[ai][bj][m][1]; const int col = cl + bj * HALF;
                    if (sq) {
#pragma unroll
                        for (int j = 0; j < 4; ++j) { const float a = v0[j] > 0.f ? v0[j] : 0.f, b = v1[j] > 0.f ? v1[j] : 0.f; v0[j] = a * a; v1[j] = b * b; } }
                    if (d16) { u32x4 w; w.x = cvt_pk_bf16(v0[0], v0[1]); w.y = cvt_pk_bf16(v0[2], v0[3]); w.z = cvt_pk_bf16(v1[0], v1[1]); w.w = cvt_pk_bf16(v1[2], v1[3]);
                        if (nt16) __builtin_nontemporal_store(w, (u32x4*)(d16 + (size_t)row * l16 + col)); else *(u32x4*)(d16 + (size_t)row * l16 + col) = w; }
                    if (d32) { float* p = d32 + (size_t)(row - radj) * l32 + col;
                        if (mode >= 3) { __builtin_nontemporal_store(v0, (f32x4*)p); __builtin_nontemporal_store(v1, (f32x4*)(p + 4)); }
                        else { *(f32x4*)p = v0; *(f32x4*)(p + 4) = v1; } } } }
    }
};
struct TailSplit {
    StaticOrder full; int nF, nN, nsl, nts, G, c, split;
    __device__ void init(int M, int N, int K, int G_, int c_, int split_, int nsl_ = 8) { split = split_; full.init(split_ ? 64 * BM : M, N, K, G_, c_); nN = N / BM; nF = 64 * nN; nsl = nsl_; nts = K / BK / nsl; G = G_; c = c_; }
    __device__ __forceinline__ bool next(int i, Unit& u) const {
        const long L = (long)i * G + c; int pm = 0, pn = 0, kt0 = 0, nt = full.ntf, ks = 0; bool ok; if (c < 0) { u.pm = 0; u.pn = 0; u.kt0 = 0; u.nt = nt; u.ks = 0; return false; }
        if (!split || L < nF) { Unit t; ok = full.next(i, t); pm = t.pm; pn = t.pn; }
        else { const int Ls = (int)(L - nF); ok = Ls < 4 * nN * nsl; pn = Ls % nN; const int rest = Ls / nN; pm = 64 + (rest & 3); ks = rest >> 2; kt0 = ks * nts; nt = nts; }
        u.pm = pm; u.pn = pn; u.kt0 = kt0; u.nt = nt; u.ks = ks; return ok;
    }
    __device__ __forceinline__ void a_ready(const Unit&) const {}
    __device__ __forceinline__ void done(const Unit&) const {}
};
}
namespace pg8 {
template <class Epi, class Sched, bool ALIGN_EPI = false, bool SP2 = false>
__device__ __forceinline__ void gemm_phase(PG8_LAS unsigned char* lds, const Gemm g, const Sched& S, const Epi& E, const int tid) {
    const int wid = __builtin_amdgcn_readfirstlane(tid >> 6), lane = tid & 63, wr = wid >> 2, wc = wid & 3, fr = lane & 15, fq = lane >> 4;
    const int K = g.K;
    unsigned voffA[2], voffB[2];
#pragma unroll
    for (int i = 0; i < 2; ++i) { int R, C; stage_rc(tid * 16 + i * 8192, R, C); const int Rb = Epi::PERM ? ((R & ~31) + perm32(R & 31)) : R;
        voffA[i] = (unsigned)(R * K + C) * 2u; voffB[i] = (unsigned)(Rb * K + C) * 2u; }
    const size_t kstep = (size_t)(BK * 2);
    const size_t hstep = (size_t)HALF * K * 2;
    const size_t tstep = 2 * hstep;
    const unsigned ldsw = (unsigned)wid * 1024u;
    const int aoff = lds_byte(wr * 64 + fr, fq * 8), boff = lds_byte(wc * 32 + fr, fq * 8);
#define PG8_SA(b, h) (((b) * 2 + (h)) * HTB)
#define PG8_SB(b, h) ((4 + (b) * 2 + (h)) * HTB)
#define PG8_STAGE(bufoff, gbase, voff) do { _Pragma("unroll") for (int _i = 0; _i < 2; ++_i) \
        __builtin_amdgcn_global_load_lds((const unsigned*)((const char*)(gbase) + (voff)[_i]), (PG8_LAS unsigned*)(lds + (bufoff) + ldsw + _i * 8192), 16, 0, 0); } while (0)
#define PG8_LDA(dst, b, h) do { _Pragma("unroll") for (int m = 0; m < 4; ++m) _Pragma("unroll") for (int k = 0; k < 2; ++k) dst[m][k] = *(const PG8_LAS bf16x8*)(lds + PG8_SA(b, h) + aoff + m * 2048 + k * 1024); } while (0)
#define PG8_LDB(dst, b, h) do { _Pragma("unroll") for (int n = 0; n < 2; ++n) _Pragma("unroll") for (int k = 0; k < 2; ++k) dst[n][k] = *(const PG8_LAS bf16x8*)(lds + PG8_SB(b, h) + boff + n * 2048 + k * 1024); } while (0)
#define PG8_MMA(ai, bj, At, Bt) do { __builtin_amdgcn_s_setprio(1); _Pragma("unroll") for (int m = 0; m < 4; ++m) _Pragma("unroll") for (int n = 0; n < 2; ++n) _Pragma("unroll") for (int k = 0; k < 2; ++k) \
        acc[ai][bj][m][n] = __builtin_amdgcn_mfma_f32_16x16x32_bf16(Bt[n][k], At[m][k], acc[ai][bj][m][n], 0, 0, 0); __builtin_amdgcn_s_setprio(0); } while (0)
#define PG8_WAIT_V(n) asm volatile("s_waitcnt vmcnt(" #n ")" ::: "memory")
#define PG8_WAIT_L(n) asm volatile("s_waitcnt lgkmcnt(" #n ")" ::: "memory")
#define PG8_BAR __builtin_amdgcn_s_barrier()
#define PG8_SCHED __builtin_amdgcn_sched_barrier(0)
    Unit cur, nxt; int ui = 0;
    if (!S.next(0, cur)) return;
    f32x4 acc[2][2][4][2];
#pragma unroll
    for (int a = 0; a < 2; ++a)
#pragma unroll
        for (int b = 0; b < 2; ++b)
#pragma unroll
            for (int m = 0; m < 4; ++m)
#pragma unroll
                for (int n = 0; n < 2; ++n) acc[a][b][m][n] = (f32x4){0.f, 0.f, 0.f, 0.f};
    bf16x8 At[4][2], B0[2][2], B1[2][2];
    const char* cA = (const char*)g.A + (size_t)cur.pm * tstep + (size_t)cur.kt0 * kstep; const char* cB = (const char*)g.Bt + (size_t)cur.pn * tstep + (size_t)cur.kt0 * kstep;
    S.a_ready(cur);
    if constexpr (SP2) {
        PG8_STAGE(PG8_SB(0, 0), cB, voffB); PG8_STAGE(PG8_SB(0, 1), cB + hstep, voffB); PG8_STAGE(PG8_SA(0, 0), cA, voffA); PG8_STAGE(PG8_SA(0, 1), cA + hstep, voffA);
        if (wr == 1) PG8_BAR;
        PG8_WAIT_V(2); PG8_BAR;
        PG8_STAGE(PG8_SB(1, 0), cB + kstep, voffB); PG8_STAGE(PG8_SA(1, 0), cA + kstep, voffA); PG8_STAGE(PG8_SB(1, 1), cB + hstep + kstep, voffB);
        PG8_WAIT_V(6); PG8_BAR;
    } else {
        PG8_STAGE(PG8_SB(0, 0), cB, voffB); PG8_STAGE(PG8_SA(0, 0), cA, voffA); PG8_STAGE(PG8_SB(0, 1), cB + hstep, voffB); PG8_STAGE(PG8_SA(0, 1), cA + hstep, voffA);
        if (wr == 1) PG8_BAR;
        PG8_WAIT_V(4); PG8_BAR;
        PG8_STAGE(PG8_SB(1, 0), cB + kstep, voffB); PG8_STAGE(PG8_SA(1, 0), cA + kstep, voffA); PG8_STAGE(PG8_SB(1, 1), cB + hstep + kstep, voffB);
        PG8_WAIT_V(6); PG8_BAR;
    }
    for (;;) {
        const bool has_next = S.next(ui + 1, nxt);
        const char* nA = has_next ? (const char*)g.A + (size_t)nxt.pm * tstep + (size_t)nxt.kt0 * kstep : cA; const char* nB = has_next ? (const char*)g.Bt + (size_t)nxt.pn * tstep + (size_t)nxt.kt0 * kstep : cB;
        const int nt = cur.nt;
        for (int t = 0; t < nt; t += 2) {
            const bool last = (t == nt - 2);
            const char* a1 = cA + (size_t)(t + 1) * kstep;
            const char* a2 = last ? nA : cA + (size_t)(t + 2) * kstep; const char* b2 = last ? nB : cB + (size_t)(t + 2) * kstep;
            const char* a3 = a2 + kstep; const char* b3 = b2 + kstep;
            if (last && has_next) S.a_ready(nxt);
            if constexpr (SP2) {
            PG8_LDB(B0, 0, 0); PG8_LDB(B1, 0, 1); PG8_SCHED; PG8_LDA(At, 0, 0); PG8_STAGE(PG8_SA(1, 1), a1 + hstep, voffA);
            PG8_WAIT_V(8); PG8_WAIT_L(0); PG8_BAR; PG8_MMA(0, 0, At, B0); PG8_MMA(0, 1, At, B1); PG8_BAR; PG8_SCHED;
            PG8_LDA(At, 0, 1); PG8_STAGE(PG8_SB(0, 0), b2, voffB); PG8_STAGE(PG8_SB(0, 1), b2 + hstep, voffB); PG8_STAGE(PG8_SA(0, 0), a2, voffA);
            PG8_WAIT_V(8); PG8_WAIT_L(0); PG8_BAR; PG8_MMA(1, 0, At, B0); PG8_MMA(1, 1, At, B1); PG8_BAR; PG8_SCHED;
            PG8_LDB(B0, 1, 0); PG8_LDB(B1, 1, 1); PG8_SCHED; PG8_LDA(At, 1, 0); PG8_STAGE(PG8_SA(0, 1), a2 + hstep, voffA);
            PG8_WAIT_V(8); PG8_WAIT_L(0); PG8_BAR; PG8_MMA(0, 0, At, B0); PG8_MMA(0, 1, At, B1); PG8_BAR; PG8_SCHED;
            PG8_LDA(At, 1, 1); PG8_STAGE(PG8_SB(1, 0), b3, voffB); PG8_STAGE(PG8_SB(1, 1), b3 + hstep, voffB); PG8_STAGE(PG8_SA(1, 0), a3, voffA);
            PG8_WAIT_V(8); PG8_WAIT_L(0); PG8_BAR; PG8_MMA(1, 0, At, B0); PG8_MMA(1, 1, At, B1); PG8_BAR; PG8_SCHED;
            } else {
            PG8_LDB(B0, 0, 0); PG8_SCHED; PG8_LDA(At, 0, 0); PG8_STAGE(PG8_SA(1, 1), a1 + hstep, voffA);
            PG8_WAIT_L(8); PG8_BAR; PG8_WAIT_L(0); PG8_MMA(0, 0, At, B0); PG8_BAR; PG8_SCHED;
            PG8_LDB(B1, 0, 1); PG8_STAGE(PG8_SB(0, 0), b2, voffB);
            PG8_BAR; PG8_WAIT_L(0); PG8_MMA(0, 1, At, B1); PG8_BAR;
            PG8_LDA(At, 0, 1); PG8_STAGE(PG8_SA(0, 0), a2, voffA);
            PG8_BAR; PG8_WAIT_L(0); PG8_MMA(1, 0, At, B0); PG8_BAR; PG8_SCHED;
            PG8_STAGE(PG8_SB(0, 1), b2 + hstep, voffB);
            PG8_WAIT_V(6); PG8_BAR; PG8_MMA(1, 1, At, B1); PG8_BAR;
            PG8_LDB(B0, 1, 0); PG8_SCHED; PG8_LDA(At, 1, 0); PG8_STAGE(PG8_SA(0, 1), a2 + hstep, voffA);
            PG8_WAIT_L(8); PG8_BAR; PG8_WAIT_L(0); PG8_MMA(0, 0, At, B0); PG8_BAR; PG8_SCHED;
            PG8_LDB(B1, 1, 1); PG8_STAGE(PG8_SB(1, 0), b3, voffB);
            PG8_BAR; PG8_WAIT_L(0); PG8_MMA(0, 1, At, B1); PG8_BAR;
            PG8_LDA(At, 1, 1); PG8_STAGE(PG8_SA(1, 0), a3, voffA);
            PG8_BAR; PG8_WAIT_L(0); PG8_MMA(1, 0, At, B0); PG8_BAR; PG8_SCHED;
            PG8_STAGE(PG8_SB(1, 1), b3 + hstep, voffB);
            PG8_WAIT_V(6); PG8_BAR; PG8_MMA(1, 1, At, B1); PG8_BAR;
            }
        }
        if constexpr (ALIGN_EPI) { if (wr == 0) PG8_BAR; }
        if constexpr (!Epi::AFTER_DRAIN) { E(acc, cur, wr, wc, fr, fq); S.done(cur); }
        if (!has_next) break;
#pragma unroll
        for (int a = 0; a < 2; ++a)
#pragma unroll
            for (int b = 0; b < 2; ++b)
#pragma unroll
                for (int m = 0; m < 4; ++m)
#pragma unroll
                    for (int n = 0; n < 2; ++n) acc[a][b][m][n] = (f32x4){0.f, 0.f, 0.f, 0.f};
        cur = nxt; cA = nA; cB = nB; ++ui;
        if constexpr (ALIGN_EPI) { if (wr == 1) PG8_BAR; }
    }
    PG8_WAIT_V(0);
    if constexpr (!ALIGN_EPI) { if (wr == 0) PG8_BAR; }
    PG8_BAR;
    if constexpr (Epi::AFTER_DRAIN) { E.fused(acc, cur, wr, wc, fr, fq, lds, wid, lane); S.done(cur); }
#undef PG8_SA
#undef PG8_SB
#undef PG8_STAGE
#undef PG8_LDA
#undef PG8_LDB
#undef PG8_MMA
#undef PG8_WAIT_V
#undef PG8_WAIT_L
#undef PG8_BAR
#undef PG8_SCHED
}
}
typedef short bf16x8s __attribute__((ext_vector_type(8)));
#define WS_PTR(T, off) ((T*)(c.ws + (off)))
struct TJob { const float* W; int ldw, K; const float* gain; bf16_t* WT; int src0, dst0, ncols; };
__device__ __forceinline__ TJob get_job(const Ctx& c, int j) {
    TJob J; J.gain = nullptr; J.src0 = 0; J.dst0 = 0; J.K = D;
    if (j < 4) { const int l = j >> 1, p = j & 1; J.W = c.in[I_WINA] + (size_t)l * D * INA_W; J.ldw = INA_W; J.gain = c.in[I_NMIXPRE] + l * D; J.WT = WS_PTR(bf16_t, WS_WINA) + (size_t)l * 6656 * D;
        if (p == 0) { J.ncols = 6144; } else { J.src0 = 6168; J.dst0 = 6144; J.ncols = 512; } }
    else if (j == 4) { J.W = c.in[I_WINB]; J.ldw = INB_W; J.gain = c.in[I_NMIXPRE] + 2 * D; J.WT = WS_PTR(bf16_t, WS_WINB0); J.ncols = 3584; }
    else if (j == 5) { J.W = c.in[I_WKVF]; J.ldw = KVF_W; J.gain = c.in[I_NKV]; J.WT = WS_PTR(bf16_t, WS_WINB0); J.dst0 = 3584; J.ncols = 3072; }
    else if (j == 6) { J.W = c.in[I_WINB] + (size_t)D * INB_W; J.ldw = INB_W; J.gain = c.in[I_NMIXPRE] + 3 * D; J.WT = WS_PTR(bf16_t, WS_WINB1); J.ncols = 3584; }
    else if (j < 11) { const int l = j - 7; J.W = c.in[I_WO] + (size_t)l * D * D; J.ldw = D; J.WT = WS_PTR(bf16_t, WS_WO) + (size_t)l * D * D; J.ncols = D; }
    else if (j < 15) { const int l = j - 11; J.W = c.in[I_WUP] + (size_t)l * D * DFF; J.ldw = DFF; J.gain = c.in[I_NMLPPRE] + l * D; J.WT = WS_PTR(bf16_t, WS_WUP) + (size_t)l * DFF * D; J.ncols = DFF; }
    else if (j < 19) { const int l = j - 15; J.W = c.in[I_WDN] + (size_t)l * DFF * D; J.ldw = D; J.K = DFF; J.WT = WS_PTR(bf16_t, WS_WDN) + (size_t)l * D * DFF; J.ncols = D; }
    else { const int l = j - 19; J.W = c.in[I_WMEMKV] + (size_t)l * D * 1024; J.ldw = 1024; J.gain = c.in[I_NMEM] + l * D; J.WT = WS_PTR(bf16_t, WS_WMEM); J.dst0 = l * 1024; J.ncols = 1024; }
    return J;
}
constexpr int NJOBS = 23;
__device__ __forceinline__ int job_items(const TJob& J) { return (J.K / 64) * (J.ncols / 32); }
__device__ __forceinline__ void transpose_item(const TJob& J, int item, LAS float* scr, int lane) {
    const int nblk = J.ncols / 32, kb = item / nblk, nb = item % nblk, k0 = 64 * kb, n0 = 32 * nb;
    float wv[32];
#pragma unroll
    for (int i = 0; i < 32; ++i) wv[i] = __builtin_nontemporal_load(J.W + (size_t)(k0 + 2 * i + (lane >> 5)) * J.ldw + J.src0 + n0 + (lane & 31));
#pragma unroll
    for (int i = 0; i < 32; ++i) { const int kk = 2 * i + (lane >> 5); float w = wv[i]; if (J.gain) w *= J.gain[k0 + kk]; scr[kk * 33 + (lane & 31)] = w; }
    asm volatile("s_waitcnt lgkmcnt(0)" ::: "memory");
    const int cc = lane & 7;
#pragma unroll
    for (int j = 0; j < 4; ++j) { const int n = (lane >> 3) + 8 * j; const LAS float* s = scr + (8 * cc) * 33 + n;
        u32x4 o; o.x = pk2(s[0 * 33], s[1 * 33]); o.y = pk2(s[2 * 33], s[3 * 33]); o.z = pk2(s[4 * 33], s[5 * 33]); o.w = pk2(s[6 * 33], s[7 * 33]);
        __builtin_nontemporal_store(o, (u32x4*)(J.WT + (size_t)(J.dst0 + n0 + n) * J.K + k0 + 8 * cc)); }
    asm volatile("s_waitcnt lgkmcnt(0)" ::: "memory");
}
constexpr unsigned JOBS_L0 = 0x3u | (1u << 7) | (1u << 11) | (1u << 15) | (0xfu << 19), JOBS_L1 = 0xcu | (1u << 8) | (1u << 12) | (1u << 16), JOBS_L2 = 0x30u | (1u << 9) | (1u << 13) | (1u << 17), JOBS_L3 = 0x40u | (1u << 10) | (1u << 14) | (1u << 18);
static_assert((JOBS_L0 | JOBS_L1 | JOBS_L2 | JOBS_L3) == (1u << 23) - 1 && (JOBS_L0 & JOBS_L1) == 0 && (JOBS_L2 & JOBS_L3) == 0 && ((JOBS_L0 | JOBS_L1) & (JOBS_L2 | JOBS_L3)) == 0, "every weight job in exactly one group");
__device__ __forceinline__ void ph_prep(CtxP cp, LAS unsigned char* lds, unsigned mask, int wg0, int nwg, int small) {
    CTX_LOAD(cp);
    const int bid_ = obid() - wg0, grid_ = nwg; const int tid = otid(), lane = tid & 63, wave = tid >> 6, gw = bid_ * 8 + wave, NGW = grid_ * 8;
    if (bid_ < 0) return;
    __syncthreads();
    LAS float* scr = (LAS float*)(lds + wave * 16384);
    int base = 0;
    for (int j = 0; j < NJOBS; ++j) { if (!((mask >> j) & 1u)) continue; const TJob J = get_job(c, j); const int n = job_items(J);
        int first = gw - (base % NGW); if (first < 0) first += NGW;
        for (int it = first; it < n; it += NGW) transpose_item(J, it, scr, lane);
        base += n; }
    if (!small) return;
    bf16_t* wskb = WS_PTR(bf16_t, WS_WSKB);
    for (int i = bid_ * 512 + tid; i < 3 * 32 * D; i += grid_ * 512) { const int var = i / (32 * D), r = (i / D) % 32, k = i % D; float v = 0.f;
        if (var < 2) { if (r < 24) v = c.in[I_WINA][(size_t)var * D * INA_W + (size_t)k * INA_W + 6144 + r] * c.in[I_NMIXPRE][var * D + k]; }
        else if (r < 12) v = c.in[I_WKVF][(size_t)k * KVF_W + 3072 + r] * c.in[I_NKV][k];
        wskb[i] = (bf16_t)(pk2(v, 0.f) & 0xffffu); }
}
__device__ __forceinline__ f32x4 x24_unpack(unsigned hx, unsigned hy, unsigned l) {
    return (f32x4){__uint_as_float((hx << 16) | ((l & 0xffu) << 8)), __uint_as_float((hx & 0xffff0000u) | (l & 0xff00u)), __uint_as_float((hy << 16) | ((l >> 8) & 0xff00u)), __uint_as_float((hy & 0xffff0000u) | ((l >> 16) & 0xff00u))}; }
__device__ __forceinline__ void x24_pack(const f32x4 v, unsigned& hx, unsigned& hy, unsigned& l) {
    const unsigned b0 = __float_as_uint(v.x) + 0x80u, b1 = __float_as_uint(v.y) + 0x80u, b2 = __float_as_uint(v.z) + 0x80u, b3 = __float_as_uint(v.w) + 0x80u;
    hx = (b0 >> 16) | (b1 & 0xffff0000u); hy = (b2 >> 16) | (b3 & 0xffff0000u); l = ((b0 >> 8) & 0xffu) | (b1 & 0xff00u) | ((b2 << 8) & 0xff0000u) | ((b3 << 16) & 0xff000000u); }
__device__ __forceinline__ void ph_row2(CtxP cp, int src, int use_delta, int gidx, int gl, int write_y, int first = 0, int wg0 = 0, int nwg = 0) {
    CTX_LOAD(cp);
    const int bid_ = obid() - wg0, grid_ = nwg ? nwg : ogrid();
    if (bid_ < 0 || bid_ >= grid_) return; const int tid = otid(), lane = tid & 63, wave = tid >> 6, gw = bid_ * 8 + wave, NGW = grid_ * 8;
    const bf16_t* XH = WS_PTR(bf16_t, WS_X); const unsigned char* XL = c.ws + WS_X + (size_t)M * D * 2; bf16_t* XN = WS_PTR(bf16_t, WS_XN); const bf16_t* delta = WS_PTR(bf16_t, WS_DELTA); const float* gpost = use_delta ? c.in[gidx] + gl * D : nullptr;
    const int nrows = (src == 2) ? 1024 : M, nslab = (gidx == I_NMIXPOST) ? 4 : 8;
#define EO(j) (8 * lane + 512 * ((j) >> 1) + 4 * ((j) & 1))
#define EB(jj) (8 * lane + 512 * (jj))
#define LD_BF8(dlo, dhi, ptr) do { const u32x4 t_ = __builtin_nontemporal_load((const u32x4*)(ptr)); dlo = (f32x4){bflo(t_.x), bfhi(t_.x), bflo(t_.y), bfhi(t_.y)}; dhi = (f32x4){bflo(t_.z), bfhi(t_.z), bflo(t_.w), bfhi(t_.w)}; } while (0)
#define ADD_BF8(dlo, dhi, ptr) do { const u32x4 t_ = __builtin_nontemporal_load((const u32x4*)(ptr)); dlo = dlo + (f32x4){bflo(t_.x), bfhi(t_.x), bflo(t_.y), bfhi(t_.y)}; dhi = dhi + (f32x4){bflo(t_.z), bfhi(t_.z), bflo(t_.w), bfhi(t_.w)}; } while (0)
#define X24_LD2(vlo, vhi, mrow, jj) do { const u32x4 h_ = __builtin_nontemporal_load((const u32x4*)(XH + (size_t)(mrow) * D + EB(jj))); const u32x2 l_ = __builtin_nontemporal_load((const u32x2*)(XL + (size_t)(mrow) * D + EB(jj))); \
        vlo = x24_unpack(h_.x, h_.y, l_.x); vhi = x24_unpack(h_.z, h_.w, l_.y); } while (0)
#define X24_ST2(vlo, vhi, mrow, jj) do { unsigned ha_, hb_, hc_, hd_, la_, lb_; x24_pack(vlo, ha_, hb_, la_); x24_pack(vhi, hc_, hd_, lb_); const u32x4 h_ = {ha_, hb_, hc_, hd_}; const u32x2 l_ = {la_, lb_}; \
        __builtin_nontemporal_store(h_, (u32x4*)((bf16_t*)XH + (size_t)(mrow) * D + EB(jj))); __builtin_nontemporal_store(l_, (u32x2*)((unsigned char*)XL + (size_t)(mrow) * D + EB(jj))); } while (0)
    const bool deal2 = (src == 0) && use_delta && (NGW == 2048);
    const int half_gw = gw >> 1, isA = !(gw & 1);
    const int nsteps = deal2 ? (isA ? 4 : 5) : (nrows + 2 * NGW - 1) / (2 * NGW);
    for (int st = 0; st < nsteps; ++st) {
        int m0, m1; bool two;
        if (deal2) { if (isA) { if (st == 0) { m0 = MP + half_gw; m1 = m0; two = false; } else { m0 = half_gw + 1024 * (2 * (st - 1)); m1 = m0 + 1024; two = true; } }
            else { m0 = 6144 + half_gw + 1024 * (2 * st); m1 = m0 + 1024; two = true; } }
        else { m0 = gw + st * 2 * NGW; if (m0 >= nrows) break; const int m1r = m0 + NGW; two = m1r < nrows; m1 = two ? m1r : m0; }
        const bool fromx = (src == 0) && !first;
        const float* xr0 = (src != 2) ? (m0 < MP ? c.in[I_XP] + (size_t)m0 * D : c.in[I_XS] + (size_t)(m0 - MP) * D) : c.in[I_MEMP] + (size_t)m0 * D;
        const float* xr1 = (src != 2) ? (m1 < MP ? c.in[I_XP] + (size_t)m1 * D : c.in[I_XS] + (size_t)(m1 - MP) * D) : c.in[I_MEMP] + (size_t)m1 * D;
        f32x4 v0[8], v1[8];
        if (fromx) {
#pragma unroll
            for (int jj = 0; jj < 4; ++jj) { X24_LD2(v0[2 * jj], v0[2 * jj + 1], m0, jj); if (two) X24_LD2(v1[2 * jj], v1[2 * jj + 1], m1, jj); else { v1[2 * jj] = v0[2 * jj]; v1[2 * jj + 1] = v0[2 * jj + 1]; } } }
        else {
#pragma unroll
            for (int j = 0; j < 8; ++j) { v0[j] = __builtin_nontemporal_load((const f32x4*)(xr0 + EO(j))); v1[j] = two ? __builtin_nontemporal_load((const f32x4*)(xr1 + EO(j))) : v0[j]; } }
        if (use_delta) { f32x4 d0[8], d1[8]; float s0 = 0.f, s1 = 0.f;
#pragma unroll
            for (int jj = 0; jj < 4; ++jj) {
                if (m0 < MP) LD_BF8(d0[2 * jj], d0[2 * jj + 1], delta + (size_t)m0 * D + EB(jj));
                else { const bf16_t* sp = WS_PTR(bf16_t, WS_SLAB) + (size_t)(m0 - MP) * D + EB(jj); LD_BF8(d0[2 * jj], d0[2 * jj + 1], sp);
#pragma unroll
                    for (int s8 = 1; s8 < 8; ++s8) if (s8 < nslab) ADD_BF8(d0[2 * jj], d0[2 * jj + 1], sp + (size_t)s8 * 1024 * D); }
                if (!two) { d1[2 * jj] = d0[2 * jj]; d1[2 * jj + 1] = d0[2 * jj + 1]; }
                else if (m1 < MP) LD_BF8(d1[2 * jj], d1[2 * jj + 1], delta + (size_t)m1 * D + EB(jj));
                else { const bf16_t* sp = WS_PTR(bf16_t, WS_SLAB) + (size_t)(m1 - MP) * D + EB(jj); LD_BF8(d1[2 * jj], d1[2 * jj + 1], sp);
#pragma unroll
                    for (int s8 = 1; s8 < 8; ++s8) if (s8 < nslab) ADD_BF8(d1[2 * jj], d1[2 * jj + 1], sp + (size_t)s8 * 1024 * D); } }
#pragma unroll
            for (int j = 0; j < 8; ++j) { s0 += (d0[j].x * d0[j].x + d0[j].y * d0[j].y) + (d0[j].z * d0[j].z + d0[j].w * d0[j].w); s1 += (d1[j].x * d1[j].x + d1[j].y * d1[j].y) + (d1[j].z * d1[j].z + d1[j].w * d1[j].w); }
            const float r0 = rsqrtf(wave_sum_dpp(s0) * (1.f / D) + EPS), r1 = rsqrtf(wave_sum_dpp(s1) * (1.f / D) + EPS);
#pragma unroll
            for (int j = 0; j < 8; ++j) { const f32x4 g = *(const f32x4*)(gpost + EO(j)); v0[j] = v0[j] + d0[j] * r0 * g; v1[j] = v1[j] + d1[j] * r1 * g; } }
        if (src == 0 && !write_y) {
#pragma unroll
            for (int jj = 0; jj < 4; ++jj) { X24_ST2(v0[2 * jj], v0[2 * jj + 1], m0, jj); if (two) X24_ST2(v1[2 * jj], v1[2 * jj + 1], m1, jj); } }
        if (write_y) {
#pragma unroll
            for (int j = 0; j < 8; ++j) { __builtin_nontemporal_store(v0[j], (f32x4*)(c.out + O_YP + (size_t)m0 * D + EO(j))); if (two) __builtin_nontemporal_store(v1[j], (f32x4*)(c.out + O_YP + (size_t)m1 * D + EO(j))); }
            continue; }
        float q0 = 0.f, q1 = 0.f;
#pragma unroll
        for (int j = 0; j < 8; ++j) { q0 += (v0[j].x * v0[j].x + v0[j].y * v0[j].y) + (v0[j].z * v0[j].z + v0[j].w * v0[j].w); q1 += (v1[j].x * v1[j].x + v1[j].y * v1[j].y) + (v1[j].z * v1[j].z + v1[j].w * v1[j].w); }
        const float t0 = rsqrtf(wave_sum_dpp(q0) * (1.f / D) + EPS), t1 = rsqrtf(wave_sum_dpp(q1) * (1.f / D) + EPS);
        bf16_t* xn0 = ((src == 2) ? WS_PTR(bf16_t, WS_MEMN) : XN) + (size_t)m0 * D; bf16_t* xn1 = ((src == 2) ? WS_PTR(bf16_t, WS_MEMN) : XN) + (size_t)m1 * D;
#pragma unroll
        for (int jj = 0; jj < 4; ++jj) { const f32x4 a0 = v0[2 * jj], b0 = v0[2 * jj + 1], a1 = v1[2 * jj], b1 = v1[2 * jj + 1]; u32x4 w0, w1;
            w0.x = pk2(a0.x * t0, a0.y * t0); w0.y = pk2(a0.z * t0, a0.w * t0); w0.z = pk2(b0.x * t0, b0.y * t0); w0.w = pk2(b0.z * t0, b0.w * t0);
            w1.x = pk2(a1.x * t1, a1.y * t1); w1.y = pk2(a1.z * t1, a1.w * t1); w1.z = pk2(b1.x * t1, b1.y * t1); w1.w = pk2(b1.z * t1, b1.w * t1);
            *(u32x4*)(xn0 + EB(jj)) = w0; if (two) *(u32x4*)(xn1 + EB(jj)) = w1; }
    }
#undef EO
#undef EB
#undef LD_BF8
#undef ADD_BF8
#undef X24_LD2
#undef X24_ST2
}
__device__ __forceinline__ void ph_skinny(CtxP cp, int var, LAS unsigned char* lds) {
    CTX_LOAD(cp);
    const int bid_ = obid(), grid_ = ogrid(); const int tid = otid(), lane = tid & 63, wave = tid >> 6, n16 = lane & 15, q = lane >> 4;
    const bf16_t* Wb = WS_PTR(bf16_t, WS_WSKB) + (size_t)var * 32 * D + (size_t)n16 * D + 8 * q + 256 * wave;
    bf16x8s wa[8], wb[8];
#pragma unroll
    for (int ks = 0; ks < 8; ++ks) { wa[ks] = *(const bf16x8s*)(Wb + 32 * ks); wb[ks] = *(const bf16x8s*)(Wb + (size_t)16 * D + 32 * ks); }
    LAS float* P = (LAS float*)lds;
    const bf16_t* xp = WS_PTR(bf16_t, WS_XN) + (size_t)n16 * D + 8 * q + 256 * wave;
    __syncthreads();
    bf16x8s xb[8];
#pragma unroll
    for (int ks = 0; ks < 8; ++ks) xb[ks] = *(const bf16x8s*)(xp + (size_t)(16 * bid_) * D + 32 * ks);
    int nt = 0;
    for (int rt = bid_; rt < M / 16; rt += grid_, ++nt) {
        bf16x8s xn[8]; const int rn = rt + grid_;
        if (rn < M / 16) {
#pragma unroll
            for (int ks = 0; ks < 8; ++ks) xn[ks] = *(const bf16x8s*)(xp + (size_t)(16 * rn) * D + 32 * ks); }
        else {
#pragma unroll
            for (int ks = 0; ks < 8; ++ks) xn[ks] = xb[ks]; }
        f32x4 a0 = {0.f, 0.f, 0.f, 0.f}, a1 = {0.f, 0.f, 0.f, 0.f};
#pragma unroll
        for (int ks = 0; ks < 8; ++ks) { a0 = __builtin_amdgcn_mfma_f32_16x16x32_bf16(wa[ks], xb[ks], a0, 0, 0, 0); a1 = __builtin_amdgcn_mfma_f32_16x16x32_bf16(wb[ks], xb[ks], a1, 0, 0, 0); }
        LAS float* pp = P + (size_t)((nt * 8 + wave) * 8) * 64 + lane;
#pragma unroll
        for (int i = 0; i < 4; ++i) { pp[i * 64] = a0[i]; pp[(4 + i) * 64] = a1[i]; }
#pragma unroll
        for (int ks = 0; ks < 8; ++ks) xb[ks] = xn[ks];
    }
    __syncthreads();
    const int cc = (wave < 4) ? 4 * q + wave : 16 + 4 * q + (wave - 4);
    for (int t = 0; t < nt; ++t) { const int m = 16 * (bid_ + t * grid_) + n16; float s = 0.f;
#pragma unroll
        for (int w = 0; w < 8; ++w) s += P[(size_t)((t * 8 + w) * 8 + wave) * 64 + lane];
        if (var < 2) {
            if (cc < 12) WS_PTR(float, WS_G)[(size_t)m * 12 + cc] = -exp_fast(c.in[I_ALOG][var * 12 + cc]) * softplus_fast(s + c.in[I_DTB][var * 12 + cc]);
            else if (cc < 24) WS_PTR(float, WS_BETA)[(size_t)m * 12 + (cc - 12)] = fast_sigmoid(s); }
        else if (cc < 12) { const float lf = -softplus_fast(-(s + c.in[I_BF][cc])); WS_PTR(float, WS_LOGF)[(size_t)m * 12 + cc] = lf;
            c.out[(m < MP ? O_PLOGF + (size_t)m * 12 : O_SLOGF + (size_t)(m - MP) * 12) + cc] = lf; } }
    __syncthreads();
}
__device__ __forceinline__ void ph_gdn_c(CtxP cp, int l) {
    CTX_LOAD(cp);
    const int bid_ = obid(), grid_ = ogrid(); const int tid = otid(), lane = tid & 63, wave = tid >> 6, gw = bid_ * 8 + wave, NGW = grid_ * 8, sub = lane >> 4, c8 = (lane & 15) * 8;
    const bf16_t* PROJ = WS_PTR(bf16_t, WS_PROJ); const bf16_t* Of = WS_PTR(bf16_t, WS_OF); bf16_t* ACT = WS_PTR(bf16_t, WS_ACT);
    const f32x4 g0 = *(const f32x4*)(c.in[I_GDNN] + l * HD + c8), g1 = *(const f32x4*)(c.in[I_GDNN] + l * HD + c8 + 4);
    for (int it = gw * 4 + sub; it < M * H; it += NGW * 4) { const int m = it / H, h = it % H;
        const u32x4 ou = __builtin_nontemporal_load((const u32x4*)(Of + (size_t)m * TOK + h * HD + c8));
        const f32x4 o0 = {bflo(ou.x), bfhi(ou.x), bflo(ou.y), bfhi(ou.y)}, o1 = {bflo(ou.z), bfhi(ou.z), bflo(ou.w), bfhi(ou.w)};
        const u32x4 zu = __builtin_nontemporal_load((const u32x4*)(PROJ + (size_t)m * PJ + QKV + h * HD + c8));
        float ss = (o0.x * o0.x + o0.y * o0.y) + (o0.z * o0.z + o0.w * o0.w) + (o1.x * o1.x + o1.y * o1.y) + (o1.z * o1.z + o1.w * o1.w);
        ss += __int_as_float(__builtin_amdgcn_update_dpp(0, __float_as_int(ss), 0x111, 0xf, 0xf, true)); ss += __int_as_float(__builtin_amdgcn_update_dpp(0, __float_as_int(ss), 0x112, 0xf, 0xf, true));
        ss += __int_as_float(__builtin_amdgcn_update_dpp(0, __float_as_int(ss), 0x114, 0xf, 0xf, true)); ss += __int_as_float(__builtin_amdgcn_update_dpp(0, __float_as_int(ss), 0x118, 0xf, 0xf, true));
        ss = lane_get(ss, lane | 15);
        const float r = rsqrtf(ss * (1.f / HD) + EPS);
        const float z0 = bflo(zu.x), z1 = bfhi(zu.x), z2 = bflo(zu.y), z3 = bfhi(zu.y), z4 = bflo(zu.z), z5 = bfhi(zu.z), z6 = bflo(zu.w), z7 = bfhi(zu.w);
        u32x4 w4; w4.x = pk2(o0.x * r * g0.x * (z0 * fast_sigmoid(z0)), o0.y * r * g0.y * (z1 * fast_sigmoid(z1))); w4.y = pk2(o0.z * r * g0.z * (z2 * fast_sigmoid(z2)), o0.w * r * g0.w * (z3 * fast_sigmoid(z3)));
        w4.z = pk2(o1.x * r * g1.x * (z4 * fast_sigmoid(z4)), o1.y * r * g1.y * (z5 * fast_sigmoid(z5))); w4.w = pk2(o1.z * r * g1.z * (z6 * fast_sigmoid(z6)), o1.w * r * g1.w * (z7 * fast_sigmoid(z7)));
        *(u32x4*)(ACT + (size_t)m * D + h * HD + c8) = w4; }
}
__device__ __forceinline__ float wave_scan_dpp(float v, int lane, float& total) {
    v += __int_as_float(__builtin_amdgcn_update_dpp(0, __float_as_int(v), 0x111, 0xf, 0xf, true));
    v += __int_as_float(__builtin_amdgcn_update_dpp(0, __float_as_int(v), 0x112, 0xf, 0xf, true));
    v += __int_as_float(__builtin_amdgcn_update_dpp(0, __float_as_int(v), 0x114, 0xf, 0xf, true));
    v += __int_as_float(__builtin_amdgcn_update_dpp(0, __float_as_int(v), 0x118, 0xf, 0xf, true));
    const int iv = __float_as_int(v);
    const float r0 = __int_as_float(__builtin_amdgcn_readlane(iv, 15)), r1 = __int_as_float(__builtin_amdgcn_readlane(iv, 31)), r2 = __int_as_float(__builtin_amdgcn_readlane(iv, 47)), r3 = __int_as_float(__builtin_amdgcn_readlane(iv, 63));
    const int row = lane >> 4; total = ((r0 + r1) + r2) + r3;
    return v + (row == 0 ? 0.f : row == 1 ? r0 : row == 2 ? r0 + r1 : (r0 + r1) + r2);
}
__device__ __forceinline__ void ph_cumsum(CtxP cp) {
    CTX_LOAD(cp);
    const int bid_ = obid(), grid_ = ogrid(); const int tid = otid(), lane = tid & 63, wave = tid >> 6, NGW = grid_ * 8;
    const float* LOGF = WS_PTR(float, WS_LOGF); float* CUMP = WS_PTR(float, WS_CUMP); float* CUMS = WS_PTR(float, WS_CUMS);
    for (int task = bid_ + grid_ * wave; task < 192 + 384; task += NGW) {
        const bool smp = task >= 192; int b, h, jb, n; float carry = 0.f;
        if (!smp) { const int seg = task / 48, ts = task % 48; b = ts / 12; h = ts % 12; jb = seg * 1024; n = jb + 1024; float ps = 0.f;
#pragma unroll 16
            for (int j = lane; j < jb; j += 64) ps += LOGF[(size_t)(b * 4096 + j) * 12 + h];
            carry = wave_sum_dpp(ps); }
        else { const int ts = task - 192; b = ts / 12; h = ts % 12; jb = 0; n = PAST + 32; }
        for (int j0 = jb; j0 < n; j0 += 1024) { float vv[16];
#pragma unroll
            for (int u = 0; u < 16; ++u) { const int j = j0 + 64 * u + lane; vv[u] = 0.f;
                if (j < n) vv[u] = !smp ? LOGF[(size_t)(b * 4096 + j) * 12 + h] : (j < PAST ? c.in[I_CLOGF][(size_t)(b * PAST + j) * 12 + h] : LOGF[(size_t)(MP + b * 32 + j - PAST) * 12 + h]); }
#pragma unroll
            for (int u = 0; u < 16; ++u) { const int j = j0 + 64 * u + lane; float tot; const float v = wave_scan_dpp(vv[u], lane, tot);
                if (j < n) { if (smp) CUMS[(size_t)(b * (PAST + 32) + j) * 12 + h] = carry + v; else { CUMP[(size_t)(b * 4096 + j) * 12 + h] = carry + v;
                        const float cr = (carry + v) * (1.f / SCALE); const unsigned c1 = pk2(cr, 0.f) & 0xffffu; const float r1 = cr - __uint_as_float(c1 << 16); const unsigned c2 = pk2(r1, 0.f) & 0xffffu;
                        const float r2 = r1 - __uint_as_float(c2 << 16); const unsigned c3 = pk2(r2, 0.f) & 0xffffu; const size_t o8 = ((size_t)(b * 12 + h) * 4096 + j) * 8;
                        u32x4 qv, kv; qv.x = c1 | (c2 << 16); qv.y = c3 | 0x3f800000u; qv.z = 0x3f803f80u; qv.w = 0u; kv.x = 0x3f803f80u; kv.y = 0x3f80u | ((c1 ^ 0x8000u) << 16); kv.z = (c2 ^ 0x8000u) | ((c3 ^ 0x8000u) << 16); kv.w = 0u;
                        *(u32x4*)(WS_PTR(bf16_t, WS_QX) + o8) = qv; *(u32x4*)(WS_PTR(bf16_t, WS_KX) + o8) = kv; } }
                carry += tot; } }
    }
}
typedef short bf16x8 __attribute__((ext_vector_type(8)));
typedef float f32x16 __attribute__((ext_vector_type(16)));
constexpr int GT_W = 0, GT_QG = 16384, GT_KG = 32768, GT_AT = 49152, GT_U = 57344, GT_BYTES = 73728;
constexpr int NTASK_P = 4 * 12 * 64, NTASK = NTASK_P + 384;
constexpr size_t WS_GDNBUF = WS_BIG;
static_assert((size_t)NTASK * GT_BYTES <= 306 * MiB, "GDNBUF must not reach WS_OF");
__device__ __forceinline__ int permpos(int x) { return (x & ~31) | (((x >> 2) & 3) << 3) | (((x >> 4) & 1) << 2) | (x & 3); }
__device__ __forceinline__ int crow32(int r, int hi) { return (r & 3) + 8 * (r >> 2) + 4 * hi; }
constexpr int L_KN = 0, L_QN = 17408, L_VBT = 34816, L_KBT = 53248, L_AS = 71680, L_TS = 88320, L_KGT = 97536, L_ATP = 113920, L_GS = 122112, L_BS = 122368, L_TD = 122624, L_CW = 131072;
#define LDS_BARRIER() do { asm volatile("s_waitcnt lgkmcnt(0)" ::: "memory"); __builtin_amdgcn_s_barrier(); asm volatile("" ::: "memory"); } while (0)
__device__ __forceinline__ void ph_gdn_prep(CtxP cp, int l, LAS unsigned char* lds) {
    CTX_LOAD(cp);
    const int bid_ = obid(), grid_ = ogrid(); const int tid0 = otid();
    const bf16_t* PROJ = WS_PTR(bf16_t, WS_PROJ); const float* cw = c.in[I_CONVW] + (size_t)l * 4 * QKV;
    LAS float* Gs = (LAS float*)(lds + L_GS); LAS float* Bs = (LAS float*)(lds + L_BS); LAS float* As = (LAS float*)(lds + L_AS);
    unsigned warm = 0u;
    for (int tk = bid_; tk < NTASK; tk += grid_) {
        asm volatile("" :: "v"(warm));
        int tid = tid0; asm volatile("" : "+v"(tid));
        const int lane = tid & 63, w = __builtin_amdgcn_readfirstlane(tid >> 6);
        int grp, b, h, ch, L, m0, t0;
        if (tk < NTASK_P) { grp = 0; ch = tk & 63; const int bh = tk >> 6; b = bh / 12; h = bh % 12; L = 64; t0 = ch * 64; m0 = b * 4096 + t0; }
        else { grp = 1; ch = 0; const int bh = tk - NTASK_P; b = bh / 12; h = bh % 12; L = 32; t0 = 0; m0 = MP + b * 32; }
        const int T = grp ? 32 : 4096, nb = grp ? 32 : 4;
        unsigned char* gb = c.ws + WS_GDNBUF + (size_t)tk * GT_BYTES;
        if (tid >= 128) { const int e4 = 4 * (tid - 128); *(LAS f32x4*)(lds + L_CW + e4 * 4) = *(const f32x4*)(cw + (size_t)((e4 >> 7) & 3) * QKV + (e4 >> 9) * TOK + h * HD + (e4 & 127)); }
        if (tid < 64) { const bool v = tid < L; float gv = v ? WS_PTR(float, WS_G)[(size_t)(m0 + tid) * 12 + h] : 0.f; const float bv = v ? WS_PTR(float, WS_BETA)[(size_t)(m0 + tid) * 12 + h] : 0.f;
#pragma unroll
            for (int o = 1; o < 64; o <<= 1) { const float n = lane_get(gv, lane - o); if (lane >= o) gv += n; }
            Gs[tid] = gv; Bs[tid] = bv; }
        LDS_BARRIER();
        const int r = tid >> 3, seg = tid & 7; const bool valid = r < L; const int t = t0 + r, m = m0 + r;
        const float gr = Gs[r], eg = expf(gr), egl = expf(Gs[63] - gr), bt = Bs[r]; const int pr = permpos(r);
#pragma unroll
        for (int pi = 0; pi < 3; ++pi) { const int part = (pi == 0) ? 1 : (pi == 1 ? 0 : 2);
            const int col0 = part * TOK + h * HD + 16 * seg; float y[16];
#pragma unroll
            for (int e = 0; e < 16; ++e) y[e] = 0.f;
            if (valid) {
#pragma unroll
                for (int jj = 0; jj < 4; ++jj) { const int tt = t - 3 + jj; float x[16];
                    if (tt >= 0) { const u32x4 a = *(const u32x4*)(PROJ + (size_t)(m - 3 + jj) * PJ + col0), bq = *(const u32x4*)(PROJ + (size_t)(m - 3 + jj) * PJ + col0 + 8);
                        x[0] = bflo(a.x); x[1] = bfhi(a.x); x[2] = bflo(a.y); x[3] = bfhi(a.y); x[4] = bflo(a.z); x[5] = bfhi(a.z); x[6] = bflo(a.w); x[7] = bfhi(a.w);
                        x[8] = bflo(bq.x); x[9] = bfhi(bq.x); x[10] = bflo(bq.y); x[11] = bfhi(bq.y); x[12] = bflo(bq.z); x[13] = bfhi(bq.z); x[14] = bflo(bq.w); x[15] = bfhi(bq.w); }
                    else if (grp) { const float* hp = c.in[I_SCONV] + (size_t)((l * 32 + b) * 3 + (3 + tt)) * QKV + col0;
#pragma unroll
                        for (int i = 0; i < 4; ++i) { const f32x4 a = *(const f32x4*)(hp + 4 * i); x[4 * i] = a.x; x[4 * i + 1] = a.y; x[4 * i + 2] = a.z; x[4 * i + 3] = a.w; } }
                    else {
#pragma unroll
                        for (int e = 0; e < 16; ++e) x[e] = 0.f; }
#pragma unroll
                    for (int i = 0; i < 4; ++i) { const f32x4 wv = *(const LAS f32x4*)(lds + L_CW + ((part * 4 + jj) * 128 + 16 * seg + 4 * i) * 4);
                        y[4 * i] += x[4 * i] * wv.x; y[4 * i + 1] += x[4 * i + 1] * wv.y; y[4 * i + 2] += x[4 * i + 2] * wv.z; y[4 * i + 3] += x[4 * i + 3] * wv.w; } }
                if (t >= T - 3) { const u32x4 a = *(const u32x4*)(PROJ + (size_t)m * PJ + col0), bq = *(const u32x4*)(PROJ + (size_t)m * PJ + col0 + 8);
                    float* dst = c.out + (grp ? O_SCONV : O_PCONV) + (size_t)((l * nb + b) * 3 + (t - (T - 3))) * QKV + col0;
                    *(f32x4*)(dst) = (f32x4){bflo(a.x), bfhi(a.x), bflo(a.y), bfhi(a.y)}; *(f32x4*)(dst + 4) = (f32x4){bflo(a.z), bfhi(a.z), bflo(a.w), bfhi(a.w)};
                    *(f32x4*)(dst + 8) = (f32x4){bflo(bq.x), bfhi(bq.x), bflo(bq.y), bfhi(bq.y)}; *(f32x4*)(dst + 12) = (f32x4){bflo(bq.z), bfhi(bq.z), bflo(bq.w), bfhi(bq.w)}; }
#pragma unroll
                for (int e = 0; e < 16; ++e) y[e] = y[e] * fast_sigmoid(y[e]);
            }
            if (part < 2) { float ss = 0.f;
#pragma unroll
                for (int e = 0; e < 16; ++e) ss += y[e] * y[e];
                ss += lane_get(ss, lane ^ 1); ss += lane_get(ss, lane ^ 2); ss += lane_get(ss, lane ^ 4);
                const float rn = rsqrtf(ss + EPS) * (part == 0 ? SCALE : 1.f);
#pragma unroll
                for (int e = 0; e < 16; ++e) y[e] *= rn;
                u32x4 p0, p1; p0.x = pk2(y[0], y[1]); p0.y = pk2(y[2], y[3]); p0.z = pk2(y[4], y[5]); p0.w = pk2(y[6], y[7]); p1.x = pk2(y[8], y[9]); p1.y = pk2(y[10], y[11]); p1.z = pk2(y[12], y[13]); p1.w = pk2(y[14], y[15]);
                const int dst = (part == 1 ? L_KN : L_QN) + r * 272 + seg * 32;
                *(LAS u32x4*)(lds + dst) = p0; *(LAS u32x4*)(lds + dst + 16) = p1; }
            if (part == 1) {
#pragma unroll
                for (int e = 0; e < 16; ++e) { const int col = 16 * seg + e;
                    *(LAS bf16_t*)(lds + L_KBT + col * 144 + (((r >> 3) ^ seg) << 4) + (r & 7) * 2) = (bf16_t)(pk2(bt * eg * y[e], 0.f) & 0xffffu);
                    *(LAS bf16_t*)(lds + L_KGT + col * 128 + (((pr >> 3) ^ seg) << 4) + (pr & 7) * 2) = (bf16_t)(pk2(egl * y[e], 0.f) & 0xffffu); } }
            else if (part == 0) {
#pragma unroll
                for (int q4 = 0; q4 < 4; ++q4) { u32x2 v2; v2.x = pk2(eg * y[4 * q4], eg * y[4 * q4 + 1]); v2.y = pk2(eg * y[4 * q4 + 2], eg * y[4 * q4 + 3]);
                    __builtin_nontemporal_store(v2, (u32x2*)(gb + GT_QG + r * 256 + (32 * (seg >> 1) + 8 * q4 + 4 * (seg & 1)) * 2)); } }
            else {
#pragma unroll
                for (int e = 0; e < 16; ++e) *(LAS bf16_t*)(lds + L_VBT + (16 * seg + e) * 144 + (((r >> 3) ^ seg) << 4) + (r & 7) * 2) = (bf16_t)(pk2(bt * y[e], 0.f) & 0xffffu); }
            __builtin_amdgcn_sched_barrier(0);
        }
        if (tid == 0) WS_PTR(float, WS_EGL)[tk] = expf(Gs[63]);
        { const int tkn = tk + grid_;
            if (tkn < NTASK && tid < 402) { int m0n, hn; if (tkn < NTASK_P) { const int bh = tkn >> 6; hn = bh % 12; m0n = (bh / 12) * 4096 + (tkn & 63) * 64; } else { const int bh = tkn - NTASK_P; hn = bh % 12; m0n = MP + (bh / 12) * 32; }
                const int row = tid / 6, rem = tid % 6; int mm = m0n - 3 + row; mm = mm < 0 ? 0 : (mm >= M ? M - 1 : mm);
                warm = *(const volatile unsigned*)(PROJ + (size_t)mm * PJ + (rem >> 1) * TOK + hn * HD + (rem & 1) * 64); } }
        LDS_BARRIER();
        { const int r32 = lane & 31, hi = lane >> 5;
            if (w < 6) { const int which = w / 3, tt3 = w % 3, ib = tt3 ? 1 : 0, jb = (tt3 == 2) ? 1 : 0; f32x16 acc = {};
                const int xoff = (which ? L_QN : L_KN) + (ib * 32 + r32) * 272 + hi * 16, koff = L_KN + (jb * 32 + r32) * 272 + hi * 16;
#pragma unroll
                for (int kk = 0; kk < 8; ++kk) { const bf16x8 a = *(const LAS bf16x8*)(lds + xoff + kk * 32), bq = *(const LAS bf16x8*)(lds + koff + kk * 32);
                    acc = __builtin_amdgcn_mfma_f32_32x32x16_bf16(a, bq, acc, 0, 0, 0); }
                const int j = jb * 32 + r32; const float gj = Gs[j]; const int pj = permpos(j);
#pragma unroll
                for (int rr = 0; rr < 16; ++rr) { const int i = ib * 32 + crow32(rr, hi); const float dec = expf(fminf(Gs[i] - gj, 0.f));
                    if (which == 0) As[i * 65 + j] = (i > j) ? Bs[i] * acc[rr] * dec : 0.f;
                    else *(LAS bf16_t*)(lds + L_ATP + i * 128 + pj * 2) = (bf16_t)(pk2((i >= j) ? acc[rr] * dec : 0.f, 0.f) & 0xffffu); } }
            else { const int j = 32 + r32;
#pragma unroll
                for (int rr = 0; rr < 16; ++rr) { const int i = crow32(rr, hi);
                    if (w == 6) As[i * 65 + j] = 0.f; else *(LAS bf16_t*)(lds + L_ATP + i * 128 + permpos(j) * 2) = (bf16_t)0; } } }
        LDS_BARRIER();
        if (w == 0) { const int blk = lane >> 5, col = lane & 31, r32 = col, hi = blk; float x[32];
            const LAS float* Asv = As + blk * (32 * 65 + 32); asm volatile("" : "+v"(Asv));
            LAS float* Td = (LAS float*)(lds + L_TD);
#pragma unroll
            for (int i = 0; i < 32; ++i) { float a = (col == i) ? 1.f : 0.f;
#pragma unroll
                for (int j = 0; j < i; ++j) a -= Asv[i * 65 + j] * x[j];
                x[i] = a; Td[blk * (32 * 33) + i * 33 + col] = a;
                *(LAS bf16_t*)(lds + L_TS + (blk * 32 + i) * 144 + (blk * 32 + col) * 2) = (bf16_t)(pk2(a, 0.f) & 0xffffu);
                if (blk) *(LAS bf16_t*)(lds + L_TS + i * 144 + (32 + col) * 2) = (bf16_t)0;
                if ((i & 7) == 7) __builtin_amdgcn_sched_barrier(0); }
            f32x16 acc = {};
#pragma unroll
            for (int s = 0; s < 16; ++s) acc = __builtin_amdgcn_mfma_f32_32x32x2f32(As[(32 + r32) * 65 + 2 * s + hi], Td[(2 * s + hi) * 33 + r32], acc, 0, 0, 0);
#pragma unroll
            for (int rr = 0; rr < 16; ++rr) Td[crow32(rr, hi) * 33 + r32] = acc[rr];
            f32x16 acc2 = {};
#pragma unroll
            for (int s = 0; s < 16; ++s) acc2 = __builtin_amdgcn_mfma_f32_32x32x2f32(Td[32 * 33 + r32 * 33 + 2 * s + hi], Td[(2 * s + hi) * 33 + r32], acc2, 0, 0, 0);
#pragma unroll
            for (int rr = 0; rr < 16; ++rr) *(LAS bf16_t*)(lds + L_TS + (32 + crow32(rr, hi)) * 144 + r32 * 2) = (bf16_t)(pk2(-acc2[rr], 0.f) & 0xffffu); }
        LDS_BARRIER();
        { const int r32 = lane & 31, hi = lane >> 5; const int src = (w < 4 ? L_VBT : L_KBT) + ((w & 3) * 32 + r32) * 144, sw = (((w & 3) * 32 + r32) >> 4) & 7;
#pragma unroll
            for (int ib = 0; ib < 2; ++ib) { f32x16 acc = {}; const int toff = L_TS + (ib * 32 + r32) * 144 + hi * 16;
#pragma unroll
                for (int kk = 0; kk < 4; ++kk) { if (kk < 2 * (ib + 1)) { const bf16x8 a = *(const LAS bf16x8*)(lds + toff + kk * 32), bq = *(const LAS bf16x8*)(lds + src + (((2 * kk + hi) ^ sw) << 4));
                        acc = __builtin_amdgcn_mfma_f32_32x32x16_bf16(a, bq, acc, 0, 0, 0); } }
                const int col = (w & 3) * 32 + r32;
                if (w < 4) {
#pragma unroll
                    for (int g = 0; g < 4; ++g) { u32x2 v2; v2.x = pk2(acc[4 * g], acc[4 * g + 1]); v2.y = pk2(acc[4 * g + 2], acc[4 * g + 3]);
                        *(LAS u32x2*)(lds + L_QN + col * 128 + (((4 * ib + g) ^ (col & 7)) << 4) + hi * 8) = v2; } }
                else { const int pc = permpos(col);
#pragma unroll
                    for (int rr = 0; rr < 16; ++rr) { const int i = ib * 32 + crow32(rr, hi); *(LAS bf16_t*)(lds + L_KN + i * 256 + pc * 2) = (bf16_t)(pk2(acc[rr], 0.f) & 0xffffu); } } } }
        LDS_BARRIER();
#pragma unroll
        for (int k = 0; k < 7; ++k) { const int u = tid + 512 * k; int lo, go;
            if (k < 2) { lo = L_KN + u * 16; go = GT_W + u * 16; } else if (k < 4) { const int uu = u - 1024, row = uu >> 3; lo = L_QN + row * 128 + (((uu & 7) ^ (row & 7)) << 4); go = GT_U + uu * 16; }
            else if (k < 6) { const int uu = u - 2048, row = uu >> 3; lo = L_KGT + row * 128 + (((uu & 7) ^ ((row >> 4) & 7)) << 4); go = GT_KG + uu * 16; } else { lo = L_ATP + (u - 3072) * 16; go = GT_AT + (u - 3072) * 16; }
            __builtin_nontemporal_store(*(const LAS u32x4*)(lds + lo), (u32x4*)(gb + go)); }
    }
}
constexpr int SC_W = 0, SC_QG = 17408, SC_KG = 34816, SC_AT = 53248, SC_BUF = 62464, SC_OS = 2 * SC_BUF;
__device__ __forceinline__ void ph_gdn_scan(CtxP cp, int l, LAS unsigned char* lds) {
    CTX_LOAD(cp);
    const int bid_ = obid(), grid_ = ogrid(); const int tid = otid(), lane = tid & 63, w = __builtin_amdgcn_readfirstlane(tid >> 6), m16 = lane & 15, q = lane >> 4;
    const float* EGL = WS_PTR(float, WS_EGL);
    const int nsmpwg = grid_ - 96;
    for (int it = 0;; ++it) {
        int grp, bh, half, nch, tk0;
        if (bid_ < 96) { if (it > 0) break; grp = 0; half = (bid_ >> 3) & 1; bh = (bid_ >> 4) * 8 + (bid_ & 7); nch = 64; tk0 = bh * 64; }
        else { const int si = (bid_ - 96) + nsmpwg * it; if (si >= 768) break; grp = 1; bh = si >> 1; half = si & 1; nch = 1; tk0 = NTASK_P + bh; }
        const int b = bh / 12, h = bh % 12, m0 = grp ? MP + b * 32 : b * 4096;
        __syncthreads();
        if (w >= 4) {
            const int lt = tid - 256; u32x4 stA[14], stB[14];
#define SC_LOAD(ST, tk) do { const unsigned char* gsrc = c.ws + WS_GDNBUF + (size_t)(tk) * GT_BYTES; _Pragma("unroll") for (int k = 0; k < 14; ++k) ST[k] = *(const u32x4*)(gsrc + (size_t)(lt + 256 * k) * 16); } while (0)
#define SC_WRITE(ST, bufoff) do { _Pragma("unroll") for (int k = 0; k < 14; ++k) { const int u = lt + 256 * k; int lo; \
            if (k < 4) lo = SC_W + (u >> 4) * 272 + (u & 15) * 16; else if (k < 8) lo = SC_QG + ((u - 1024) >> 4) * 272 + (u & 15) * 16; \
            else if (k < 12) lo = SC_KG + ((u - 2048) >> 3) * 144 + (u & 7) * 16; else lo = SC_AT + ((u - 3072) >> 3) * 144 + (u & 7) * 16; \
            *(LAS u32x4*)(lds + (bufoff) + lo) = ST[k]; } } while (0)
            bf16_t* Ob = WS_PTR(bf16_t, WS_OF) + (size_t)m0 * TOK + h * HD + half * 64; const int nou = grp ? 256 : 512;
#define SC_OUT(ch_) do { _Pragma("unroll") for (int k = 0; k < 2; ++k) { const int u = lt + 256 * k; if (u < nou) \
                *(u32x4*)(Ob + (size_t)((ch_) * 64 + (u >> 3)) * TOK + (u & 7) * 8) = *(const LAS u32x4*)(lds + SC_OS + ((ch_) & 1) * 8192 + u * 16); } } while (0)
            SC_LOAD(stA, tk0); SC_WRITE(stA, 0);
            if (1 < nch) SC_LOAD(stA, tk0 + 1);
            if (2 < nch) SC_LOAD(stB, tk0 + 2);
            LDS_BARRIER();
            for (int ch = 0; ch < nch; ch += 2) {
                if (ch >= 1) SC_OUT(ch - 1);
                if (ch + 1 < nch) SC_WRITE(stA, ((ch + 1) & 1) * SC_BUF);
                if (ch + 3 < nch) SC_LOAD(stA, tk0 + ch + 3);
                LDS_BARRIER();
                if (ch + 1 < nch) {
                    SC_OUT(ch);
                    if (ch + 2 < nch) SC_WRITE(stB, ((ch + 2) & 1) * SC_BUF);
                    if (ch + 4 < nch) SC_LOAD(stB, tk0 + ch + 4);
                    LDS_BARRIER(); }
            }
            SC_OUT(nch - 1);
#undef SC_OUT
#undef SC_LOAD
#undef SC_WRITE
        } else {
            __builtin_amdgcn_s_setprio(2);
            const int c0 = half * 64 + 16 * w;
            f32x4 S[8];
            if (grp) { const float* S0 = c.in[I_SGDN] + (size_t)((l * 32 + b) * 12 + h) * 16384;
#pragma unroll
                for (int dt = 0; dt < 8; ++dt)
#pragma unroll
                    for (int i = 0; i < 4; ++i) S[dt][i] = S0[(16 * dt + 4 * q + i) * 128 + c0 + m16]; }
            else {
#pragma unroll
                for (int dt = 0; dt < 8; ++dt) S[dt] = (f32x4){0.f, 0.f, 0.f, 0.f}; }
            u32x2 un[4]; float egn;
#define UE_LOAD(tk_) do { const unsigned char* ut_ = c.ws + WS_GDNBUF + (size_t)(tk_) * GT_BYTES + GT_U + (c0 + m16) * 128 + 8 * q; \
            _Pragma("unroll") for (int mt = 0; mt < 4; ++mt) un[mt] = *(const u32x2*)(ut_ + 32 * mt); egn = EGL[tk_]; } while (0)
            UE_LOAD(tk0);
            LDS_BARRIER();
            for (int ch = 0; ch < nch; ++ch) { const int bo = (ch & 1) * SC_BUF; const int tk = tk0 + ch;
                u32x2 uc[4]; const float egl = egn;
#pragma unroll
                for (int mt = 0; mt < 4; ++mt) uc[mt] = un[mt];
                if (ch + 1 < nch) UE_LOAD(tk + 1);
                bf16x8 Sb[4];
#pragma unroll
                for (int ks = 0; ks < 4; ++ks) { u32x4 t4; t4.x = pk2(S[2 * ks][0], S[2 * ks][1]); t4.y = pk2(S[2 * ks][2], S[2 * ks][3]); t4.z = pk2(S[2 * ks + 1][0], S[2 * ks + 1][1]); t4.w = pk2(S[2 * ks + 1][2], S[2 * ks + 1][3]);
                    Sb[ks] = __builtin_bit_cast(bf16x8, t4); }
                f32x4 Vn[4], Out[4];
#pragma unroll
                for (int mt = 0; mt < 4; ++mt) { f32x4 a1 = {0.f, 0.f, 0.f, 0.f}, a2 = {0.f, 0.f, 0.f, 0.f};
#pragma unroll
                    for (int ks = 0; ks < 4; ++ks) { const bf16x8 aw = *(const LAS bf16x8*)(lds + bo + SC_W + (16 * mt + m16) * 272 + ks * 64 + q * 16), aq = *(const LAS bf16x8*)(lds + bo + SC_QG + (16 * mt + m16) * 272 + ks * 64 + q * 16);
                        a1 = __builtin_amdgcn_mfma_f32_16x16x32_bf16(aw, Sb[ks], a1, 0, 0, 0); a2 = __builtin_amdgcn_mfma_f32_16x16x32_bf16(aq, Sb[ks], a2, 0, 0, 0); }
                    const u32x2 uu = uc[mt];
                    Vn[mt] = (f32x4){bflo(uu.x) - a1[0], bfhi(uu.x) - a1[1], bflo(uu.y) - a1[2], bfhi(uu.y) - a1[3]}; Out[mt] = a2; }
                bf16x8 Vb[2];
#pragma unroll
                for (int ks = 0; ks < 2; ++ks) { u32x4 t4; t4.x = pk2(Vn[2 * ks][0], Vn[2 * ks][1]); t4.y = pk2(Vn[2 * ks][2], Vn[2 * ks][3]); t4.z = pk2(Vn[2 * ks + 1][0], Vn[2 * ks + 1][1]); t4.w = pk2(Vn[2 * ks + 1][2], Vn[2 * ks + 1][3]);
                    Vb[ks] = __builtin_bit_cast(bf16x8, t4); }
#pragma unroll
                for (int mt = 0; mt < 4; ++mt)
#pragma unroll
                    for (int ks = 0; ks < 2; ++ks) { const bf16x8 aa = *(const LAS bf16x8*)(lds + bo + SC_AT + (16 * mt + m16) * 144 + ks * 64 + q * 16);
                        Out[mt] = __builtin_amdgcn_mfma_f32_16x16x32_bf16(aa, Vb[ks], Out[mt], 0, 0, 0); }
#pragma unroll
                for (int dt = 0; dt < 8; ++dt) { S[dt] = S[dt] * egl;
#pragma unroll
                    for (int ks = 0; ks < 2; ++ks) { const bf16x8 ak = *(const LAS bf16x8*)(lds + bo + SC_KG + (16 * dt + m16) * 144 + ks * 64 + q * 16);
                        S[dt] = __builtin_amdgcn_mfma_f32_16x16x32_bf16(ak, Vb[ks], S[dt], 0, 0, 0); } }
#pragma unroll
                for (int mt = 0; mt < 4; ++mt)
#pragma unroll
                    for (int e = 0; e < 4; ++e) *(LAS bf16_t*)(lds + SC_OS + (ch & 1) * 8192 + (16 * mt + 4 * q + e) * 128 + (16 * w + m16) * 2) = (bf16_t)(pk2(Out[mt][e], 0.f) & 0xffffu);
                LDS_BARRIER();
            }
            float* So = c.out + (grp ? O_SGDN + (size_t)((l * 32 + b) * 12 + h) * 16384 : O_PGDN + (size_t)((l * 4 + b) * 12 + h) * 16384);
#pragma unroll
            for (int dt = 0; dt < 8; ++dt)
#pragma unroll
                for (int i = 0; i < 4; ++i) So[(16 * dt + 4 * q + i) * 128 + c0 + m16] = S[dt][i];
            __builtin_amdgcn_s_setprio(0);
#undef UE_LOAD
        }
    }
}
#undef LDS_BARRIER
#define XB_TMO      128
#define XB_XCNT(j)  (256  + 64 * (j))
#define XB_XSUB(j)  (1280 + 64 * (j))
#define XB_XGEN(j)  (2304 + 64 * (j))
#define XB_TOP      3328
#define XB_TOPGEN   3392
#define XCD_BAR_WORDS 3456
#define XB_SPIN_CAP (1u << 18)

__device__ __forceinline__ unsigned xb_ld(unsigned* p)              { return __hip_atomic_load(p, __ATOMIC_RELAXED, __HIP_MEMORY_SCOPE_AGENT); }
__device__ __forceinline__ unsigned xb_add(unsigned* p, unsigned v) { return __hip_atomic_fetch_add(p, v, __ATOMIC_RELAXED, __HIP_MEMORY_SCOPE_AGENT); }
__device__ __forceinline__ unsigned xb_xcc_id() { return (unsigned)__builtin_amdgcn_s_getreg((3 << 11) | 20) & 0xFu; }
#define XB_SPIN(cond, bar) do { unsigned _sp = 0; while (cond) { __builtin_amdgcn_s_sleep(1); \
    if ((++_sp & 255u) == 0u) { if (xb_ld(&(bar)[XB_TMO])) break; if (_sp > XB_SPIN_CAP) { atomicAdd(&(bar)[XB_TMO], 1u); break; } } } } while (0)
struct XcdBarrier {
    unsigned* bar; unsigned x;
    volatile LAS unsigned* st;
};

__device__ __forceinline__ XcdBarrier xcd_barrier_post(unsigned* bar, volatile LAS unsigned* st) {
    XcdBarrier b; b.bar = bar; b.x = xb_xcc_id(); b.st = st;
    if (threadIdx.x == 0) (void)xb_add(&bar[XB_XCNT(b.x)], 1u);
    return b;
}
__device__ __forceinline__ void xcd_barrier_complete(unsigned* bar, unsigned x, unsigned& nloc, unsigned& nx) {
    const unsigned G = gridDim.x * gridDim.y * gridDim.z;
    unsigned sum, cnt, mine, sp = 0u;
    for (;;) {
        sum = 0u; cnt = 0u; mine = 0u;
#pragma unroll
        for (unsigned j = 0; j < 16; ++j) { const unsigned c = xb_ld(&bar[XB_XCNT(j)]); sum += c; cnt += (c > 0u) ? 1u : 0u; mine = (j == x) ? c : mine; }
        if (sum == G) break;
        __builtin_amdgcn_s_sleep(1);
        if ((++sp & 255u) == 0u) { if (xb_ld(&bar[XB_TMO])) break; if (sp > XB_SPIN_CAP) { atomicAdd(&bar[XB_TMO], 1u); break; } }
    }
    nloc = mine > 0u ? mine : 1u; nx = cnt > 0u ? cnt : 1u;
}

__device__ __forceinline__ void xcd_barrier(const XcdBarrier& b, const bool leader  ) {
    asm volatile("s_waitcnt vmcnt(0)" ::: "memory");
    __syncthreads();
    if (leader) {
        unsigned* bar = b.bar;
        __builtin_amdgcn_s_waitcnt(0);
        unsigned nloc = b.st[0], nx = b.st[1];
        if (nloc == 0u) { xcd_barrier_complete(bar, b.x, nloc, nx); b.st[0] = nloc; b.st[1] = nx; }
        const unsigned old = xb_add(&bar[XB_XSUB(b.x)], 1u);
        const unsigned gen = old / nloc;
        if (old + 1u == (gen + 1u) * nloc) {
            __builtin_amdgcn_fence(__ATOMIC_RELEASE, "agent");
            asm volatile("s_waitcnt vmcnt(0)" ::: "memory");
            const unsigned og = xb_add(&bar[XB_TOP], 1u);
            const unsigned tg = og / nx;
            if (og + 1u == (tg + 1u) * nx) xb_add(&bar[XB_TOPGEN], 1u);
            else XB_SPIN(xb_ld(&bar[XB_TOPGEN]) == tg, bar);
            __builtin_amdgcn_fence(__ATOMIC_ACQUIRE, "agent");
            xb_add(&bar[XB_XGEN(b.x)], 1u);
            asm volatile("s_waitcnt vmcnt(0)" ::: "memory");
        } else {
            XB_SPIN(xb_ld(&bar[XB_XGEN(b.x)]) == gen, bar);
            __builtin_amdgcn_fence(__ATOMIC_ACQUIRE, "agent");
            asm volatile("s_waitcnt vmcnt(0)" ::: "memory");
        }
    }
    __syncthreads();
}
namespace fa {
constexpr int NW = 8, QBLK = 32, KVBLK = 64, QB = NW * QBLK, HDm = 128;
constexpr int SHM_V = KVBLK * HDm * 2, SHM_K = KVBLK * HDm * 2;
constexpr int LDS_BYTES = 2 * SHM_V + 2 * SHM_K + NW * 64 * 4;
constexpr float THR = 8.f;
constexpr int XOFF = LDS_BYTES + 64, XBUF = 2048;
typedef short s16x4 __attribute__((ext_vector_type(4)));
#define KSWZ(row, colB) ((row) * 256 + ((colB) ^ (((row) & 7) << 4)))
#define SBAR() __builtin_amdgcn_sched_barrier(0)
__device__ __forceinline__ int v_st(int k, int c) { const int kk = (k & ~0xC) | ((k & 4) << 1) | ((k & 8) >> 1); return ((kk >> 3) * 4 + (c >> 5)) * 512 + ((kk & 7) * 32 + (c & 31)) * 2; }
__device__ __forceinline__ int v_rd_base(int lane) { return ((lane & 3) << 3) | (((lane >> 2) & 3) << 6) | (((lane >> 4) & 1) << 5) | (((lane >> 5) & 1) << 8); }
constexpr int v_rd_off(int d0, int ks, int half) { return d0 * 512 + ks * 4096 + half * 2048; }
__device__ __forceinline__ int crow(int r, int hi) { return (r & 3) + 8 * (r >> 2) + 4 * hi; }
__device__ __forceinline__ unsigned cvtpk(float lo, float hi) { unsigned r; asm volatile("v_cvt_pk_bf16_f32 %0, %1, %2" : "=v"(r) : "v"(lo), "v"(hi)); return r; }
__device__ __forceinline__ bf16x8 load8(const bf16_t* p) { return *reinterpret_cast<const bf16x8*>(p); }
__device__ __forceinline__ void mask_tile(f32x16& p0, f32x16& p1, int dq, unsigned W) {
    const float NEG = -__builtin_inff();
#pragma unroll
    for (int r = 0; r < 16; ++r) { const int c = (r & 3) + 8 * (r >> 2);
        if ((unsigned)(dq - c) >= W) p0[r] = NEG;
        if ((unsigned)(dq - c - 32) >= W) p1[r] = NEG; }
}
__device__ __forceinline__ void partialSM(f32x16& p0, f32x16& p1, float& m_reg, float& mn, float& alpha) {
    float pmax = p0[0]; for (int r = 1; r < 16; ++r) pmax = fmaxf(pmax, p0[r]); for (int r = 0; r < 16; ++r) pmax = fmaxf(pmax, p1[r]);
    { auto rr = __builtin_amdgcn_permlane32_swap(__float_as_uint(pmax), __float_as_uint(pmax), false, false);
      pmax = fmaxf(__uint_as_float(rr[0]), __uint_as_float(rr[1])); }
    constexpr float C2 = 1.4426950408889634f * SCALE;
    if (__builtin_expect(__all((pmax - m_reg) * SCALE <= THR), 1)) { mn = m_reg; alpha = 1.f; }
    else { mn = fmaxf(m_reg, pmax); alpha = __builtin_amdgcn_exp2f((m_reg - mn) * C2); m_reg = mn; }
    const float mnL = -mn * C2;
    for (int r = 0; r < 16; ++r) p0[r] = fmaf(p0[r], C2, mnL); for (int r = 0; r < 16; ++r) p1[r] = fmaf(p1[r], C2, mnL);
    for (int r = 0; r < 16; ++r) p0[r] = __builtin_amdgcn_exp2f(p0[r]);
}
__device__ __forceinline__ void finishSM(f32x16& p0, f32x16& p1, float alpha, float& l_reg, bf16x8& pa0, bf16x8& pa1, bf16x8& pa2, bf16x8& pa3) {
    for (int r = 0; r < 16; ++r) p1[r] = __builtin_amdgcn_exp2f(p1[r]);
    float ps = 0; for (int r = 0; r < 16; ++r) ps += p0[r]; for (int r = 0; r < 16; ++r) ps += p1[r];
    { auto rr = __builtin_amdgcn_permlane32_swap(__float_as_uint(ps), __float_as_uint(ps), false, false);
      ps = __uint_as_float(rr[0]) + __uint_as_float(rr[1]); }
    l_reg = l_reg * alpha + ps;
#define PK4(P, B_, OUT) do { unsigned a0 = cvtpk(P[B_+0], P[B_+1]), a1 = cvtpk(P[B_+2], P[B_+3]);                          \
        unsigned b0 = cvtpk(P[B_+4], P[B_+5]), b1 = cvtpk(P[B_+6], P[B_+7]);                                             \
        auto r0 = __builtin_amdgcn_permlane32_swap(a0, b0, false, false); auto r1 = __builtin_amdgcn_permlane32_swap(a1, b1, false, false); \
        u32x4 w = {r0[0], r1[0], r0[1], r1[1]}; OUT = *reinterpret_cast<bf16x8*>(&w); } while (0)
    PK4(p0, 0, pa0); PK4(p0, 8, pa1); PK4(p1, 0, pa2); PK4(p1, 8, pa3);
#undef PK4
}
template <int KB, bool BIAS>
__device__ __forceinline__ void qkt(f32x16& p0, f32x16& p1, const char* K_lds, const char* X_lds, int r32, int hi, const bf16x8* qr, bf16x8 qx) {
    p0 = f32x16{}; p1 = f32x16{};
    const char* kb[4];
#pragma unroll
    for (int dd = 0; dd < 4; ++dd) kb[dd] = K_lds + KB * SHM_K + KSWZ(r32, (dd * 16 + hi * 8) * 2);
    if (BIAS) { const bf16x8 kx0 = *reinterpret_cast<const bf16x8*>(X_lds + KB * XBUF + r32 * 32 + hi * 16), kx1 = *reinterpret_cast<const bf16x8*>(X_lds + KB * XBUF + (32 + r32) * 32 + hi * 16);
        p0 = __builtin_amdgcn_mfma_f32_32x32x16_bf16(kx0, qx, p0, 0, 0, 0); p1 = __builtin_amdgcn_mfma_f32_32x32x16_bf16(kx1, qx, p1, 0, 0, 0); }
#pragma unroll
    for (int d0 = 0; d0 < 8; ++d0) { const char* a = kb[d0 & 3] + (d0 >> 2) * 128;
        bf16x8 b0 = *reinterpret_cast<const bf16x8*>(a);
        bf16x8 b1 = *reinterpret_cast<const bf16x8*>(a + 32 * 256);
        p0 = __builtin_amdgcn_mfma_f32_32x32x16_bf16(b0, qr[d0], p0, 0, 0, 0);
        p1 = __builtin_amdgcn_mfma_f32_32x32x16_bf16(b1, qr[d0], p1, 0, 0, 0); }
}
template <int VB>
__device__ __forceinline__ void pv_tile(f32x16* o, int vb0, bf16x8 pa0, bf16x8 pa1, bf16x8 pa2, bf16x8 pa3) {
#define TRRD(dst, off) asm volatile("ds_read_b64_tr_b16 %0, %1 offset:%2" : "=&v"(dst) : "v"(vb0), "i"(off) : "memory")
#define PV_D0(d0) do { s16x4 l0, l1, l2, l3, h0, h1, h2, h3; constexpr int b_ = VB * SHM_V + v_rd_off(d0, 0, 0); \
        TRRD(l0, b_); TRRD(h0, b_ + 2048); TRRD(l1, b_ + 4096); TRRD(h1, b_ + 6144); TRRD(l2, b_ + 8192); TRRD(h2, b_ + 10240); TRRD(l3, b_ + 12288); TRRD(h3, b_ + 14336); \
        asm volatile("s_waitcnt lgkmcnt(0)" ::: "memory"); SBAR();   \
        o[d0] = __builtin_amdgcn_mfma_f32_32x32x16_bf16(pa0, (bf16x8){l0[0], l0[1], l0[2], l0[3], h0[0], h0[1], h0[2], h0[3]}, o[d0], 0, 0, 0);   \
        o[d0] = __builtin_amdgcn_mfma_f32_32x32x16_bf16(pa1, (bf16x8){l1[0], l1[1], l1[2], l1[3], h1[0], h1[1], h1[2], h1[3]}, o[d0], 0, 0, 0);   \
        o[d0] = __builtin_amdgcn_mfma_f32_32x32x16_bf16(pa2, (bf16x8){l2[0], l2[1], l2[2], l2[3], h2[0], h2[1], h2[2], h2[3]}, o[d0], 0, 0, 0);   \
        o[d0] = __builtin_amdgcn_mfma_f32_32x32x16_bf16(pa3, (bf16x8){l3[0], l3[1], l3[2], l3[3], h3[0], h3[1], h3[2], h3[3]}, o[d0], 0, 0, 0); } while (0)
    PV_D0(0); PV_D0(1); PV_D0(2); PV_D0(3);
#undef PV_D0
#undef TRRD
}
struct Ref { int a, b, c; };
struct Seam { bf16x8 qr[8]; bf16x8 qx; bf16x8 st_v0, st_v1, st_k0, st_k1, st_kx; };
__device__ __forceinline__ int swa_jlo(int P0, int W) { const int lowk = P0 - W + 1; return lowk > 0 ? lowk / KVBLK : 0; }
#define ROW(p, k0, rr) ((p) + (size_t)((k0) + (rr)) * KP + sc)
#define VMW() asm volatile("s_waitcnt vmcnt(0)" ::: "memory")
#define VMWN(n) asm volatile("s_waitcnt vmcnt(%0)" :: "i"(n) : "memory")
#define SLOAD_H(Kp, Vp, k0) do { S.st_v0 = load8(ROW(Vp, k0, sr)); S.st_v1 = load8(ROW(Vp, k0, 32 + sr)); S.st_k0 = load8(ROW(Kp, k0, sr)); S.st_k1 = load8(ROW(Kp, k0, 32 + sr)); } while (0)
#define LOADKX(KXp, k0) do { if (BIAS && tid < 64) S.st_kx = load8((KXp) + (size_t)((k0) + tid) * 8); } while (0)
#define SWRITE_HK(bf) do { *(bf16x8*)(K_lds + (bf) * SHM_K + kws) = S.st_k0; *(bf16x8*)(K_lds + (bf) * SHM_K + kws + 32 * 256) = S.st_k1; if (BIAS && tid < 64) *(bf16x8*)(lds + XOFF + (bf) * XBUF + tid * 32) = S.st_kx; } while (0)
#define SWRITE_HV(bf) do { *(bf16x8*)(V_lds + (bf) * SHM_V + vst0) = S.st_v0; *(bf16x8*)(V_lds + (bf) * SHM_V + vst1) = S.st_v1; } while (0)
#define SWRITE_H(bf) do { SWRITE_HV(bf); SWRITE_HK(bf); } while (0)
template <class Lay>
__device__ __forceinline__ void prime(unsigned char* wsb, const Ref& cur, int W, char* lds, Seam& S, int tid) {
    constexpr int QP = Lay::QP, KP = Lay::KP; constexpr bool BIAS = Lay::BIAS;
    const int wid = __builtin_amdgcn_readfirstlane(tid >> 6), lane = tid & 63, r32 = lane & 31, hi = lane >> 5;
    const int sr = tid >> 4, sc = (tid & 15) * 8, kws = KSWZ(sr, sc * 2); char* K_lds = lds + 2 * SHM_V;
    const int kb0 = swa_jlo(Lay::p0(cur), W) * KVBLK; const bf16_t* Qc = Lay::q(wsb, cur);
#pragma unroll
    for (int d0 = 0; d0 < 8; ++d0) S.qr[d0] = load8(Qc + (size_t)(wid * QBLK + r32) * QP + d0 * 16 + hi * 8);
    S.qx = bf16x8{}; S.st_kx = bf16x8{};
    if (BIAS && tid < 128) { unsigned zz = 0u; asm volatile("" : "+v"(zz)); *(u32x4*)(lds + XOFF + (tid >> 6) * XBUF + (tid & 63) * 32 + 16) = (u32x4){zz, zz, zz, zz}; }
    if (BIAS) S.qx = load8(hi ? Lay::z(wsb) : Lay::qx(wsb, cur) + (size_t)(wid * QBLK + r32) * 8);
    { const bf16_t* Kc = Lay::k(wsb, cur); const bf16_t* Vc = Lay::v(wsb, cur); SLOAD_H(Kc, Vc, kb0); LOADKX(Lay::kx(wsb, cur), kb0); } VMW(); SWRITE_HK(0);
    __syncthreads();
}
template <class Lay>
__device__ __forceinline__ void block(unsigned char* wsb, const Ref& cur, const Ref& nxt, int skv, int W, char* lds, Seam& S, int tid) {
    asm volatile("" : "+v"(tid));
    constexpr int QP = Lay::QP, KP = Lay::KP, OP = Lay::OP; constexpr bool BIAS = Lay::BIAS, GATE = Lay::GATE; const int P0c = Lay::p0(cur);
    const int wid = __builtin_amdgcn_readfirstlane(tid >> 6), lane = tid & 63, r32 = lane & 31, hi = lane >> 5;
    const int j_lo = swa_jlo(P0c, W);
    int j_hi = (P0c + QB - 1) / KVBLK + 1; if (j_hi > skv / KVBLK) j_hi = skv / KVBLK;
    const int NT = j_hi - j_lo;
    const int kbn = swa_jlo(Lay::p0(nxt), W) * KVBLK;
    const int qlo = P0c + wid * QBLK, qm = qlo + r32 - 4 * hi;
    char* V_lds = lds; char* K_lds = lds + 2 * SHM_V;
    float* ws = (float*)(lds + 2 * SHM_V + 2 * SHM_K) + wid * 64; float* li_l = ws, * al_l = ws + 32;
    float m_reg = -1e30f, l_reg = 0; f32x16 o[4] = {};
    const int sr = tid >> 4, sc = (tid & 15) * 8, vst0 = v_st(sr, sc), vst1 = v_st(32 + sr, sc), kws = KSWZ(sr, sc * 2);
    const int vb0 = (int)(uintptr_t)V_lds + v_rd_base(lane);
    const bf16_t* Kh = Lay::k(wsb, cur); const bf16_t* Vh = Lay::v(wsb, cur); const bf16_t* KXh = Lay::kx(wsb, cur);
    const char* X_lds = lds + XOFF;
#define RESC(a) do { if (__any((a) < 1.f)) { if (hi == 0) al_l[r32] = (a); asm volatile("s_waitcnt lgkmcnt(0)" ::: "memory");              \
                     for (int d_ = 0; d_ < 4; ++d_) for (int r = 0; r < 16; ++r) o[d_][r] *= al_l[crow(r, hi)]; } } while (0)
#define KBASE(t) ((j_lo + (t)) * KVBLK)
#define MASKT(P0_, P1_, t) do { const int kb_ = KBASE(t); if (kb_ + KVBLK - 1 > qlo || kb_ <= qlo + QBLK - 1 - W) mask_tile(P0_, P1_, qm - kb_, (unsigned)W); } while (0)
    constexpr int NQL = BIAS ? 9 : 8;
#define SEAM_K0() do { VMWN(NQL); SWRITE_HK(0); SBAR(); } while (0)
    f32x16 pA0, pA1, pB0, pB1; float mnA, mnB, alA, alB; bf16x8 pa0, pa1, pa2, pa3;
    SWRITE_HV(0); SBAR();
    if (NT > 1) { SLOAD_H(Kh, Vh, KBASE(1)); LOADKX(KXh, KBASE(1)); }
    SBAR(); qkt<0, BIAS>(pA0, pA1, K_lds, X_lds, r32, hi, S.qr, S.qx);
    MASKT(pA0, pA1, 0); partialSM(pA0, pA1, m_reg, mnA, alA);
    if (NT > 1) { VMW(); SWRITE_H(1); }
    __syncthreads();
#define HALF_STEP(PX0, PX1, mnX, alX, PY0, PY1, alY, t, KB, VB, SB) do {                                                      \
        SBAR(); qkt<KB, BIAS>(PX0, PX1, K_lds, X_lds, r32, hi, S.qr, S.qx);                                             \
        finishSM(PY0, PY1, alY, l_reg, pa0, pa1, pa2, pa3); SBAR();                                                           \
        if ((t) + 1 < NT) { SLOAD_H(Kh, Vh, KBASE((t) + 1)); LOADKX(KXh, KBASE((t) + 1)); SBAR(); }               \
        pv_tile<VB>(o, vb0, pa0, pa1, pa2, pa3); MASKT(PX0, PX1, (t)); partialSM(PX0, PX1, m_reg, mnX, alX);                  \
        __syncthreads();                                                                                                      \
        if ((t) + 1 < NT) { VMW(); SWRITE_H(SB); }                                                                            \
        RESC(alX); __syncthreads(); } while (0)
    for (int t = 1; t + 1 < NT; t += 2) {
        HALF_STEP(pB0, pB1, mnB, alB, pA0, pA1, alA, t, 1, 0, 0);
        HALF_STEP(pA0, pA1, mnA, alA, pB0, pB1, alB, t + 1, 0, 1, 1);
    }
    const bool even = (NT & 1) == 0;
    if (even) { SBAR(); qkt<1, BIAS>(pB0, pB1, K_lds, X_lds, r32, hi, S.qr, S.qx); SBAR(); }
    { const bf16_t* Kn = Lay::k(wsb, nxt); const bf16_t* Vn = Lay::v(wsb, nxt); SLOAD_H(Kn, Vn, kbn); LOADKX(Lay::kx(wsb, nxt), kbn); } SBAR();
    { const bf16_t* Qn = Lay::q(wsb, nxt);
#pragma unroll
    for (int d0 = 0; d0 < 8; ++d0) S.qr[d0] = load8(Qn + (size_t)(wid * QBLK + r32) * QP + d0 * 16 + hi * 8); }
    if (BIAS) S.qx = load8(hi ? Lay::z(wsb) : Lay::qx(wsb, nxt) + (size_t)(wid * QBLK + r32) * 8);
    SBAR();
    finishSM(pA0, pA1, alA, l_reg, pa0, pa1, pa2, pa3); SBAR();
    pv_tile<0>(o, vb0, pa0, pa1, pa2, pa3);
    if (even) { MASKT(pB0, pB1, NT - 1); partialSM(pB0, pB1, m_reg, mnB, alB); __syncthreads(); RESC(alB);
        finishSM(pB0, pB1, alB, l_reg, pa0, pa1, pa2, pa3); SBAR(); pv_tile<1>(o, vb0, pa0, pa1, pa2, pa3); }
    SBAR(); SEAM_K0();
    if (hi == 0) li_l[r32] = l_reg; asm volatile("s_waitcnt lgkmcnt(0)" ::: "memory");
    float rli[16];
#pragma unroll
    for (int r = 0; r < 16; ++r) rli[r] = __builtin_amdgcn_rcpf(li_l[crow(r, hi)]);
    bf16_t* Ow = Lay::o(wsb, cur) + (size_t)(wid * QBLK) * OP; const bf16_t* Gw = Lay::g(wsb, cur) + (size_t)(wid * QBLK) * QP;
#pragma unroll
    for (int r = 0; r < 16; ++r) { const int orow = crow(r, hi);
#pragma unroll
        for (int d0 = 0; d0 < 4; ++d0) { const float v = o[d0][r] * rli[r];
            const float vn = lane_get(v, lane ^ 1);
            if ((r32 & 1) == 0) { float a = v, b = vn;
                if (GATE) { const unsigned gu = *(const unsigned*)(Gw + (size_t)orow * QP + d0 * 32 + r32); a *= fast_sigmoid(bflo(gu)); b *= fast_sigmoid(bfhi(gu)); }
                *(unsigned*)(Ow + (size_t)orow * OP + d0 * 32 + r32) = cvtpk(a, b); } } }
    __syncthreads();
#undef RESC
#undef KBASE
#undef MASKT
#undef SEAM_K0
#undef HALF_STEP
}
#undef ROW
#undef VMW
#undef VMWN
#undef SLOAD_H
#undef LOADKX
#undef SWRITE_HK
#undef SWRITE_HV
#undef SWRITE_H
#undef KSWZ
#undef SBAR
}
struct LayFox {
    static constexpr int QP = PJ, KP = TOK, OP = D; static constexpr bool BIAS = true, GATE = false;
    static __device__ __forceinline__ size_t row0(const fa::Ref& r) { return (size_t)(r.a / 12) * 4096 + r.b * 256; }
    static __device__ __forceinline__ int p0(const fa::Ref& r) { return r.b * 256; }
    static __device__ __forceinline__ const bf16_t* q(unsigned char* ws, const fa::Ref& r) { return (const bf16_t*)(ws + WS_PROJ) + row0(r) * PJ + (r.a % 12) * HD; }
    static __device__ __forceinline__ const bf16_t* g(unsigned char* ws, const fa::Ref& r) { return q(ws, r) + TOK; }
    static __device__ __forceinline__ const bf16_t* k(unsigned char* ws, const fa::Ref& r) { return (const bf16_t*)(ws + WS_KB) + (size_t)(r.a / 12) * 4096 * TOK + (r.a % 12) * HD; }
    static __device__ __forceinline__ const bf16_t* v(unsigned char* ws, const fa::Ref& r) { return (const bf16_t*)(ws + WS_VB) + (size_t)(r.a / 12) * 4096 * TOK + (r.a % 12) * HD; }
    static __device__ __forceinline__ bf16_t* o(unsigned char* ws, const fa::Ref& r) { return (bf16_t*)(ws + WS_ACT) + row0(r) * D + (r.a % 12) * HD; }
    static __device__ __forceinline__ const bf16_t* qx(unsigned char* ws, const fa::Ref& r) { return (const bf16_t*)(ws + WS_QX) + ((size_t)r.a * 4096 + r.b * 256) * 8; }
    static __device__ __forceinline__ const bf16_t* kx(unsigned char* ws, const fa::Ref& r) { return (const bf16_t*)(ws + WS_KX) + (size_t)r.a * 4096 * 8; }
    static __device__ __forceinline__ const bf16_t* z(unsigned char* ws) { return (const bf16_t*)(ws + WS_CTL + CTL_ZROW); }
};
__device__ __forceinline__ void fox_gate_block(unsigned char* ws, const fa::Ref& r, int tid) {
    asm volatile("s_waitcnt vmcnt(0)" ::: "memory"); __syncthreads();
    asm volatile("" : "+v"(tid));
    bf16_t* O = LayFox::o(ws, r); const bf16_t* G = LayFox::g(ws, r);
#pragma unroll
    for (int k = 0; k < 8; ++k) { const int u = tid + 512 * k, row = u >> 4, cu = (u & 15) * 8;
        const u32x4 ov = *(const u32x4*)(O + (size_t)row * D + cu), gv = __builtin_nontemporal_load((const u32x4*)(G + (size_t)row * PJ + cu)); u32x4 w;
        w.x = pk2(bflo(ov.x) * fast_sigmoid(bflo(gv.x)), bfhi(ov.x) * fast_sigmoid(bfhi(gv.x))); w.y = pk2(bflo(ov.y) * fast_sigmoid(bflo(gv.y)), bfhi(ov.y) * fast_sigmoid(bfhi(gv.y)));
        w.z = pk2(bflo(ov.z) * fast_sigmoid(bflo(gv.z)), bfhi(ov.z) * fast_sigmoid(bfhi(gv.z))); w.w = pk2(bflo(ov.w) * fast_sigmoid(bflo(gv.w)), bfhi(ov.w) * fast_sigmoid(bfhi(gv.w)));
        *(u32x4*)(O + (size_t)row * D + cu) = w; }
}
__device__ __forceinline__ void ph_fox_prompt(CtxP cp, int l, char* ldsg, LAS unsigned char* lds) {
    CTX_LOAD(cp);
    const int tid = otid();
    unsigned* qheads = (unsigned*)(c.ws + WS_CTL + CTL_QFOX) + 64 * 8 * l;
    LAS int* slot = (LAS int*)(lds + fa::LDS_BYTES);
    if (tid == 0) { slot[2] = (int)(xb_xcc_id() & 7u); slot[3] = 8; }
#define FOX_FETCH(dst, k) do { if (tid == 0) { int r_ = -1, myq_ = slot[2], qleft_ = slot[3]; while (qleft_ > 0) { const int i_ = (int)__hip_atomic_fetch_add(qheads + 64 * myq_, 1u, __ATOMIC_RELAXED, __HIP_MEMORY_SCOPE_AGENT); \
                if (i_ < 96) { r_ = ((i_ % 6) * 8 + myq_) * 16 + (15 - i_ / 6); break; } myq_ = (myq_ + 1) & 7; --qleft_; } slot[k] = r_; slot[2] = myq_; slot[3] = qleft_; } \
            __syncthreads(); dst = __builtin_amdgcn_readfirstlane(slot[k]); } while (0)
    int idx; FOX_FETCH(idx, 0);
    if (idx >= 0) {
        fa::Ref cur{idx >> 4, idx & 15, 0}, nxt; fa::Seam S;
        fa::prime<LayFox>(c.ws, cur, 1 << 29, ldsg, S, tid);
        for (int k = 1;; k ^= 1) {
            int nidx; FOX_FETCH(nidx, k);
            const bool more = nidx >= 0;
            if (more) nxt = fa::Ref{nidx >> 4, nidx & 15, 0}; else nxt = cur;
            fa::block<LayFox>(c.ws, cur, nxt, 4096, 1 << 29, ldsg, S, tid);
            fox_gate_block(c.ws, cur, tid);
            if (!more) break;
            cur = nxt;
        }
    }
#undef FOX_FETCH
}
struct LayMem {
    static constexpr int QP = PJ, KP = 4096, OP = D; static constexpr bool BIAS = false, GATE = false;
    static __device__ __forceinline__ size_t row0(const fa::Ref& r) { return (size_t)(r.a >> 2) * 4096 + r.b * 256; }
    static __device__ __forceinline__ int p0(const fa::Ref&) { return 256; }
    static __device__ __forceinline__ const bf16_t* q(unsigned char* ws, const fa::Ref& r) { return (const bf16_t*)(ws + WS_PROJ) + row0(r) * PJ + (r.c < 2 ? 6144 : 3072) + (r.a & 3) * HD; }
    static __device__ __forceinline__ const bf16_t* g(unsigned char* ws, const fa::Ref& r) { return q(ws, r); }
    static __device__ __forceinline__ const bf16_t* k(unsigned char* ws, const fa::Ref& r) { return (const bf16_t*)(ws + WS_MEMKVB) + (size_t)(r.a >> 2) * 256 * 4096 + r.c * 1024 + (r.a & 3) * HD; }
    static __device__ __forceinline__ const bf16_t* v(unsigned char* ws, const fa::Ref& r) { return k(ws, r) + 512; }
    static __device__ __forceinline__ bf16_t* o(unsigned char* ws, const fa::Ref& r) { return (bf16_t*)(ws + WS_ACT) + row0(r) * D + TOK + (r.a & 3) * HD; }
    static __device__ __forceinline__ const bf16_t* qx(unsigned char* ws, const fa::Ref& r) { return nullptr; }
    static __device__ __forceinline__ const bf16_t* kx(unsigned char* ws, const fa::Ref& r) { return nullptr; }
    static __device__ __forceinline__ const bf16_t* z(unsigned char* ws) { return nullptr; }
};
__device__ __forceinline__ void ph_mem_prompt(CtxP cp, int l, char* ldsg, int wg0, int nwg) {
    CTX_LOAD(cp);
    const int tid = otid(), bid_ = obid() - wg0, grid_ = nwg;
    int idx = bid_;
    if (idx >= 0 && idx < 256) {
        fa::Ref cur{idx >> 4, idx & 15, l}, nxt; fa::Seam S;
        fa::prime<LayMem>(c.ws, cur, 1 << 29, ldsg, S, tid);
        for (;;) {
            const int nidx = idx + grid_; const bool more = nidx < 256;
            if (more) nxt = fa::Ref{nidx >> 4, nidx & 15, l}; else nxt = cur;
            fa::block<LayMem>(c.ws, cur, nxt, 256, 1 << 29, ldsg, S, tid);
            if (!more) break;
            cur = nxt; idx = nidx;
        }
    }
}
constexpr int SF_REG = 16384, SF_AUX = 8 * SF_REG, SF_Q = SF_AUX + 8 * 512, SF_LDS = SF_Q + 32 * 272;
template <bool FOX>
__device__ __forceinline__ void ph_attn_sample(CtxP cp, int l, LAS unsigned char* lds, int wg0, int nwg) {
    CTX_LOAD(cp);
    const int bid_ = obid() - wg0, grid_ = nwg; const int tid0 = otid();
    if (bid_ < 0) return;
    constexpr int NH = FOX ? 12 : 4, NTASKS = 32 * NH, NTILE = FOX ? 65 : 8, KP = FOX ? TOK : MEMD, NPAST = FOX ? PAST : NMEM;
    constexpr float LOG2E = 1.4426950408889634f, C2 = LOG2E * SCALE;
    for (int task = bid_; task < NTASKS; task += grid_) {
        int tid = tid0; asm volatile("" : "+v"(tid));
        const int lane = tid & 63, w = __builtin_amdgcn_readfirstlane(tid >> 6), r32 = lane & 31, hi = lane >> 5;
        const int b = task / NH, h = task % NH;
        LAS unsigned char* T = lds + w * SF_REG; LAS float* aux = (LAS float*)(lds + SF_AUX + w * 512);
        const float* CUM = WS_PTR(float, WS_CUMS) + (size_t)b * (PAST + 32) * 12 + h;
        const float* Kc = (FOX ? c.in[I_CK] : c.in[I_CMK] + (size_t)l * 32 * NMEM * MEMD) + (size_t)b * NPAST * KP + h * HD; const float* Vc = (FOX ? c.in[I_CV] : c.in[I_CMV] + (size_t)l * 32 * NMEM * MEMD) + (size_t)b * NPAST * KP + h * HD;
        const int qcol = FOX ? h * HD : ((l < 2) ? 6144 : 3072) + h * HD, ocol = FOX ? h * HD : TOK + h * HD;
        float cq2 = 0.f; if (FOX) cq2 = CUM[(size_t)(PAST + r32) * 12] * LOG2E;
        float m_run = -1e30f, l_run = 0.f; f32x16 o[4] = {};
        f32x4 st[16];
        const int lrow = lane >> 5, lcol = (lane & 31) * 4;
        const unsigned voff = (unsigned)(lrow * KP + lcol) * 4u;
#define SF_LOAD(P, j0) do { const char* p_ = (const char*)((P) + (size_t)(j0) * KP);     \
        _Pragma("unroll") for (int i = 0; i < 16; ++i) st[i] = __builtin_nontemporal_load((const f32x4*)(p_ + (size_t)(2 * i) * KP * 4 + voff)); } while (0)
        __syncthreads();
        *(LAS u32x4*)(lds + SF_Q + (tid >> 4) * 272 + (tid & 15) * 16) = *(const u32x4*)(WS_PTR(bf16_t, WS_PROJ) + (size_t)(MP + b * 32 + (tid >> 4)) * PJ + qcol + (tid & 15) * 8);
        int t = w; SF_LOAD(Kc, 32 * t);
        __syncthreads();
        for (; t < NTILE; t += 8) { const bool isnew = FOX && (t == 64); const int j0 = 32 * t;
            if (!isnew) {
#pragma unroll
                for (int i = 0; i < 16; ++i) { u32x2 v2; v2.x = pk2(st[i].x, st[i].y); v2.y = pk2(st[i].z, st[i].w); *(LAS u32x2*)(T + (2 * i + lrow) * 272 + lcol * 2) = v2; }
                SF_LOAD(Vc, j0); }
            else { const char* kp = (const char*)(WS_PTR(bf16_t, WS_KB) + (size_t)(MP + b * 32) * TOK + h * HD);
                int ln = lane; asm volatile("" : "+v"(ln)); const int rw0 = ln >> 4, cc = (ln & 15) * 8; const unsigned vo = (unsigned)(rw0 * TOK + cc) * 2u;
#pragma unroll
                for (int i = 0; i < 8; ++i) *(LAS u32x4*)(T + (4 * i + rw0) * 272 + cc * 2) = *(const u32x4*)(kp + (size_t)(4 * i) * TOK * 2 + vo); }
            if (lane < 32) aux[lane] = FOX ? CUM[(size_t)(j0 + lane) * 12] * LOG2E : 0.f;
            f32x16 p = {};
#pragma unroll
            for (int d0 = 0; d0 < 8; ++d0) p = __builtin_amdgcn_mfma_f32_32x32x16_bf16(*(const LAS bf16x8*)(T + r32 * 272 + d0 * 32 + hi * 16), *(const LAS bf16x8*)(lds + SF_Q + r32 * 272 + d0 * 32 + hi * 16), p, 0, 0, 0);
            float pmax = -__builtin_inff();
#pragma unroll
            for (int g = 0; g < 4; ++g) { const f32x4 ck = *(const LAS f32x4*)(aux + 8 * g + 4 * hi);
#pragma unroll
                for (int e = 0; e < 4; ++e) { const int rr = 4 * g + e; float s = fmaf(p[rr], C2, cq2 - ck[e]);
                    if (isnew && (8 * g + 4 * hi + e) > r32) s = -__builtin_inff();
                    p[rr] = s; pmax = fmaxf(pmax, s); } }
            pmax = fmaxf(pmax, lane_get(pmax, lane ^ 32));
            const float mn = fmaxf(m_run, pmax), alpha = __builtin_amdgcn_exp2f(m_run - mn); m_run = mn;
            float ps = 0.f;
#pragma unroll
            for (int rr = 0; rr < 16; ++rr) { p[rr] = __builtin_amdgcn_exp2f(p[rr] - mn); ps += p[rr]; }
            ps += lane_get(ps, lane ^ 32); l_run = l_run * alpha + ps;
            bf16x8 pa0, pa1;
#define PK4(P, B_, OUT) do { unsigned a0 = pk2(P[B_+0], P[B_+1]), a1 = pk2(P[B_+2], P[B_+3]); unsigned b0 = pk2(P[B_+4], P[B_+5]), b1 = pk2(P[B_+6], P[B_+7]); \
            auto r0 = __builtin_amdgcn_permlane32_swap(a0, b0, false, false); auto r1 = __builtin_amdgcn_permlane32_swap(a1, b1, false, false); \
            u32x4 w4 = {r0[0], r1[0], r0[1], r1[1]}; OUT = __builtin_bit_cast(bf16x8, w4); } while (0)
            PK4(p, 0, pa0); PK4(p, 8, pa1);
#undef PK4
            if (hi == 0) aux[32 + r32] = alpha;
            if (!isnew) {
#pragma unroll
                for (int i = 0; i < 16; ++i) { const int key = 2 * i + lrow;
                    *(LAS bf16_t*)(T + (lcol + 0) * 80 + key * 2) = (bf16_t)(pk2(st[i].x, 0.f) & 0xffffu); *(LAS bf16_t*)(T + (lcol + 1) * 80 + key * 2) = (bf16_t)(pk2(st[i].y, 0.f) & 0xffffu);
                    *(LAS bf16_t*)(T + (lcol + 2) * 80 + key * 2) = (bf16_t)(pk2(st[i].z, 0.f) & 0xffffu); *(LAS bf16_t*)(T + (lcol + 3) * 80 + key * 2) = (bf16_t)(pk2(st[i].w, 0.f) & 0xffffu); }
                if (FOX && t + 8 < 64) SF_LOAD(Kc, j0 + 256); }
            else { const char* vp = (const char*)(WS_PTR(bf16_t, WS_VB) + (size_t)(MP + b * 32) * TOK + h * HD);
                int ln = lane; asm volatile("" : "+v"(ln)); const int rw0 = ln >> 4, cc = (ln & 15) * 8; const unsigned vo = (unsigned)(rw0 * TOK + cc) * 2u;
#pragma unroll
                for (int i = 0; i < 8; ++i) { const int rw = 4 * i + rw0; const u32x4 v4 = *(const u32x4*)(vp + (size_t)(4 * i) * TOK * 2 + vo);
                    *(LAS bf16_t*)(T + (cc + 0) * 80 + rw * 2) = (bf16_t)(v4.x & 0xffffu); *(LAS bf16_t*)(T + (cc + 1) * 80 + rw * 2) = (bf16_t)(v4.x >> 16);
                    *(LAS bf16_t*)(T + (cc + 2) * 80 + rw * 2) = (bf16_t)(v4.y & 0xffffu); *(LAS bf16_t*)(T + (cc + 3) * 80 + rw * 2) = (bf16_t)(v4.y >> 16);
                    *(LAS bf16_t*)(T + (cc + 4) * 80 + rw * 2) = (bf16_t)(v4.z & 0xffffu); *(LAS bf16_t*)(T + (cc + 5) * 80 + rw * 2) = (bf16_t)(v4.z >> 16);
                    *(LAS bf16_t*)(T + (cc + 6) * 80 + rw * 2) = (bf16_t)(v4.w & 0xffffu); *(LAS bf16_t*)(T + (cc + 7) * 80 + rw * 2) = (bf16_t)(v4.w >> 16); } }
            if (__any(alpha < 1.f)) {
#pragma unroll
                for (int g = 0; g < 4; ++g) { const f32x4 al = *(const LAS f32x4*)(aux + 32 + 8 * g + 4 * hi);
#pragma unroll
                    for (int e = 0; e < 4; ++e)
#pragma unroll
                        for (int db = 0; db < 4; ++db) o[db][4 * g + e] *= al[e]; } }
#pragma unroll
            for (int db = 0; db < 4; ++db) {
                o[db] = __builtin_amdgcn_mfma_f32_32x32x16_bf16(pa0, *(const LAS bf16x8*)(T + (db * 32 + r32) * 80 + hi * 16), o[db], 0, 0, 0);
                o[db] = __builtin_amdgcn_mfma_f32_32x32x16_bf16(pa1, *(const LAS bf16x8*)(T + (db * 32 + r32) * 80 + 32 + hi * 16), o[db], 0, 0, 0); }
        }
        asm volatile("s_waitcnt lgkmcnt(0)" ::: "memory");
#pragma unroll
        for (int db = 0; db < 4; ++db)
#pragma unroll
            for (int rr = 0; rr < 16; ++rr) *(LAS float*)(T + crow32(rr, hi) * 512 + (db * 32 + r32) * 4) = o[db][rr];
        if (hi == 0) { aux[64 + r32] = m_run; aux[96 + r32] = l_run; }
        __syncthreads();
        { const int qy = tid >> 4, d0 = (tid & 15) * 8; float M = -1e30f;
#pragma unroll
            for (int ww = 0; ww < 8; ++ww) M = fmaxf(M, *(const LAS float*)(lds + SF_AUX + ww * 512 + (64 + qy) * 4));
            float num[8] = {0.f, 0.f, 0.f, 0.f, 0.f, 0.f, 0.f, 0.f}, den = 0.f;
#pragma unroll
            for (int ww = 0; ww < 8; ++ww) { const float e = __builtin_amdgcn_exp2f(*(const LAS float*)(lds + SF_AUX + ww * 512 + (64 + qy) * 4) - M); den += e * *(const LAS float*)(lds + SF_AUX + ww * 512 + (96 + qy) * 4);
                const f32x4 a = *(const LAS f32x4*)(lds + ww * SF_REG + qy * 512 + d0 * 4), bq = *(const LAS f32x4*)(lds + ww * SF_REG + qy * 512 + d0 * 4 + 16);
                num[0] += e * a.x; num[1] += e * a.y; num[2] += e * a.z; num[3] += e * a.w; num[4] += e * bq.x; num[5] += e * bq.y; num[6] += e * bq.z; num[7] += e * bq.w; }
            const float inv = 1.f / den; const size_t row = (size_t)(MP + b * 32 + qy);
            u32x4 gv = {0x7f007f00u, 0x7f007f00u, 0x7f007f00u, 0x7f007f00u};
            if (FOX) gv = *(const u32x4*)(WS_PTR(bf16_t, WS_PROJ) + row * PJ + TOK + h * HD + d0);
            u32x4 ov;
            ov.x = pk2(num[0] * inv * fast_sigmoid(bflo(gv.x)), num[1] * inv * fast_sigmoid(bfhi(gv.x))); ov.y = pk2(num[2] * inv * fast_sigmoid(bflo(gv.y)), num[3] * inv * fast_sigmoid(bfhi(gv.y)));
            ov.z = pk2(num[4] * inv * fast_sigmoid(bflo(gv.z)), num[5] * inv * fast_sigmoid(bfhi(gv.z))); ov.w = pk2(num[6] * inv * fast_sigmoid(bflo(gv.w)), num[7] * inv * fast_sigmoid(bfhi(gv.w)));
            *(u32x4*)(WS_PTR(bf16_t, WS_ACT) + row * D + ocol + d0) = ov; }
#undef SF_LOAD
    }
}
constexpr int GEMM_LDS = pg8::STAGE_BYTES;
constexpr int LDS_BAR = 147456 - 256, LDS_BYTES = 147456;
static_assert(SF_LDS <= LDS_BAR && GEMM_LDS <= LDS_BAR, "LDS map");
constexpr size_t CTL_ZERO_BYTES = 65536;
__device__ __forceinline__ void ph_gemm(CtxP cp, int which, int l, LAS unsigned char* lds) {
    CTX_LOAD(cp);
    const bf16_t* A = WS_PTR(bf16_t, WS_XN); const bf16_t* Bt; int Mg = M, N, K = D, mode; bf16_t* o16 = nullptr; int ld16 = 0; float* o32 = nullptr; int ld32 = 0;
    if (which == 0) { A = WS_PTR(bf16_t, WS_MEMN); Bt = WS_PTR(bf16_t, WS_WMEM); Mg = 1024; N = 4096; mode = 4; }
    else if (which == 1) { Bt = (l < 2) ? WS_PTR(bf16_t, WS_WINA) + (size_t)l * 6656 * D : (l == 2 ? WS_PTR(bf16_t, WS_WINB0) : WS_PTR(bf16_t, WS_WINB1)); N = (l == 3) ? 3584 : 6656;
        mode = (l == 2) ? 3 : 0; o16 = WS_PTR(bf16_t, WS_PROJ); ld16 = PJ; }
    else if (which == 2) { A = WS_PTR(bf16_t, WS_ACT); Bt = WS_PTR(bf16_t, WS_WO) + (size_t)l * D * D; N = D; mode = 2; o16 = WS_PTR(bf16_t, WS_DELTA); ld16 = D; }
    else if (which == 3) { Bt = WS_PTR(bf16_t, WS_WUP) + (size_t)l * DFF * D; N = DFF; mode = 1; o16 = WS_PTR(bf16_t, WS_UP); ld16 = DFF; }
    else { A = WS_PTR(bf16_t, WS_UP); Bt = WS_PTR(bf16_t, WS_WDN) + (size_t)l * D * DFF; N = D; K = DFF; mode = 2; o16 = WS_PTR(bf16_t, WS_DELTA); ld16 = D; }
    const pg8::Gemm g{A, Bt, Mg, N, K};
    const pg8::Epi E{mode, o16, ld16, o32, ld32, c.ws, c.out, K / pg8::BK, (which == 1) ? (l < 2 ? 4608 : 0) : -1};
    pg8::TailSplit S; if (which == 0) S.init(g.M, g.N, g.K, 64, obid() - (ogrid() - 64), 0); else S.init(g.M, g.N, g.K, ogrid(), obid(), (which == 2 || which == 4) ? 1 : 0, which == 2 ? 4 : 8);
    pg8::gemm_phase<pg8::Epi, pg8::TailSplit, true, true>(lds, g, S, E, otid());
}
__global__ void __launch_bounds__(512, 2) fwd(Ctx carg) {
    CtxP c = (CtxP)((unsigned long long)__builtin_amdgcn_kernarg_segment_ptr() | (unsigned long long)__builtin_amdgcn_readfirstlane((int)(threadIdx.x >> 6)));
    extern __shared__ __attribute__((aligned(16))) unsigned char lds_raw[];
    LAS unsigned char* lds = (LAS unsigned char*)lds_raw;
    if (threadIdx.x < 4) ((LAS unsigned*)(lds + LDS_BAR))[threadIdx.x] = 0u;
    __syncthreads();
    const XcdBarrier bar = xcd_barrier_post((unsigned*)(((CtxP)((unsigned long long)c & ~7ull))->ws + WS_CTL), (volatile LAS unsigned*)(lds + LDS_BAR));
#define BAR() do { XcdBarrier b2_; b2_.bar = (unsigned*)(((CtxP)((unsigned long long)c & ~7ull))->ws + WS_CTL); b2_.st = bar.st; unsigned bx_ = bar.x; asm volatile("" : "+s"(bx_)); b2_.x = bx_; xcd_barrier(b2_, otid_cp(c) == 0); } while (0)
    ph_prep(c, lds, 0x3u | (0xfu << 19), 0, (int)gridDim.x, 1); ph_row2(c, 2, 0, 0, 0, 0); BAR();
    ph_row2(c, 1, 0, 0, 0, 0, 0, 0, (int)gridDim.x - 64); ph_gemm(c, 0, 0, lds); BAR();
    const bool upt = (gridDim.x == 256);
    for (int l = 0; l < 4; ++l) {
        if (l < 2) ph_skinny(c, l, lds);
        else if (l == 2) { ph_skinny(c, 2, lds); BAR(); ph_cumsum(c); }
        ph_gemm(c, 1, l, lds); BAR();
        if (l < 2) { ph_gdn_prep(c, l, lds); BAR(); ph_gdn_scan(c, l, lds);
            ph_prep(c, lds, (l == 0 ? (JOBS_L1 | (1u << 7) | (1u << 11) | (1u << 15)) : (JOBS_L2 | JOBS_L3)) & ~(upt ? (7u << 12) : 0u), 96, (int)gridDim.x - 96, 0);
            BAR(); ph_gdn_c(c, l); }
        if (l >= 2) { ph_attn_sample<true>(c, l, lds, 0, (int)gridDim.x); __syncthreads(); }
        ph_mem_prompt(c, l, (char*)lds_raw, 0, (int)gridDim.x); ph_attn_sample<false>(c, l, lds, 0, (int)gridDim.x);
        if (l >= 2) { __syncthreads(); ph_fox_prompt(c, l, (char*)lds_raw, lds); }
        BAR();
        ph_gemm(c, 2, l, lds); BAR();
        ph_row2(c, 0, 1, I_NMIXPOST, l, 0, l == 0); BAR();
        ph_gemm(c, 3, l, lds); if (upt && l < 3) ph_prep(c, lds, 1u << (12 + l), 128, 128, 0); BAR();
        ph_gemm(c, 4, l, lds); BAR();
        ph_row2(c, 0, 1, I_NMLPPOST, l, l == 3);
        if (l < 3) BAR();
    }
#undef BAR
}
extern "C" void kernel_launch(void* const* d_in, const int* in_sizes, int n_in, void* d_out, int out_size, void* d_ws, size_t ws_size, hipStream_t stream) {
    static int grid = 0;
    if (grid == 0) {
        if (n_in != 28 || (size_t)out_size != O_END || ws_size < WS_END2) { fprintf(stderr, "kernel_launch: unexpected shapes: n_in %d out %d ws %zu (need %zu)\n", n_in, out_size, ws_size, (size_t)WS_END2); grid = -1; return; }
        int dev = 0, cus = 0, per_cu = 0;
        if (hipGetDevice(&dev) != hipSuccess || hipDeviceGetAttribute(&cus, hipDeviceAttributeMultiprocessorCount, dev) != hipSuccess) { grid = -1; return; }
        if (hipFuncSetAttribute((const void*)fwd, hipFuncAttributeMaxDynamicSharedMemorySize, LDS_BYTES) != hipSuccess) { fprintf(stderr, "kernel_launch: hipFuncSetAttribute failed\n"); grid = -1; return; }
        if (hipOccupancyMaxActiveBlocksPerMultiprocessor(&per_cu, (const void*)fwd, 512, LDS_BYTES) != hipSuccess || per_cu < 1) { fprintf(stderr, "kernel_launch: occupancy query says %d blocks per CU\n", per_cu); grid = -1; return; }
        (void)hipGetLastError();
        grid = cus;
    }
    if (grid < 0) return;
    (void)hipMemsetAsync((char*)d_ws + WS_CTL, 0, CTL_ZERO_BYTES, stream);
    Ctx c{}; for (int i = 0; i < 28; ++i) c.in[i] = (const float*)d_in[i]; c.out = (float*)d_out; c.ws = (unsigned char*)d_ws; c.ph_lo = 0; c.ph_hi = 0;
    hipLaunchKernelGGL(fwd, dim3(grid), dim3(512), LDS_BYTES, stream, c);
}
```
